# Optimizing an MI355X kernel written in HIP

```python
import jax, jax.numpy as jnp
from jax import lax
import numpy as np

D_MODEL = 2048
BATCH = 8
SEQ = 2048
DEPTH = 1

CHUNK = 64
EPS = 1e-6
NEG_INF = -1e30

MIX_WIDTH = D_MODEL
POOL_WIDTH = D_MODEL // 2
POOL_WINDOWS = (2, 4, 8, 16)
POOL_GROUPS = len(POOL_WINDOWS)
POOL_GROUP_DIM = POOL_WIDTH // POOL_GROUPS
V_HEAD_DIM = 128
MLA_WIDTH = MIX_WIDTH - POOL_WIDTH
MLA_HEADS = MLA_WIDTH // V_HEAD_DIM
QK_NOPE_DIM = 128
QK_ROPE_DIM = 64
QK_HEAD_DIM = QK_NOPE_DIM + QK_ROPE_DIM
Q_LORA_RANK = 512
KV_LORA_RANK = 256
ROPE_THETA = 10000.0
IN_WIDTH = POOL_WIDTH + Q_LORA_RANK + KV_LORA_RANK + QK_ROPE_DIM
Q_BLOCK = 128

PEER_HEADS = 8
PEER_N_KEYS = 128
PEER_N_EXPERTS = PEER_N_KEYS * PEER_N_KEYS
PEER_QUERY_DIM = 256
PEER_HALF_DIM = PEER_QUERY_DIM // 2
PEER_TOPK = 16
PEER_TOKEN_BLOCK = 128

kernel_name = "hybrid_pool_mla_peer_block"


def rms_norm(x, g):
    xf = x.astype(jnp.float32)
    y = xf * lax.rsqrt(jnp.mean(xf * xf, axis=-1, keepdims=True) + EPS)
    return (y * g.astype(jnp.float32)).astype(x.dtype)


def modulate(h, shift, scale):
    return h * (1 + scale[:, None, :]) + shift[:, None, :]


def apply_rope(x, cos, sin):
    x1, x2 = jnp.split(x.astype(jnp.float32), 2, axis=-1)
    return jnp.concatenate([x1 * cos - x2 * sin, x2 * cos + x1 * sin], axis=-1).astype(x.dtype)


def multiscale_pool(u, w_pool, pool_scale):
    b, s, _ = u.shape
    ug = u.astype(jnp.float32).reshape(b, s, POOL_GROUPS, POOL_GROUP_DIM)
    cs0 = jnp.concatenate([jnp.zeros_like(ug[:, :1]), jnp.cumsum(ug, axis=1)], axis=1)
    t = jnp.arange(s)
    groups = []
    for g, w in enumerate(POOL_WINDOWS):
        c_g = cs0[:, :, g]
        lagged = jnp.pad(c_g[:, : s + 1 - w], ((0, 0), (w - 1, 0), (0, 0)))
        count = jnp.minimum(t + 1, w).astype(jnp.float32)[None, :, None]
        groups.append((c_g[:, 1:] - lagged) / count - ug[:, :, g])
    z = jnp.stack(groups, axis=2).astype(u.dtype)
    y = jnp.einsum('bsgc,gcd->bsgd', z, w_pool)
    return y.reshape(b, s, POOL_WIDTH) * pool_scale


def mla_attention(c_q, c_kv, k_pe, cos, sin, q_norm_g, w_uq, kv_norm_g, w_ukv):
    b, s, _ = c_q.shape
    q = (rms_norm(c_q, q_norm_g) @ w_uq).reshape(b, s, MLA_HEADS, QK_HEAD_DIM)
    q_nope = q[..., :QK_NOPE_DIM]
    q_pe = apply_rope(q[..., QK_NOPE_DIM:], cos[:, :, None, :], sin[:, :, None, :])
    kv = (rms_norm(c_kv, kv_norm_g) @ w_ukv).reshape(b, s, MLA_HEADS, QK_NOPE_DIM + V_HEAD_DIM)
    k_nope = kv[..., :QK_NOPE_DIM]
    v = kv[..., QK_NOPE_DIM:]
    k_pe = apply_rope(k_pe, cos, sin)
    scale = QK_HEAD_DIM ** -0.5
    chunk_id = jnp.arange(s) // CHUNK
    outs = []
    for i in range(s // Q_BLOCK):
        qs, qe = i * Q_BLOCK, (i + 1) * Q_BLOCK
        kend = qe
        sc = (jnp.einsum('bqhd,bkhd->bhqk', q_nope[:, qs:qe], k_nope[:, :kend])
              + jnp.einsum('bqhr,bkr->bhqk', q_pe[:, qs:qe], k_pe[:, :kend])).astype(jnp.float32) * scale
        mask = chunk_id[qs:qe, None] >= chunk_id[None, :kend]
        sc = jnp.where(mask[None, None], sc, NEG_INF)
        p = jax.nn.softmax(sc, axis=-1).astype(v.dtype)
        outs.append(jnp.einsum('bhqk,bkhd->bqhd', p, v[:, :kend]))
    return jnp.concatenate(outs, axis=1).reshape(b, s, MLA_WIDTH)


def peer_ffn(h, w_q, sub_keys, expert_u, expert_v):
    b, s, d = h.shape
    t = b * s
    hf = h.reshape(t, d)
    q = (hf @ w_q).reshape(t, PEER_HEADS, 2, PEER_HALF_DIM)
    sc = jnp.einsum('thpd,hpnd->thpn', q, sub_keys).astype(jnp.float32)
    sv, si = lax.top_k(sc, PEER_TOPK)
    cand = (sv[:, :, 0, :, None] + sv[:, :, 1, None, :]).reshape(t, PEER_HEADS, PEER_TOPK * PEER_TOPK)
    cidx = (si[:, :, 0, :, None] * PEER_N_KEYS + si[:, :, 1, None, :]).reshape(t, PEER_HEADS, PEER_TOPK * PEER_TOPK)
    best, pos = lax.top_k(cand, PEER_TOPK)
    eidx = jnp.take_along_axis(cidx, pos, axis=-1).reshape(t, PEER_HEADS * PEER_TOPK)
    gate = jax.nn.softmax(best, axis=-1).reshape(t, PEER_HEADS * PEER_TOPK)
    nb = t // PEER_TOKEN_BLOCK

    def block(args):
        xb, ib, gb = args
        u = jnp.take(expert_u, ib, axis=0)
        a = jnp.einsum('ted,td->te', u, xb).astype(jnp.float32)
        act = (jax.nn.gelu(a, approximate=False) * gb).astype(xb.dtype)
        vv = jnp.take(expert_v, ib, axis=0)
        return jnp.einsum('te,ted->td', act, vv)

    out = lax.map(block, (hf.reshape(nb, PEER_TOKEN_BLOCK, d),
                          eidx.reshape(nb, PEER_TOKEN_BLOCK, -1),
                          gate.reshape(nb, PEER_TOKEN_BLOCK, -1)))
    return out.reshape(b, s, d)


def setup_inputs(seed: int = 0) -> dict:
    key = jax.random.key(seed)
    ks = jax.random.split(key, 24)
    f32 = jnp.float32

    def nrm(k, shape, s):
        return jax.random.normal(k, shape, f32) * s

    def gain(k, shape):
        return 1.0 + 0.05 * jax.random.normal(k, shape, f32)

    x = jax.random.normal(ks[0], (BATCH, SEQ, D_MODEL), f32)
    c = jax.random.normal(ks[1], (BATCH, D_MODEL), f32)
    offset = jax.random.randint(ks[2], (BATCH, 1), 0, 64, dtype=jnp.int32) * CHUNK
    positions = (offset + jnp.arange(SEQ, dtype=jnp.int32)[None, :]).astype(jnp.int32)
    L = DEPTH
    return {
        "x": x,
        "c": c,
        "positions": positions,
        "ada_w": nrm(ks[3], (L, D_MODEL, 6 * D_MODEL), 0.5 * D_MODEL ** -0.5),
        "ada_b": nrm(ks[4], (L, 6 * D_MODEL), 0.02),
        "pre_mix_g": gain(ks[5], (L, D_MODEL)),
        "post_mix_g": gain(ks[6], (L, D_MODEL)),
        "pre_ffn_g": gain(ks[7], (L, D_MODEL)),
        "post_ffn_g": gain(ks[8], (L, D_MODEL)),
        "w_in": nrm(ks[9], (L, D_MODEL, IN_WIDTH), D_MODEL ** -0.5),
        "pool_w": nrm(ks[10], (L, POOL_GROUPS, POOL_GROUP_DIM, POOL_GROUP_DIM), POOL_GROUP_DIM ** -0.5),
        "pool_scale": 1.0 + 0.1 * jax.random.normal(ks[11], (L, POOL_WIDTH), f32),
        "q_norm_g": gain(ks[12], (L, Q_LORA_RANK)),
        "w_uq": nrm(ks[13], (L, Q_LORA_RANK, MLA_HEADS * QK_HEAD_DIM), Q_LORA_RANK ** -0.5),
        "kv_norm_g": gain(ks[14], (L, KV_LORA_RANK)),
        "w_ukv": nrm(ks[15], (L, KV_LORA_RANK, MLA_HEADS * (QK_NOPE_DIM + V_HEAD_DIM)), KV_LORA_RANK ** -0.5),
        "w_out": nrm(ks[16], (L, MIX_WIDTH, D_MODEL), MIX_WIDTH ** -0.5),
        "peer_wq": nrm(ks[17], (L, D_MODEL, PEER_HEADS * PEER_QUERY_DIM), D_MODEL ** -0.5),
        "peer_sub_keys": nrm(ks[18], (L, PEER_HEADS, 2, PEER_N_KEYS, PEER_HALF_DIM), PEER_HALF_DIM ** -0.5),
        "peer_u": nrm(ks[19], (L, PEER_N_EXPERTS, D_MODEL), D_MODEL ** -0.5),
        "peer_v": nrm(ks[20], (L, PEER_N_EXPERTS, D_MODEL), PEER_HEADS ** -0.5),
    }


def reference(x, c, positions, ada_w, ada_b, pre_mix_g, post_mix_g, pre_ffn_g, post_ffn_g,
              w_in, pool_w, pool_scale, q_norm_g, w_uq, kv_norm_g, w_ukv, w_out,
              peer_wq, peer_sub_keys, peer_u, peer_v):
    half = QK_ROPE_DIM // 2
    inv_freq = ROPE_THETA ** (-jnp.arange(half, dtype=jnp.float32) / half)
    ang = positions.astype(jnp.float32)[..., None] * inv_freq
    cos, sin = jnp.cos(ang), jnp.sin(ang)
    c_act = jax.nn.silu(c)
    for l in range(DEPTH):
        mod = c_act @ ada_w[l] + ada_b[l]
        shift1, scale1, gate1, shift2, scale2, gate2 = jnp.split(mod, 6, axis=-1)

        h = modulate(rms_norm(x, pre_mix_g[l]), shift1, scale1)
        proj = h @ w_in[l]
        o1 = POOL_WIDTH
        o2 = o1 + Q_LORA_RANK
        o3 = o2 + KV_LORA_RANK
        y_pool = multiscale_pool(proj[..., :o1], pool_w[l], pool_scale[l])
        y_mla = mla_attention(proj[..., o1:o2], proj[..., o2:o3], proj[..., o3:], cos, sin,
                              q_norm_g[l], w_uq[l], kv_norm_g[l], w_ukv[l])
        y = jnp.concatenate([y_pool, y_mla], axis=-1) @ w_out[l]
        x = x + gate1[:, None, :] * rms_norm(y, post_mix_g[l])

        h = modulate(rms_norm(x, pre_ffn_g[l]), shift2, scale2)
        y = peer_ffn(h, peer_wq[l], peer_sub_keys[l], peer_u[l], peer_v[l])
        x = x + gate2[:, None, :] * rms_norm(y, post_ffn_g[l])
    return x
```

```cpp
#include <hip/hip_runtime.h>
#include <hip/hip_bf16.h>
#include <stdint.h>
#include <stdio.h>

#ifndef MK_MULTI
#define MK_MULTI 0
#endif

typedef unsigned short bf16_t;
typedef short bf16x8 __attribute__((ext_vector_type(8)));
typedef float f32x4 __attribute__((ext_vector_type(4)));
typedef float f32x16 __attribute__((ext_vector_type(16)));
typedef unsigned u32x4 __attribute__((ext_vector_type(4)));
typedef int i32x4 __attribute__((ext_vector_type(4)));
template <bool I8> struct AccT { typedef f32x4 type; };
template <> struct AccT<true> { typedef i32x4 type; };
typedef unsigned u32x2 __attribute__((ext_vector_type(2)));
typedef _Float16 h2v __attribute__((ext_vector_type(2)));

constexpr int NTOK = 16384, DM = 2048, SEQ = 2048;
constexpr int NTHREADS = 512, NWAVES = 8;
constexpr int LDS_BYTES = 140 * 1024;
constexpr int XB_OFF = LDS_BYTES - 64;
constexpr float EPS = 1e-6f;

constexpr size_t MiB = 1024 * 1024;
constexpr size_t WS_ZERO   = 0;
constexpr size_t WS_BAR    = 0;
constexpr size_t WS_MOD    = 16384;
constexpr size_t ZERO_BYTES = 16384;
constexpr size_t WS_CS     = 1 * MiB;
constexpr size_t WS_RSTDQ  = 5 * MiB;
constexpr size_t WS_RSTDKV = 5 * MiB + 65536;
constexpr size_t WS_WIN    = 6 * MiB;
constexpr size_t WS_WOUT   = 14 * MiB;
constexpr size_t WS_WPQ    = 22 * MiB;
constexpr size_t WS_WUQ    = 30 * MiB;
constexpr size_t WS_WUKV   = 32 * MiB;
constexpr size_t WS_WPOOL  = 33 * MiB;
constexpr size_t WS_SK     = 34 * MiB;
constexpr size_t WS_U8     = 35 * MiB;
constexpr size_t WS_V8     = 67 * MiB;
constexpr size_t WS_H8     = 99 * MiB;
constexpr size_t WS_PACK   = 131 * MiB;
constexpr size_t WS_SU     = 139 * MiB;
constexpr size_t WS_SV     = 139 * MiB + 65536;
constexpr size_t WS_SH     = 139 * MiB + 131072;
constexpr size_t WS_SH1    = 139 * MiB + 196608;
constexpr size_t WS_CMAX   = 139 * MiB + 262144;
constexpr size_t WS_WSC    = 139 * MiB + 278528;
constexpr size_t CMAX_BYTES = 2 * 2048 * 4;
constexpr size_t WS_BUF1   = 163 * MiB;
constexpr size_t WS_BUF2   = 227 * MiB;
constexpr size_t WS_BIG    = 291 * MiB;
constexpr size_t WS_Z      = WS_BIG;
constexpr size_t WS_Q      = WS_BIG + 32 * MiB;
constexpr size_t WS_KN     = WS_BIG + 80 * MiB;
constexpr size_t WS_VT     = WS_BIG + 112 * MiB;
constexpr size_t WS_KPE    = WS_BIG + 144 * MiB;
constexpr size_t WS_X1     = WS_BIG;
constexpr size_t WS_IDX    = 438 * MiB;
constexpr size_t WS_GATE   = 446 * MiB;
constexpr size_t WS_PART   = WS_BUF1;
constexpr size_t WS_Y2     = WS_BUF2;
constexpr size_t WS_END    = 454 * MiB;

struct Params {
    const float *x, *c; const int* pos;
    const float *ada_w, *ada_b, *pre_mix_g, *post_mix_g, *pre_ffn_g, *post_ffn_g;
    const float *w_in, *pool_w, *pool_scale, *q_norm_g, *w_uq, *kv_norm_g, *w_ukv, *w_out;
    const float *peer_wq, *sub_keys, *peer_u, *peer_v;
    float* out; char* ws;
};

__device__ __forceinline__ unsigned pk2(float lo, float hi) {
    typedef __bf16 bf2 __attribute__((ext_vector_type(2)));
    bf2 v; v[0] = (__bf16)lo; v[1] = (__bf16)hi; return __builtin_bit_cast(unsigned, v);
}
__device__ __forceinline__ float bflo(unsigned u) { return __uint_as_float(u << 16); }
__device__ __forceinline__ float bfhi(unsigned u) { return __uint_as_float(u & 0xffff0000u); }
__device__ __forceinline__ float bf2f(short b) { return __uint_as_float(((unsigned)(unsigned short)b) << 16); }
__device__ __forceinline__ short f2bf(float f) { return (short)(pk2(f, 0.f) & 0xffffu); }
__device__ __forceinline__ unsigned pack_i8x4(float a, float b, float c, float d) {
    unsigned r = 0u;
    r = __builtin_amdgcn_cvt_pk_u8_f32(a + 128.f, 0, r); r = __builtin_amdgcn_cvt_pk_u8_f32(b + 128.f, 1, r);
    r = __builtin_amdgcn_cvt_pk_u8_f32(c + 128.f, 2, r); r = __builtin_amdgcn_cvt_pk_u8_f32(d + 128.f, 3, r);
    return r ^ 0x80808080u;
}
__device__ __forceinline__ float wave_sum(float v) {
#pragma unroll
    for (int o = 1; o < 64; o <<= 1) v += __shfl_xor(v, o);
    return v;
}

#define XB_TMO      128
#define XB_XCNT(j)  (256  + 64 * (j))
#define XB_XSUB(j)  (1280 + 64 * (j))
#define XB_XGEN(j)  (2304 + 64 * (j))
#define XB_TOP      3328
#define XB_TOPGEN   3392
#define XCD_BAR_WORDS 3456
#define XB_SPIN_CAP (1u << 20)
#define LAS __attribute__((address_space(3)))
__device__ __forceinline__ unsigned xb_ld(unsigned* p)              { return __hip_atomic_load(p, __ATOMIC_RELAXED, __HIP_MEMORY_SCOPE_AGENT); }
__device__ __forceinline__ unsigned xb_add(unsigned* p, unsigned v) { return __hip_atomic_fetch_add(p, v, __ATOMIC_RELAXED, __HIP_MEMORY_SCOPE_AGENT); }
__device__ __forceinline__ unsigned xb_xcc_id() { return (unsigned)__builtin_amdgcn_s_getreg((3 << 11) | 20) & 0xFu; }
#define XB_SPIN(cond, bar) do { unsigned _sp = 0; while (cond) { __builtin_amdgcn_s_sleep(1); \
    if ((++_sp & 255u) == 0u) { if (xb_ld(&(bar)[XB_TMO])) break; if (_sp > XB_SPIN_CAP) { atomicAdd(&(bar)[XB_TMO], 1u); break; } } } } while (0)
struct XcdBarrier { unsigned* bar; unsigned x; volatile LAS unsigned* st; };
__device__ __forceinline__ XcdBarrier xcd_barrier_post(unsigned* bar, volatile LAS unsigned* st) {
    XcdBarrier b; b.bar = bar; b.x = xb_xcc_id(); b.st = st;
    if (threadIdx.x == 0) (void)xb_add(&bar[XB_XCNT(b.x)], 1u);
    return b;
}
__device__ __forceinline__ void xcd_barrier_complete(unsigned* bar, unsigned x, unsigned& nloc, unsigned& nx) {
    const unsigned G = gridDim.x * gridDim.y * gridDim.z;
    unsigned sum, cnt, mine, sp = 0u;
    for (;;) {
        sum = 0u; cnt = 0u; mine = 0u;
#pragma unroll
        for (unsigned j = 0; j < 16; ++j) { const unsigned c = xb_ld(&bar[XB_XCNT(j)]); sum += c; cnt += (c > 0u) ? 1u : 0u; mine = (j == x) ? c : mine; }
        if (sum == G) break;
        __builtin_amdgcn_s_sleep(1);
        if ((++sp & 255u) == 0u) { if (xb_ld(&bar[XB_TMO])) break; if (sp > XB_SPIN_CAP) { atomicAdd(&bar[XB_TMO], 1u); break; } }
    }
    nloc = mine > 0u ? mine : 1u; nx = cnt > 0u ? cnt : 1u;
}
__device__ __forceinline__ void xcd_barrier(const XcdBarrier& b) {
    asm volatile("s_waitcnt vmcnt(0)" ::: "memory");
    __syncthreads();
    if (threadIdx.x == 0) {
        unsigned* bar = b.bar;
        __builtin_amdgcn_s_waitcnt(0);
        unsigned nloc = b.st[0], nx = b.st[1];
        if (nloc == 0u) { xcd_barrier_complete(bar, b.x, nloc, nx); b.st[0] = nloc; b.st[1] = nx; }
        const unsigned old = xb_add(&bar[XB_XSUB(b.x)], 1u);
        const unsigned gen = old / nloc;
        if (old + 1u == (gen + 1u) * nloc) {
            __builtin_amdgcn_fence(__ATOMIC_RELEASE, "agent");
            asm volatile("s_waitcnt vmcnt(0)" ::: "memory");
            const unsigned og = xb_add(&bar[XB_TOP], 1u);
            const unsigned tg = og / nx;
            if (og + 1u == (tg + 1u) * nx) xb_add(&bar[XB_TOPGEN], 1u);
            else XB_SPIN(xb_ld(&bar[XB_TOPGEN]) == tg, bar);
            __builtin_amdgcn_fence(__ATOMIC_ACQUIRE, "agent");
            xb_add(&bar[XB_XGEN(b.x)], 1u);
            asm volatile("s_waitcnt vmcnt(0)" ::: "memory");
        } else {
            XB_SPIN(xb_ld(&bar[XB_XGEN(b.x)]) == gen, bar);
            __builtin_amdgcn_fence(__ATOMIC_ACQUIRE, "agent");
            asm volatile("s_waitcnt vmcnt(0)" ::: "memory");
        }
    }
    __syncthreads();
}

constexpr int G_BK = 64, G_HALF = 128, G_HT = G_HALF * G_BK;
__device__ __forceinline__ int lds_byte(int r, int c) {
    int st = (r >> 4) * 2 + (c >> 5), rr = r & 15, cc = c & 31, ob = rr * 64 + cc * 2;
    return st * 1024 + (ob ^ (((ob >> 9) & 1) << 5));
}
__device__ __forceinline__ void stage_rc(int b, int& R, int& C) {
    int st = b / 1024, sb = b % 1024, swz = sb ^ (((sb >> 9) & 1) << 5);
    R = (st >> 1) * 16 + swz / 64; C = (st & 1) * 32 + (swz % 64) / 2;
}

template <bool NOSWAP, bool I8, class A_>
__device__ __forceinline__ A_ mma1(bf16x8 a, bf16x8 b, A_ c);
template <> __device__ __forceinline__ f32x4 mma1<false, false, f32x4>(bf16x8 a, bf16x8 b, f32x4 c) { return __builtin_amdgcn_mfma_f32_16x16x32_bf16(b, a, c, 0, 0, 0); }
template <> __device__ __forceinline__ f32x4 mma1<true, false, f32x4>(bf16x8 a, bf16x8 b, f32x4 c) { return __builtin_amdgcn_mfma_f32_16x16x32_bf16(a, b, c, 0, 0, 0); }
template <> __device__ __forceinline__ i32x4 mma1<false, true, i32x4>(bf16x8 a, bf16x8 b, i32x4 c) { return __builtin_amdgcn_mfma_i32_16x16x64_i8(__builtin_bit_cast(i32x4, b), __builtin_bit_cast(i32x4, a), c, 0, 0, 0); }
template <> __device__ __forceinline__ i32x4 mma1<true, true, i32x4>(bf16x8 a, bf16x8 b, i32x4 c) { return __builtin_amdgcn_mfma_i32_16x16x64_i8(__builtin_bit_cast(i32x4, a), __builtin_bit_cast(i32x4, b), c, 0, 0, 0); }

struct NextTile { const bf16_t* A; const bf16_t* Bt; int lda, ldb, brow, bcol; };
template <bool VT1, bool I8, class Epi>
__device__ __forceinline__ void gemm_tile(const bf16_t* __restrict__ A, int lda, const bf16_t* __restrict__ Bt, int ldb, int nt,
                                          int brow, int bcol, char* shmc, const Epi& epi, bool pre, const NextTile nx) {
    bf16_t* shm = (bf16_t*)shmc;
    asm volatile("" : "+s"(nt));
#define SA(b,h) (shm+((b)*2+(h))*G_HT)
#define SB(b,h) (shm+(4+(b)*2+(h))*G_HT)
#define STAGE_X(OFF,LOFF,P,BASE,LD,br,kt) do{ const bf16_t* _gb=(BASE)+(long)(br)*(LD)+(long)(kt)*G_BK; \
    __builtin_amdgcn_global_load_lds((const unsigned*)(_gb+(OFF)), (unsigned*)((char*)(P)+(LOFF)),16,0,0); \
    __builtin_amdgcn_global_load_lds((const unsigned*)(_gb+64*(LD)+(OFF)), (unsigned*)((char*)(P)+(LOFF)+8192),16,0,0);}while(0)
#define STAGE_A(P,br,kt) STAGE_X(offA,loff,P,A,lda,br,kt)
#define STAGE_B(P,br,kt) STAGE_X(offB,loff,P,Bt,ldb,br,kt)
#define LDA(dst,b,h) _Pragma("unroll") for(int m=0;m<4;++m) _Pragma("unroll") for(int k=0;k<2;++k) \
    dst[m][k]=*reinterpret_cast<const bf16x8*>((char*)SA(b,h)+lds_byte(wr*64+m*16+fr,k*32+fq*8))
#define LDB(dst,b,h) _Pragma("unroll") for(int n=0;n<2;++n) _Pragma("unroll") for(int k=0;k<2;++k) \
    dst[n][k]=*reinterpret_cast<const bf16x8*>((char*)SB(b,h)+lds_byte(wc*32+n*16+fr,k*32+fq*8))
#define MMA(ai,bj,At_,Bt_) do{__builtin_amdgcn_s_setprio(1); \
    _Pragma("unroll") for(int m=0;m<4;++m) _Pragma("unroll") for(int n=0;n<2;++n) _Pragma("unroll") for(int k=0;k<2;++k) \
      acc[ai][bj][m][n]=mma1<VT1 && (bj)==1, I8, typename AccT<I8>::type>(At_[m][k],Bt_[n][k],acc[ai][bj][m][n]); \
    __builtin_amdgcn_s_setprio(0);}while(0)
#define WAIT_V(n) asm volatile("s_waitcnt vmcnt(" #n ")":::"memory")
#define WAIT_L(n) asm volatile("s_waitcnt lgkmcnt(" #n ")":::"memory")
#define BAR __builtin_amdgcn_s_barrier()
#define SCHED __builtin_amdgcn_sched_barrier(0)
    int t0 = threadIdx.x; asm volatile("" : "+v"(t0));
    int wid = t0 >> 6, lane = t0 & 63, wr = wid >> 2, wc = wid & 3, fr = lane & 15, fq = lane >> 4;
    typename AccT<I8>::type acc[2][2][4][2] = {};
    bf16x8 At[4][2], B0[2][2], B1[2][2];
    int loff = t0 * 16;
    unsigned offA, offB;
    { int r_, c_; stage_rc(loff, r_, c_); offA = (unsigned)(r_ * lda + c_);
      const int i_ = r_ & 15, n_ = (r_ >> 4) & 1;
      offB = (unsigned)(((r_ & ~31) + 8 * (i_ >> 2) + 4 * n_ + (i_ & 3)) * ldb + c_); }
    if (!pre) {
        STAGE_B(SB(0,0),bcol,0); STAGE_A(SA(0,0),brow,0);
        STAGE_B(SB(0,1),bcol+G_HALF,0); STAGE_A(SA(0,1),brow+G_HALF,0);
        if (wr == 1) BAR;
        WAIT_V(4); BAR;
        STAGE_B(SB(1,0),bcol,1); STAGE_A(SA(1,0),brow,1); STAGE_B(SB(1,1),bcol+G_HALF,1);
        WAIT_V(6); BAR;
    } else {
        if (wr == 1) BAR;
        WAIT_V(4); BAR;
        BAR;
    }
    for (int t = 0; t < nt - 2; t += 2) {
        LDB(B0,0,0); SCHED; LDA(At,0,0); STAGE_A(SA(1,1),brow+G_HALF,t+1);
        WAIT_L(8); BAR; WAIT_L(0); MMA(0,0,At,B0); BAR; SCHED;
        LDB(B1,0,1); STAGE_B(SB(0,0),bcol,t+2);
        BAR; WAIT_L(0); MMA(0,1,At,B1); BAR;
        LDA(At,0,1); STAGE_A(SA(0,0),brow,t+2);
        BAR; WAIT_L(0); MMA(1,0,At,B0); BAR; SCHED;
        STAGE_B(SB(0,1),bcol+G_HALF,t+2);
        WAIT_V(6); BAR; MMA(1,1,At,B1); BAR;
        LDB(B0,1,0); SCHED; LDA(At,1,0); STAGE_A(SA(0,1),brow+G_HALF,t+2);
        WAIT_L(8); BAR; WAIT_L(0); MMA(0,0,At,B0); BAR; SCHED;
        LDB(B1,1,1); STAGE_B(SB(1,0),bcol,t+3);
        BAR; WAIT_L(0); MMA(0,1,At,B1); BAR;
        LDA(At,1,1); STAGE_A(SA(1,0),brow,t+3);
        BAR; WAIT_L(0); MMA(1,0,At,B0); BAR; SCHED;
        STAGE_B(SB(1,1),bcol+G_HALF,t+3);
        WAIT_V(6); BAR; MMA(1,1,At,B1); BAR;
    }
    int tz = threadIdx.x; asm volatile("" : "+v"(tz)); wid = tz >> 6; lane = tz & 63; wr = wid >> 2; wc = wid & 3; fr = lane & 15; fq = lane >> 4;
    loff = tz * 16;
    { int r_, c_; stage_rc(loff, r_, c_); offA = (unsigned)(r_ * lda + c_); }
    { LDB(B0,0,0); WAIT_V(0); LDA(At,0,0); STAGE_A(SA(1,1),brow+G_HALF,nt-1);
      BAR; WAIT_L(0); MMA(0,0,At,B0); BAR;
      LDB(B1,0,1); BAR; WAIT_L(0); MMA(0,1,At,B1); BAR;
      LDA(At,0,1); WAIT_V(4); BAR; WAIT_L(0); MMA(1,0,At,B0); MMA(1,1,At,B1); BAR; }
    { LDB(B0,1,0); LDA(At,1,0); WAIT_V(2); BAR; WAIT_L(0); MMA(0,0,At,B0); BAR;
      LDB(B1,1,1); WAIT_V(0); BAR; WAIT_L(0); MMA(0,1,At,B1); BAR;
      LDA(At,1,1); BAR; WAIT_L(0); MMA(1,0,At,B0); MMA(1,1,At,B1); BAR; }
    if (wr == 0) BAR;
    if (nx.brow >= 0) {
        int r_, c_; stage_rc(loff, r_, c_);
        const int i_ = r_ & 15, n_ = (r_ >> 4) & 1;
        const unsigned offA2 = (unsigned)(r_ * nx.lda + c_);
        const unsigned offB2 = (unsigned)(((r_ & ~31) + 8 * (i_ >> 2) + 4 * n_ + (i_ & 3)) * nx.ldb + c_);
#define NXT_A(P,h,k) STAGE_X(offA2,loff,P,nx.A,nx.lda,nx.brow+(h),k)
#define NXT_B(P,h,k) STAGE_X(offB2,loff,P,nx.Bt,nx.ldb,nx.bcol+(h),k)
        NXT_B(SB(0,0),0,0); NXT_A(SA(0,0),0,0); NXT_B(SB(0,1),G_HALF,0); NXT_A(SA(0,1),G_HALF,0);
        NXT_B(SB(1,0),0,1); NXT_A(SA(1,0),0,1); NXT_B(SB(1,1),G_HALF,1);
#undef NXT_A
#undef NXT_B
    }
#pragma unroll
    for (int ai = 0; ai < 2; ++ai)
#pragma unroll
    for (int m = 0; m < 4; ++m) {
#pragma unroll
        for (int bj = 0; bj < 2; ++bj) {
            if (VT1 && bj == 1) {
#pragma unroll
                for (int n = 0; n < 2; ++n)
                    epi.storeT(brow + ai * G_HALF + wr * 64 + m * 16 + fq * 4, bcol + bj * G_HALF + wc * 32 + 8 * (fr >> 2) + 4 * n + (fr & 3), fq, acc[ai][bj][m][n]);
            } else {
                epi.store8(brow + ai * G_HALF + wr * 64 + m * 16 + fr, bcol + bj * G_HALF + wc * 32 + fq * 8, acc[ai][bj][m][0], acc[ai][bj][m][1]);
            }
        }
        asm volatile("" ::: "memory");
    }
    __syncthreads();
#undef SA
#undef SB
#undef STAGE_X
#undef STAGE_A
#undef STAGE_B
#undef LDA
#undef LDB
#undef MMA
#undef WAIT_V
#undef WAIT_L
#undef BAR
#undef SCHED
}

typedef int i32x8 __attribute__((ext_vector_type(8)));
__device__ __forceinline__ int pk_fp8x4(float a, float b, float c, float d) {
    int w = __builtin_amdgcn_cvt_pk_fp8_f32(a, b, 0, false);
    return __builtin_amdgcn_cvt_pk_fp8_f32(c, d, w, true);
}
__device__ __forceinline__ void st4bf(bf16_t* p, f32x4 v) {
    u32x2 o; o.x = pk2(v[0], v[1]); o.y = pk2(v[2], v[3]); *reinterpret_cast<u32x2*>(p) = o;
}
__device__ __forceinline__ void st8bf(bf16_t* p, f32x4 a, f32x4 b) {
    u32x4 o; o.x = pk2(a[0], a[1]); o.y = pk2(a[2], a[3]); o.z = pk2(b[0], b[1]); o.w = pk2(b[2], b[3]); *reinterpret_cast<u32x4*>(p) = o;
}
struct EpiBf16 {
    bf16_t* C; int ldc;
    __device__ __forceinline__ void store8(int row, int col, f32x4 a, f32x4 b) const { st8bf(C + (size_t)row * ldc + col, a, b); }
    __device__ __forceinline__ void storeT(int, int, int, f32x4) const {}
};
struct EpiI8 {
    bf16_t* C; int ldc; const float* rs; const float* cs;
    __device__ __forceinline__ void store8(int row, int col, i32x4 a, i32x4 b) const {
        const float r = rs[row];
        const f32x4 c0 = *reinterpret_cast<const f32x4*>(cs + col), c1 = *reinterpret_cast<const f32x4*>(cs + col + 4);
        f32x4 fa = {(float)a[0], (float)a[1], (float)a[2], (float)a[3]}, fb = {(float)b[0], (float)b[1], (float)b[2], (float)b[3]};
        st8bf(C + (size_t)row * ldc + col, fa * c0 * r, fb * c1 * r);
    }
    __device__ __forceinline__ void storeT(int, int, int, i32x4) const {}
};
struct EpiPool {
    bf16_t* C; const float* scale; int gcol0;
    __device__ __forceinline__ void store8(int row, int col, f32x4 a, f32x4 b) const {
        f32x4 s0 = *reinterpret_cast<const f32x4*>(scale + gcol0 + col), s1 = *reinterpret_cast<const f32x4*>(scale + gcol0 + col + 4);
        st8bf(C + (size_t)row * DM + gcol0 + col, a * s0, b * s1);
    }
    __device__ __forceinline__ void storeT(int, int, int, f32x4) const {}
};
struct EpiQ {
    bf16_t* C; const float* rstd;
    __device__ __forceinline__ void store8(int row, int col, f32x4 a, f32x4 b) const {
        float s = rstd[row] * (0.07216878364870322f * 1.4426950408889634f);
        st8bf(C + (size_t)row * 1536 + col, a * s, b * s);
    }
    __device__ __forceinline__ void storeT(int, int, int, f32x4) const {}
};
struct EpiKV {
    bf16_t* Kn; bf16_t* Vt; const float* rstd;
    __device__ __forceinline__ void store8(int row, int col, f32x4 a, f32x4 b) const {
        int head = col >> 8, d = col & 127; float r = rstd[row];
        u32x2 w = {(unsigned)pk_fp8x4(a[0] * r, a[1] * r, a[2] * r, a[3] * r), (unsigned)pk_fp8x4(b[0] * r, b[1] * r, b[2] * r, b[3] * r)};
        *reinterpret_cast<u32x2*>((char*)Kn + (size_t)row * 1024 + head * 128 + d) = w;
    }
    __device__ __forceinline__ void storeT(int row0, int col, int fq, f32x4 v) const {
        int head = col >> 8, d = col & 127, b = row0 >> 11, s = row0 & 2047;
        f32x4 r = *reinterpret_cast<const f32x4*>(rstd + row0);
        const int kk = s & 63;
        const int pos = (s & ~63) + 32 * ((kk >> 2) & 1) + 16 * (kk >> 5) + 4 * ((kk & 31) >> 3);
        *reinterpret_cast<int*>((char*)Vt + ((size_t)((b * 8 + head) * 128 + d)) * SEQ + pos) = pk_fp8x4(v[0] * r[0], v[1] * r[1], v[2] * r[2], v[3] * r[3]);
    }
};

__device__ __forceinline__ int vcu_of(int bid, int nb) { return (nb % 8 == 0) ? (bid % 8) * (nb / 8) + bid / 8 : bid; }

__device__ __forceinline__ void xpose_item(const float* __restrict__ W, int K, int N, bf16_t* __restrict__ WT, int ldt, float* scr, int item, int lane,
                                           const float* __restrict__ rowscale) {
    const int nblk = N / 32, kb = item / nblk, nb = item % nblk, k0 = 64 * kb, n0 = 32 * nb;
#pragma unroll 8
    for (int i = 0; i < 32; ++i) {
        const int kk = 2 * i + (lane >> 5);
        float w = W[(size_t)(k0 + kk) * N + n0 + (lane & 31)];
        if (rowscale) w *= rowscale[k0 + kk];
        scr[kk * 33 + (lane & 31)] = w;
    }
    __builtin_amdgcn_s_waitcnt(0xc07f); asm volatile("" ::: "memory");
    const int c = lane & 7;
#pragma unroll
    for (int j = 0; j < 4; ++j) {
        const int n = (lane >> 3) + 8 * j; const float* s = scr + (8 * c) * 33 + n;
        u32x4 o; o.x = pk2(s[0 * 33], s[1 * 33]); o.y = pk2(s[2 * 33], s[3 * 33]); o.z = pk2(s[4 * 33], s[5 * 33]); o.w = pk2(s[6 * 33], s[7 * 33]);
        *reinterpret_cast<u32x4*>(WT + (size_t)(n0 + n) * ldt + k0 + 8 * c) = o;
    }
    __builtin_amdgcn_s_waitcnt(0xc07f); asm volatile("" ::: "memory");
}
__device__ __forceinline__ void xpose8_item(const float* __restrict__ W, int N, char* __restrict__ WT8, float* scr, int item, int lane,
                                            const unsigned* __restrict__ cmax, float* __restrict__ wsc) {
    const int nblk = N / 32, kb = item / nblk, nb = item % nblk, k0 = 64 * kb, n0 = 32 * nb;
    const float cm = __uint_as_float(cmax[n0 + (lane & 31)]);
    const float qm = cm > 0.f ? 127.f / cm : 0.f;
    if (kb == 0 && lane < 32) wsc[n0 + lane] = cm * (1.f / 127.f);
#pragma unroll 8
    for (int i = 0; i < 32; ++i) {
        const int kk = 2 * i + (lane >> 5);
        scr[kk * 33 + (lane & 31)] = W[(size_t)(k0 + kk) * N + n0 + (lane & 31)] * qm;
    }
    __builtin_amdgcn_s_waitcnt(0xc07f); asm volatile("" ::: "memory");
    const int c = lane & 7;
#pragma unroll
    for (int j = 0; j < 4; ++j) {
        const int n = (lane >> 3) + 8 * j; const float* s = scr + (8 * c) * 33 + n;
        u32x2 o;
        o.x = pack_i8x4(s[0 * 33], s[1 * 33], s[2 * 33], s[3 * 33]); o.y = pack_i8x4(s[4 * 33], s[5 * 33], s[6 * 33], s[7 * 33]);
        *reinterpret_cast<u32x2*>(WT8 + (size_t)(n0 + n) * 2048 + k0 + 8 * c) = o;
    }
    __builtin_amdgcn_s_waitcnt(0xc07f); asm volatile("" ::: "memory");
}
__device__ __forceinline__ void cvt_bf16_range(const float* __restrict__ src, bf16_t* __restrict__ dst, size_t n8, size_t gtid, size_t gthreads) {
    for (size_t i = gtid; i < n8; i += gthreads) {
        f32x4 a = *reinterpret_cast<const f32x4*>(src + i * 8), b = *reinterpret_cast<const f32x4*>(src + i * 8 + 4);
        u32x4 o; o.x = pk2(a[0], a[1]); o.y = pk2(a[2], a[3]); o.z = pk2(b[0], b[1]); o.w = pk2(b[2], b[3]);
        *reinterpret_cast<u32x4*>(dst + i * 8) = o;
    }
}
__device__ __forceinline__ void phase0(const Params& p, char* shm, int bid, int nb) {
    const int tid = threadIdx.x, wave = tid >> 6, lane = tid & 63;
    char* ws = p.ws;
#ifndef DUP_P0
#define DUP_P0 (-1)
#endif
    for (int rp_ = 0; rp_ < (DUP_P0 == 0 ? 2 : 1); ++rp_)
    {
        float* sl = (float*)shm;
        float* red = (float*)(shm + 65536);
        float* mod = (float*)(ws + WS_MOD);
        if (bid < 192 || nb != 256) {
            for (int i = tid; i < 8 * DM; i += NTHREADS) { float cv = p.c[i]; sl[i] = cv / (1.f + __expf(-cv)); }
            __syncthreads();
            for (int it = bid; it < 192; it += nb) {
                const int col = it * 64 + lane;
                float acc[8];
#pragma unroll
                for (int b = 0; b < 8; ++b) acc[b] = 0.f;
                const float* wp = p.ada_w + (size_t)(wave * 256) * 12288 + col;
                const float* sp = sl + wave * 256;
#pragma unroll 1
                for (int r0 = 0; r0 < 256; r0 += 32) {
                    float w[32];
#pragma unroll
                    for (int i = 0; i < 32; ++i) w[i] = wp[(size_t)(r0 + i) * 12288];
#pragma unroll
                    for (int q = 0; q < 8; ++q)
#pragma unroll
                        for (int b = 0; b < 8; ++b) {
                            const f32x4 s4 = *reinterpret_cast<const f32x4*>(sp + b * DM + r0 + 4 * q);
                            acc[b] += w[4 * q] * s4[0] + w[4 * q + 1] * s4[1] + w[4 * q + 2] * s4[2] + w[4 * q + 3] * s4[3];
                        }
                }
#pragma unroll
                for (int b = 0; b < 8; ++b) red[(wave * 8 + b) * 64 + lane] = acc[b];
                __syncthreads();
                {
                    const int b = tid >> 6, cl = tid & 63;
                    float sum = 0.f;
#pragma unroll
                    for (int w = 0; w < 8; ++w) sum += red[(w * 8 + b) * 64 + cl];
                    mod[b * 12288 + it * 64 + cl] = sum + p.ada_b[it * 64 + cl];
                }
                __syncthreads();
            }
        }
    }
    const int gw = bid * NWAVES + wave, ngw = nb * NWAVES;
    const size_t gtid = (size_t)bid * NTHREADS + tid, gthreads = (size_t)nb * NTHREADS;
    for (int rp_ = 0; rp_ < (DUP_P0 == 1 ? 2 : 1); ++rp_)
    {
        float* scr = (float*)(shm + wave * 8448);
        constexpr int I_POOL = 4 * 4 * 8, I_UQ = 8 * 48, I_UKV = 4 * 64, I_OUT = 32 * 64;
        constexpr int NIT = I_POOL + I_UQ + I_UKV + I_OUT;
        for (int it = gw; it < NIT; it += ngw) {
            int r = it;
            if (r < I_POOL) { int g = r / 32; xpose_item(p.pool_w + g * 65536, 256, 256, (bf16_t*)(ws + WS_WPOOL) + g * 65536, 256, scr, r % 32, lane, nullptr); continue; } r -= I_POOL;
            if (r < I_UQ) { xpose_item(p.w_uq, 512, 1536, (bf16_t*)(ws + WS_WUQ), 512, scr, r, lane, p.q_norm_g); continue; } r -= I_UQ;
            if (r < I_UKV) { xpose_item(p.w_ukv, 256, 2048, (bf16_t*)(ws + WS_WUKV), 256, scr, r, lane, p.kv_norm_g); continue; } r -= I_UKV;
            xpose_item(p.w_out, 2048, 2048, (bf16_t*)(ws + WS_WOUT), 2048, scr, r, lane, nullptr);
        }
        unsigned* cmax = (unsigned*)(ws + WS_CMAX);
        for (int it = gw; it < (29 + 32) * 16; it += ngw) {
            const int strip = it >> 4, kc = it & 15;
            const bool isq = strip >= 29;
            const int n = (isq ? strip - 29 : strip) * 64 + lane, N = isq ? 2048 : 1856;
            const float* wp = (isq ? p.peer_wq : p.w_in) + (size_t)(kc * 128) * N + n;
            float m = 0.f;
#pragma unroll 32
            for (int r = 0; r < 128; ++r) m = fmaxf(m, fabsf(wp[(size_t)r * N]));
            atomicMax(cmax + (isq ? 2048 : 0) + n, __float_as_uint(m));
        }
    }
    cvt_bf16_range(p.sub_keys, (bf16_t*)(ws + WS_SK), 262144 / 8, gtid, gthreads);
    for (int rp_ = 0; rp_ < (DUP_P0 == 2 ? 2 : 1); ++rp_)
    {
        float* tile = (float*)shm;
        float* redm = (float*)(shm + 16 * 2052 * 4);
        float* scl = redm + 128;
        int ntl, tfirst, tstep;
        if (nb == 256) { if (bid < 192) { ntl = 7; tfirst = bid * 7; } else { ntl = 11; tfirst = 192 * 7 + (bid - 192) * 11; } tstep = 1; }
        else { ntl = (2048 - bid + nb - 1) / nb; tfirst = bid; tstep = nb; }
#define Q_LOAD(dst, i_) do { const int itl_ = tfirst + (i_) * tstep; \
            const float* src_ = ((itl_ >> 10) ? p.peer_v : p.peer_u) + (size_t)((itl_ & 1023) * 16) * DM; \
            _Pragma("unroll") for (int k = 0; k < 16; ++k) dst[k] = *reinterpret_cast<const f32x4*>(reinterpret_cast<const char*>(src_ + (size_t)k * DM) + qoff); } while (0)
#define Q_TILE(vs, i_) do { \
            const int it = tfirst + (i_) * tstep; \
            const int isv = it >> 10, e0 = (it & 1023) * 16; \
            float mx[16]; \
            _Pragma("unroll") for (int k = 0; k < 16; ++k) { \
                *reinterpret_cast<f32x4*>(tile + k * 2052 + tid * 4) = vs[k]; \
                mx[k] = fmaxf(fmaxf(fabsf(vs[k][0]), fabsf(vs[k][1])), fmaxf(fabsf(vs[k][2]), fabsf(vs[k][3]))); \
            } \
            if ((i_) + 1 < ntl) Q_LOAD(vs, (i_) + 1); \
            _Pragma("unroll") for (int k = 0; k < 16; ++k) { \
                _Pragma("unroll") for (int o = 1; o < 64; o <<= 1) mx[k] = fmaxf(mx[k], __shfl_xor(mx[k], o)); \
            } \
            if (lane == 0) { _Pragma("unroll") for (int k = 0; k < 16; ++k) redm[wave * 16 + k] = mx[k]; } \
            __syncthreads(); \
            if (tid < 16) { \
                float m = 0.f; \
                _Pragma("unroll") for (int w = 0; w < 8; ++w) m = fmaxf(m, redm[w * 16 + tid]); \
                const float top = isv ? 256.f : 127.f; \
                scl[tid] = m > 0.f ? top / m : 0.f; \
                ((float*)(ws + (isv ? WS_SV : WS_SU)))[e0 + tid] = m / top; \
            } \
            __syncthreads(); \
            char* dst = ws + (isv ? WS_V8 : WS_U8); \
            _Pragma("unroll") for (int k = 0; k < 8; ++k) { \
                const int item = tid + k * NTHREADS, e = item & 15, sl = item >> 4; \
                const float* tp = tile + e * 2052 + sl * 8; \
                f32x4 a = *reinterpret_cast<const f32x4*>(tp), c = *reinterpret_cast<const f32x4*>(tp + 4); \
                const float m = scl[e]; \
                u32x2 o; \
                if (isv) { \
                    int w0 = __builtin_amdgcn_cvt_pk_fp8_f32(a[0] * m, a[1] * m, 0, false); \
                    w0 = __builtin_amdgcn_cvt_pk_fp8_f32(a[2] * m, a[3] * m, w0, true); \
                    int w1 = __builtin_amdgcn_cvt_pk_fp8_f32(c[0] * m, c[1] * m, 0, false); \
                    w1 = __builtin_amdgcn_cvt_pk_fp8_f32(c[2] * m, c[3] * m, w1, true); \
                    o.x = (unsigned)w0; o.y = (unsigned)w1; \
                } else { \
                    o.x = pack_i8x4(a[0] * m, a[1] * m, a[2] * m, a[3] * m); o.y = pack_i8x4(c[0] * m, c[1] * m, c[2] * m, c[3] * m); \
                } \
                *reinterpret_cast<u32x2*>(dst + ((size_t)sl * 16384 + e0 + e) * 8) = o; \
                if (k & 1) __builtin_amdgcn_sched_barrier(0); \
            } \
            __syncthreads(); } while (0)
        f32x4 va[16];
        const unsigned qoff = (unsigned)tid * 16u;
        Q_LOAD(va, 0);
        __syncthreads();
#pragma unroll 1
        for (int i = 0; i < ntl; ++i) Q_TILE(va, i);
#undef Q_LOAD
#undef Q_TILE
    }
    {
        float2* cs = (float2*)(ws + WS_CS);
        for (size_t i = gtid; i < (size_t)NTOK * 32; i += gthreads) {
            int t = (int)(i >> 5), k = (int)(i & 31);
            float invf = exp2f(-(float)k * (13.287712379549449f / 32.f));
            float ang = (float)p.pos[t] * invf;
            double sd, cd; sincos((double)ang, &sd, &cd);
            cs[i] = make_float2((float)cd, (float)sd);
        }
    }
}

__device__ __forceinline__ void phase1(const Params& p, char* shm, int bid, int nb) {
    const int tid = threadIdx.x, wave = tid >> 6, lane = tid & 63;
    const float* mod = (const float*)(p.ws + WS_MOD);
    char* h1 = p.ws + WS_BUF1;
    float* sh1 = (float*)(p.ws + WS_SH1);
    float* lv = (float*)shm;
    for (int item = bid; item < NTOK / 64; item += nb) {
        const int b = item >> 5;
        __syncthreads();
        for (int i = tid; i < 512; i += NTHREADS) {
            *reinterpret_cast<f32x4*>(lv + 0 * DM + i * 4) = *reinterpret_cast<const f32x4*>(p.pre_mix_g + i * 4);
            *reinterpret_cast<f32x4*>(lv + 1 * DM + i * 4) = *reinterpret_cast<const f32x4*>(mod + b * 12288 + i * 4);
            *reinterpret_cast<f32x4*>(lv + 2 * DM + i * 4) = *reinterpret_cast<const f32x4*>(mod + b * 12288 + 2048 + i * 4);
        }
        __syncthreads();
#pragma unroll 1
        for (int rr = 0; rr < 8; ++rr) {
            const int row = item * 64 + rr * 8 + wave;
            const float* xr = p.x + (size_t)row * DM + lane * 4;
            f32x4 v[8]; float ss = 0.f;
#pragma unroll
            for (int i = 0; i < 8; ++i) { v[i] = *reinterpret_cast<const f32x4*>(xr + i * 256); ss += v[i][0] * v[i][0] + v[i][1] * v[i][1] + v[i][2] * v[i][2] + v[i][3] * v[i][3]; }
            const float rstd = rsqrtf(wave_sum(ss) * (1.f / DM) + EPS);
            float hmax = 0.f;
#pragma unroll
            for (int i = 0; i < 8; ++i) {
                const int col = i * 256 + lane * 4;
                f32x4 g = *reinterpret_cast<const f32x4*>(lv + col);
                f32x4 sh = *reinterpret_cast<const f32x4*>(lv + DM + col);
                f32x4 sc = *reinterpret_cast<const f32x4*>(lv + 2 * DM + col);
                v[i] = v[i] * rstd * g * (sc + 1.f) + sh;
                hmax = fmaxf(hmax, fmaxf(fmaxf(fabsf(v[i][0]), fabsf(v[i][1])), fmaxf(fabsf(v[i][2]), fabsf(v[i][3]))));
            }
#pragma unroll
            for (int o = 1; o < 64; o <<= 1) hmax = fmaxf(hmax, __shfl_xor(hmax, o));
            const float qm = hmax > 0.f ? 127.f / hmax : 0.f;
            if (lane == 0) sh1[row] = hmax * (1.f / 127.f);
#pragma unroll
            for (int i = 0; i < 8; ++i) {
                *reinterpret_cast<unsigned*>(h1 + (size_t)row * DM + i * 256 + lane * 4) = pack_i8x4(v[i][0] * qm, v[i][1] * qm, v[i][2] * qm, v[i][3] * qm);
            }
        }
    }
    {
        __syncthreads();
        float* scr = (float*)(shm + wave * 8448);
        const unsigned* cmax = (const unsigned*)(p.ws + WS_CMAX);
        float* wsc = (float*)(p.ws + WS_WSC);
        const int gw = bid * NWAVES + wave, ngw = nb * NWAVES;
        constexpr int I_IN = 32 * 58, I_PQ = 32 * 64;
        for (int it = gw; it < I_IN + I_PQ; it += ngw) {
            if (it < I_IN) xpose8_item(p.w_in, 1856, p.ws + WS_WIN, scr, it, lane, cmax, wsc);
            else xpose8_item(p.peer_wq, 2048, p.ws + WS_WPQ, scr, it - I_IN, lane, cmax + 2048, wsc + 2048);
        }
        const size_t gtid = (size_t)bid * NTHREADS + tid, gthreads = (size_t)nb * NTHREADS;
        for (size_t i = gtid; i < 24576; i += gthreads) *reinterpret_cast<u32x4*>(p.ws + WS_WIN + (size_t)1856 * 2048 + i * 16) = u32x4{0u, 0u, 0u, 0u};
        for (size_t i = gtid; i < 192; i += gthreads) wsc[1856 + i] = 0.f;
        __syncthreads();
    }
}

template <bool VT1, bool I8, class Epi>
__device__ __forceinline__ void gemm_phase(const bf16_t* A, int lda, const bf16_t* Bt, int ldb, int K, int nN, int ntiles, int tile0, int vcu, int nb,
                                           char* shm, const Epi& epi) {
    int first = ((vcu - tile0) % nb + nb) % nb;
    bool pre = false;
    for (int t = first; t < ntiles; t += nb) {
        const int pm = t / nN, pn = t % nN;
        const int tn = t + nb;
        const bool has = tn < ntiles;
        const NextTile nx{A, Bt, lda, ldb, has ? (tn / nN) * 256 : -1, (tn % nN) * 256};
        gemm_tile<VT1, I8>(A, lda, Bt, ldb, K / 64, pm * 256, pn * 256, shm, epi, pre, nx);
        pre = has;
    }
}

__device__ __forceinline__ void phase3(const Params& p, int bid, int nb) {
    const int tid = threadIdx.x, wave = tid >> 6, lane = tid & 63;
    const bf16_t* proj = (const bf16_t*)(p.ws + WS_BUF2);
    bf16_t* z = (bf16_t*)(p.ws + WS_Z);
    for (int it = bid * NTHREADS + tid; it < 1024 * 128; it += nb * NTHREADS) {
        const int strip = it >> 7, c8 = it & 127, g = c8 >> 5, w = 2 << g;
        const int t0 = strip * 16, s0 = t0 & 2047;
        const bf16_t* up = proj + (size_t)t0 * DM + c8 * 8;
        float sum[8];
#pragma unroll
        for (int j = 0; j < 8; ++j) sum[j] = 0.f;
        for (int i = 1; i <= w; ++i) {
            if (s0 - i >= 0) {
                u32x4 r = *reinterpret_cast<const u32x4*>(up - (ptrdiff_t)i * DM);
#pragma unroll
                for (int j = 0; j < 4; ++j) { sum[2 * j] += bflo(r[j]); sum[2 * j + 1] += bfhi(r[j]); }
            }
        }
        for (int tt = 0; tt < 16; ++tt) {
            const int s = s0 + tt;
            u32x4 r = *reinterpret_cast<const u32x4*>(up + (size_t)tt * DM);
            float cur[8];
#pragma unroll
            for (int j = 0; j < 4; ++j) { cur[2 * j] = bflo(r[j]); cur[2 * j + 1] = bfhi(r[j]); }
#pragma unroll
            for (int j = 0; j < 8; ++j) sum[j] += cur[j];
            if (s >= w) {
                u32x4 o = *reinterpret_cast<const u32x4*>(up + (ptrdiff_t)(tt - w) * DM);
#pragma unroll
                for (int j = 0; j < 4; ++j) { sum[2 * j] -= bflo(o[j]); sum[2 * j + 1] -= bfhi(o[j]); }
            }
            const float inv = 1.f / (float)min(s + 1, w);
            u32x4 o;
#pragma unroll
            for (int j = 0; j < 4; ++j) o[j] = pk2(sum[2 * j] * inv - cur[2 * j], sum[2 * j + 1] * inv - cur[2 * j + 1]);
            *reinterpret_cast<u32x4*>(z + (size_t)(t0 + tt) * 1024 + c8 * 8) = o;
        }
    }
    float* rq = (float*)(p.ws + WS_RSTDQ); float* rkv = (float*)(p.ws + WS_RSTDKV);
    bf16_t* kpe = (bf16_t*)(p.ws + WS_KPE);
    const float2* cs = (const float2*)(p.ws + WS_CS);
    for (int t = bid * NWAVES + wave; t < NTOK; t += nb * NWAVES) {
        const bf16_t* pr = proj + (size_t)t * DM;
        u32x4 a = *reinterpret_cast<const u32x4*>(pr + 1024 + lane * 8);
        float s1 = 0.f;
#pragma unroll
        for (int j = 0; j < 4; ++j) { float lo = bflo(a[j]), hi = bfhi(a[j]); s1 += lo * lo + hi * hi; }
        u32x2 bq = *reinterpret_cast<const u32x2*>(pr + 1536 + lane * 4);
        float s2 = 0.f;
#pragma unroll
        for (int j = 0; j < 2; ++j) { float lo = bflo(bq[j]), hi = bfhi(bq[j]); s2 += lo * lo + hi * hi; }
        s1 = wave_sum(s1); s2 = wave_sum(s2);
        if (lane == 0) { rq[t] = rsqrtf(s1 * (1.f / 512.f) + EPS); rkv[t] = rsqrtf(s2 * (1.f / 256.f) + EPS); }
        if (lane < 32) {
            float x1 = bf2f((short)pr[1792 + lane]), x2 = bf2f((short)pr[1792 + 32 + lane]);
            float2 c = cs[(size_t)t * 32 + lane];
            unsigned char* k8 = (unsigned char*)kpe + (size_t)t * 64 + 32 * (lane >> 4) + (lane & 15);
            const int w = pk_fp8x4(x1 * c.x - x2 * c.y, x2 * c.x + x1 * c.y, 0.f, 0.f);
            k8[0] = (unsigned char)(w & 0xff); k8[16] = (unsigned char)((w >> 8) & 0xff);
        }
    }
}

constexpr int KS_STRIDE = 208, VS_STRIDE = 80;
constexpr int KS_BYTES = 64 * KS_STRIDE, VS_BYTES = 128 * VS_STRIDE, AT_STAGE = KS_BYTES + VS_BYTES;
__device__ __forceinline__ void attn_unit(const Params& p, char* shm, int b, int head, int qb) {
    int tid = threadIdx.x; asm volatile("" : "+v"(tid));
    const int wave = __builtin_amdgcn_readfirstlane(tid >> 6), lane = tid & 63, l31 = lane & 31, hh = lane >> 5;
    const bool grpB = wave >= 4;
    const int rowblk = (wave & 3) * 2 + (wave >> 2);
    const bf16_t* Q = (const bf16_t*)(p.ws + WS_Q);
    const bf16_t* Kn = (const bf16_t*)(p.ws + WS_KN);
    const bf16_t* Kpe = (const bf16_t*)(p.ws + WS_KPE);
    const bf16_t* Vt = (const bf16_t*)(p.ws + WS_VT);
    const float2* cs = (const float2*)(p.ws + WS_CS);
    bf16_t* ycat = (bf16_t*)(p.ws + WS_BUF1);
    const int q0 = qb * 256 + rowblk * 32, mychunk = q0 >> 6, nkt = 4 * qb + 4;
    const int tq = b * SEQ + q0 + l31;
    i32x8 qf[3];
    {
        const bf16_t* qrow = Q + (size_t)tq * 1536 + head * 192;
#pragma unroll
        for (int ks = 0; ks < 2; ++ks)
#pragma unroll
            for (int i = 0; i < 4; ++i) {
                const bf16x8 v = *reinterpret_cast<const bf16x8*>(qrow + ks * 64 + hh * 32 + 8 * i);
                qf[ks][2 * i] = pk_fp8x4(bf2f(v[0]) * 8.f, bf2f(v[1]) * 8.f, bf2f(v[2]) * 8.f, bf2f(v[3]) * 8.f);
                qf[ks][2 * i + 1] = pk_fp8x4(bf2f(v[4]) * 8.f, bf2f(v[5]) * 8.f, bf2f(v[6]) * 8.f, bf2f(v[7]) * 8.f);
            }
#pragma unroll
        for (int i = 0; i < 2; ++i) {
            const bf16x8 a = *reinterpret_cast<const bf16x8*>(qrow + 128 + 16 * hh + 8 * i);
            const bf16x8 c2 = *reinterpret_cast<const bf16x8*>(qrow + 160 + 16 * hh + 8 * i);
            const float2* cp = cs + (size_t)tq * 32 + 16 * hh + 8 * i;
            float o1[8], o2[8];
#pragma unroll
            for (int j = 0; j < 8; ++j) {
                const float2 c = cp[j];
                const float x1 = bf2f(a[j]) * 8.f, x2 = bf2f(c2[j]) * 8.f;
                o1[j] = x1 * c.x - x2 * c.y; o2[j] = x2 * c.x + x1 * c.y;
            }
            qf[2][2 * i] = pk_fp8x4(o1[0], o1[1], o1[2], o1[3]); qf[2][2 * i + 1] = pk_fp8x4(o1[4], o1[5], o1[6], o1[7]);
            qf[2][4 + 2 * i] = pk_fp8x4(o2[0], o2[1], o2[2], o2[3]); qf[2][4 + 2 * i + 1] = pk_fp8x4(o2[4], o2[5], o2[6], o2[7]);
        }
    }
    f32x16 O[4];
#pragma unroll
    for (int dt = 0; dt < 4; ++dt)
#pragma unroll
        for (int r = 0; r < 16; ++r) O[dt][r] = 0.f;
    float mrun = -1e30f, lsum = 0.f;
    f32x16 s0, s1;
    const int kkey = tid >> 3, kch = tid & 7;
    const int pk_key = tid >> 2, pk_ch = tid & 3;
    const int vd = tid >> 2, vch = tid & 3;
    const size_t tokb = (size_t)b * SEQ;
    const char* Kn8 = (const char*)Kn; const char* Kpe8 = (const char*)Kpe;
    const char* vbase = (const char*)Vt + (size_t)((b * 8 + head) * 128) * SEQ;
    u32x4 r0, r2, r3;
#define AT_LOAD(kt) do { const int k0_ = (kt) * 64; \
        r0 = *reinterpret_cast<const u32x4*>(Kn8 + (tokb + k0_ + kkey) * 1024 + head * 128 + kch * 16); \
        if (wave < 4) r2 = *reinterpret_cast<const u32x4*>(Kpe8 + (tokb + k0_ + pk_key) * 64 + pk_ch * 16); \
        r3 = *reinterpret_cast<const u32x4*>(vbase + (size_t)vd * SEQ + k0_ + vch * 16); } while (0)
#define AT_WRITE(buf) do { char* ks_ = shm + (buf) * AT_STAGE; char* vs_ = ks_ + KS_BYTES; \
        *reinterpret_cast<u32x4*>(ks_ + kkey * KS_STRIDE + kch * 16) = r0; \
        if (wave < 4) *reinterpret_cast<u32x4*>(ks_ + pk_key * KS_STRIDE + 128 + pk_ch * 16) = r2; \
        *reinterpret_cast<u32x4*>(vs_ + vd * VS_STRIDE + vch * 16) = r3; } while (0)
#define LDK(ks_, t_) __builtin_shufflevector(*reinterpret_cast<const i32x4*>(kb + (t_) * 32 * KS_STRIDE + (ks_) * 64), \
                                             *reinterpret_cast<const i32x4*>(kb + (t_) * 32 * KS_STRIDE + (ks_) * 64 + 16), 0, 1, 2, 3, 4, 5, 6, 7)
#define MXQK(a_, b_, c_) __builtin_amdgcn_mfma_scale_f32_32x32x64_f8f6f4(a_, b_, c_, 0, 0, 0, 0x7F7F7F7F, 0, 0x7F7F7F7F)
#define QK(buf) do { \
        const char* kb = shm + (buf) * AT_STAGE + l31 * KS_STRIDE + hh * 32; \
        i32x8 ka0 = LDK(0, 0), ka1 = LDK(0, 1), kb0 = LDK(1, 0), kb1 = LDK(1, 1); \
        _Pragma("unroll") for (int r = 0; r < 16; ++r) { s0[r] = 0.f; s1[r] = 0.f; } \
        __builtin_amdgcn_sched_barrier(0); \
        s0 = MXQK(ka0, qf[0], s0); \
        s1 = MXQK(ka1, qf[0], s1); \
        ka0 = LDK(2, 0); ka1 = LDK(2, 1); \
        __builtin_amdgcn_sched_barrier(0); \
        s0 = MXQK(kb0, qf[1], s0); \
        s1 = MXQK(kb1, qf[1], s1); \
        __builtin_amdgcn_sched_barrier(0); \
        s0 = MXQK(ka0, qf[2], s0); \
        s1 = MXQK(ka1, qf[2], s1); \
        __builtin_amdgcn_sched_barrier(0); } while (0)
#define LDV(dt_) __builtin_shufflevector(*reinterpret_cast<const i32x4*>(vb + (dt_) * 32 * VS_STRIDE), *reinterpret_cast<const i32x4*>(vb + (dt_) * 32 * VS_STRIDE + 16), 0, 1, 2, 3, 4, 5, 6, 7)
#define SMPV(buf) do { \
        const char* vb = shm + (buf) * AT_STAGE + KS_BYTES + l31 * VS_STRIDE + hh * 32; \
        i32x8 va[4]; \
        _Pragma("unroll") for (int dt = 0; dt < 4; ++dt) va[dt] = LDV(dt); \
        float mx = s0[0]; \
        _Pragma("unroll") for (int r = 1; r < 16; ++r) mx = fmaxf(mx, s0[r]); \
        _Pragma("unroll") for (int r = 0; r < 16; ++r) mx = fmaxf(mx, s1[r]); \
        mx = fmaxf(mx, __shfl_xor(mx, 32)); \
        const float mxs = mx * 0.125f; \
          \
          \
        if (__builtin_amdgcn_ballot_w64(mxs - mrun > 2.f) != 0) { \
            const float mnew = fmaxf(mrun, mxs); \
            const float alpha = __builtin_amdgcn_exp2f(mrun - mnew); \
            mrun = mnew; lsum *= alpha; \
            _Pragma("unroll") for (int dt = 0; dt < 4; ++dt) _Pragma("unroll") for (int r = 0; r < 16; ++r) O[dt][r] *= alpha; \
        } \
        const float moff = 6.f - mrun; \
        float ps = 0.f; \
        _Pragma("unroll") for (int r = 0; r < 16; ++r) { s0[r] = __builtin_amdgcn_exp2f(fmaf(s0[r], 0.125f, moff)); ps += s0[r]; } \
        _Pragma("unroll") for (int r = 0; r < 16; ++r) { s1[r] = __builtin_amdgcn_exp2f(fmaf(s1[r], 0.125f, moff)); ps += s1[r]; } \
        lsum += ps; \
        i32x8 pf; \
        _Pragma("unroll") for (int g = 0; g < 4; ++g) { \
            pf[g] = pk_fp8x4(s0[4 * g], s0[4 * g + 1], s0[4 * g + 2], s0[4 * g + 3]); \
            pf[4 + g] = pk_fp8x4(s1[4 * g], s1[4 * g + 1], s1[4 * g + 2], s1[4 * g + 3]); \
        } \
        __builtin_amdgcn_sched_barrier(0); \
        _Pragma("unroll") for (int dt = 0; dt < 4; ++dt) O[dt] = MXQK(va[dt], pf, O[dt]); \
        __builtin_amdgcn_sched_barrier(0); } while (0)
    __syncthreads();
    AT_LOAD(0); AT_WRITE(0);
    AT_LOAD(1);
    __syncthreads();
    if (grpB) __syncthreads();
    int bcur = 0, bnext = 1;
    for (int kt = 0; kt < nkt; ++kt) {
        if (kt + 1 < nkt) AT_WRITE(bnext);
        if (kt + 2 < nkt) AT_LOAD(kt + 2);
        __builtin_amdgcn_sched_barrier(0);
        if (kt <= mychunk) QK(bcur);
        __syncthreads();
        if (kt <= mychunk) SMPV(bcur);
        __syncthreads();
        bcur = bnext; bnext = (bnext == 2) ? 0 : bnext + 1;
    }
    if (!grpB) __syncthreads();
#undef AT_LOAD
#undef AT_WRITE
#undef QK
#undef SMPV
#undef LDK
#undef MXQK
#undef LDV
    lsum += __shfl_xor(lsum, 32);
    const float inv = 1.f / lsum;
    bf16_t* orow = ycat + (size_t)tq * DM + 1024 + head * 128 + 4 * hh;
#pragma unroll
    for (int dt = 0; dt < 4; ++dt)
#pragma unroll
        for (int g = 0; g < 4; ++g) {
            f32x4 v = {O[dt][4 * g] * inv, O[dt][4 * g + 1] * inv, O[dt][4 * g + 2] * inv, O[dt][4 * g + 3] * inv};
            st4bf(orow + dt * 32 + 8 * g, v);
        }
}
__device__ __forceinline__ void phase5(const Params& p, char* shm, int bid, int nb) {
    for (int it = bid; it < 256; it += nb) {
        const int bh = it >> 2, pr = it & 3, b = bh >> 3, head = bh & 7;
        attn_unit(p, shm, b, head, 7 - pr);
        attn_unit(p, shm, b, head, pr);
    }
}

__device__ __forceinline__ void phase7(const Params& p, char* shm, int bid, int nb) {
    const int tid = threadIdx.x, wave = tid >> 6, lane = tid & 63;
    const float* mod = (const float*)(p.ws + WS_MOD);
    const bf16_t* y = (const bf16_t*)(p.ws + WS_BUF2);
    bf16_t* x1 = (bf16_t*)(p.ws + WS_X1);
    float* lv = (float*)shm;
    for (int item = bid; item < NTOK / 64; item += nb) {
        const int b = item >> 5;
        const float* md = mod + b * 12288;
        __syncthreads();
        for (int i = tid; i < 512; i += NTHREADS) {
            *reinterpret_cast<f32x4*>(lv + 0 * DM + i * 4) = *reinterpret_cast<const f32x4*>(p.post_mix_g + i * 4);
            *reinterpret_cast<f32x4*>(lv + 1 * DM + i * 4) = *reinterpret_cast<const f32x4*>(md + 4096 + i * 4);
            *reinterpret_cast<f32x4*>(lv + 2 * DM + i * 4) = *reinterpret_cast<const f32x4*>(p.pre_ffn_g + i * 4);
            *reinterpret_cast<f32x4*>(lv + 3 * DM + i * 4) = *reinterpret_cast<const f32x4*>(md + 6144 + i * 4);
            *reinterpret_cast<f32x4*>(lv + 4 * DM + i * 4) = *reinterpret_cast<const f32x4*>(md + 8192 + i * 4);
        }
        __syncthreads();
#pragma unroll 1
        for (int rr = 0; rr < 8; ++rr) {
            const int row = item * 64 + rr * 8 + wave;
            f32x4 yv[8]; float ss = 0.f;
#pragma unroll
            for (int i = 0; i < 8; ++i) {
                u32x2 r = *reinterpret_cast<const u32x2*>(y + (size_t)row * DM + i * 256 + lane * 4);
                yv[i] = f32x4{bflo(r.x), bfhi(r.x), bflo(r.y), bfhi(r.y)};
                ss += yv[i][0] * yv[i][0] + yv[i][1] * yv[i][1] + yv[i][2] * yv[i][2] + yv[i][3] * yv[i][3];
            }
            const float rstd = rsqrtf(wave_sum(ss) * (1.f / DM) + EPS);
            float s2 = 0.f;
#pragma unroll
            for (int i = 0; i < 8; ++i) {
                const int col = i * 256 + lane * 4;
                f32x4 xv = *reinterpret_cast<const f32x4*>(p.x + (size_t)row * DM + col);
                f32x4 g = *reinterpret_cast<const f32x4*>(lv + col);
                f32x4 gt = *reinterpret_cast<const f32x4*>(lv + DM + col);
                f32x4 v = xv + gt * (yv[i] * rstd * g);
                st4bf(x1 + (size_t)row * DM + col, v);
                yv[i] = v;
                s2 += v[0] * v[0] + v[1] * v[1] + v[2] * v[2] + v[3] * v[3];
            }
            const float rstd2 = rsqrtf(wave_sum(s2) * (1.f / DM) + EPS);
            float hmax = 0.f;
#pragma unroll
            for (int i = 0; i < 8; ++i) {
                const int col = i * 256 + lane * 4;
                f32x4 g = *reinterpret_cast<const f32x4*>(lv + 2 * DM + col);
                f32x4 sh = *reinterpret_cast<const f32x4*>(lv + 3 * DM + col);
                f32x4 sc = *reinterpret_cast<const f32x4*>(lv + 4 * DM + col);
                yv[i] = yv[i] * rstd2 * g * (sc + 1.f) + sh;
                hmax = fmaxf(hmax, fmaxf(fmaxf(fabsf(yv[i][0]), fabsf(yv[i][1])), fmaxf(fabsf(yv[i][2]), fabsf(yv[i][3]))));
            }
#pragma unroll
            for (int o = 1; o < 64; o <<= 1) hmax = fmaxf(hmax, __shfl_xor(hmax, o));
            const float qm = hmax > 0.f ? 127.f / hmax : 0.f;
            if (lane == 0) ((float*)(p.ws + WS_SH))[row] = hmax * (1.f / 127.f);
#pragma unroll
            for (int i = 0; i < 8; ++i) {
                *reinterpret_cast<unsigned*>(p.ws + WS_H8 + (size_t)row * DM + i * 256 + lane * 4) = pack_i8x4(yv[i][0] * qm, yv[i][1] * qm, yv[i][2] * qm, yv[i][3] * qm);
            }
        }
    }
}

__device__ __forceinline__ int fmap(float f) { int i = __float_as_int(f); return i ^ ((i >> 31) & 0x7fffffff); }
__device__ __forceinline__ float funmap(int i) { return __int_as_float(i ^ ((i >> 31) & 0x7fffffff)); }
__device__ __forceinline__ void ins16(int (&top)[16], int k) {
#pragma unroll
    for (int i = 0; i < 16; ++i) { int hi = max(top[i], k); k = min(top[i], k); top[i] = hi; }
}
__device__ __forceinline__ int bsel(int m, int a, int b) { return (a & ~m) | (b & m); }
__device__ __forceinline__ int sel16(const int (&a)[16], int i) {
    const int m0 = -(i & 1), m1 = -((i >> 1) & 1), m2 = -((i >> 2) & 1), m3 = -((i >> 3) & 1);
    int t8[8], t4[4], t2[2];
#pragma unroll
    for (int k = 0; k < 8; ++k) t8[k] = bsel(m0, a[2 * k], a[2 * k + 1]);
#pragma unroll
    for (int k = 0; k < 4; ++k) t4[k] = bsel(m1, t8[2 * k], t8[2 * k + 1]);
#pragma unroll
    for (int k = 0; k < 2; ++k) t2[k] = bsel(m2, t4[2 * k], t4[2 * k + 1]);
    return bsel(m3, t2[0], t2[1]);
}
#define BITONIC_CE(x, K, J) _Pragma("unroll") for (int i_ = 0; i_ < 16; ++i_) { const int l_ = i_ ^ (J); if (l_ > i_) { const int a_ = x[i_], b_ = x[l_]; \
        if ((i_ & (K)) == 0) { x[i_] = max(a_, b_); x[l_] = min(a_, b_); } else { x[i_] = min(a_, b_); x[l_] = max(a_, b_); } } }
#define BITONIC_MERGE16(x) BITONIC_CE(x, 16, 8) BITONIC_CE(x, 16, 4) BITONIC_CE(x, 16, 2) BITONIC_CE(x, 16, 1)
#define BITONIC_SORT16(x) BITONIC_CE(x, 2, 1) BITONIC_CE(x, 4, 2) BITONIC_CE(x, 4, 1) BITONIC_CE(x, 8, 4) BITONIC_CE(x, 8, 2) BITONIC_CE(x, 8, 1) BITONIC_MERGE16(x)
#define SCE(x, i, j) { const int a_ = x[i], b_ = x[j]; x[i] = max(a_, b_); x[j] = min(a_, b_); }
#define SORT16_60(x) SCE(x,0,13) SCE(x,1,12) SCE(x,2,15) SCE(x,3,14) SCE(x,4,8) SCE(x,5,6) SCE(x,7,11) SCE(x,9,10) SCE(x,0,5) SCE(x,1,7) SCE(x,2,9) SCE(x,3,4) SCE(x,6,13) SCE(x,8,14) SCE(x,10,15) SCE(x,11,12) SCE(x,0,1) SCE(x,2,3) SCE(x,4,5) SCE(x,6,8) SCE(x,7,9) SCE(x,10,11) SCE(x,12,13) SCE(x,14,15) SCE(x,0,2) SCE(x,1,3) SCE(x,4,10) SCE(x,5,11) SCE(x,6,7) SCE(x,8,9) SCE(x,12,14) SCE(x,13,15) SCE(x,1,2) SCE(x,3,12) SCE(x,4,6) SCE(x,5,7) SCE(x,8,10) SCE(x,9,11) SCE(x,13,14) SCE(x,1,4) SCE(x,2,6) SCE(x,5,8) SCE(x,7,10) SCE(x,9,13) SCE(x,11,14) SCE(x,2,4) SCE(x,3,6) SCE(x,9,12) SCE(x,11,13) SCE(x,3,5) SCE(x,6,8) SCE(x,7,9) SCE(x,10,12) SCE(x,3,4) SCE(x,5,6) SCE(x,7,8) SCE(x,9,10) SCE(x,11,12) SCE(x,6,7) SCE(x,8,9)
__device__ __forceinline__ void pk_half_list(const bf16_t* __restrict__ qrow, const char* kl, int hh, int (&out)[16]) {
    bf16x8 qf[8];
#pragma unroll
    for (int ks = 0; ks < 8; ++ks) qf[ks] = *reinterpret_cast<const bf16x8*>(qrow + ks * 16);
    int top[16];
#pragma unroll 1
    for (int kt = 0; kt < 4; ++kt) {
        f32x16 acc;
#pragma unroll
        for (int r = 0; r < 16; ++r) acc[r] = 0.f;
#pragma unroll
        for (int ks = 0; ks < 8; ++ks) {
            bf16x8 kf = *reinterpret_cast<const bf16x8*>(kl + kt * 32 * 272 + ks * 32);
            acc = __builtin_amdgcn_mfma_f32_32x32x16_bf16(kf, qf[ks], acc, 0, 0, 0);
        }
        int nw[16];
#pragma unroll
        for (int r = 0; r < 16; ++r) {
            const int n = kt * 32 + (r & 3) + 8 * (r >> 2) + 4 * hh;
            nw[r] = (fmap(acc[r]) & ~127) | (127 - n);
        }
        SORT16_60(nw)
        if (kt == 0) {
#pragma unroll
            for (int i = 0; i < 16; ++i) top[i] = nw[i];
        } else {
#pragma unroll
            for (int i = 0; i < 16; ++i) top[i] = max(top[i], nw[15 - i]);
            BITONIC_MERGE16(top)
        }
    }
#pragma unroll
    for (int i = 0; i < 16; ++i) out[i] = __shfl_xor(top[15 - i], 32);
#pragma unroll
    for (int i = 0; i < 16; ++i) out[i] = max(out[i], top[i]);
    BITONIC_MERGE16(out)
}
__device__ __forceinline__ void phase9(const Params& p, char* shm, int bid, int nb) {
    int tid = threadIdx.x; asm volatile("" : "+v"(tid));
    const int wave = tid >> 6, lane = tid & 63, l31 = lane & 31, hh = lane >> 5;
    const bf16_t* pq = (const bf16_t*)(p.ws + WS_BUF2);
    const bf16_t* sk = (const bf16_t*)(p.ws + WS_SK);
    int* idxo = (int*)(p.ws + WS_IDX); float* gateo = (float*)(p.ws + WS_GATE);
    for (int item = bid; item < 8 * 64; item += nb) {
        const int head = item & 7, tt = (item >> 3) * 8 + wave, tok = tt * 32 + l31;
        __syncthreads();
        for (int c = tid; c < 4096; c += NTHREADS) {
            const int row = c >> 4, ch = c & 15;
            *reinterpret_cast<u32x4*>(shm + row * 272 + ch * 16) = *reinterpret_cast<const u32x4*>(sk + (size_t)(head * 256 + row) * 128 + ch * 8);
        }
        __syncthreads();
        int la[16], lb[16];
        pk_half_list(pq + (size_t)tok * DM + head * 256 + hh * 8, shm + l31 * 272 + hh * 16, hh, la);
        pk_half_list(pq + (size_t)tok * DM + head * 256 + 128 + hh * 8, shm + (128 + l31) * 272 + hh * 16, hh, lb);
        float va[16], vb[16]; int ia[16], ib[16];
#pragma unroll
        for (int i = 0; i < 16; ++i) {
            va[i] = funmap(la[i] & ~127); ia[i] = 127 - (la[i] & 127);
            vb[i] = funmap(lb[i] & ~127); ib[i] = 127 - (lb[i] & 127);
        }
#define CKEY(i, j) ((fmap(va[i] + vb[j]) & ~255) | (255 - ((i) * 16 + (j))))
        int top2[16], ga[16], gb[16];
#pragma unroll
        for (int j = 0; j < 16; ++j) top2[j] = CKEY(0, j);
#pragma unroll
        for (int j = 0; j < 8; ++j) { ga[j] = CKEY(1, j); ga[8 + j] = CKEY(15 - j, 0); }
        BITONIC_MERGE16(ga)
        gb[0] = CKEY(2, 0); gb[1] = CKEY(2, 1); gb[2] = CKEY(2, 2); gb[3] = CKEY(2, 3); gb[4] = CKEY(2, 4);
        gb[5] = CKEY(3, 0); gb[6] = CKEY(3, 1); gb[7] = CKEY(3, 2); gb[8] = CKEY(3, 3);
        gb[9] = CKEY(4, 0); gb[10] = CKEY(4, 1); gb[11] = CKEY(4, 2);
        gb[12] = CKEY(5, 0); gb[13] = CKEY(5, 1); gb[14] = CKEY(6, 0); gb[15] = CKEY(6, 1);
        SORT16_60(gb)
#pragma unroll
        for (int i = 0; i < 16; ++i) top2[i] = max(top2[i], ga[15 - i]);
        BITONIC_MERGE16(top2)
#pragma unroll
        for (int i = 0; i < 16; ++i) top2[i] = max(top2[i], gb[15 - i]);
        BITONIC_MERGE16(top2)
        ins16(top2, CKEY(7, 0)); ins16(top2, CKEY(7, 1));
#undef CKEY
        float bv[16], mxv, sum = 0.f; int ex[16];
        {
            LAS int* tA = (LAS int*)(uintptr_t)(69632 + wave * 8192) + lane;
            LAS int* tB = tA + 16 * 64;
#pragma unroll
            for (int i = 0; i < 16; ++i) { tA[i * 64] = ia[i] * 128; tB[i * 64] = ib[i]; }
#pragma unroll
            for (int r = 0; r < 16; ++r) {
                const int code = 255 - (top2[r] & 255);
                ex[r] = tA[(code >> 4) * 64] + tB[(code & 15) * 64];
                bv[r] = funmap(top2[r] & ~255);
            }
        }
        mxv = bv[0];
#pragma unroll
        for (int r = 0; r < 16; ++r) { bv[r] = __expf(bv[r] - mxv); sum += bv[r]; }
        const float inv = 1.f / sum;
        if (hh == 0) {
            const size_t ob = ((size_t)(tok >> 6) * 128 + head * 16) * 64 + (tok & 63);
#pragma unroll
            for (int r = 0; r < 16; ++r) { idxo[ob + r * 64] = ex[r]; gateo[ob + r * 64] = bv[r] * inv; }
        }
    }
}

__device__ __forceinline__ void phase10(const Params& p, char* shm, int bid, int nb) {
    int tid = threadIdx.x; asm volatile("" : "+v"(tid));
    const int wave = tid >> 6, lane = tid & 63;
    const int* idxT = (const int*)(p.ws + WS_IDX);
    const char* U8 = p.ws + WS_U8;
    const char* H8 = p.ws + WS_H8;
    int* part = (int*)(p.ws + WS_PART);
    for (int task = bid; task < 256; task += nb) {
        const int tg = task >> 3, cg = task & 7;
        const int tt = tg * 8 + wave, t = tt * 64 + lane;
        unsigned ip[64]; int acc[128];
#pragma unroll
        for (int k = 0; k < 64; ++k) {
            const unsigned lo = (unsigned)idxT[((size_t)tt * 128 + 2 * k) * 64 + lane], hi = (unsigned)idxT[((size_t)tt * 128 + 2 * k + 1) * 64 + lane];
            ip[k] = lo | (hi << 16);
        }
#pragma unroll
        for (int j = 0; j < 128; ++j) acc[j] = 0;
#pragma unroll 1
        for (int s = 0; s < 32; ++s) {
            const int slice = cg * 32 + s;
            __syncthreads();
            const char* sbase = U8 + (size_t)slice * 131072;
            const unsigned toff = (unsigned)tid * 16u;
#pragma unroll
            for (int k = 0; k < 16; ++k)
                __builtin_amdgcn_global_load_lds((const unsigned*)(sbase + k * 8192 + toff), (unsigned*)(shm + k * 8192 + tid * 16), 16, 0, 0);
            const u32x2 h = *reinterpret_cast<const u32x2*>(H8 + (size_t)t * DM + slice * 8);
            asm volatile("s_waitcnt vmcnt(0)" ::: "memory");
            __syncthreads();
#define U_LOAD(g, dst) _Pragma("unroll") for (int q = 0; q < 4; ++q) { unsigned w = ip[(g) * 4 + q]; asm volatile("" : "+v"(w)); \
                dst[2 * q] = *reinterpret_cast<const u32x2*>(shm + ((w & 0xffffu) << 3)); dst[2 * q + 1] = *reinterpret_cast<const u32x2*>(shm + ((w >> 16) << 3)); }
#define U_DOT(g, srcv) _Pragma("unroll") for (int q = 0; q < 8; ++q) { \
                acc[(g) * 8 + q] = __builtin_amdgcn_sdot4((int)srcv[q].x, (int)h.x, acc[(g) * 8 + q], false); \
                acc[(g) * 8 + q] = __builtin_amdgcn_sdot4((int)srcv[q].y, (int)h.y, acc[(g) * 8 + q], false); }
            u32x2 ua[8], ub[8];
            U_LOAD(0, ua)
#pragma unroll
            for (int g = 0; g < 16; g += 2) {
                U_LOAD(g + 1, ub)
                U_DOT(g, ua)
                __builtin_amdgcn_sched_barrier(0);
                if (g + 2 < 16) { U_LOAD(g + 2, ua) }
                U_DOT(g + 1, ub)
                __builtin_amdgcn_sched_barrier(0);
            }
#undef U_LOAD
#undef U_DOT
        }
#pragma unroll
        for (int k = 0; k < 64; ++k) part[((size_t)cg * 64 + k) * NTOK + t] = (int)pk2((float)acc[2 * k], (float)acc[2 * k + 1]);
    }
}

__device__ __forceinline__ void phase11(const Params& p, int bid, int nb) {
    const int* part = (const int*)(p.ws + WS_PART);
    const int* idxT = (const int*)(p.ws + WS_IDX); const float* gateT = (const float*)(p.ws + WS_GATE);
    const float* su = (const float*)(p.ws + WS_SU); const float* sv = (const float*)(p.ws + WS_SV); const float* sh = (const float*)(p.ws + WS_SH);
    unsigned* pack = (unsigned*)(p.ws + WS_PACK);
    for (int item = bid * NTHREADS + threadIdx.x; item < NTOK * 128; item += nb * NTHREADS) {
        const int lane = item & 63, j = (item >> 6) & 127, tt = item >> 13, t = tt * 64 + lane;
        float sum = 0.f;
#pragma unroll
        for (int cg = 0; cg < 8; ++cg) { const unsigned w = (unsigned)part[((size_t)cg * 64 + (j >> 1)) * NTOK + t]; sum += (j & 1) ? bfhi(w) : bflo(w); }
        const int e = idxT[item];
        const float a = sum * sh[t] * su[e];
        const float act = 0.5f * a * (1.f + erff(a * 0.70710678118654752f)) * gateT[item] * sv[e];
        { const _Float16 ah = (_Float16)(act * 256.f); pack[item] = ((unsigned)__builtin_bit_cast(unsigned short, ah) << 16) | ((unsigned)e << 2); }
    }
}

__device__ __forceinline__ void phase12(const Params& p, char* shm, int bid, int nb) {
    int tid = threadIdx.x; asm volatile("" : "+v"(tid));
    const int wave = tid >> 6, lane = tid & 63;
    const unsigned* pack = (const unsigned*)(p.ws + WS_PACK);
    const char* V8 = p.ws + WS_V8;
    bf16_t* y2 = (bf16_t*)(p.ws + WS_Y2);
    for (int slice = bid; slice < 256; slice += nb) {
        __syncthreads();
        const char* src = V8 + (size_t)slice * 131072 + tid * 16;
#pragma unroll
        for (int k = 0; k < 16; ++k)
            __builtin_amdgcn_global_load_lds((const unsigned*)(src + k * 8192), (unsigned*)(shm + k * 8192 + tid * 16), 16, 0, 0);
        asm volatile("s_waitcnt vmcnt(0)" ::: "memory");
        __syncthreads();
#define V_LOAD(ptr, g, dst) _Pragma("unroll") for (int q = 0; q < 16; ++q) dst[q] = *reinterpret_cast<const unsigned*>(reinterpret_cast<const char*>((ptr) + (g) * 1024) + lane4 + q * 256);
#define V_LDS(srcp, dstv) _Pragma("unroll") for (int q = 0; q < 16; ++q) { unsigned ad_; \
            asm("v_lshlrev_b32_sdwa %0, %1, %2 dst_sel:DWORD dst_unused:UNUSED_PAD src0_sel:DWORD src1_sel:WORD_0" : "=v"(ad_) : "v"(one_), "v"(srcp[q])); \
            dstv[q] = *reinterpret_cast<const LAS u32x2*>((uintptr_t)ad_); }
#define V_CVT(w_, hi_) __builtin_bit_cast(h2v, __builtin_amdgcn_cvt_scalef32_pk_f16_fp8(w_, __uint_as_float(0x3F80007Fu), hi_))
#define V_FMAS(srcp, srcv) _Pragma("unroll") for (int q = 0; q < 16; ++q) { const h2v ph = __builtin_bit_cast(h2v, srcp[q]); const h2v act = {ph[1], ph[1]}; \
                y[0] = __builtin_elementwise_fma(act, V_CVT(srcv[q].x, false), y[0]); y[1] = __builtin_elementwise_fma(act, V_CVT(srcv[q].x, true), y[1]); \
                y[2] = __builtin_elementwise_fma(act, V_CVT(srcv[q].y, false), y[2]); y[3] = __builtin_elementwise_fma(act, V_CVT(srcv[q].y, true), y[3]); }
#define V_STEP(ptr, g, pkLoad, pkLds, vLds, pkCur, vCur) V_LOAD(ptr, g, pkLoad) V_LDS(pkLds, vLds) V_FMAS(pkCur, vCur) __builtin_amdgcn_sched_barrier(0);
        unsigned pkA[16], pkB[16], pkC[16]; u32x2 vA[16], vB[16];
        unsigned one_ = 1u; asm volatile("" : "+v"(one_));
        const int wave_u = __builtin_amdgcn_readfirstlane(wave);
        const unsigned lane4 = (unsigned)lane * 4u;
        {
            const unsigned* pp0 = pack + (size_t)wave_u * 8192;
            V_LOAD(pp0, 0, pkA) V_LOAD(pp0, 1, pkB) V_LDS(pkA, vA)
        }
#pragma unroll 1
        for (int tt = wave_u; tt < 256; tt += NWAVES) {
            h2v y[4];
#pragma unroll
            for (int c = 0; c < 4; ++c) y[c] = h2v{(_Float16)0.f, (_Float16)0.f};
            const unsigned* pp = pack + (size_t)tt * 8192;
            const int ttn = (tt + NWAVES < 256) ? tt + NWAVES : tt;
            const unsigned* pn = pack + (size_t)ttn * 8192;
            V_STEP(pp, 2, pkC, pkB, vB, pkA, vA)
            V_STEP(pp, 3, pkA, pkC, vA, pkB, vB)
            V_STEP(pp, 4, pkB, pkA, vB, pkC, vA)
            V_STEP(pp, 5, pkC, pkB, vA, pkA, vB)
            V_STEP(pp, 6, pkA, pkC, vB, pkB, vA)
            V_STEP(pp, 7, pkB, pkA, vA, pkC, vB)
            V_STEP(pn, 0, pkC, pkB, vB, pkA, vA)
            V_STEP(pn, 1, pkA, pkC, vA, pkB, vB)
#pragma unroll
            for (int q = 0; q < 16; ++q) { const unsigned t0_ = pkA[q]; pkA[q] = pkC[q]; pkB[q] = t0_; }
            *reinterpret_cast<u32x4*>(y2 + (size_t)(tt * 64 + lane) * DM + slice * 8) =
                u32x4{__builtin_bit_cast(unsigned, y[0]), __builtin_bit_cast(unsigned, y[1]), __builtin_bit_cast(unsigned, y[2]), __builtin_bit_cast(unsigned, y[3])};
        }
#undef V_LOAD
#undef V_LDS
#undef V_CVT
#undef V_FMAS
#undef V_STEP
    }
}

__device__ __forceinline__ float h16f(unsigned h) {
    const unsigned s_ = (h & 0x8000u) << 16, e_ = (h >> 10) & 31u, m_ = h & 0x3ffu;
    return e_ == 0u ? __uint_as_float(s_) : __uint_as_float(s_ | ((e_ + 112u) << 23) | (m_ << 13));
}
__device__ __forceinline__ void phase13(const Params& p, char* shm, int bid, int nb) {
    const int tid = threadIdx.x, wave = tid >> 6, lane = tid & 63;
    const float* mod = (const float*)(p.ws + WS_MOD);
    const bf16_t* y2 = (const bf16_t*)(p.ws + WS_Y2);
    const bf16_t* x1 = (const bf16_t*)(p.ws + WS_X1);
    float* lv = (float*)shm;
    for (int item = bid; item < NTOK / 64; item += nb) {
        const int b = item >> 5;
        __syncthreads();
        for (int i = tid; i < 512; i += NTHREADS) {
            *reinterpret_cast<f32x4*>(lv + 0 * DM + i * 4) = *reinterpret_cast<const f32x4*>(p.post_ffn_g + i * 4);
            *reinterpret_cast<f32x4*>(lv + 1 * DM + i * 4) = *reinterpret_cast<const f32x4*>(mod + b * 12288 + 10240 + i * 4);
        }
        __syncthreads();
#pragma unroll 1
        for (int rr = 0; rr < 8; ++rr) {
            const int row = item * 64 + rr * 8 + wave;
            f32x4 yv[8]; u32x2 xr[8]; float ss = 0.f;
#pragma unroll
            for (int i = 0; i < 8; ++i) {
                u32x2 r = *reinterpret_cast<const u32x2*>(y2 + (size_t)row * DM + i * 256 + lane * 4);
                xr[i] = *reinterpret_cast<const u32x2*>(x1 + (size_t)row * DM + i * 256 + lane * 4);
                yv[i] = f32x4{h16f(r.x & 0xffffu), h16f(r.x >> 16), h16f(r.y & 0xffffu), h16f(r.y >> 16)};
                ss += yv[i][0] * yv[i][0] + yv[i][1] * yv[i][1] + yv[i][2] * yv[i][2] + yv[i][3] * yv[i][3];
            }
            const float rstd = rsqrtf(wave_sum(ss) * (1.f / DM) + EPS);
#pragma unroll
            for (int i = 0; i < 8; ++i) {
                const int col = i * 256 + lane * 4;
                f32x4 xv = f32x4{bflo(xr[i].x), bfhi(xr[i].x), bflo(xr[i].y), bfhi(xr[i].y)};
                f32x4 g = *reinterpret_cast<const f32x4*>(lv + col);
                f32x4 gt = *reinterpret_cast<const f32x4*>(lv + DM + col);
                *reinterpret_cast<f32x4*>(p.out + (size_t)row * DM + col) = xv + gt * (yv[i] * rstd * g);
            }
        }
    }
}

constexpr int NPHASE = 14;
__global__ void __launch_bounds__(NTHREADS, 2) mega(Params p, int ph_lo, int ph_hi) {
    extern __shared__ __attribute__((aligned(16))) char shm[];
    const int bid = blockIdx.x, nb = gridDim.x;
    const int vcu = vcu_of(bid, nb);
    char* ws = p.ws;
    volatile LAS unsigned* xbw = (volatile LAS unsigned*)(shm + XB_OFF);
    if (threadIdx.x == 0) { xbw[0] = 0u; xbw[1] = 0u; }
    __syncthreads();
    XcdBarrier bar; bar.bar = (unsigned*)(ws + WS_BAR); bar.x = 0; bar.st = xbw;
    if (ph_hi - ph_lo > 1) bar = xcd_barrier_post((unsigned*)(ws + WS_BAR), xbw);
#ifndef DUP_PH
#define DUP_PH (-1)
#endif
#define REP(k) for (int rep_ = 0; rep_ < ((k) == DUP_PH ? 2 : 1); ++rep_)
#ifdef ONLY_PH
#define PH(k) ((k) == ONLY_PH && ph_lo <= (k) && (k) < ph_hi)
#else
#define PH(k) (ph_lo <= (k) && (k) < ph_hi)
#endif
#define SEAM(k) do { if (ph_lo <= (k) && (k) + 1 < ph_hi) xcd_barrier(bar); } while (0)
    if (PH(0)) REP(0) phase0(p, shm, bid, nb);
    SEAM(0);
    if (PH(1)) REP(1) phase1(p, shm, bid, nb);
    SEAM(1);
    if (PH(2)) REP(2) {
        EpiI8 e{(bf16_t*)(ws + WS_BUF2), DM, (const float*)(ws + WS_SH1), (const float*)(ws + WS_WSC)};
        gemm_phase<false, true>((const bf16_t*)(ws + WS_BUF1), DM / 2, (const bf16_t*)(ws + WS_WIN), DM / 2, 1024, 8, 512, 0, vcu, nb, shm, e);
    }
    SEAM(2);
    if (PH(3)) REP(3) phase3(p, bid, nb);
    SEAM(3);
    if (PH(4)) REP(4) {
        const bf16_t* projb = (const bf16_t*)(ws + WS_BUF2);
        EpiQ eq{(bf16_t*)(ws + WS_Q), (const float*)(ws + WS_RSTDQ)};
        EpiKV ekv{(bf16_t*)(ws + WS_KN), (bf16_t*)(ws + WS_VT), (const float*)(ws + WS_RSTDKV)};
        if (nb == 256) {
            const int nq = vcu < 128 ? 2 : 1, q0 = vcu < 128 ? 2 * vcu : vcu + 128;
            const int nkv = vcu < 128 ? 1 : 3, kv0 = vcu < 128 ? vcu : 128 + 3 * (vcu - 128);
            const int g = vcu >> 6, pmp = vcu & 63;
            const bf16_t* qA = projb + 1024; const bf16_t* qB = (const bf16_t*)(ws + WS_WUQ);
            const bf16_t* kA = projb + 1536; const bf16_t* kB = (const bf16_t*)(ws + WS_WUKV);
            const bf16_t* pA = (const bf16_t*)(ws + WS_Z) + g * 256; const bf16_t* pB = (const bf16_t*)(ws + WS_WPOOL) + g * 65536;
            const NextTile kvfirst{kA, kB, DM, 256, (kv0 >> 3) * 256, (kv0 & 7) * 256};
            const NextTile poolt{pA, pB, 1024, 256, pmp * 256, 0};
#pragma unroll 1
            for (int i = 0; i < nq; ++i) {
                const int t = q0 + i;
                const NextTile nx = (i + 1 < nq) ? NextTile{qA, qB, DM, 512, ((t + 1) / 6) * 256, ((t + 1) % 6) * 256} : kvfirst;
                gemm_tile<false, false>(qA, DM, qB, 512, 8, (t / 6) * 256, (t % 6) * 256, shm, eq, i > 0, nx);
            }
#pragma unroll 1
            for (int i = 0; i < nkv; ++i) {
                const int t = kv0 + i;
                const NextTile nx = (i + 1 < nkv) ? NextTile{kA, kB, DM, 256, ((t + 1) >> 3) * 256, ((t + 1) & 7) * 256} : poolt;
                gemm_tile<true, false>(kA, DM, kB, 256, 4, (t >> 3) * 256, (t & 7) * 256, shm, ekv, true, nx);
            }
            {
                EpiPool e{(bf16_t*)(ws + WS_BUF1), p.pool_scale, g * 256};
                gemm_tile<false, false>(pA, 1024, pB, 256, 4, pmp * 256, 0, shm, e, true, NextTile{pA, pB, 1024, 256, -1, 0});
            }
        } else {
            gemm_phase<false, false>(projb + 1024, DM, (const bf16_t*)(ws + WS_WUQ), 512, 512, 6, 384, 0, vcu, nb, shm, eq);
            gemm_phase<true, false>(projb + 1536, DM, (const bf16_t*)(ws + WS_WUKV), 256, 256, 8, 512, 384, vcu, nb, shm, ekv);
            const int first = ((vcu - 896) % nb + nb) % nb;
            for (int t = first; t < 256; t += nb) {
                const int g = t >> 6, pm = t & 63;
                EpiPool e{(bf16_t*)(ws + WS_BUF1), p.pool_scale, g * 256};
                gemm_tile<false, false>((const bf16_t*)(ws + WS_Z) + g * 256, 1024, (const bf16_t*)(ws + WS_WPOOL) + g * 65536, 256, 4, pm * 256, 0, shm, e, false, NextTile{nullptr, nullptr, 0, 0, -1, 0});
            }
        }
    }
    SEAM(4);
    if (PH(5)) REP(5) phase5(p, shm, vcu, nb);
    SEAM(5);
    if (PH(6)) REP(6) {
        EpiBf16 e{(bf16_t*)(ws + WS_BUF2), DM};
        gemm_phase<false, false>((const bf16_t*)(ws + WS_BUF1), DM, (const bf16_t*)(ws + WS_WOUT), DM, 2048, 8, 512, 0, vcu, nb, shm, e);
    }
    SEAM(6);
    if (PH(7)) REP(7) phase7(p, shm, bid, nb);
    SEAM(7);
    if (PH(8)) REP(8) {
        EpiI8 e{(bf16_t*)(ws + WS_BUF2), DM, (const float*)(ws + WS_SH), (const float*)(ws + WS_WSC) + 2048};
        gemm_phase<false, true>((const bf16_t*)(ws + WS_H8), DM / 2, (const bf16_t*)(ws + WS_WPQ), DM / 2, 1024, 8, 512, 0, vcu, nb, shm, e);
    }
    SEAM(8);
    if (PH(9)) REP(9) phase9(p, shm, bid, nb);
    SEAM(9);
    if (PH(10)) REP(10) phase10(p, shm, bid, nb);
    SEAM(10);
    if (PH(11)) REP(11) phase11(p, bid, nb);
    SEAM(11);
    if (PH(12)) REP(12) phase12(p, shm, vcu, nb);
    SEAM(12);
    if (PH(13)) REP(13) phase13(p, shm, bid, nb);
#undef PH
#undef SEAM
}

extern "C" void kernel_launch(void* const* d_in, const int* in_sizes, int n_in, void* d_out, int out_size, void* d_ws, size_t ws_size, hipStream_t stream) {
    static int grid = 0;
    if (grid == 0) {
        if (n_in != 21 || ws_size < WS_END) { fprintf(stderr, "kernel_launch: unexpected n_in %d / ws_size %zu (need %zu)\n", n_in, ws_size, (size_t)WS_END); grid = -1; return; }
        int dev = 0, cus = 0;
        if (hipGetDevice(&dev) != hipSuccess || hipDeviceGetAttribute(&cus, hipDeviceAttributeMultiprocessorCount, dev) != hipSuccess) { grid = -1; return; }
        if (hipFuncSetAttribute((const void*)mega, hipFuncAttributeMaxDynamicSharedMemorySize, LDS_BYTES) != hipSuccess) { fprintf(stderr, "hipFuncSetAttribute failed\n"); grid = -1; return; }
        int per_cu = 0;
        if (hipOccupancyMaxActiveBlocksPerMultiprocessor(&per_cu, (const void*)mega, NTHREADS, LDS_BYTES) != hipSuccess || per_cu < 1)
            fprintf(stderr, "kernel_launch: occupancy query reports %d blocks per CU\n", per_cu);
        (void)hipGetLastError();
        grid = cus;
    }
    if (grid < 0) return;
    (void)hipMemsetAsync((char*)d_ws + WS_ZERO, 0, ZERO_BYTES, stream);
    (void)hipMemsetAsync((char*)d_ws + WS_CMAX, 0, CMAX_BYTES, stream);
    Params p{};
    p.x = (const float*)d_in[0]; p.c = (const float*)d_in[1]; p.pos = (const int*)d_in[2];
    p.ada_w = (const float*)d_in[3]; p.ada_b = (const float*)d_in[4];
    p.pre_mix_g = (const float*)d_in[5]; p.post_mix_g = (const float*)d_in[6]; p.pre_ffn_g = (const float*)d_in[7]; p.post_ffn_g = (const float*)d_in[8];
    p.w_in = (const float*)d_in[9]; p.pool_w = (const float*)d_in[10]; p.pool_scale = (const float*)d_in[11];
    p.q_norm_g = (const float*)d_in[12]; p.w_uq = (const float*)d_in[13]; p.kv_norm_g = (const float*)d_in[14]; p.w_ukv = (const float*)d_in[15];
    p.w_out = (const float*)d_in[16]; p.peer_wq = (const float*)d_in[17]; p.sub_keys = (const float*)d_in[18];
    p.peer_u = (const float*)d_in[19]; p.peer_v = (const float*)d_in[20];
    p.out = (float*)d_out; p.ws = (char*)d_ws;
#if MK_MULTI
    for (int k = 0; k < NPHASE; ++k) hipLaunchKernelGGL(mega, dim3(grid), dim3(NTHREADS), LDS_BYTES, stream, p, k, k + 1);
#else
    hipLaunchKernelGGL(mega, dim3(grid), dim3(NTHREADS), LDS_BYTES, stream, p, 0, NPHASE);
#endif
}
```

```cpp
#include <hip/hip_runtime.h>
#include <hip/hip_bf16.h>
#include <stdint.h>
#include <stdio.h>

#ifndef MK_MULTI
#define MK_MULTI 0
#endif

typedef unsigned short bf16_t;
typedef short bf16x8 __attribute__((ext_vector_type(8)));
typedef float f32x4 __attribute__((ext_vector_type(4)));
typedef float f32x16 __attribute__((ext_vector_type(16)));
typedef unsigned u32x4 __attribute__((ext_vector_type(4)));
typedef int i32x4 __attribute__((ext_vector_type(4)));
typedef int i32x8 __attribute__((ext_vector_type(8)));
__device__ __forceinline__ int pk_fp8x4(float a, float b, float c, float d) {
    int w = __builtin_amdgcn_cvt_pk_fp8_f32(a, b, 0, false);
    return __builtin_amdgcn_cvt_pk_fp8_f32(c, d, w, true);
}
template <bool I8> struct AccT { typedef f32x4 type; };
template <> struct AccT<true> { typedef i32x4 type; };
typedef unsigned u32x2 __attribute__((ext_vector_type(2)));
typedef _Float16 h2v __attribute__((ext_vector_type(2)));

constexpr int NTOK = 16384, DM = 2048, SEQ = 2048;
constexpr int NTHREADS = 512, NWAVES = 8;
constexpr int LDS_BYTES = 140 * 1024;
constexpr int XB_OFF = LDS_BYTES - 64;
constexpr float EPS = 1e-6f;

constexpr size_t MiB = 1024 * 1024;
constexpr size_t WS_ZERO   = 0;
constexpr size_t WS_BAR    = 0;
constexpr size_t WS_MOD    = 16384;
constexpr size_t ZERO_BYTES = 16384;
constexpr size_t WS_CS     = 1 * MiB;
constexpr size_t WS_RSTDQ  = 5 * MiB;
constexpr size_t WS_RSTDKV = 5 * MiB + 65536;
constexpr size_t WS_WIN    = 6 * MiB;
constexpr size_t WS_WOUT   = 14 * MiB;
constexpr size_t WS_WPQ    = 22 * MiB;
constexpr size_t WS_WUQ    = 30 * MiB;
constexpr size_t WS_WUKV   = 32 * MiB;
constexpr size_t WS_WPOOL  = 33 * MiB;
constexpr size_t WS_SK     = 34 * MiB;
constexpr size_t WS_U8     = 35 * MiB;
constexpr size_t WS_V8     = 67 * MiB;
constexpr size_t WS_H8     = 99 * MiB;
constexpr size_t WS_PACK   = 131 * MiB;
constexpr size_t WS_SU     = 139 * MiB;
constexpr size_t WS_SV     = 139 * MiB + 65536;
constexpr size_t WS_SH     = 139 * MiB + 131072;
constexpr size_t WS_SH1    = 139 * MiB + 196608;
constexpr size_t WS_CMAX   = 139 * MiB + 262144;
constexpr size_t WS_WSC    = 139 * MiB + 278528;
constexpr size_t CMAX_BYTES = 2 * 2048 * 4;
constexpr size_t WS_BUF1   = 163 * MiB;
constexpr size_t WS_BUF2   = 227 * MiB;
constexpr size_t WS_BIG    = 291 * MiB;
constexpr size_t WS_Z      = WS_BIG;
constexpr size_t WS_Q      = WS_BIG + 32 * MiB;
constexpr size_t WS_KN     = WS_BIG + 80 * MiB;
constexpr size_t WS_VT     = WS_BIG + 112 * MiB;
constexpr size_t WS_KPE    = WS_BIG + 144 * MiB;
constexpr size_t WS_X1     = WS_BIG;
constexpr size_t WS_IDX    = 438 * MiB;
constexpr size_t WS_GATE   = 446 * MiB;
constexpr size_t WS_PART   = WS_BUF1;
constexpr size_t WS_Y2     = WS_BUF2;
constexpr size_t WS_END    = 454 * MiB;

struct Params {
    const float *x, *c; const int* pos;
    const float *ada_w, *ada_b, *pre_mix_g, *post_mix_g, *pre_ffn_g, *post_ffn_g;
    const float *w_in, *pool_w, *pool_scale, *q_norm_g, *w_uq, *kv_norm_g, *w_ukv, *w_out;
    const float *peer_wq, *sub_keys, *peer_u, *peer_v;
    float* out; char* ws;
    int wave_s;
};

__device__ __forceinline__ unsigned pk2(float lo, float hi) {
    typedef __bf16 bf2 __attribute__((ext_vector_type(2)));
    bf2 v; v[0] = (__bf16)lo; v[1] = (__bf16)hi; return __builtin_bit_cast(unsigned, v);
}
__device__ __forceinline__ float bflo(unsigned u) { return __uint_as_float(u << 16); }
__device__ __forceinline__ float bfhi(unsigned u) { return __uint_as_float(u & 0xffff0000u); }
__device__ __forceinline__ float bf2f(short b) { return __uint_as_float(((unsigned)(unsigned short)b) << 16); }
__device__ __forceinline__ short f2bf(float f) { return (short)(pk2(f, 0.f) & 0xffffu); }
__device__ __forceinline__ unsigned pack_i8x4(float a, float b, float c, float d) {
    unsigned r = 0u;
    r = __builtin_amdgcn_cvt_pk_u8_f32(a + 128.f, 0, r); r = __builtin_amdgcn_cvt_pk_u8_f32(b + 128.f, 1, r);
    r = __builtin_amdgcn_cvt_pk_u8_f32(c + 128.f, 2, r); r = __builtin_amdgcn_cvt_pk_u8_f32(d + 128.f, 3, r);
    return r ^ 0x80808080u;
}
__device__ __forceinline__ float wave_sum(float v) {
#pragma unroll
    for (int o = 1; o < 64; o <<= 1) v += __shfl_xor(v, o);
    return v;
}

#define XB_TMO      128
#define XB_XCNT(j)  (256  + 64 * (j))
#define XB_XSUB(j)  (1280 + 64 * (j))
#define XB_XGEN(j)  (2304 + 64 * (j))
#define XB_TOP      3328
#define XB_TOPGEN   3392
#define XCD_BAR_WORDS 3456
#define XB_SPIN_CAP (1u << 20)
#define LAS __attribute__((address_space(3)))
#define TIDX(ws_) ((int)((unsigned)(ws_) * 64u + __builtin_amdgcn_mbcnt_hi(~0u, __builtin_amdgcn_mbcnt_lo(~0u, 0u))))
__device__ __forceinline__ unsigned xb_ld(unsigned* p)              { return __hip_atomic_load(p, __ATOMIC_RELAXED, __HIP_MEMORY_SCOPE_AGENT); }
__device__ __forceinline__ unsigned xb_add(unsigned* p, unsigned v) { return __hip_atomic_fetch_add(p, v, __ATOMIC_RELAXED, __HIP_MEMORY_SCOPE_AGENT); }
__device__ __forceinline__ unsigned xb_xcc_id() { return (unsigned)__builtin_amdgcn_s_getreg((3 << 11) | 20) & 0xFu; }
#define XB_SPIN(cond, bar) do { unsigned _sp = 0; while (cond) { __builtin_amdgcn_s_sleep(1); \
    if ((++_sp & 255u) == 0u) { if (xb_ld(&(bar)[XB_TMO])) break; if (_sp > XB_SPIN_CAP) { atomicAdd(&(bar)[XB_TMO], 1u); break; } } } } while (0)
struct XcdBarrier { unsigned* bar; unsigned x; volatile LAS unsigned* st; int ws; };
__device__ __forceinline__ XcdBarrier xcd_barrier_post(unsigned* bar, volatile LAS unsigned* st, int ws) {
    XcdBarrier b; b.bar = bar; b.x = xb_xcc_id(); b.st = st; b.ws = ws;
    if (TIDX(ws) == 0) (void)xb_add(&bar[XB_XCNT(b.x)], 1u);
    return b;
}
__device__ __forceinline__ void xcd_barrier_complete(unsigned* bar, unsigned x, unsigned& nloc, unsigned& nx) {
    const unsigned G = gridDim.x * gridDim.y * gridDim.z;
    unsigned sum, cnt, mine, sp = 0u;
    for (;;) {
        sum = 0u; cnt = 0u; mine = 0u;
#pragma unroll
        for (unsigned j = 0; j < 16; ++j) { const unsigned c = xb_ld(&bar[XB_XCNT(j)]); sum += c; cnt += (c > 0u) ? 1u : 0u; mine = (j == x) ? c : mine; }
        if (sum == G) break;
        __builtin_amdgcn_s_sleep(1);
        if ((++sp & 255u) == 0u) { if (xb_ld(&bar[XB_TMO])) break; if (sp > XB_SPIN_CAP) { atomicAdd(&bar[XB_TMO], 1u); break; } }
    }
    nloc = mine > 0u ? mine : 1u; nx = cnt > 0u ? cnt : 1u;
}
__device__ __forceinline__ void xcd_barrier(const XcdBarrier& b) {
    asm volatile("s_waitcnt vmcnt(0)" ::: "memory");
    __syncthreads();
    if (TIDX(b.ws) == 0) {
        unsigned* bar = b.bar;
        __builtin_amdgcn_s_waitcnt(0);
        unsigned nloc = b.st[0], nx = b.st[1];
        if (nloc == 0u) { xcd_barrier_complete(bar, b.x, nloc, nx); b.st[0] = nloc; b.st[1] = nx; }
        const unsigned old = xb_add(&bar[XB_XSUB(b.x)], 1u);
        const unsigned gen = old / nloc;
        if (old + 1u == (gen + 1u) * nloc) {
            __builtin_amdgcn_fence(__ATOMIC_RELEASE, "agent");
            asm volatile("s_waitcnt vmcnt(0)" ::: "memory");
            const unsigned og = xb_add(&bar[XB_TOP], 1u);
            const unsigned tg = og / nx;
            if (og + 1u == (tg + 1u) * nx) xb_add(&bar[XB_TOPGEN], 1u);
            else XB_SPIN(xb_ld(&bar[XB_TOPGEN]) == tg, bar);
            __builtin_amdgcn_fence(__ATOMIC_ACQUIRE, "agent");
            xb_add(&bar[XB_XGEN(b.x)], 1u);
            asm volatile("s_waitcnt vmcnt(0)" ::: "memory");
        } else {
            XB_SPIN(xb_ld(&bar[XB_XGEN(b.x)]) == gen, bar);
            __builtin_amdgcn_fence(__ATOMIC_ACQUIRE, "agent");
            asm volatile("s_waitcnt vmcnt(0)" ::: "memory");
        }
    }
    __syncthreads();
}

constexpr int G_BK = 64, G_HALF = 128, G_HT = G_HALF * G_BK;
__device__ __forceinline__ int lds_byte(int r, int c) {
    int st = (r >> 4) * 2 + (c >> 5), rr = r & 15, cc = c & 31, ob = rr * 64 + cc * 2;
    return st * 1024 + (ob ^ (((ob >> 9) & 1) << 5));
}
__device__ __forceinline__ void stage_rc(int b, int& R, int& C) {
    int st = b / 1024, sb = b % 1024, swz = sb ^ (((sb >> 9) & 1) << 5);
    R = (st >> 1) * 16 + swz / 64; C = (st & 1) * 32 + (swz % 64) / 2;
}

template <bool NOSWAP, bool I8, class A_>
__device__ __forceinline__ A_ mma1(bf16x8 a, bf16x8 b, A_ c);
template <> __device__ __forceinline__ f32x4 mma1<false, false, f32x4>(bf16x8 a, bf16x8 b, f32x4 c) { return __builtin_amdgcn_mfma_f32_16x16x32_bf16(b, a, c, 0, 0, 0); }
template <> __device__ __forceinline__ f32x4 mma1<true, false, f32x4>(bf16x8 a, bf16x8 b, f32x4 c) { return __builtin_amdgcn_mfma_f32_16x16x32_bf16(a, b, c, 0, 0, 0); }
template <> __device__ __forceinline__ i32x4 mma1<false, true, i32x4>(bf16x8 a, bf16x8 b, i32x4 c) { return __builtin_amdgcn_mfma_i32_16x16x64_i8(__builtin_bit_cast(i32x4, b), __builtin_bit_cast(i32x4, a), c, 0, 0, 0); }
template <> __device__ __forceinline__ i32x4 mma1<true, true, i32x4>(bf16x8 a, bf16x8 b, i32x4 c) { return __builtin_amdgcn_mfma_i32_16x16x64_i8(__builtin_bit_cast(i32x4, a), __builtin_bit_cast(i32x4, b), c, 0, 0, 0); }

template <bool NOSWAP, bool I8, bool F8, class A_>
__device__ __forceinline__ A_ mma2(i32x8 a, i32x8 b, A_ c) {
    if constexpr (F8) {
        if constexpr (NOSWAP) return __builtin_amdgcn_mfma_scale_f32_16x16x128_f8f6f4(a, b, c, 0, 0, 0, 0, 0, 0);
        else return __builtin_amdgcn_mfma_scale_f32_16x16x128_f8f6f4(b, a, c, 0, 0, 0, 0, 0, 0);
    } else {
        const bf16x8 a0 = __builtin_bit_cast(bf16x8, __builtin_shufflevector(a, a, 0, 1, 2, 3)), a1 = __builtin_bit_cast(bf16x8, __builtin_shufflevector(a, a, 4, 5, 6, 7));
        const bf16x8 b0 = __builtin_bit_cast(bf16x8, __builtin_shufflevector(b, b, 0, 1, 2, 3)), b1 = __builtin_bit_cast(bf16x8, __builtin_shufflevector(b, b, 4, 5, 6, 7));
        c = mma1<NOSWAP, I8, A_>(a0, b0, c);
        return mma1<NOSWAP, I8, A_>(a1, b1, c);
    }
}
struct NextTile { const bf16_t* A; const bf16_t* Bt; int lda, ldb, brow, bcol; };
template <bool VT1, bool I8, bool F8 = false, class Epi>
__device__ __forceinline__ void gemm_tile(const bf16_t* __restrict__ A, int lda, const bf16_t* __restrict__ Bt, int ldb, int nt,
                                          int brow, int bcol, char* shmc, const Epi& epi, bool pre, const NextTile nx, int ws_) {
    bf16_t* shm = (bf16_t*)shmc;
    asm volatile("" : "+s"(nt));
#define SA(b,h) (shm+((b)*2+(h))*G_HT)
#define SB(b,h) (shm+(4+(b)*2+(h))*G_HT)
#define STAGE_X(OFF,LOFF,P,RS,LD,br,kt) do{ const int _so=((br)*(LD)+(kt)*G_BK)*2; \
    __builtin_amdgcn_raw_ptr_buffer_load_lds(RS, (__attribute__((address_space(3))) void*)((char*)(P)+(LOFF)),16,(int)(OFF),_so,0,0); \
    __builtin_amdgcn_raw_ptr_buffer_load_lds(RS, (__attribute__((address_space(3))) void*)((char*)(P)+(LOFF)+8192),16,(int)(OFF),_so+128*(LD),0,0);}while(0)
#define STAGE_A(P,br,kt) STAGE_X(offA,lwv,P,rsA,lda,br,kt)
#define STAGE_B(P,br,kt) STAGE_X(offB,lwv,P,rsB,ldb,br,kt)
#define LDF(base_,off_) (*reinterpret_cast<const i32x4*>((base_)+(off_)))
#define LDA(dst,b,h) _Pragma("unroll") for(int m=0;m<4;++m) \
    dst[m]=__builtin_shufflevector(LDF(fa_base,((b)*2+(h))*16384+m*2048),LDF(fa_base,((b)*2+(h))*16384+m*2048+1024),0,1,2,3,4,5,6,7)
#define LDB(dst,b,h) _Pragma("unroll") for(int n=0;n<2;++n) \
    dst[n]=__builtin_shufflevector(LDF(fb_base,((b)*2+(h))*16384+n*2048),LDF(fb_base,((b)*2+(h))*16384+n*2048+1024),0,1,2,3,4,5,6,7)
#define MMA(ai,bj,At_,Bt_) do{__builtin_amdgcn_s_setprio(1); \
    _Pragma("unroll") for(int m=0;m<4;++m) _Pragma("unroll") for(int n=0;n<2;++n) \
      acc[ai][bj][m][n]=mma2<VT1 && (bj)==1, I8, F8, typename AccT<I8>::type>(At_[m],Bt_[n],acc[ai][bj][m][n]); \
    __builtin_amdgcn_s_setprio(0);}while(0)
#define WAIT_V(n) asm volatile("s_waitcnt vmcnt(" #n ")":::"memory")
#define WAIT_L(n) asm volatile("s_waitcnt lgkmcnt(" #n ")":::"memory")
#define BAR __builtin_amdgcn_s_barrier()
#define SCHED __builtin_amdgcn_sched_barrier(0)
    int t0 = TIDX(ws_); asm volatile("" : "+v"(t0));
    int wid = t0 >> 6, lane = t0 & 63, wr = wid >> 2, wc = wid & 3, fr = lane & 15, fq = lane >> 4;
    typename AccT<I8>::type acc[2][2][4][2] = {};
    const char* fa_base = (const char*)shm + lds_byte(wr * 64 + fr, fq * 8);
    const char* fb_base = (const char*)shm + 65536 + lds_byte(wc * 32 + fr, fq * 8);
    i32x8 At[4], B0[2], B1[2];
    int loff = t0 * 16;
    const int lwv = __builtin_amdgcn_readfirstlane(t0 >> 6) * 1024;
    unsigned offA, offB;
    const __amdgpu_buffer_rsrc_t rsA = __builtin_amdgcn_make_buffer_rsrc((void*)A, (short)0, -1, 0x00020000);
    const __amdgpu_buffer_rsrc_t rsB = __builtin_amdgcn_make_buffer_rsrc((void*)Bt, (short)0, -1, 0x00020000);
    { int r_, c_; stage_rc(loff, r_, c_); offA = (unsigned)(r_ * lda + c_) * 2;
      const int i_ = r_ & 15, n_ = (r_ >> 4) & 1;
      offB = (unsigned)(((r_ & ~31) + 8 * (i_ >> 2) + 4 * n_ + (i_ & 3)) * ldb + c_) * 2; }
    if (!pre) {
        STAGE_B(SB(0,0),bcol,0); STAGE_A(SA(0,0),brow,0);
        STAGE_B(SB(0,1),bcol+G_HALF,0); STAGE_A(SA(0,1),brow+G_HALF,0);
        if (wr == 1) BAR;
        WAIT_V(4); BAR;
        STAGE_B(SB(1,0),bcol,1); STAGE_A(SA(1,0),brow,1); STAGE_B(SB(1,1),bcol+G_HALF,1);
        WAIT_V(6); BAR;
    } else {
        if (wr == 1) BAR;
        WAIT_V(4); BAR;
        BAR;
    }
    for (int t = 0; t < nt - 2; t += 2) {
        LDB(B0,0,0); SCHED; LDA(At,0,0); STAGE_A(SA(1,1),brow+G_HALF,t+1);
        WAIT_L(8); BAR; WAIT_L(0); MMA(0,0,At,B0); BAR; SCHED;
        LDB(B1,0,1); STAGE_B(SB(0,0),bcol,t+2);
        BAR; WAIT_L(0); MMA(0,1,At,B1); BAR;
        LDA(At,0,1); STAGE_A(SA(0,0),brow,t+2);
        BAR; WAIT_L(0); MMA(1,0,At,B0); BAR; SCHED;
        STAGE_B(SB(0,1),bcol+G_HALF,t+2);
        WAIT_V(6); BAR; MMA(1,1,At,B1); BAR;
        LDB(B0,1,0); SCHED; LDA(At,1,0); STAGE_A(SA(0,1),brow+G_HALF,t+2);
        WAIT_L(8); BAR; WAIT_L(0); MMA(0,0,At,B0); BAR; SCHED;
        LDB(B1,1,1); STAGE_B(SB(1,0),bcol,t+3);
        BAR; WAIT_L(0); MMA(0,1,At,B1); BAR;
        LDA(At,1,1); STAGE_A(SA(1,0),brow,t+3);
        BAR; WAIT_L(0); MMA(1,0,At,B0); BAR; SCHED;
        STAGE_B(SB(1,1),bcol+G_HALF,t+3);
        WAIT_V(6); BAR; MMA(1,1,At,B1); BAR;
    }
    int tz = TIDX(ws_); asm volatile("" : "+v"(tz)); wid = tz >> 6; lane = tz & 63; wr = wid >> 2; wc = wid & 3; fr = lane & 15; fq = lane >> 4;
    loff = tz * 16;
    fa_base = (const char*)shm + lds_byte(wr * 64 + fr, fq * 8); fb_base = (const char*)shm + 65536 + lds_byte(wc * 32 + fr, fq * 8);
    { int r_, c_; stage_rc(loff, r_, c_); offA = (unsigned)(r_ * lda + c_) * 2; }
    { LDB(B0,0,0); WAIT_V(0); LDA(At,0,0); STAGE_A(SA(1,1),brow+G_HALF,nt-1);
      BAR; WAIT_L(0); MMA(0,0,At,B0); BAR;
      LDB(B1,0,1); BAR; WAIT_L(0); MMA(0,1,At,B1); BAR;
      LDA(At,0,1); WAIT_V(4); BAR; WAIT_L(0); MMA(1,0,At,B0); MMA(1,1,At,B1); BAR; }
    { LDB(B0,1,0); LDA(At,1,0); WAIT_V(2); BAR; WAIT_L(0); MMA(0,0,At,B0); BAR;
      LDB(B1,1,1); WAIT_V(0); BAR; WAIT_L(0); MMA(0,1,At,B1); BAR;
      LDA(At,1,1); BAR; WAIT_L(0); MMA(1,0,At,B0); MMA(1,1,At,B1); BAR; }
    if (wr == 0) BAR;
    { int te = TIDX(ws_); asm volatile("" : "+v"(te)); wid = te >> 6; lane = te & 63; wr = wid >> 2; wc = wid & 3; fr = lane & 15; fq = lane >> 4; loff = te * 16; }
    if (nx.brow >= 0) {
        int r_, c_; stage_rc(loff, r_, c_);
        const int i_ = r_ & 15, n_ = (r_ >> 4) & 1;
        const unsigned offA2 = (unsigned)(r_ * nx.lda + c_) * 2;
        const unsigned offB2 = (unsigned)(((r_ & ~31) + 8 * (i_ >> 2) + 4 * n_ + (i_ & 3)) * nx.ldb + c_) * 2;
        const __amdgpu_buffer_rsrc_t rsA2 = __builtin_amdgcn_make_buffer_rsrc((void*)nx.A, (short)0, -1, 0x00020000);
        const __amdgpu_buffer_rsrc_t rsB2 = __builtin_amdgcn_make_buffer_rsrc((void*)nx.Bt, (short)0, -1, 0x00020000);
#define NXT_A(P,h,k) STAGE_X(offA2,lwv,P,rsA2,nx.lda,nx.brow+(h),k)
#define NXT_B(P,h,k) STAGE_X(offB2,lwv,P,rsB2,nx.ldb,nx.bcol+(h),k)
        NXT_B(SB(0,0),0,0); NXT_A(SA(0,0),0,0); NXT_B(SB(0,1),G_HALF,0); NXT_A(SA(0,1),G_HALF,0);
        NXT_B(SB(1,0),0,1); NXT_A(SA(1,0),0,1); NXT_B(SB(1,1),G_HALF,1);
#undef NXT_A
#undef NXT_B
    }
#pragma unroll
    for (int ai = 0; ai < 2; ++ai)
#pragma unroll
    for (int m = 0; m < 4; ++m) {
#pragma unroll
        for (int bj = 0; bj < 2; ++bj) {
            if (VT1 && bj == 1) {
#pragma unroll
                for (int n = 0; n < 2; ++n)
                    epi.storeT(brow + ai * G_HALF + wr * 64 + m * 16 + fq * 4, bcol + bj * G_HALF + wc * 32 + 8 * (fr >> 2) + 4 * n + (fr & 3), fq, acc[ai][bj][m][n]);
            } else {
                epi.store8(brow + ai * G_HALF + wr * 64 + m * 16 + fr, bcol + bj * G_HALF + wc * 32 + fq * 8, acc[ai][bj][m][0], acc[ai][bj][m][1]);
            }
        }
        asm volatile("" ::: "memory");
    }
    __syncthreads();
#undef SA
#undef SB
#undef STAGE_X
#undef STAGE_A
#undef STAGE_B
#undef LDA
#undef LDF
#undef LDB
#undef MMA
#undef WAIT_V
#undef WAIT_L
#undef BAR
#undef SCHED
}

__device__ __forceinline__ void st4bf(bf16_t* p, f32x4 v) {
    u32x2 o; o.x = pk2(v[0], v[1]); o.y = pk2(v[2], v[3]); *reinterpret_cast<u32x2*>(p) = o;
}
__device__ __forceinline__ void st8bf(bf16_t* p, f32x4 a, f32x4 b) {
    u32x4 o; o.x = pk2(a[0], a[1]); o.y = pk2(a[2], a[3]); o.z = pk2(b[0], b[1]); o.w = pk2(b[2], b[3]); *reinterpret_cast<u32x4*>(p) = o;
}
struct EpiBf16 {
    bf16_t* C; int ldc; float sc;
    __device__ __forceinline__ void store8(int row, int col, f32x4 a, f32x4 b) const { st8bf(C + (size_t)row * ldc + col, a * sc, b * sc); }
    __device__ __forceinline__ void storeT(int, int, int, f32x4) const {}
};
struct EpiI8 {
    bf16_t* C; int ldc; const float* rs; const float* cs;
    __device__ __forceinline__ void store8(int row, int col, i32x4 a, i32x4 b) const {
        const float r = rs[row];
        const f32x4 c0 = *reinterpret_cast<const f32x4*>(cs + col), c1 = *reinterpret_cast<const f32x4*>(cs + col + 4);
        f32x4 fa = {(float)a[0], (float)a[1], (float)a[2], (float)a[3]}, fb = {(float)b[0], (float)b[1], (float)b[2], (float)b[3]};
        st8bf(C + (size_t)row * ldc + col, fa * c0 * r, fb * c1 * r);
    }
    __device__ __forceinline__ void storeT(int, int, int, i32x4) const {}
};
struct EpiPool {
    bf16_t* C; const float* scale; int gcol0;
    __device__ __forceinline__ void store8(int row, int col, f32x4 a, f32x4 b) const {
        f32x4 s0 = *reinterpret_cast<const f32x4*>(scale + gcol0 + col), s1 = *reinterpret_cast<const f32x4*>(scale + gcol0 + col + 4);
        a = a * s0; b = b * s1;
        u32x2 w = {(unsigned)pk_fp8x4(a[0], a[1], a[2], a[3]), (unsigned)pk_fp8x4(b[0], b[1], b[2], b[3])};
        *reinterpret_cast<u32x2*>((char*)C + (size_t)row * DM + gcol0 + col) = w;
    }
    __device__ __forceinline__ void storeT(int, int, int, f32x4) const {}
};
struct EpiQ {
    bf16_t* C; const float* rstd;
    __device__ __forceinline__ void store8(int row, int col, f32x4 a, f32x4 b) const {
        float s = rstd[row] * (0.07216878364870322f * 1.4426950408889634f);
        st8bf(C + (size_t)row * 1536 + col, a * s, b * s);
    }
    __device__ __forceinline__ void storeT(int, int, int, f32x4) const {}
};
struct EpiKV {
    bf16_t* Kn; bf16_t* Vt; const float* rstd;
    __device__ __forceinline__ void store8(int row, int col, f32x4 a, f32x4 b) const {
        int head = col >> 8, d = col & 127; float r = rstd[row];
        u32x2 w = {(unsigned)pk_fp8x4(a[0] * r, a[1] * r, a[2] * r, a[3] * r), (unsigned)pk_fp8x4(b[0] * r, b[1] * r, b[2] * r, b[3] * r)};
        *reinterpret_cast<u32x2*>((char*)Kn + (size_t)row * 1024 + head * 128 + d) = w;
    }
    __device__ __forceinline__ void storeT(int row0, int col, int fq, f32x4 v) const {
        int head = col >> 8, d = col & 127, b = row0 >> 11, s = row0 & 2047;
        f32x4 r = *reinterpret_cast<const f32x4*>(rstd + row0);
        const int kk = s & 63;
        const int pos = (s & ~63) + 32 * ((kk >> 2) & 1) + 16 * (kk >> 5) + 4 * ((kk & 31) >> 3);
        *reinterpret_cast<int*>((char*)Vt + ((size_t)((b * 8 + head) * 128 + d)) * SEQ + pos) = pk_fp8x4(v[0] * r[0], v[1] * r[1], v[2] * r[2], v[3] * r[3]);
    }
};

__device__ __forceinline__ int vcu_of(int bid, int nb) { return (nb % 8 == 0) ? (bid % 8) * (nb / 8) + bid / 8 : bid; }

__device__ __forceinline__ void xpose_item(const float* __restrict__ W, int K, int N, bf16_t* __restrict__ WT, int ldt, float* scr, int item, int lane,
                                           const float* __restrict__ rowscale) {
    const int nblk = N / 32, kb = item / nblk, nb = item % nblk, k0 = 64 * kb, n0 = 32 * nb;
#pragma unroll 8
    for (int i = 0; i < 32; ++i) {
        const int kk = 2 * i + (lane >> 5);
        float w = W[(size_t)(k0 + kk) * N + n0 + (lane & 31)];
        if (rowscale) w *= rowscale[k0 + kk];
        scr[kk * 33 + (lane & 31)] = w;
    }
    __builtin_amdgcn_s_waitcnt(0xc07f); asm volatile("" ::: "memory");
    const int c = lane & 7;
#pragma unroll
    for (int j = 0; j < 4; ++j) {
        const int n = (lane >> 3) + 8 * j; const float* s = scr + (8 * c) * 33 + n;
        u32x4 o; o.x = pk2(s[0 * 33], s[1 * 33]); o.y = pk2(s[2 * 33], s[3 * 33]); o.z = pk2(s[4 * 33], s[5 * 33]); o.w = pk2(s[6 * 33], s[7 * 33]);
        *reinterpret_cast<u32x4*>(WT + (size_t)(n0 + n) * ldt + k0 + 8 * c) = o;
    }
    __builtin_amdgcn_s_waitcnt(0xc07f); asm volatile("" ::: "memory");
}
__device__ __forceinline__ void xposef8_item(const float* __restrict__ W, int K, int N, char* __restrict__ WT8, int ldt, float* scr, int item, int lane, float mul) {
    const int nblk = N / 32, kb = item / nblk, nb = item % nblk, k0 = 64 * kb, n0 = 32 * nb;
#pragma unroll 8
    for (int i = 0; i < 32; ++i) {
        const int kk = 2 * i + (lane >> 5);
        scr[kk * 33 + (lane & 31)] = W[(size_t)(k0 + kk) * N + n0 + (lane & 31)] * mul;
    }
    __builtin_amdgcn_s_waitcnt(0xc07f); asm volatile("" ::: "memory");
    const int c = lane & 7;
#pragma unroll
    for (int j = 0; j < 4; ++j) {
        const int n = (lane >> 3) + 8 * j; const float* s = scr + (8 * c) * 33 + n;
        u32x2 o;
        o.x = (unsigned)pk_fp8x4(s[0 * 33], s[1 * 33], s[2 * 33], s[3 * 33]); o.y = (unsigned)pk_fp8x4(s[4 * 33], s[5 * 33], s[6 * 33], s[7 * 33]);
        *reinterpret_cast<u32x2*>(WT8 + (size_t)(n0 + n) * ldt + k0 + 8 * c) = o;
    }
    __builtin_amdgcn_s_waitcnt(0xc07f); asm volatile("" ::: "memory");
}
__device__ __forceinline__ void xpose8_item(const float* __restrict__ W, int N, char* __restrict__ WT8, float* scr, int item, int lane,
                                            const unsigned* __restrict__ cmax, float* __restrict__ wsc) {
    const int nblk = N / 32, kb = item / nblk, nb = item % nblk, k0 = 64 * kb, n0 = 32 * nb;
    const float cm = __uint_as_float(cmax[n0 + (lane & 31)]);
    const float qm = cm > 0.f ? 127.f / cm : 0.f;
    if (kb == 0 && lane < 32) wsc[n0 + lane] = cm * (1.f / 127.f);
#pragma unroll 8
    for (int i = 0; i < 32; ++i) {
        const int kk = 2 * i + (lane >> 5);
        scr[kk * 33 + (lane & 31)] = W[(size_t)(k0 + kk) * N + n0 + (lane & 31)] * qm;
    }
    __builtin_amdgcn_s_waitcnt(0xc07f); asm volatile("" ::: "memory");
    const int c = lane & 7;
#pragma unroll
    for (int j = 0; j < 4; ++j) {
        const int n = (lane >> 3) + 8 * j; const float* s = scr + (8 * c) * 33 + n;
        u32x2 o;
        o.x = pack_i8x4(s[0 * 33], s[1 * 33], s[2 * 33], s[3 * 33]); o.y = pack_i8x4(s[4 * 33], s[5 * 33], s[6 * 33], s[7 * 33]);
        *reinterpret_cast<u32x2*>(WT8 + (size_t)(n0 + n) * 2048 + k0 + 8 * c) = o;
    }
    __builtin_amdgcn_s_waitcnt(0xc07f); asm volatile("" ::: "memory");
}
__device__ __forceinline__ void cvt_bf16_range(const float* __restrict__ src, bf16_t* __restrict__ dst, size_t n8, size_t gtid, size_t gthreads) {
    for (size_t i = gtid; i < n8; i += gthreads) {
        f32x4 a = *reinterpret_cast<const f32x4*>(src + i * 8), b = *reinterpret_cast<const f32x4*>(src + i * 8 + 4);
        u32x4 o; o.x = pk2(a[0], a[1]); o.y = pk2(a[2], a[3]); o.z = pk2(b[0], b[1]); o.w = pk2(b[2], b[3]);
        *reinterpret_cast<u32x4*>(dst + i * 8) = o;
    }
}
__device__ __forceinline__ void phase0(const Params& p, char* shm, int bid, int nb) {
    const int tid = TIDX(p.wave_s), wave = tid >> 6, lane = tid & 63;
    char* ws = p.ws;
#ifndef DUP_P0
#define DUP_P0 (-1)
#endif
    for (int rp_ = 0; rp_ < (DUP_P0 == 0 ? 2 : 1); ++rp_)
    {
        float* sl = (float*)shm;
        float* red = (float*)(shm + 65536);
        float* mod = (float*)(ws + WS_MOD);
        if (bid < 192 || nb != 256) {
            for (int i = tid; i < 8 * DM; i += NTHREADS) { float cv = p.c[i]; sl[i] = cv / (1.f + __expf(-cv)); }
            __syncthreads();
            for (int it = bid; it < 192; it += nb) {
                const int col = it * 64 + lane;
                float acc[8];
#pragma unroll
                for (int b = 0; b < 8; ++b) acc[b] = 0.f;
                const float* wp = p.ada_w + (size_t)(wave * 256) * 12288 + col;
                const float* sp = sl + wave * 256;
#pragma unroll 1
                for (int r0 = 0; r0 < 256; r0 += 32) {
                    float w[32];
#pragma unroll
                    for (int i = 0; i < 32; ++i) w[i] = wp[(size_t)(r0 + i) * 12288];
#pragma unroll
                    for (int q = 0; q < 8; ++q)
#pragma unroll
                        for (int b = 0; b < 8; ++b) {
                            const f32x4 s4 = *reinterpret_cast<const f32x4*>(sp + b * DM + r0 + 4 * q);
                            acc[b] += w[4 * q] * s4[0] + w[4 * q + 1] * s4[1] + w[4 * q + 2] * s4[2] + w[4 * q + 3] * s4[3];
                        }
                }
#pragma unroll
                for (int b = 0; b < 8; ++b) red[(wave * 8 + b) * 64 + lane] = acc[b];
                __syncthreads();
                {
                    const int b = tid >> 6, cl = tid & 63;
                    float sum = 0.f;
#pragma unroll
                    for (int w = 0; w < 8; ++w) sum += red[(w * 8 + b) * 64 + cl];
                    mod[b * 12288 + it * 64 + cl] = sum + p.ada_b[it * 64 + cl];
                }
                __syncthreads();
            }
        }
    }
    const int gw = bid * NWAVES + wave, ngw = nb * NWAVES;
    const size_t gtid = (size_t)bid * NTHREADS + tid, gthreads = (size_t)nb * NTHREADS;
    for (int rp_ = 0; rp_ < (DUP_P0 == 1 ? 2 : 1); ++rp_)
    {
        float* scr = (float*)(shm + wave * 8448);
        constexpr int I_POOL = 4 * 4 * 8, I_UQ = 8 * 48, I_UKV = 4 * 64, I_OUT = 32 * 64;
        constexpr int NIT = I_POOL + I_UQ + I_UKV + I_OUT;
        for (int it = gw; it < NIT; it += ngw) {
            int r = it;
            if (r < I_POOL) { int g = r / 32; xpose_item(p.pool_w + g * 65536, 256, 256, (bf16_t*)(ws + WS_WPOOL) + g * 65536, 256, scr, r % 32, lane, nullptr); continue; } r -= I_POOL;
            if (r < I_UQ) { xpose_item(p.w_uq, 512, 1536, (bf16_t*)(ws + WS_WUQ), 512, scr, r, lane, p.q_norm_g); continue; } r -= I_UQ;
            if (r < I_UKV) { xpose_item(p.w_ukv, 256, 2048, (bf16_t*)(ws + WS_WUKV), 256, scr, r, lane, p.kv_norm_g); continue; } r -= I_UKV;
            xposef8_item(p.w_out, 2048, 2048, ws + WS_WOUT, 2048, scr, r, lane, 32.f);
        }
        unsigned* cmax = (unsigned*)(ws + WS_CMAX);
        for (int it = gw; it < (29 + 32) * 16; it += ngw) {
            const int strip = it >> 4, kc = it & 15;
            const bool isq = strip >= 29;
            const int n = (isq ? strip - 29 : strip) * 64 + lane, N = isq ? 2048 : 1856;
            const float* wp = (isq ? p.peer_wq : p.w_in) + (size_t)(kc * 128) * N + n;
            float m = 0.f;
#pragma unroll 32
            for (int r = 0; r < 128; ++r) m = fmaxf(m, fabsf(wp[(size_t)r * N]));
            atomicMax(cmax + (isq ? 2048 : 0) + n, __float_as_uint(m));
        }
    }
    cvt_bf16_range(p.sub_keys, (bf16_t*)(ws + WS_SK), 262144 / 8, gtid, gthreads);
    for (int rp_ = 0; rp_ < (DUP_P0 == 2 ? 2 : 1); ++rp_)
    {
        float* tile = (float*)shm;
        float* redm = (float*)(shm + 16 * 2052 * 4);
        float* scl = redm + 128;
        int ntl, tfirst, tstep;
        if (nb == 256) { if (bid < 192) { ntl = 7; tfirst = bid * 7; } else { ntl = 11; tfirst = 192 * 7 + (bid - 192) * 11; } tstep = 1; }
        else { ntl = (2048 - bid + nb - 1) / nb; tfirst = bid; tstep = nb; }
#define Q_LOAD(dst, i_) do { const int itl_ = tfirst + (i_) * tstep; \
            const float* src_ = ((itl_ >> 10) ? p.peer_v : p.peer_u) + (size_t)((itl_ & 1023) * 16) * DM; \
            _Pragma("unroll") for (int k = 0; k < 16; ++k) dst[k] = *reinterpret_cast<const f32x4*>(reinterpret_cast<const char*>(src_ + (size_t)k * DM) + qoff); } while (0)
#define Q_TILE(vs, i_) do { \
            const int it = tfirst + (i_) * tstep; \
            const int isv = it >> 10, e0 = (it & 1023) * 16; \
            float mx[16]; \
            _Pragma("unroll") for (int k = 0; k < 16; ++k) { \
                *reinterpret_cast<f32x4*>(tile + k * 2052 + tid * 4) = vs[k]; \
                mx[k] = fmaxf(fmaxf(fabsf(vs[k][0]), fabsf(vs[k][1])), fmaxf(fabsf(vs[k][2]), fabsf(vs[k][3]))); \
            } \
            if ((i_) + 1 < ntl) Q_LOAD(vs, (i_) + 1); \
            _Pragma("unroll") for (int k = 0; k < 16; ++k) { \
                _Pragma("unroll") for (int o = 1; o < 64; o <<= 1) mx[k] = fmaxf(mx[k], __shfl_xor(mx[k], o)); \
            } \
            if (lane == 0) { _Pragma("unroll") for (int k = 0; k < 16; ++k) redm[wave * 16 + k] = mx[k]; } \
            __syncthreads(); \
            if (tid < 16) { \
                float m = 0.f; \
                _Pragma("unroll") for (int w = 0; w < 8; ++w) m = fmaxf(m, redm[w * 16 + tid]); \
                const float top = isv ? 256.f : 127.f; \
                scl[tid] = m > 0.f ? top / m : 0.f; \
                ((float*)(ws + (isv ? WS_SV : WS_SU)))[e0 + tid] = m / top; \
            } \
            __syncthreads(); \
            char* dst = ws + (isv ? WS_V8 : WS_U8); \
            _Pragma("unroll") for (int k = 0; k < 8; ++k) { \
                const int item = tid + k * NTHREADS, e = item & 15, sl = item >> 4; \
                const float* tp = tile + e * 2052 + sl * 8; \
                f32x4 a = *reinterpret_cast<const f32x4*>(tp), c = *reinterpret_cast<const f32x4*>(tp + 4); \
                const float m = scl[e]; \
                u32x2 o; \
                if (isv) { \
                    int w0 = __builtin_amdgcn_cvt_pk_fp8_f32(a[0] * m, a[1] * m, 0, false); \
                    w0 = __builtin_amdgcn_cvt_pk_fp8_f32(a[2] * m, a[3] * m, w0, true); \
                    int w1 = __builtin_amdgcn_cvt_pk_fp8_f32(c[0] * m, c[1] * m, 0, false); \
                    w1 = __builtin_amdgcn_cvt_pk_fp8_f32(c[2] * m, c[3] * m, w1, true); \
                    o.x = (unsigned)w0; o.y = (unsigned)w1; \
                } else { \
                    o.x = pack_i8x4(a[0] * m, a[1] * m, a[2] * m, a[3] * m); o.y = pack_i8x4(c[0] * m, c[1] * m, c[2] * m, c[3] * m); \
                } \
                *reinterpret_cast<u32x2*>(dst + ((size_t)sl * 16384 + e0 + e) * 8) = o; \
                if (k & 1) __builtin_amdgcn_sched_barrier(0); \
            } \
            __syncthreads(); } while (0)
        f32x4 va[16];
        const unsigned qoff = (unsigned)tid * 16u;
        Q_LOAD(va, 0);
        __syncthreads();
#pragma unroll 1
        for (int i = 0; i < ntl; ++i) Q_TILE(va, i);
#undef Q_LOAD
#undef Q_TILE
    }
    {
        float2* cs = (float2*)(ws + WS_CS);
        for (size_t i = gtid; i < (size_t)NTOK * 32; i += gthreads) {
            int t = (int)(i >> 5), k = (int)(i & 31);
            float invf = exp2f(-(float)k * (13.287712379549449f / 32.f));
            float ang = (float)p.pos[t] * invf;
            double sd, cd; sincos((double)ang, &sd, &cd);
            cs[i] = make_float2((float)cd, (float)sd);
        }
    }
}

__device__ __forceinline__ void phase1(const Params& p, char* shm, int bid, int nb) {
    const int tid = TIDX(p.wave_s), wave = tid >> 6, lane = tid & 63;
    const float* mod = (const float*)(p.ws + WS_MOD);
    char* h1 = p.ws + WS_BUF1;
    float* sh1 = (float*)(p.ws + WS_SH1);
    float* lv = (float*)shm;
    for (int item = bid; item < NTOK / 64; item += nb) {
        const int b = item >> 5;
        __syncthreads();
        for (int i = tid; i < 512; i += NTHREADS) {
            *reinterpret_cast<f32x4*>(lv + 0 * DM + i * 4) = *reinterpret_cast<const f32x4*>(p.pre_mix_g + i * 4);
            *reinterpret_cast<f32x4*>(lv + 1 * DM + i * 4) = *reinterpret_cast<const f32x4*>(mod + b * 12288 + i * 4);
            *reinterpret_cast<f32x4*>(lv + 2 * DM + i * 4) = *reinterpret_cast<const f32x4*>(mod + b * 12288 + 2048 + i * 4);
        }
        __syncthreads();
#pragma unroll 1
        for (int rr = 0; rr < 8; ++rr) {
            const int row = item * 64 + rr * 8 + wave;
            const float* xr = p.x + (size_t)row * DM + lane * 4;
            f32x4 v[8]; float ss = 0.f;
#pragma unroll
            for (int i = 0; i < 8; ++i) { v[i] = *reinterpret_cast<const f32x4*>(xr + i * 256); ss += v[i][0] * v[i][0] + v[i][1] * v[i][1] + v[i][2] * v[i][2] + v[i][3] * v[i][3]; }
            const float rstd = rsqrtf(wave_sum(ss) * (1.f / DM) + EPS);
            float hmax = 0.f;
#pragma unroll
            for (int i = 0; i < 8; ++i) {
                const int col = i * 256 + lane * 4;
                f32x4 g = *reinterpret_cast<const f32x4*>(lv + col);
                f32x4 sh = *reinterpret_cast<const f32x4*>(lv + DM + col);
                f32x4 sc = *reinterpret_cast<const f32x4*>(lv + 2 * DM + col);
                v[i] = v[i] * rstd * g * (sc + 1.f) + sh;
                hmax = fmaxf(hmax, fmaxf(fmaxf(fabsf(v[i][0]), fabsf(v[i][1])), fmaxf(fabsf(v[i][2]), fabsf(v[i][3]))));
            }
#pragma unroll
            for (int o = 1; o < 64; o <<= 1) hmax = fmaxf(hmax, __shfl_xor(hmax, o));
            const float qm = hmax > 0.f ? 127.f / hmax : 0.f;
            if (lane == 0) sh1[row] = hmax * (1.f / 127.f);
#pragma unroll
            for (int i = 0; i < 8; ++i) {
                *reinterpret_cast<unsigned*>(h1 + (size_t)row * DM + i * 256 + lane * 4) = pack_i8x4(v[i][0] * qm, v[i][1] * qm, v[i][2] * qm, v[i][3] * qm);
            }
        }
    }
    {
        __syncthreads();
        float* scr = (float*)(shm + wave * 8448);
        const unsigned* cmax = (const unsigned*)(p.ws + WS_CMAX);
        float* wsc = (float*)(p.ws + WS_WSC);
        const int gw = bid * NWAVES + wave, ngw = nb * NWAVES;
        constexpr int I_IN = 32 * 58, I_PQ = 32 * 64;
        for (int it = gw; it < I_IN + I_PQ; it += ngw) {
            if (it < I_IN) xpose8_item(p.w_in, 1856, p.ws + WS_WIN, scr, it, lane, cmax, wsc);
            else xpose8_item(p.peer_wq, 2048, p.ws + WS_WPQ, scr, it - I_IN, lane, cmax + 2048, wsc + 2048);
        }
        const size_t gtid = (size_t)bid * NTHREADS + tid, gthreads = (size_t)nb * NTHREADS;
        for (size_t i = gtid; i < 24576; i += gthreads) *reinterpret_cast<u32x4*>(p.ws + WS_WIN + (size_t)1856 * 2048 + i * 16) = u32x4{0u, 0u, 0u, 0u};
        for (size_t i = gtid; i < 192; i += gthreads) wsc[1856 + i] = 0.f;
        __syncthreads();
    }
}

template <bool VT1, bool I8, bool F8 = false, class Epi>
__device__ __forceinline__ void gemm_phase(const bf16_t* A, int lda, const bf16_t* Bt, int ldb, int K, int nN, int ntiles, int tile0, int vcu, int nb,
                                           char* shm, const Epi& epi, int ws_) {
    int first = ((vcu - tile0) % nb + nb) % nb;
    bool pre = false;
    for (int t = first; t < ntiles; t += nb) {
        const int pm = t / nN, pn = t % nN;
        const int tn = t + nb;
        const bool has = tn < ntiles;
        const NextTile nx{A, Bt, lda, ldb, has ? (tn / nN) * 256 : -1, (tn % nN) * 256};
        gemm_tile<VT1, I8, F8>(A, lda, Bt, ldb, K / 64, pm * 256, pn * 256, shm, epi, pre, nx, ws_);
        pre = has;
    }
}

__device__ __forceinline__ void phase3(const Params& p, int bid, int nb) {
    const int tid = TIDX(p.wave_s), wave = tid >> 6, lane = tid & 63;
    const bf16_t* proj = (const bf16_t*)(p.ws + WS_BUF2);
    bf16_t* z = (bf16_t*)(p.ws + WS_Z);
    for (int it = bid * NTHREADS + tid; it < 1024 * 128; it += nb * NTHREADS) {
        const int strip = it >> 7, c8 = it & 127, g = c8 >> 5, w = 2 << g;
        const int t0 = strip * 16, s0 = t0 & 2047;
        const bf16_t* up = proj + (size_t)t0 * DM + c8 * 8;
        float sum[8];
#pragma unroll
        for (int j = 0; j < 8; ++j) sum[j] = 0.f;
        for (int i = 1; i <= w; ++i) {
            if (s0 - i >= 0) {
                u32x4 r = *reinterpret_cast<const u32x4*>(up - (ptrdiff_t)i * DM);
#pragma unroll
                for (int j = 0; j < 4; ++j) { sum[2 * j] += bflo(r[j]); sum[2 * j + 1] += bfhi(r[j]); }
            }
        }
        for (int tt = 0; tt < 16; ++tt) {
            const int s = s0 + tt;
            u32x4 r = *reinterpret_cast<const u32x4*>(up + (size_t)tt * DM);
            float cur[8];
#pragma unroll
            for (int j = 0; j < 4; ++j) { cur[2 * j] = bflo(r[j]); cur[2 * j + 1] = bfhi(r[j]); }
#pragma unroll
            for (int j = 0; j < 8; ++j) sum[j] += cur[j];
            if (s >= w) {
                u32x4 o = *reinterpret_cast<const u32x4*>(up + (ptrdiff_t)(tt - w) * DM);
#pragma unroll
                for (int j = 0; j < 4; ++j) { sum[2 * j] -= bflo(o[j]); sum[2 * j + 1] -= bfhi(o[j]); }
            }
            const float inv = 1.f / (float)min(s + 1, w);
            u32x4 o;
#pragma unroll
            for (int j = 0; j < 4; ++j) o[j] = pk2(sum[2 * j] * inv - cur[2 * j], sum[2 * j + 1] * inv - cur[2 * j + 1]);
            *reinterpret_cast<u32x4*>(z + (size_t)(t0 + tt) * 1024 + c8 * 8) = o;
        }
    }
    float* rq = (float*)(p.ws + WS_RSTDQ); float* rkv = (float*)(p.ws + WS_RSTDKV);
    bf16_t* kpe = (bf16_t*)(p.ws + WS_KPE);
    const float2* cs = (const float2*)(p.ws + WS_CS);
    for (int t = bid * NWAVES + wave; t < NTOK; t += nb * NWAVES) {
        const bf16_t* pr = proj + (size_t)t * DM;
        u32x4 a = *reinterpret_cast<const u32x4*>(pr + 1024 + lane * 8);
        float s1 = 0.f;
#pragma unroll
        for (int j = 0; j < 4; ++j) { float lo = bflo(a[j]), hi = bfhi(a[j]); s1 += lo * lo + hi * hi; }
        u32x2 bq = *reinterpret_cast<const u32x2*>(pr + 1536 + lane * 4);
        float s2 = 0.f;
#pragma unroll
        for (int j = 0; j < 2; ++j) { float lo = bflo(bq[j]), hi = bfhi(bq[j]); s2 += lo * lo + hi * hi; }
        s1 = wave_sum(s1); s2 = wave_sum(s2);
        if (lane == 0) { rq[t] = rsqrtf(s1 * (1.f / 512.f) + EPS); rkv[t] = rsqrtf(s2 * (1.f / 256.f) + EPS); }
        if (lane < 32) {
            float x1 = bf2f((short)pr[1792 + lane]), x2 = bf2f((short)pr[1792 + 32 + lane]);
            float2 c = cs[(size_t)t * 32 + lane];
            unsigned char* k8 = (unsigned char*)kpe + (size_t)t * 64 + 32 * (lane >> 4) + (lane & 15);
            const int w = pk_fp8x4(x1 * c.x - x2 * c.y, x2 * c.x + x1 * c.y, 0.f, 0.f);
            k8[0] = (unsigned char)(w & 0xff); k8[16] = (unsigned char)((w >> 8) & 0xff);
        }
    }
}

constexpr int KS_STRIDE = 208, VS_STRIDE = 80;
constexpr int KS_BYTES = 64 * KS_STRIDE, VS_BYTES = 128 * VS_STRIDE, AT_STAGE = KS_BYTES + VS_BYTES;
__device__ __forceinline__ void attn_unit(const Params& p, char* shm, int b, int head, int qb) {
    int tid = TIDX(p.wave_s); asm volatile("" : "+v"(tid));
    const int wave = __builtin_amdgcn_readfirstlane(tid >> 6), lane = tid & 63, l31 = lane & 31, hh = lane >> 5;
    const bool grpB = wave >= 4;
    const int rowblk = (wave & 3) * 2 + (wave >> 2);
    const bf16_t* Q = (const bf16_t*)(p.ws + WS_Q);
    const bf16_t* Kn = (const bf16_t*)(p.ws + WS_KN);
    const bf16_t* Kpe = (const bf16_t*)(p.ws + WS_KPE);
    const bf16_t* Vt = (const bf16_t*)(p.ws + WS_VT);
    const float2* cs = (const float2*)(p.ws + WS_CS);
    bf16_t* ycat = (bf16_t*)(p.ws + WS_BUF1);
    const int q0 = qb * 256 + rowblk * 32, mychunk = q0 >> 6, nkt = 4 * qb + 4;
    const int tq = b * SEQ + q0 + l31;
    i32x8 qf[3];
    {
        const bf16_t* qrow = Q + (size_t)tq * 1536 + head * 192;
#pragma unroll
        for (int ks = 0; ks < 2; ++ks)
#pragma unroll
            for (int i = 0; i < 4; ++i) {
                const bf16x8 v = *reinterpret_cast<const bf16x8*>(qrow + ks * 64 + hh * 32 + 8 * i);
                qf[ks][2 * i] = pk_fp8x4(bf2f(v[0]) * 8.f, bf2f(v[1]) * 8.f, bf2f(v[2]) * 8.f, bf2f(v[3]) * 8.f);
                qf[ks][2 * i + 1] = pk_fp8x4(bf2f(v[4]) * 8.f, bf2f(v[5]) * 8.f, bf2f(v[6]) * 8.f, bf2f(v[7]) * 8.f);
            }
#pragma unroll
        for (int i = 0; i < 2; ++i) {
            const bf16x8 a = *reinterpret_cast<const bf16x8*>(qrow + 128 + 16 * hh + 8 * i);
            const bf16x8 c2 = *reinterpret_cast<const bf16x8*>(qrow + 160 + 16 * hh + 8 * i);
            const float2* cp = cs + (size_t)tq * 32 + 16 * hh + 8 * i;
            float o1[8], o2[8];
#pragma unroll
            for (int j = 0; j < 8; ++j) {
                const float2 c = cp[j];
                const float x1 = bf2f(a[j]) * 8.f, x2 = bf2f(c2[j]) * 8.f;
                o1[j] = x1 * c.x - x2 * c.y; o2[j] = x2 * c.x + x1 * c.y;
            }
            qf[2][2 * i] = pk_fp8x4(o1[0], o1[1], o1[2], o1[3]); qf[2][2 * i + 1] = pk_fp8x4(o1[4], o1[5], o1[6], o1[7]);
            qf[2][4 + 2 * i] = pk_fp8x4(o2[0], o2[1], o2[2], o2[3]); qf[2][4 + 2 * i + 1] = pk_fp8x4(o2[4], o2[5], o2[6], o2[7]);
        }
    }
    f32x16 O[4];
#pragma unroll
    for (int dt = 0; dt < 4; ++dt)
#pragma unroll
        for (int r = 0; r < 16; ++r) O[dt][r] = 0.f;
    float mrun = -1e30f, lsum = 0.f;
    f32x16 s0, s1;
    const int kkey = tid >> 3, kch = tid & 7;
    const int pk_key = tid >> 2, pk_ch = tid & 3;
    const int vd = tid >> 2, vch = tid & 3;
    const size_t tokb = (size_t)b * SEQ;
    const char* Kn8 = (const char*)Kn; const char* Kpe8 = (const char*)Kpe;
    const char* vbase = (const char*)Vt + (size_t)((b * 8 + head) * 128) * SEQ;
    u32x4 r0, r2, r3;
#define AT_LOAD(kt) do { const int k0_ = (kt) * 64; \
        r0 = *reinterpret_cast<const u32x4*>(Kn8 + (tokb + k0_ + kkey) * 1024 + head * 128 + kch * 16); \
        if (wave < 4) r2 = *reinterpret_cast<const u32x4*>(Kpe8 + (tokb + k0_ + pk_key) * 64 + pk_ch * 16); \
        r3 = *reinterpret_cast<const u32x4*>(vbase + (size_t)vd * SEQ + k0_ + vch * 16); } while (0)
#define AT_WRITE(buf) do { char* ks_ = shm + (buf) * AT_STAGE; char* vs_ = ks_ + KS_BYTES; \
        *reinterpret_cast<u32x4*>(ks_ + kkey * KS_STRIDE + kch * 16) = r0; \
        if (wave < 4) *reinterpret_cast<u32x4*>(ks_ + pk_key * KS_STRIDE + 128 + pk_ch * 16) = r2; \
        *reinterpret_cast<u32x4*>(vs_ + vd * VS_STRIDE + vch * 16) = r3; } while (0)
#define LDK(ks_, t_) __builtin_shufflevector(*reinterpret_cast<const i32x4*>(kb + (t_) * 32 * KS_STRIDE + (ks_) * 64), \
                                             *reinterpret_cast<const i32x4*>(kb + (t_) * 32 * KS_STRIDE + (ks_) * 64 + 16), 0, 1, 2, 3, 4, 5, 6, 7)
#define MXQK(a_, b_, c_) __builtin_amdgcn_mfma_scale_f32_32x32x64_f8f6f4(a_, b_, c_, 0, 0, 0, 0x7F7F7F7F, 0, 0x7F7F7F7F)
#define QK(buf) do { \
        const char* kb = shm + (buf) * AT_STAGE + l31 * KS_STRIDE + hh * 32; \
        i32x8 ka0 = LDK(0, 0), ka1 = LDK(0, 1), kb0 = LDK(1, 0), kb1 = LDK(1, 1); \
        _Pragma("unroll") for (int r = 0; r < 16; ++r) { s0[r] = 0.f; s1[r] = 0.f; } \
        __builtin_amdgcn_sched_barrier(0); \
        s0 = MXQK(ka0, qf[0], s0); \
        s1 = MXQK(ka1, qf[0], s1); \
        ka0 = LDK(2, 0); ka1 = LDK(2, 1); \
        __builtin_amdgcn_sched_barrier(0); \
        s0 = MXQK(kb0, qf[1], s0); \
        s1 = MXQK(kb1, qf[1], s1); \
        __builtin_amdgcn_sched_barrier(0); \
        s0 = MXQK(ka0, qf[2], s0); \
        s1 = MXQK(ka1, qf[2], s1); \
        __builtin_amdgcn_sched_barrier(0); } while (0)
#define LDV(dt_) __builtin_shufflevector(*reinterpret_cast<const i32x4*>(vb + (dt_) * 32 * VS_STRIDE), *reinterpret_cast<const i32x4*>(vb + (dt_) * 32 * VS_STRIDE + 16), 0, 1, 2, 3, 4, 5, 6, 7)
#define SMPV(buf) do { \
        const char* vb = shm + (buf) * AT_STAGE + KS_BYTES + l31 * VS_STRIDE + hh * 32; \
        i32x8 va[4]; \
        _Pragma("unroll") for (int dt = 0; dt < 4; ++dt) va[dt] = LDV(dt); \
        float mx = s0[0]; \
        _Pragma("unroll") for (int r = 1; r < 16; ++r) mx = fmaxf(mx, s0[r]); \
        _Pragma("unroll") for (int r = 0; r < 16; ++r) mx = fmaxf(mx, s1[r]); \
        mx = fmaxf(mx, __shfl_xor(mx, 32)); \
        const float mnew = fmaxf(mrun, mx * 0.125f); \
        const float alpha = __builtin_amdgcn_exp2f(mrun - mnew); \
        mrun = mnew; \
        const float moff = 6.f - mnew;        \
        float ps = 0.f; \
        _Pragma("unroll") for (int r = 0; r < 16; ++r) { s0[r] = __builtin_amdgcn_exp2f(fmaf(s0[r], 0.125f, moff)); ps += s0[r]; } \
        _Pragma("unroll") for (int r = 0; r < 16; ++r) { s1[r] = __builtin_amdgcn_exp2f(fmaf(s1[r], 0.125f, moff)); ps += s1[r]; } \
        lsum = lsum * alpha + ps; \
        _Pragma("unroll") for (int dt = 0; dt < 4; ++dt) _Pragma("unroll") for (int r = 0; r < 16; ++r) O[dt][r] *= alpha; \
        i32x8 pf; \
        _Pragma("unroll") for (int g = 0; g < 4; ++g) { \
            pf[g] = pk_fp8x4(s0[4 * g], s0[4 * g + 1], s0[4 * g + 2], s0[4 * g + 3]); \
            pf[4 + g] = pk_fp8x4(s1[4 * g], s1[4 * g + 1], s1[4 * g + 2], s1[4 * g + 3]); \
        } \
        __builtin_amdgcn_sched_barrier(0); \
        _Pragma("unroll") for (int dt = 0; dt < 4; ++dt) O[dt] = MXQK(va[dt], pf, O[dt]); \
        __builtin_amdgcn_sched_barrier(0); } while (0)
    __syncthreads();
    AT_LOAD(0); AT_WRITE(0);
    AT_LOAD(1);
    __syncthreads();
    if (grpB) __syncthreads();
    int bcur = 0, bnext = 1;
    for (int kt = 0; kt < nkt; ++kt) {
        if (kt + 1 < nkt) AT_WRITE(bnext);
        if (kt + 2 < nkt) AT_LOAD(kt + 2);
        __builtin_amdgcn_sched_barrier(0);
        if (kt <= mychunk) QK(bcur);
        __syncthreads();
        if (kt <= mychunk) SMPV(bcur);
        __syncthreads();
        bcur = bnext; bnext = (bnext == 2) ? 0 : bnext + 1;
    }
    if (!grpB) __syncthreads();
#undef AT_LOAD
#undef AT_WRITE
#undef QK
#undef SMPV
#undef LDK
#undef MXQK
#undef LDV
    lsum += __shfl_xor(lsum, 32);
    const float inv = 1.f / lsum;
    char* orow = (char*)ycat + (size_t)tq * DM + 1024 + head * 128 + 4 * hh;
#pragma unroll
    for (int dt = 0; dt < 4; ++dt)
#pragma unroll
        for (int g = 0; g < 4; ++g)
            *reinterpret_cast<int*>(orow + dt * 32 + 8 * g) = pk_fp8x4(O[dt][4 * g] * inv, O[dt][4 * g + 1] * inv, O[dt][4 * g + 2] * inv, O[dt][4 * g + 3] * inv);
}
__device__ __forceinline__ void phase5(const Params& p, char* shm, int bid, int nb) {
    for (int it = bid; it < 256; it += nb) {
        const int bh = it >> 2, pr = it & 3, b = bh >> 3, head = bh & 7;
        attn_unit(p, shm, b, head, 7 - pr);
        attn_unit(p, shm, b, head, pr);
    }
}

__device__ __forceinline__ void phase7(const Params& p, char* shm, int bid, int nb) {
    const int tid = TIDX(p.wave_s), wave = tid >> 6, lane = tid & 63;
    const float* mod = (const float*)(p.ws + WS_MOD);
    const bf16_t* y = (const bf16_t*)(p.ws + WS_BUF2);
    bf16_t* x1 = (bf16_t*)(p.ws + WS_X1);
    float* lv = (float*)shm;
    for (int item = bid; item < NTOK / 64; item += nb) {
        const int b = item >> 5;
        const float* md = mod + b * 12288;
        __syncthreads();
        for (int i = tid; i < 512; i += NTHREADS) {
            *reinterpret_cast<f32x4*>(lv + 0 * DM + i * 4) = *reinterpret_cast<const f32x4*>(p.post_mix_g + i * 4);
            *reinterpret_cast<f32x4*>(lv + 1 * DM + i * 4) = *reinterpret_cast<const f32x4*>(md + 4096 + i * 4);
            *reinterpret_cast<f32x4*>(lv + 2 * DM + i * 4) = *reinterpret_cast<const f32x4*>(p.pre_ffn_g + i * 4);
            *reinterpret_cast<f32x4*>(lv + 3 * DM + i * 4) = *reinterpret_cast<const f32x4*>(md + 6144 + i * 4);
            *reinterpret_cast<f32x4*>(lv + 4 * DM + i * 4) = *reinterpret_cast<const f32x4*>(md + 8192 + i * 4);
        }
        __syncthreads();
#pragma unroll 1
        for (int rr = 0; rr < 8; ++rr) {
            const int row = item * 64 + rr * 8 + wave;
            f32x4 yv[8]; float ss = 0.f;
#pragma unroll
            for (int i = 0; i < 8; ++i) {
                u32x2 r = *reinterpret_cast<const u32x2*>(y + (size_t)row * DM + i * 256 + lane * 4);
                yv[i] = f32x4{bflo(r.x), bfhi(r.x), bflo(r.y), bfhi(r.y)};
                ss += yv[i][0] * yv[i][0] + yv[i][1] * yv[i][1] + yv[i][2] * yv[i][2] + yv[i][3] * yv[i][3];
            }
            const float rstd = rsqrtf(wave_sum(ss) * (1.f / DM) + EPS);
            float s2 = 0.f;
#pragma unroll
            for (int i = 0; i < 8; ++i) {
                const int col = i * 256 + lane * 4;
                f32x4 xv = *reinterpret_cast<const f32x4*>(p.x + (size_t)row * DM + col);
                f32x4 g = *reinterpret_cast<const f32x4*>(lv + col);
                f32x4 gt = *reinterpret_cast<const f32x4*>(lv + DM + col);
                f32x4 v = xv + gt * (yv[i] * rstd * g);
                st4bf(x1 + (size_t)row * DM + col, v);
                yv[i] = v;
                s2 += v[0] * v[0] + v[1] * v[1] + v[2] * v[2] + v[3] * v[3];
            }
            const float rstd2 = rsqrtf(wave_sum(s2) * (1.f / DM) + EPS);
            float hmax = 0.f;
#pragma unroll
            for (int i = 0; i < 8; ++i) {
                const int col = i * 256 + lane * 4;
                f32x4 g = *reinterpret_cast<const f32x4*>(lv + 2 * DM + col);
                f32x4 sh = *reinterpret_cast<const f32x4*>(lv + 3 * DM + col);
                f32x4 sc = *reinterpret_cast<const f32x4*>(lv + 4 * DM + col);
                yv[i] = yv[i] * rstd2 * g * (sc + 1.f) + sh;
                hmax = fmaxf(hmax, fmaxf(fmaxf(fabsf(yv[i][0]), fabsf(yv[i][1])), fmaxf(fabsf(yv[i][2]), fabsf(yv[i][3]))));
            }
#pragma unroll
            for (int o = 1; o < 64; o <<= 1) hmax = fmaxf(hmax, __shfl_xor(hmax, o));
            const float qm = hmax > 0.f ? 127.f / hmax : 0.f;
            if (lane == 0) ((float*)(p.ws + WS_SH))[row] = hmax * (1.f / 127.f);
#pragma unroll
            for (int i = 0; i < 8; ++i) {
                *reinterpret_cast<unsigned*>(p.ws + WS_H8 + (size_t)row * DM + i * 256 + lane * 4) = pack_i8x4(yv[i][0] * qm, yv[i][1] * qm, yv[i][2] * qm, yv[i][3] * qm);
            }
        }
    }
}

__device__ __forceinline__ int fmap(float f) { int i = __float_as_int(f); return i ^ ((i >> 31) & 0x7fffffff); }
__device__ __forceinline__ float funmap(int i) { return __int_as_float(i ^ ((i >> 31) & 0x7fffffff)); }
__device__ __forceinline__ void ins16(int (&top)[16], int k) {
#pragma unroll
    for (int i = 0; i < 16; ++i) { int hi = max(top[i], k); k = min(top[i], k); top[i] = hi; }
}
__device__ __forceinline__ int bsel(int m, int a, int b) { return (a & ~m) | (b & m); }
__device__ __forceinline__ int sel16(const int (&a)[16], int i) {
    const int m0 = -(i & 1), m1 = -((i >> 1) & 1), m2 = -((i >> 2) & 1), m3 = -((i >> 3) & 1);
    int t8[8], t4[4], t2[2];
#pragma unroll
    for (int k = 0; k < 8; ++k) t8[k] = bsel(m0, a[2 * k], a[2 * k + 1]);
#pragma unroll
    for (int k = 0; k < 4; ++k) t4[k] = bsel(m1, t8[2 * k], t8[2 * k + 1]);
#pragma unroll
    for (int k = 0; k < 2; ++k) t2[k] = bsel(m2, t4[2 * k], t4[2 * k + 1]);
    return bsel(m3, t2[0], t2[1]);
}
#define BITONIC_CE(x, K, J) _Pragma("unroll") for (int i_ = 0; i_ < 16; ++i_) { const int l_ = i_ ^ (J); if (l_ > i_) { const int a_ = x[i_], b_ = x[l_]; \
        if ((i_ & (K)) == 0) { x[i_] = max(a_, b_); x[l_] = min(a_, b_); } else { x[i_] = min(a_, b_); x[l_] = max(a_, b_); } } }
#define BITONIC_MERGE16(x) BITONIC_CE(x, 16, 8) BITONIC_CE(x, 16, 4) BITONIC_CE(x, 16, 2) BITONIC_CE(x, 16, 1)
#define BITONIC_SORT16(x) BITONIC_CE(x, 2, 1) BITONIC_CE(x, 4, 2) BITONIC_CE(x, 4, 1) BITONIC_CE(x, 8, 4) BITONIC_CE(x, 8, 2) BITONIC_CE(x, 8, 1) BITONIC_MERGE16(x)
#define SCE(x, i, j) { const int a_ = x[i], b_ = x[j]; x[i] = max(a_, b_); x[j] = min(a_, b_); }
#define SORT16_60(x) SCE(x,0,13) SCE(x,1,12) SCE(x,2,15) SCE(x,3,14) SCE(x,4,8) SCE(x,5,6) SCE(x,7,11) SCE(x,9,10) SCE(x,0,5) SCE(x,1,7) SCE(x,2,9) SCE(x,3,4) SCE(x,6,13) SCE(x,8,14) SCE(x,10,15) SCE(x,11,12) SCE(x,0,1) SCE(x,2,3) SCE(x,4,5) SCE(x,6,8) SCE(x,7,9) SCE(x,10,11) SCE(x,12,13) SCE(x,14,15) SCE(x,0,2) SCE(x,1,3) SCE(x,4,10) SCE(x,5,11) SCE(x,6,7) SCE(x,8,9) SCE(x,12,14) SCE(x,13,15) SCE(x,1,2) SCE(x,3,12) SCE(x,4,6) SCE(x,5,7) SCE(x,8,10) SCE(x,9,11) SCE(x,13,14) SCE(x,1,4) SCE(x,2,6) SCE(x,5,8) SCE(x,7,10) SCE(x,9,13) SCE(x,11,14) SCE(x,2,4) SCE(x,3,6) SCE(x,9,12) SCE(x,11,13) SCE(x,3,5) SCE(x,6,8) SCE(x,7,9) SCE(x,10,12) SCE(x,3,4) SCE(x,5,6) SCE(x,7,8) SCE(x,9,10) SCE(x,11,12) SCE(x,6,7) SCE(x,8,9)
__device__ __forceinline__ void pk_half_list(const bf16_t* __restrict__ qrow, const char* kl, int hh, int (&out)[16]) {
    bf16x8 qf[8];
#pragma unroll
    for (int ks = 0; ks < 8; ++ks) qf[ks] = *reinterpret_cast<const bf16x8*>(qrow + ks * 16);
    int top[16];
#pragma unroll 1
    for (int kt = 0; kt < 4; ++kt) {
        f32x16 acc;
#pragma unroll
        for (int r = 0; r < 16; ++r) acc[r] = 0.f;
#pragma unroll
        for (int ks = 0; ks < 8; ++ks) {
            bf16x8 kf = *reinterpret_cast<const bf16x8*>(kl + kt * 32 * 272 + ks * 32);
            acc = __builtin_amdgcn_mfma_f32_32x32x16_bf16(kf, qf[ks], acc, 0, 0, 0);
        }
        int nw[16];
#pragma unroll
        for (int r = 0; r < 16; ++r) {
            const int n = kt * 32 + (r & 3) + 8 * (r >> 2) + 4 * hh;
            nw[r] = (fmap(acc[r]) & ~127) | (127 - n);
        }
        SORT16_60(nw)
        if (kt == 0) {
#pragma unroll
            for (int i = 0; i < 16; ++i) top[i] = nw[i];
        } else {
#pragma unroll
            for (int i = 0; i < 16; ++i) top[i] = max(top[i], nw[15 - i]);
            BITONIC_MERGE16(top)
        }
    }
#pragma unroll
    for (int i = 0; i < 16; ++i) out[i] = __shfl_xor(top[15 - i], 32);
#pragma unroll
    for (int i = 0; i < 16; ++i) out[i] = max(out[i], top[i]);
    BITONIC_MERGE16(out)
}
__device__ __forceinline__ void phase9(const Params& p, char* shm, int bid, int nb) {
    int tid = TIDX(p.wave_s); asm volatile("" : "+v"(tid));
    const int wave = tid >> 6, lane = tid & 63, l31 = lane & 31, hh = lane >> 5;
    const bf16_t* pq = (const bf16_t*)(p.ws + WS_BUF2);
    const bf16_t* sk = (const bf16_t*)(p.ws + WS_SK);
    int* idxo = (int*)(p.ws + WS_IDX); float* gateo = (float*)(p.ws + WS_GATE);
    for (int item = bid; item < 8 * 64; item += nb) {
        const int head = item & 7, tt = (item >> 3) * 8 + wave, tok = tt * 32 + l31;
        __syncthreads();
        for (int c = tid; c < 4096; c += NTHREADS) {
            const int row = c >> 4, ch = c & 15;
            *reinterpret_cast<u32x4*>(shm + row * 272 + ch * 16) = *reinterpret_cast<const u32x4*>(sk + (size_t)(head * 256 + row) * 128 + ch * 8);
        }
        __syncthreads();
        int la[16], lb[16];
        pk_half_list(pq + (size_t)tok * DM + head * 256 + hh * 8, shm + l31 * 272 + hh * 16, hh, la);
        pk_half_list(pq + (size_t)tok * DM + head * 256 + 128 + hh * 8, shm + (128 + l31) * 272 + hh * 16, hh, lb);
        float va[16], vb[16]; int ia[16], ib[16];
#pragma unroll
        for (int i = 0; i < 16; ++i) {
            va[i] = funmap(la[i] & ~127); ia[i] = 127 - (la[i] & 127);
            vb[i] = funmap(lb[i] & ~127); ib[i] = 127 - (lb[i] & 127);
        }
#define CKEY(i, j) ((fmap(va[i] + vb[j]) & ~255) | (255 - ((i) * 16 + (j))))
        int top2[16], ga[16], gb[16];
#pragma unroll
        for (int j = 0; j < 16; ++j) top2[j] = CKEY(0, j);
#pragma unroll
        for (int j = 0; j < 8; ++j) { ga[j] = CKEY(1, j); ga[8 + j] = CKEY(15 - j, 0); }
        BITONIC_MERGE16(ga)
        gb[0] = CKEY(2, 0); gb[1] = CKEY(2, 1); gb[2] = CKEY(2, 2); gb[3] = CKEY(2, 3); gb[4] = CKEY(2, 4);
        gb[5] = CKEY(3, 0); gb[6] = CKEY(3, 1); gb[7] = CKEY(3, 2); gb[8] = CKEY(3, 3);
        gb[9] = CKEY(4, 0); gb[10] = CKEY(4, 1); gb[11] = CKEY(4, 2);
        gb[12] = CKEY(5, 0); gb[13] = CKEY(5, 1); gb[14] = CKEY(6, 0); gb[15] = CKEY(6, 1);
        SORT16_60(gb)
#pragma unroll
        for (int i = 0; i < 16; ++i) top2[i] = max(top2[i], ga[15 - i]);
        BITONIC_MERGE16(top2)
#pragma unroll
        for (int i = 0; i < 16; ++i) top2[i] = max(top2[i], gb[15 - i]);
        BITONIC_MERGE16(top2)
        ins16(top2, CKEY(7, 0)); ins16(top2, CKEY(7, 1));
#undef CKEY
        float bv[16], mxv, sum = 0.f; int ex[16];
        {
            LAS int* tA = (LAS int*)(uintptr_t)(69632 + wave * 8192) + lane;
            LAS int* tB = tA + 16 * 64;
#pragma unroll
            for (int i = 0; i < 16; ++i) { tA[i * 64] = ia[i] * 128; tB[i * 64] = ib[i]; }
#pragma unroll
            for (int r = 0; r < 16; ++r) {
                const int code = 255 - (top2[r] & 255);
                ex[r] = tA[(code >> 4) * 64] + tB[(code & 15) * 64];
                bv[r] = funmap(top2[r] & ~255);
            }
        }
        mxv = bv[0];
#pragma unroll
        for (int r = 0; r < 16; ++r) { bv[r] = __expf(bv[r] - mxv); sum += bv[r]; }
        const float inv = 1.f / sum;
        if (hh == 0) {
            const size_t ob = ((size_t)(tok >> 6) * 128 + head * 16) * 64 + (tok & 63);
#pragma unroll
            for (int r = 0; r < 16; ++r) { idxo[ob + r * 64] = ex[r]; gateo[ob + r * 64] = bv[r] * inv; }
        }
    }
}

__device__ __forceinline__ void phase10(const Params& p, char* shm, int bid, int nb) {
    int tid = TIDX(p.wave_s); asm volatile("" : "+v"(tid));
    const int wave = tid >> 6, lane = tid & 63;
    const int* idxT = (const int*)(p.ws + WS_IDX);
    const char* U8 = p.ws + WS_U8;
    const char* H8 = p.ws + WS_H8;
    int* part = (int*)(p.ws + WS_PART);
    for (int task = bid; task < 256; task += nb) {
        const int tg = task >> 3, cg = task & 7;
        const int tt = tg * 8 + wave, t = tt * 64 + lane;
        unsigned ip[64]; int acc[128];
#pragma unroll
        for (int k = 0; k < 64; ++k) {
            const unsigned lo = (unsigned)idxT[((size_t)tt * 128 + 2 * k) * 64 + lane], hi = (unsigned)idxT[((size_t)tt * 128 + 2 * k + 1) * 64 + lane];
            ip[k] = lo | (hi << 16);
        }
#pragma unroll
        for (int j = 0; j < 128; ++j) acc[j] = 0;
#pragma unroll 1
        for (int s = 0; s < 32; ++s) {
            const int slice = cg * 32 + s;
            __syncthreads();
            const char* sbase = U8 + (size_t)slice * 131072;
            const unsigned toff = (unsigned)tid * 16u;
#pragma unroll
            for (int k = 0; k < 16; ++k)
                __builtin_amdgcn_global_load_lds((const unsigned*)(sbase + k * 8192 + toff), (unsigned*)(shm + k * 8192 + tid * 16), 16, 0, 0);
            const u32x2 h = *reinterpret_cast<const u32x2*>(H8 + (size_t)t * DM + slice * 8);
            asm volatile("s_waitcnt vmcnt(0)" ::: "memory");
            __syncthreads();
#define U_LOAD(g, dst) _Pragma("unroll") for (int q = 0; q < 4; ++q) { unsigned w = ip[(g) * 4 + q]; asm volatile("" : "+v"(w)); \
                dst[2 * q] = *reinterpret_cast<const u32x2*>(shm + ((w & 0xffffu) << 3)); dst[2 * q + 1] = *reinterpret_cast<const u32x2*>(shm + ((w >> 16) << 3)); }
#define U_DOT(g, srcv) _Pragma("unroll") for (int q = 0; q < 8; ++q) { \
                acc[(g) * 8 + q] = __builtin_amdgcn_sdot4((int)srcv[q].x, (int)h.x, acc[(g) * 8 + q], false); \
                acc[(g) * 8 + q] = __builtin_amdgcn_sdot4((int)srcv[q].y, (int)h.y, acc[(g) * 8 + q], false); }
            u32x2 ua[8], ub[8];
            U_LOAD(0, ua)
#pragma unroll
            for (int g = 0; g < 16; g += 2) {
                U_LOAD(g + 1, ub)
                U_DOT(g, ua)
                __builtin_amdgcn_sched_barrier(0);
                if (g + 2 < 16) { U_LOAD(g + 2, ua) }
                U_DOT(g + 1, ub)
                __builtin_amdgcn_sched_barrier(0);
            }
#undef U_LOAD
#undef U_DOT
        }
#pragma unroll
        for (int k = 0; k < 64; ++k) part[((size_t)cg * 64 + k) * NTOK + t] = (int)pk2((float)acc[2 * k], (float)acc[2 * k + 1]);
    }
}

__device__ __forceinline__ void phase11(const Params& p, int bid, int nb) {
    const int* part = (const int*)(p.ws + WS_PART);
    const int* idxT = (const int*)(p.ws + WS_IDX); const float* gateT = (const float*)(p.ws + WS_GATE);
    const float* su = (const float*)(p.ws + WS_SU); const float* sv = (const float*)(p.ws + WS_SV); const float* sh = (const float*)(p.ws + WS_SH);
    unsigned* pack = (unsigned*)(p.ws + WS_PACK);
    int t11 = TIDX(p.wave_s); asm volatile("" : "+v"(t11));
    for (int item = bid * NTHREADS + t11; item < NTOK * 128; item += nb * NTHREADS) {
        const int lane = item & 63, j = (item >> 6) & 127, tt = item >> 13, t = tt * 64 + lane;
        float sum = 0.f;
#pragma unroll
        for (int cg = 0; cg < 8; ++cg) { const unsigned w = (unsigned)part[((size_t)cg * 64 + (j >> 1)) * NTOK + t]; sum += (j & 1) ? bfhi(w) : bflo(w); }
        const int e = idxT[item];
        const float a = sum * sh[t] * su[e];
        const float act = 0.5f * a * (1.f + erff(a * 0.70710678118654752f)) * gateT[item] * sv[e];
        { const _Float16 ah = (_Float16)(act * 256.f); pack[item] = ((unsigned)__builtin_bit_cast(unsigned short, ah) << 16) | ((unsigned)e << 2); }
    }
}

__device__ __forceinline__ void phase12(const Params& p, char* shm, int bid, int nb) {
    int tid = TIDX(p.wave_s); asm volatile("" : "+v"(tid));
    const int wave = tid >> 6, lane = tid & 63;
    const unsigned* pack = (const unsigned*)(p.ws + WS_PACK);
    const char* V8 = p.ws + WS_V8;
    bf16_t* y2 = (bf16_t*)(p.ws + WS_Y2);
    for (int slice = bid; slice < 256; slice += nb) {
        __syncthreads();
        const char* src = V8 + (size_t)slice * 131072 + tid * 16;
#pragma unroll
        for (int k = 0; k < 16; ++k)
            __builtin_amdgcn_global_load_lds((const unsigned*)(src + k * 8192), (unsigned*)(shm + k * 8192 + tid * 16), 16, 0, 0);
        asm volatile("s_waitcnt vmcnt(0)" ::: "memory");
        __syncthreads();
#define V_LOAD(ptr, g, dst) _Pragma("unroll") for (int q = 0; q < 16; ++q) dst[q] = *reinterpret_cast<const unsigned*>(reinterpret_cast<const char*>((ptr) + (g) * 1024) + lane4 + q * 256);
#define V_LDS(srcp, dstv) _Pragma("unroll") for (int q = 0; q < 16; ++q) { unsigned ad_; \
            asm("v_lshlrev_b32_sdwa %0, %1, %2 dst_sel:DWORD dst_unused:UNUSED_PAD src0_sel:DWORD src1_sel:WORD_0" : "=v"(ad_) : "v"(one_), "v"(srcp[q])); \
            dstv[q] = *reinterpret_cast<const LAS u32x2*>((uintptr_t)ad_); }
#define V_CVT(w_, hi_) __builtin_bit_cast(h2v, __builtin_amdgcn_cvt_scalef32_pk_f16_fp8(w_, __uint_as_float(0x3F80007Fu), hi_))
#define V_FMAS(srcp, srcv) _Pragma("unroll") for (int q = 0; q < 16; ++q) { const h2v ph = __builtin_bit_cast(h2v, srcp[q]); const h2v act = {ph[1], ph[1]}; \
                y[0] = __builtin_elementwise_fma(act, V_CVT(srcv[q].x, false), y[0]); y[1] = __builtin_elementwise_fma(act, V_CVT(srcv[q].x, true), y[1]); \
                y[2] = __builtin_elementwise_fma(act, V_CVT(srcv[q].y, false), y[2]); y[3] = __builtin_elementwise_fma(act, V_CVT(srcv[q].y, true), y[3]); }
#define V_STEP(ptr, g, pkLoad, pkLds, vLds, pkCur, vCur) V_LOAD(ptr, g, pkLoad) V_LDS(pkLds, vLds) V_FMAS(pkCur, vCur) __builtin_amdgcn_sched_barrier(0);
        unsigned pkA[16], pkB[16], pkC[16]; u32x2 vA[16], vB[16];
        unsigned one_ = 1u; asm volatile("" : "+v"(one_));
        const int wave_u = __builtin_amdgcn_readfirstlane(wave);
        const unsigned lane4 = (unsigned)lane * 4u;
        {
            const unsigned* pp0 = pack + (size_t)wave_u * 8192;
            V_LOAD(pp0, 0, pkA) V_LOAD(pp0, 1, pkB) V_LDS(pkA, vA)
        }
#pragma unroll 1
        for (int tt = wave_u; tt < 256; tt += NWAVES) {
            h2v y[4];
#pragma unroll
            for (int c = 0; c < 4; ++c) y[c] = h2v{(_Float16)0.f, (_Float16)0.f};
            const unsigned* pp = pack + (size_t)tt * 8192;
            const int ttn = (tt + NWAVES < 256) ? tt + NWAVES : tt;
            const unsigned* pn = pack + (size_t)ttn * 8192;
            V_STEP(pp, 2, pkC, pkB, vB, pkA, vA)
            V_STEP(pp, 3, pkA, pkC, vA, pkB, vB)
            V_STEP(pp, 4, pkB, pkA, vB, pkC, vA)
            V_STEP(pp, 5, pkC, pkB, vA, pkA, vB)
            V_STEP(pp, 6, pkA, pkC, vB, pkB, vA)
            V_STEP(pp, 7, pkB, pkA, vA, pkC, vB)
            V_STEP(pn, 0, pkC, pkB, vB, pkA, vA)
            V_STEP(pn, 1, pkA, pkC, vA, pkB, vB)
#pragma unroll
            for (int q = 0; q < 16; ++q) { const unsigned t0_ = pkA[q]; pkA[q] = pkC[q]; pkB[q] = t0_; }
            *reinterpret_cast<u32x4*>(y2 + (size_t)(tt * 64 + lane) * DM + slice * 8) =
                u32x4{__builtin_bit_cast(unsigned, y[0]), __builtin_bit_cast(unsigned, y[1]), __builtin_bit_cast(unsigned, y[2]), __builtin_bit_cast(unsigned, y[3])};
        }
#undef V_LOAD
#undef V_LDS
#undef V_CVT
#undef V_FMAS
#undef V_STEP
    }
}

__device__ __forceinline__ float h16f(unsigned h) {
    const unsigned s_ = (h & 0x8000u) << 16, e_ = (h >> 10) & 31u, m_ = h & 0x3ffu;
    return e_ == 0u ? __uint_as_float(s_) : __uint_as_float(s_ | ((e_ + 112u) << 23) | (m_ << 13));
}
__device__ __forceinline__ void phase13(const Params& p, char* shm, int bid, int nb) {
    const int tid = TIDX(p.wave_s), wave = tid >> 6, lane = tid & 63;
    const float* mod = (const float*)(p.ws + WS_MOD);
    const bf16_t* y2 = (const bf16_t*)(p.ws + WS_Y2);
    const bf16_t* x1 = (const bf16_t*)(p.ws + WS_X1);
    float* lv = (float*)shm;
    for (int item = bid; item < NTOK / 64; item += nb) {
        const int b = item >> 5;
        __syncthreads();
        for (int i = tid; i < 512; i += NTHREADS) {
            *reinterpret_cast<f32x4*>(lv + 0 * DM + i * 4) = *reinterpret_cast<const f32x4*>(p.post_ffn_g + i * 4);
            *reinterpret_cast<f32x4*>(lv + 1 * DM + i * 4) = *reinterpret_cast<const f32x4*>(mod + b * 12288 + 10240 + i * 4);
        }
        __syncthreads();
#pragma unroll 1
        for (int rr = 0; rr < 8; ++rr) {
            const int row = item * 64 + rr * 8 + wave;
            f32x4 yv[8]; u32x2 xr[8]; float ss = 0.f;
#pragma unroll
            for (int i = 0; i < 8; ++i) {
                u32x2 r = *reinterpret_cast<const u32x2*>(y2 + (size_t)row * DM + i * 256 + lane * 4);
                xr[i] = *reinterpret_cast<const u32x2*>(x1 + (size_t)row * DM + i * 256 + lane * 4);
                yv[i] = f32x4{h16f(r.x & 0xffffu), h16f(r.x >> 16), h16f(r.y & 0xffffu), h16f(r.y >> 16)};
                ss += yv[i][0] * yv[i][0] + yv[i][1] * yv[i][1] + yv[i][2] * yv[i][2] + yv[i][3] * yv[i][3];
            }
            const float rstd = rsqrtf(wave_sum(ss) * (1.f / DM) + EPS);
#pragma unroll
            for (int i = 0; i < 8; ++i) {
                const int col = i * 256 + lane * 4;
                f32x4 xv = f32x4{bflo(xr[i].x), bfhi(xr[i].x), bflo(xr[i].y), bfhi(xr[i].y)};
                f32x4 g = *reinterpret_cast<const f32x4*>(lv + col);
                f32x4 gt = *reinterpret_cast<const f32x4*>(lv + DM + col);
                *reinterpret_cast<f32x4*>(p.out + (size_t)row * DM + col) = xv + gt * (yv[i] * rstd * g);
            }
        }
    }
}

constexpr int NPHASE = 14;
__global__ void __launch_bounds__(NTHREADS, 2) mega(Params p, int ph_lo, int ph_hi) {
    extern __shared__ __attribute__((aligned(16))) char shm[];
    p.wave_s = __builtin_amdgcn_readfirstlane((int)(threadIdx.x >> 6));
    const int bid = blockIdx.x, nb = gridDim.x;
    const int vcu = vcu_of(bid, nb);
    char* ws = p.ws;
    volatile LAS unsigned* xbw = (volatile LAS unsigned*)(shm + XB_OFF);
    if (TIDX(p.wave_s) == 0) { xbw[0] = 0u; xbw[1] = 0u; }
    __syncthreads();
    XcdBarrier bar; bar.bar = (unsigned*)(ws + WS_BAR); bar.x = 0; bar.st = xbw; bar.ws = p.wave_s;
    if (ph_hi - ph_lo > 1) bar = xcd_barrier_post((unsigned*)(ws + WS_BAR), xbw, p.wave_s);
#ifndef DUP_PH
#define DUP_PH (-1)
#endif
#define REP(k) for (int rep_ = 0; rep_ < ((k) == DUP_PH ? 2 : 1); ++rep_)
#ifdef ONLY_PH
#define PH(k) ((k) == ONLY_PH && ph_lo <= (k) && (k) < ph_hi)
#else
#define PH(k) (ph_lo <= (k) && (k) < ph_hi)
#endif
#define SEAM(k) do { if (ph_lo <= (k) && (k) + 1 < ph_hi) xcd_barrier(bar); } while (0)
    if (PH(0)) REP(0) phase0(p, shm, bid, nb);
    SEAM(0);
    if (PH(1)) REP(1) phase1(p, shm, bid, nb);
    SEAM(1);
    if (PH(2)) REP(2) {
        EpiI8 e{(bf16_t*)(ws + WS_BUF2), DM, (const float*)(ws + WS_SH1), (const float*)(ws + WS_WSC)};
        gemm_phase<false, true>((const bf16_t*)(ws + WS_BUF1), DM / 2, (const bf16_t*)(ws + WS_WIN), DM / 2, 1024, 8, 512, 0, vcu, nb, shm, e, p.wave_s);
    }
    SEAM(2);
    if (PH(3)) REP(3) phase3(p, bid, nb);
    SEAM(3);
    if (PH(4)) REP(4) {
        const bf16_t* projb = (const bf16_t*)(ws + WS_BUF2);
        EpiQ eq{(bf16_t*)(ws + WS_Q), (const float*)(ws + WS_RSTDQ)};
        EpiKV ekv{(bf16_t*)(ws + WS_KN), (bf16_t*)(ws + WS_VT), (const float*)(ws + WS_RSTDKV)};
        if (nb == 256) {
            const int nq = vcu < 128 ? 2 : 1, q0 = vcu < 128 ? 2 * vcu : vcu + 128;
            const int nkv = vcu < 128 ? 1 : 3, kv0 = vcu < 128 ? vcu : 128 + 3 * (vcu - 128);
            const int g = vcu >> 6, pmp = vcu & 63;
            const bf16_t* qA = projb + 1024; const bf16_t* qB = (const bf16_t*)(ws + WS_WUQ);
            const bf16_t* kA = projb + 1536; const bf16_t* kB = (const bf16_t*)(ws + WS_WUKV);
            const bf16_t* pA = (const bf16_t*)(ws + WS_Z) + g * 256; const bf16_t* pB = (const bf16_t*)(ws + WS_WPOOL) + g * 65536;
            const NextTile kvfirst{kA, kB, DM, 256, (kv0 >> 3) * 256, (kv0 & 7) * 256};
            const NextTile poolt{pA, pB, 1024, 256, pmp * 256, 0};
#pragma unroll 1
            for (int i = 0; i < nq; ++i) {
                const int t = q0 + i;
                const NextTile nx = (i + 1 < nq) ? NextTile{qA, qB, DM, 512, ((t + 1) / 6) * 256, ((t + 1) % 6) * 256} : kvfirst;
                gemm_tile<false, false>(qA, DM, qB, 512, 8, (t / 6) * 256, (t % 6) * 256, shm, eq, i > 0, nx, p.wave_s);
            }
#pragma unroll 1
            for (int i = 0; i < nkv; ++i) {
                const int t = kv0 + i;
                const NextTile nx = (i + 1 < nkv) ? NextTile{kA, kB, DM, 256, ((t + 1) >> 3) * 256, ((t + 1) & 7) * 256} : poolt;
                gemm_tile<true, false>(kA, DM, kB, 256, 4, (t >> 3) * 256, (t & 7) * 256, shm, ekv, true, nx, p.wave_s);
            }
            {
                EpiPool e{(bf16_t*)(ws + WS_BUF1), p.pool_scale, g * 256};
                gemm_tile<false, false>(pA, 1024, pB, 256, 4, pmp * 256, 0, shm, e, true, NextTile{pA, pB, 1024, 256, -1, 0}, p.wave_s);
            }
        } else {
            gemm_phase<false, false>(projb + 1024, DM, (const bf16_t*)(ws + WS_WUQ), 512, 512, 6, 384, 0, vcu, nb, shm, eq, p.wave_s);
            gemm_phase<true, false>(projb + 1536, DM, (const bf16_t*)(ws + WS_WUKV), 256, 256, 8, 512, 384, vcu, nb, shm, ekv, p.wave_s);
            const int first = ((vcu - 896) % nb + nb) % nb;
            for (int t = first; t < 256; t += nb) {
                const int g = t >> 6, pm = t & 63;
                EpiPool e{(bf16_t*)(ws + WS_BUF1), p.pool_scale, g * 256};
                gemm_tile<false, false>((const bf16_t*)(ws + WS_Z) + g * 256, 1024, (const bf16_t*)(ws + WS_WPOOL) + g * 65536, 256, 4, pm * 256, 0, shm, e, false, NextTile{nullptr, nullptr, 0, 0, -1, 0}, p.wave_s);
            }
        }
    }
    SEAM(4);
    if (PH(5)) REP(5) phase5(p, shm, vcu, nb);
    SEAM(5);
    if (PH(6)) REP(6) {
        EpiBf16 e{(bf16_t*)(ws + WS_BUF2), DM, 1.f / 32.f};
        gemm_phase<false, false, true>((const bf16_t*)(ws + WS_BUF1), DM / 2, (const bf16_t*)(ws + WS_WOUT), DM / 2, 1024, 8, 512, 0, vcu, nb, shm, e, p.wave_s);
    }
    SEAM(6);
    if (PH(7)) REP(7) phase7(p, shm, bid, nb);
    SEAM(7);
    if (PH(8)) REP(8) {
        EpiI8 e{(bf16_t*)(ws + WS_BUF2), DM, (const float*)(ws + WS_SH), (const float*)(ws + WS_WSC) + 2048};
        gemm_phase<false, true>((const bf16_t*)(ws + WS_H8), DM / 2, (const bf16_t*)(ws + WS_WPQ), DM / 2, 1024, 8, 512, 0, vcu, nb, shm, e, p.wave_s);
    }
    SEAM(8);
    if (PH(9)) REP(9) phase9(p, shm, bid, nb);
    SEAM(9);
    if (PH(10)) REP(10) phase10(p, shm, bid, nb);
    SEAM(10);
    if (PH(11)) REP(11) phase11(p, bid, nb);
    SEAM(11);
    if (PH(12)) REP(12) phase12(p, shm, vcu, nb);
    SEAM(12);
    if (PH(13)) REP(13) phase13(p, shm, bid, nb);
#undef PH
#undef SEAM
}

extern "C" void kernel_launch(void* const* d_in, const int* in_sizes, int n_in, void* d_out, int out_size, void* d_ws, size_t ws_size, hipStream_t stream) {
    static int grid = 0;
    if (grid == 0) {
        if (n_in != 21 || ws_size < WS_END) { fprintf(stderr, "kernel_launch: unexpected n_in %d / ws_size %zu (need %zu)\n", n_in, ws_size, (size_t)WS_END); grid = -1; return; }
        int dev = 0, cus = 0;
        if (hipGetDevice(&dev) != hipSuccess || hipDeviceGetAttribute(&cus, hipDeviceAttributeMultiprocessorCount, dev) != hipSuccess) { grid = -1; return; }
        if (hipFuncSetAttribute((const void*)mega, hipFuncAttributeMaxDynamicSharedMemorySize, LDS_BYTES) != hipSuccess) { fprintf(stderr, "hipFuncSetAttribute failed\n"); grid = -1; return; }
        int per_cu = 0;
        if (hipOccupancyMaxActiveBlocksPerMultiprocessor(&per_cu, (const void*)mega, NTHREADS, LDS_BYTES) != hipSuccess || per_cu < 1)
            fprintf(stderr, "kernel_launch: occupancy query reports %d blocks per CU\n", per_cu);
        (void)hipGetLastError();
        grid = cus;
    }
    if (grid < 0) return;
    (void)hipMemsetAsync((char*)d_ws + WS_ZERO, 0, ZERO_BYTES, stream);
    (void)hipMemsetAsync((char*)d_ws + WS_CMAX, 0, CMAX_BYTES, stream);
    Params p{};
    p.x = (const float*)d_in[0]; p.c = (const float*)d_in[1]; p.pos = (const int*)d_in[2];
    p.ada_w = (const float*)d_in[3]; p.ada_b = (const float*)d_in[4];
    p.pre_mix_g = (const float*)d_in[5]; p.post_mix_g = (const float*)d_in[6]; p.pre_ffn_g = (const float*)d_in[7]; p.post_ffn_g = (const float*)d_in[8];
    p.w_in = (const float*)d_in[9]; p.pool_w = (const float*)d_in[10]; p.pool_scale = (const float*)d_in[11];
    p.q_norm_g = (const float*)d_in[12]; p.w_uq = (const float*)d_in[13]; p.kv_norm_g = (const float*)d_in[14]; p.w_ukv = (const float*)d_in[15];
    p.w_out = (const float*)d_in[16]; p.peer_wq = (const float*)d_in[17]; p.sub_keys = (const float*)d_in[18];
    p.peer_u = (const float*)d_in[19]; p.peer_v = (const float*)d_in[20];
    p.out = (float*)d_out; p.ws = (char*)d_ws;
#if MK_MULTI
    for (int k = 0; k < NPHASE; ++k) hipLaunchKernelGGL(mega, dim3(grid), dim3(NTHREADS), LDS_BYTES, stream, p, k, k + 1);
#else
    hipLaunchKernelGGL(mega, dim3(grid), dim3(NTHREADS), LDS_BYTES, stream, p, 0, NPHASE);
#endif
}
```

```cpp
#include <hip/hip_runtime.h>
#include <hip/hip_bf16.h>
#include <stdint.h>
#include <stdio.h>

#ifndef MK_MULTI
#define MK_MULTI 0
#endif

typedef unsigned short bf16_t;
typedef short bf16x8 __attribute__((ext_vector_type(8)));
typedef float f32x4 __attribute__((ext_vector_type(4)));
typedef float f32x16 __attribute__((ext_vector_type(16)));
typedef unsigned u32x4 __attribute__((ext_vector_type(4)));
typedef int i32x4 __attribute__((ext_vector_type(4)));
typedef int i32x8 __attribute__((ext_vector_type(8)));
__device__ __forceinline__ int pk_fp8x4(float a, float b, float c, float d) {
    int w = __builtin_amdgcn_cvt_pk_fp8_f32(a, b, 0, false);
    return __builtin_amdgcn_cvt_pk_fp8_f32(c, d, w, true);
}
template <bool I8> struct AccT { typedef f32x4 type; };
template <> struct AccT<true> { typedef i32x4 type; };
typedef unsigned u32x2 __attribute__((ext_vector_type(2)));
typedef _Float16 h2v __attribute__((ext_vector_type(2)));

constexpr int NTOK = 16384, DM = 2048, SEQ = 2048;
constexpr int NTHREADS = 512, NWAVES = 8;
constexpr int LDS_BYTES = 140 * 1024;
constexpr int XB_OFF = LDS_BYTES - 64;
constexpr float EPS = 1e-6f;

constexpr size_t MiB = 1024 * 1024;
constexpr size_t WS_ZERO   = 0;
constexpr size_t WS_BAR    = 0;
constexpr size_t WS_MOD    = 16384;
constexpr size_t ZERO_BYTES = 16384;
constexpr size_t WS_CS     = 1 * MiB;
constexpr size_t WS_RSTDQ  = 5 * MiB;
constexpr size_t WS_RSTDKV = 5 * MiB + 65536;
constexpr size_t WS_WIN    = 6 * MiB;
constexpr size_t WS_WOUT   = 14 * MiB;
constexpr size_t WS_WPQ    = 22 * MiB;
constexpr size_t WS_WUQ    = 30 * MiB;
constexpr size_t WS_WUKV   = 32 * MiB;
constexpr size_t WS_WPOOL  = 33 * MiB;
constexpr size_t WS_SK     = 34 * MiB;
constexpr size_t WS_U8     = 35 * MiB;
constexpr size_t WS_V8     = 67 * MiB;
constexpr size_t WS_H8     = 99 * MiB;
constexpr size_t WS_PACK   = 131 * MiB;
constexpr size_t WS_SU     = 139 * MiB;
constexpr size_t WS_SV     = 139 * MiB + 65536;
constexpr size_t WS_SH     = 139 * MiB + 131072;
constexpr size_t WS_SH1    = 139 * MiB + 196608;
constexpr size_t WS_CMAX   = 139 * MiB + 262144;
constexpr size_t WS_WSC    = 139 * MiB + 278528;
constexpr size_t CMAX_BYTES = 2 * 2048 * 4;
constexpr size_t WS_BUF1   = 163 * MiB;
constexpr size_t WS_BUF2   = 227 * MiB;
constexpr size_t WS_BIG    = 291 * MiB;
constexpr size_t WS_Z      = WS_BIG;
constexpr size_t WS_PROJ8  = WS_BIG + 16 * MiB;
constexpr size_t WS_Q      = WS_BIG + 32 * MiB;
constexpr size_t WS_KN     = WS_BIG + 80 * MiB;
constexpr size_t WS_VT     = WS_BIG + 112 * MiB;
constexpr size_t WS_KPE    = WS_BIG + 144 * MiB;
constexpr size_t WS_X1     = WS_BIG;
constexpr size_t WS_IDX    = 438 * MiB;
constexpr size_t WS_GATE   = 446 * MiB;
constexpr size_t WS_PART   = WS_BUF1;
constexpr size_t WS_Y2     = WS_BUF2;
constexpr size_t WS_END    = 454 * MiB;

struct Params {
    const float *x, *c; const int* pos;
    const float *ada_w, *ada_b, *pre_mix_g, *post_mix_g, *pre_ffn_g, *post_ffn_g;
    const float *w_in, *pool_w, *pool_scale, *q_norm_g, *w_uq, *kv_norm_g, *w_ukv, *w_out;
    const float *peer_wq, *sub_keys, *peer_u, *peer_v;
    float* out; char* ws;
    int wave_s;
};

__device__ __forceinline__ unsigned pk2(float lo, float hi) {
    typedef __bf16 bf2 __attribute__((ext_vector_type(2)));
    bf2 v; v[0] = (__bf16)lo; v[1] = (__bf16)hi; return __builtin_bit_cast(unsigned, v);
}
__device__ __forceinline__ float bflo(unsigned u) { return __uint_as_float(u << 16); }
__device__ __forceinline__ float bfhi(unsigned u) { return __uint_as_float(u & 0xffff0000u); }
__device__ __forceinline__ float bf2f(short b) { return __uint_as_float(((unsigned)(unsigned short)b) << 16); }
__device__ __forceinline__ short f2bf(float f) { return (short)(pk2(f, 0.f) & 0xffffu); }
__device__ __forceinline__ unsigned pack_i8x4(float a, float b, float c, float d) {
    unsigned r = 0u;
    r = __builtin_amdgcn_cvt_pk_u8_f32(a + 128.f, 0, r); r = __builtin_amdgcn_cvt_pk_u8_f32(b + 128.f, 1, r);
    r = __builtin_amdgcn_cvt_pk_u8_f32(c + 128.f, 2, r); r = __builtin_amdgcn_cvt_pk_u8_f32(d + 128.f, 3, r);
    return r ^ 0x80808080u;
}
__device__ __forceinline__ float wave_sum(float v) {
#pragma unroll
    for (int o = 1; o < 64; o <<= 1) v += __shfl_xor(v, o);
    return v;
}

#define XB_TMO      128
#define XB_XCNT(j)  (256  + 64 * (j))
#define XB_XSUB(j)  (1280 + 64 * (j))
#define XB_XGEN(j)  (2304 + 64 * (j))
#define XB_TOP      3328
#define XB_TOPGEN   3392
#define XCD_BAR_WORDS 3456
#define XB_SPIN_CAP (1u << 20)
#define LAS __attribute__((address_space(3)))
__device__ __forceinline__ int tidx_(int ws) { unsigned l = __builtin_amdgcn_mbcnt_lo(~0u, 0u); asm volatile("" : "+v"(l)); return (int)((unsigned)ws * 64u + __builtin_amdgcn_mbcnt_hi(~0u, l)); }
#define TIDX(ws_) tidx_(ws_)
__device__ __forceinline__ unsigned xb_ld(unsigned* p)              { return __hip_atomic_load(p, __ATOMIC_RELAXED, __HIP_MEMORY_SCOPE_AGENT); }
__device__ __forceinline__ unsigned xb_add(unsigned* p, unsigned v) { return __hip_atomic_fetch_add(p, v, __ATOMIC_RELAXED, __HIP_MEMORY_SCOPE_AGENT); }
__device__ __forceinline__ unsigned xb_xcc_id() { return (unsigned)__builtin_amdgcn_s_getreg((3 << 11) | 20) & 0xFu; }
#define XB_SPIN(cond, bar) do { unsigned _sp = 0; while (cond) { __builtin_amdgcn_s_sleep(1); \
    if ((++_sp & 255u) == 0u) { if (xb_ld(&(bar)[XB_TMO])) break; if (_sp > XB_SPIN_CAP) { atomicAdd(&(bar)[XB_TMO], 1u); break; } } } } while (0)
struct XcdBarrier { unsigned* bar; unsigned x; volatile LAS unsigned* st; int ws; };
__device__ __forceinline__ XcdBarrier xcd_barrier_post(unsigned* bar, volatile LAS unsigned* st, int ws) {
    XcdBarrier b; b.bar = bar; b.x = xb_xcc_id(); b.st = st; b.ws = ws;
    if (TIDX(ws) == 0) (void)xb_add(&bar[XB_XCNT(b.x)], 1u);
    return b;
}
__device__ __forceinline__ void xcd_barrier_complete(unsigned* bar, unsigned x, unsigned& nloc, unsigned& nx) {
    const unsigned G = gridDim.x * gridDim.y * gridDim.z;
    unsigned sum, cnt, mine, sp = 0u;
    for (;;) {
        sum = 0u; cnt = 0u; mine = 0u;
#pragma unroll
        for (unsigned j = 0; j < 16; ++j) { const unsigned c = xb_ld(&bar[XB_XCNT(j)]); sum += c; cnt += (c > 0u) ? 1u : 0u; mine = (j == x) ? c : mine; }
        if (sum == G) break;
        __builtin_amdgcn_s_sleep(1);
        if ((++sp & 255u) == 0u) { if (xb_ld(&bar[XB_TMO])) break; if (sp > XB_SPIN_CAP) { atomicAdd(&bar[XB_TMO], 1u); break; } }
    }
    nloc = mine > 0u ? mine : 1u; nx = cnt > 0u ? cnt : 1u;
}
__device__ __forceinline__ void xcd_barrier(const XcdBarrier& b) {
    asm volatile("s_waitcnt vmcnt(0)" ::: "memory");
    __syncthreads();
    if (TIDX(b.ws) == 0) {
        unsigned* bar = b.bar;
        __builtin_amdgcn_s_waitcnt(0);
        unsigned nloc = b.st[0], nx = b.st[1];
        if (nloc == 0u) { xcd_barrier_complete(bar, b.x, nloc, nx); b.st[0] = nloc; b.st[1] = nx; }
        const unsigned old = xb_add(&bar[XB_XSUB(b.x)], 1u);
        const unsigned gen = old / nloc;
        if (old + 1u == (gen + 1u) * nloc) {
            __builtin_amdgcn_fence(__ATOMIC_RELEASE, "agent");
            asm volatile("s_waitcnt vmcnt(0)" ::: "memory");
            const unsigned og = xb_add(&bar[XB_TOP], 1u);
            const unsigned tg = og / nx;
            if (og + 1u == (tg + 1u) * nx) xb_add(&bar[XB_TOPGEN], 1u);
            else XB_SPIN(xb_ld(&bar[XB_TOPGEN]) == tg, bar);
            __builtin_amdgcn_fence(__ATOMIC_ACQUIRE, "agent");
            xb_add(&bar[XB_XGEN(b.x)], 1u);
            asm volatile("s_waitcnt vmcnt(0)" ::: "memory");
        } else {
            XB_SPIN(xb_ld(&bar[XB_XGEN(b.x)]) == gen, bar);
            __builtin_amdgcn_fence(__ATOMIC_ACQUIRE, "agent");
            asm volatile("s_waitcnt vmcnt(0)" ::: "memory");
        }
    }
    __syncthreads();
}

constexpr int G_BK = 64, G_HALF = 128, G_HT = G_HALF * G_BK;
__device__ __forceinline__ int lds_byte(int r, int c) {
    int st = (r >> 4) * 2 + (c >> 5), rr = r & 15, cc = c & 31, ob = rr * 64 + cc * 2;
    return st * 1024 + (ob ^ (((ob >> 9) & 1) << 5));
}
__device__ __forceinline__ void stage_rc(int b, int& R, int& C) {
    int st = b / 1024, sb = b % 1024, swz = sb ^ (((sb >> 9) & 1) << 5);
    R = (st >> 1) * 16 + swz / 64; C = (st & 1) * 32 + (swz % 64) / 2;
}

template <bool NOSWAP, bool I8, class A_>
__device__ __forceinline__ A_ mma1(bf16x8 a, bf16x8 b, A_ c);
template <> __device__ __forceinline__ f32x4 mma1<false, false, f32x4>(bf16x8 a, bf16x8 b, f32x4 c) { return __builtin_amdgcn_mfma_f32_16x16x32_bf16(b, a, c, 0, 0, 0); }
template <> __device__ __forceinline__ f32x4 mma1<true, false, f32x4>(bf16x8 a, bf16x8 b, f32x4 c) { return __builtin_amdgcn_mfma_f32_16x16x32_bf16(a, b, c, 0, 0, 0); }
template <> __device__ __forceinline__ i32x4 mma1<false, true, i32x4>(bf16x8 a, bf16x8 b, i32x4 c) { return __builtin_amdgcn_mfma_i32_16x16x64_i8(__builtin_bit_cast(i32x4, b), __builtin_bit_cast(i32x4, a), c, 0, 0, 0); }
template <> __device__ __forceinline__ i32x4 mma1<true, true, i32x4>(bf16x8 a, bf16x8 b, i32x4 c) { return __builtin_amdgcn_mfma_i32_16x16x64_i8(__builtin_bit_cast(i32x4, a), __builtin_bit_cast(i32x4, b), c, 0, 0, 0); }

template <bool NOSWAP, bool I8, bool F8, class A_>
__device__ __forceinline__ A_ mma2(i32x8 a, i32x8 b, A_ c) {
    if constexpr (F8) {
        if constexpr (NOSWAP) return __builtin_amdgcn_mfma_scale_f32_16x16x128_f8f6f4(a, b, c, 0, 0, 0, 0, 0, 0);
        else return __builtin_amdgcn_mfma_scale_f32_16x16x128_f8f6f4(b, a, c, 0, 0, 0, 0, 0, 0);
    } else {
        const bf16x8 a0 = __builtin_bit_cast(bf16x8, __builtin_shufflevector(a, a, 0, 1, 2, 3)), a1 = __builtin_bit_cast(bf16x8, __builtin_shufflevector(a, a, 4, 5, 6, 7));
        const bf16x8 b0 = __builtin_bit_cast(bf16x8, __builtin_shufflevector(b, b, 0, 1, 2, 3)), b1 = __builtin_bit_cast(bf16x8, __builtin_shufflevector(b, b, 4, 5, 6, 7));
        c = mma1<NOSWAP, I8, A_>(a0, b0, c);
        return mma1<NOSWAP, I8, A_>(a1, b1, c);
    }
}
struct NextTile { const bf16_t* A; const bf16_t* Bt; int lda, ldb, brow, bcol; };
template <bool VT1, bool I8, bool F8 = false, class Epi>
__device__ __forceinline__ void gemm_tile(const bf16_t* __restrict__ A, int lda, const bf16_t* __restrict__ Bt, int ldb, int nt,
                                          int brow, int bcol, char* shmc, const Epi& epi, bool pre, const NextTile nx, int ws_) {
    bf16_t* shm = (bf16_t*)shmc;
    asm volatile("" : "+s"(nt));
#define SA(b,h) (shm+((b)*2+(h))*G_HT)
#define SB(b,h) (shm+(4+(b)*2+(h))*G_HT)
#define STAGE_X(OFF,LOFF,P,RS,LD,br,kt) do{ const int _so=((br)*(LD)+(kt)*G_BK)*2; \
    __builtin_amdgcn_raw_ptr_buffer_load_lds(RS, (__attribute__((address_space(3))) void*)((char*)(P)+(LOFF)),16,(int)(OFF),_so,0,0); \
    __builtin_amdgcn_raw_ptr_buffer_load_lds(RS, (__attribute__((address_space(3))) void*)((char*)(P)+(LOFF)+8192),16,(int)(OFF),_so+128*(LD),0,0);}while(0)
#define STAGE_A(P,br,kt) STAGE_X(offA,lwv,P,rsA,lda,br,kt)
#define STAGE_B(P,br,kt) STAGE_X(offB,lwv,P,rsB,ldb,br,kt)
#define LDF(base_,off_) (*reinterpret_cast<const i32x4*>((base_)+(off_)))
#define LDA(dst,b,h) _Pragma("unroll") for(int m=0;m<4;++m) \
    dst[m]=__builtin_shufflevector(LDF(fa_base,((b)*2+(h))*16384+m*2048),LDF(fa_base,((b)*2+(h))*16384+m*2048+1024),0,1,2,3,4,5,6,7)
#define LDB(dst,b,h) _Pragma("unroll") for(int n=0;n<2;++n) \
    dst[n]=__builtin_shufflevector(LDF(fb_base,((b)*2+(h))*16384+n*2048),LDF(fb_base,((b)*2+(h))*16384+n*2048+1024),0,1,2,3,4,5,6,7)
#define MMA(ai,bj,At_,Bt_) do{__builtin_amdgcn_s_setprio(1); \
    _Pragma("unroll") for(int m=0;m<4;++m) _Pragma("unroll") for(int n=0;n<2;++n) \
      acc[ai][bj][m][n]=mma2<VT1 && (bj)==1, I8, F8, typename AccT<I8>::type>(At_[m],Bt_[n],acc[ai][bj][m][n]); \
    __builtin_amdgcn_s_setprio(0);}while(0)
#define WAIT_V(n) asm volatile("s_waitcnt vmcnt(" #n ")":::"memory")
#define WAIT_L(n) asm volatile("s_waitcnt lgkmcnt(" #n ")":::"memory")
#define BAR __builtin_amdgcn_s_barrier()
#define SCHED __builtin_amdgcn_sched_barrier(0)
    int t0 = TIDX(ws_); asm volatile("" : "+v"(t0));
    int wid = t0 >> 6, lane = t0 & 63, wr = wid >> 2, wc = wid & 3, fr = lane & 15, fq = lane >> 4;
    typename AccT<I8>::type acc[2][2][4][2] = {};
    const char* fa_base = (const char*)shm + lds_byte(wr * 64 + fr, fq * 8);
    const char* fb_base = (const char*)shm + 65536 + lds_byte(wc * 32 + fr, fq * 8);
    i32x8 At[4], B0[2], B1[2];
    int loff = t0 * 16;
    const int lwv = __builtin_amdgcn_readfirstlane(t0 >> 6) * 1024;
    unsigned offA, offB;
    const __amdgpu_buffer_rsrc_t rsA = __builtin_amdgcn_make_buffer_rsrc((void*)A, (short)0, -1, 0x00020000);
    const __amdgpu_buffer_rsrc_t rsB = __builtin_amdgcn_make_buffer_rsrc((void*)Bt, (short)0, -1, 0x00020000);
    { int r_, c_; stage_rc(loff, r_, c_); offA = (unsigned)(r_ * lda + c_) * 2;
      const int i_ = r_ & 15, n_ = (r_ >> 4) & 1;
      offB = (unsigned)(((r_ & ~31) + 8 * (i_ >> 2) + 4 * n_ + (i_ & 3)) * ldb + c_) * 2; }
    if (!pre) {
        STAGE_B(SB(0,0),bcol,0); STAGE_A(SA(0,0),brow,0);
        STAGE_B(SB(0,1),bcol+G_HALF,0); STAGE_A(SA(0,1),brow+G_HALF,0);
        if (wr == 1) BAR;
        WAIT_V(4); BAR;
        STAGE_B(SB(1,0),bcol,1); STAGE_A(SA(1,0),brow,1); STAGE_B(SB(1,1),bcol+G_HALF,1);
        WAIT_V(6); BAR;
    } else {
        if (wr == 1) BAR;
        WAIT_V(4); BAR;
        BAR;
    }
    for (int t = 0; t < nt - 2; t += 2) {
        LDB(B0,0,0); SCHED; LDA(At,0,0); STAGE_A(SA(1,1),brow+G_HALF,t+1);
        WAIT_L(8); BAR; WAIT_L(0); MMA(0,0,At,B0); BAR; SCHED;
        LDB(B1,0,1); STAGE_B(SB(0,0),bcol,t+2);
        BAR; WAIT_L(0); MMA(0,1,At,B1); BAR;
        LDA(At,0,1); STAGE_A(SA(0,0),brow,t+2);
        BAR; WAIT_L(0); MMA(1,0,At,B0); BAR; SCHED;
        STAGE_B(SB(0,1),bcol+G_HALF,t+2);
        WAIT_V(6); BAR; MMA(1,1,At,B1); BAR;
        LDB(B0,1,0); SCHED; LDA(At,1,0); STAGE_A(SA(0,1),brow+G_HALF,t+2);
        WAIT_L(8); BAR; WAIT_L(0); MMA(0,0,At,B0); BAR; SCHED;
        LDB(B1,1,1); STAGE_B(SB(1,0),bcol,t+3);
        BAR; WAIT_L(0); MMA(0,1,At,B1); BAR;
        LDA(At,1,1); STAGE_A(SA(1,0),brow,t+3);
        BAR; WAIT_L(0); MMA(1,0,At,B0); BAR; SCHED;
        STAGE_B(SB(1,1),bcol+G_HALF,t+3);
        WAIT_V(6); BAR; MMA(1,1,At,B1); BAR;
    }
    int tz = TIDX(ws_); asm volatile("" : "+v"(tz)); wid = tz >> 6; lane = tz & 63; wr = wid >> 2; wc = wid & 3; fr = lane & 15; fq = lane >> 4;
    loff = tz * 16;
    fa_base = (const char*)shm + lds_byte(wr * 64 + fr, fq * 8); fb_base = (const char*)shm + 65536 + lds_byte(wc * 32 + fr, fq * 8);
    { int r_, c_; stage_rc(loff, r_, c_); offA = (unsigned)(r_ * lda + c_) * 2; }
    { LDB(B0,0,0); WAIT_V(0); LDA(At,0,0); STAGE_A(SA(1,1),brow+G_HALF,nt-1);
      BAR; WAIT_L(0); MMA(0,0,At,B0); BAR;
      LDB(B1,0,1); BAR; WAIT_L(0); MMA(0,1,At,B1); BAR;
      LDA(At,0,1); WAIT_V(4); BAR; WAIT_L(0); MMA(1,0,At,B0); MMA(1,1,At,B1); BAR; }
    { LDB(B0,1,0); LDA(At,1,0); WAIT_V(2); BAR; WAIT_L(0); MMA(0,0,At,B0); BAR;
      LDB(B1,1,1); WAIT_V(0); BAR; WAIT_L(0); MMA(0,1,At,B1); BAR;
      LDA(At,1,1); BAR; WAIT_L(0); MMA(1,0,At,B0); MMA(1,1,At,B1); BAR; }
    if (wr == 0) BAR;
    { int te = TIDX(ws_); asm volatile("" : "+v"(te)); wid = te >> 6; lane = te & 63; wr = wid >> 2; wc = wid & 3; fr = lane & 15; fq = lane >> 4; loff = te * 16; }
    if (nx.brow >= 0) {
        int r_, c_; stage_rc(loff, r_, c_);
        const int i_ = r_ & 15, n_ = (r_ >> 4) & 1;
        const unsigned offA2 = (unsigned)(r_ * nx.lda + c_) * 2;
        const unsigned offB2 = (unsigned)(((r_ & ~31) + 8 * (i_ >> 2) + 4 * n_ + (i_ & 3)) * nx.ldb + c_) * 2;
        const __amdgpu_buffer_rsrc_t rsA2 = __builtin_amdgcn_make_buffer_rsrc((void*)nx.A, (short)0, -1, 0x00020000);
        const __amdgpu_buffer_rsrc_t rsB2 = __builtin_amdgcn_make_buffer_rsrc((void*)nx.Bt, (short)0, -1, 0x00020000);
#define NXT_A(P,h,k) STAGE_X(offA2,lwv,P,rsA2,nx.lda,nx.brow+(h),k)
#define NXT_B(P,h,k) STAGE_X(offB2,lwv,P,rsB2,nx.ldb,nx.bcol+(h),k)
        NXT_B(SB(0,0),0,0); NXT_A(SA(0,0),0,0); NXT_B(SB(0,1),G_HALF,0); NXT_A(SA(0,1),G_HALF,0);
        NXT_B(SB(1,0),0,1); NXT_A(SA(1,0),0,1); NXT_B(SB(1,1),G_HALF,1);
#undef NXT_A
#undef NXT_B
    }
#pragma unroll
    for (int ai = 0; ai < 2; ++ai)
#pragma unroll
    for (int m = 0; m < 4; ++m) {
#pragma unroll
        for (int bj = 0; bj < 2; ++bj) {
            if (VT1 && bj == 1) {
#pragma unroll
                for (int n = 0; n < 2; ++n)
                    epi.storeT(brow + ai * G_HALF + wr * 64 + m * 16 + fq * 4, bcol + bj * G_HALF + wc * 32 + 8 * (fr >> 2) + 4 * n + (fr & 3), fq, acc[ai][bj][m][n]);
            } else {
                epi.store8(brow + ai * G_HALF + wr * 64 + m * 16 + fr, bcol + bj * G_HALF + wc * 32 + fq * 8, acc[ai][bj][m][0], acc[ai][bj][m][1]);
            }
        }
        asm volatile("" ::: "memory");
    }
    __syncthreads();
#undef SA
#undef SB
#undef STAGE_X
#undef STAGE_A
#undef STAGE_B
#undef LDA
#undef LDF
#undef LDB
#undef MMA
#undef WAIT_V
#undef WAIT_L
#undef BAR
#undef SCHED
}

__device__ __forceinline__ void st4bf(bf16_t* p, f32x4 v) {
    u32x2 o; o.x = pk2(v[0], v[1]); o.y = pk2(v[2], v[3]); *reinterpret_cast<u32x2*>(p) = o;
}
__device__ __forceinline__ void st8bf(bf16_t* p, f32x4 a, f32x4 b) {
    u32x4 o; o.x = pk2(a[0], a[1]); o.y = pk2(a[2], a[3]); o.z = pk2(b[0], b[1]); o.w = pk2(b[2], b[3]); *reinterpret_cast<u32x4*>(p) = o;
}
struct EpiBf16 {
    bf16_t* C; int ldc; float sc;
    __device__ __forceinline__ void store8(int row, int col, f32x4 a, f32x4 b) const { st8bf(C + (size_t)row * ldc + col, a * sc, b * sc); }
    __device__ __forceinline__ void storeT(int, int, int, f32x4) const {}
};
struct EpiI8 {
    bf16_t* C; int ldc; const float* rs; const float* cs; char* c8;
    __device__ __forceinline__ void store8(int row, int col, i32x4 a, i32x4 b) const {
        const float r = rs[row];
        const f32x4 c0 = *reinterpret_cast<const f32x4*>(cs + col), c1 = *reinterpret_cast<const f32x4*>(cs + col + 4);
        f32x4 fa = {(float)a[0], (float)a[1], (float)a[2], (float)a[3]}, fb = {(float)b[0], (float)b[1], (float)b[2], (float)b[3]};
        fa = fa * c0 * r; fb = fb * c1 * r;
        st8bf(C + (size_t)row * ldc + col, fa, fb);
        const int pn = __builtin_amdgcn_readfirstlane(col >> 8);
        if (c8 != nullptr && pn >= 4 && pn < 7) {
            u32x2 w = {(unsigned)pk_fp8x4(fa[0], fa[1], fa[2], fa[3]), (unsigned)pk_fp8x4(fb[0], fb[1], fb[2], fb[3])};
            *reinterpret_cast<u32x2*>(c8 + (size_t)row * 768 + (col - 1024)) = w;
        }
    }
    __device__ __forceinline__ void storeT(int, int, int, i32x4) const {}
};
struct EpiPool {
    bf16_t* C; const float* scale; int gcol0;
    __device__ __forceinline__ void store8(int row, int col, f32x4 a, f32x4 b) const {
        f32x4 s0 = *reinterpret_cast<const f32x4*>(scale + gcol0 + col), s1 = *reinterpret_cast<const f32x4*>(scale + gcol0 + col + 4);
        a = a * s0 * (1.f / 16.f); b = b * s1 * (1.f / 16.f);
        u32x2 w = {(unsigned)pk_fp8x4(a[0], a[1], a[2], a[3]), (unsigned)pk_fp8x4(b[0], b[1], b[2], b[3])};
        *reinterpret_cast<u32x2*>((char*)C + (size_t)row * DM + gcol0 + col) = w;
    }
    __device__ __forceinline__ void storeT(int, int, int, f32x4) const {}
};
struct EpiQ {
    bf16_t* C; const float* rstd;
    __device__ __forceinline__ void store8(int row, int col, f32x4 a, f32x4 b) const {
        float s = rstd[row] * (0.07216878364870322f * 1.4426950408889634f / 16.f);
        st8bf(C + (size_t)row * 1536 + col, a * s, b * s);
    }
    __device__ __forceinline__ void storeT(int, int, int, f32x4) const {}
};
struct EpiKV {
    bf16_t* Kn; bf16_t* Vt; const float* rstd;
    __device__ __forceinline__ void store8(int row, int col, f32x4 a, f32x4 b) const {
        int head = col >> 8, d = col & 127; float r = rstd[row] * (1.f / 16.f);
        u32x2 w = {(unsigned)pk_fp8x4(a[0] * r, a[1] * r, a[2] * r, a[3] * r), (unsigned)pk_fp8x4(b[0] * r, b[1] * r, b[2] * r, b[3] * r)};
        *reinterpret_cast<u32x2*>((char*)Kn + (size_t)row * 1024 + head * 128 + d) = w;
    }
    __device__ __forceinline__ void storeT(int row0, int col, int fq, f32x4 v) const {
        int head = col >> 8, d = col & 127, b = row0 >> 11, s = row0 & 2047;
        f32x4 r = *reinterpret_cast<const f32x4*>(rstd + row0) * (1.f / 16.f);
        const int kk = s & 63;
        const int pos = (s & ~63) + 32 * ((kk >> 2) & 1) + 16 * (kk >> 5) + 4 * ((kk & 31) >> 3);
        *reinterpret_cast<int*>((char*)Vt + ((size_t)((b * 8 + head) * 128 + d)) * SEQ + pos) = pk_fp8x4(v[0] * r[0], v[1] * r[1], v[2] * r[2], v[3] * r[3]);
    }
};

__device__ __forceinline__ int vcu_of(int bid, int nb) { return (nb % 8 == 0) ? (bid % 8) * (nb / 8) + bid / 8 : bid; }

__device__ __forceinline__ void xpose_item(const float* __restrict__ W, int K, int N, bf16_t* __restrict__ WT, int ldt, float* scr, int item, int lane,
                                           const float* __restrict__ rowscale) {
    const int nblk = N / 32, kb = item / nblk, nb = item % nblk, k0 = 64 * kb, n0 = 32 * nb;
#pragma unroll 8
    for (int i = 0; i < 32; ++i) {
        const int kk = 2 * i + (lane >> 5);
        float w = W[(size_t)(k0 + kk) * N + n0 + (lane & 31)];
        if (rowscale) w *= rowscale[k0 + kk];
        scr[kk * 33 + (lane & 31)] = w;
    }
    __builtin_amdgcn_s_waitcnt(0xc07f); asm volatile("" ::: "memory");
    const int c = lane & 7;
#pragma unroll
    for (int j = 0; j < 4; ++j) {
        const int n = (lane >> 3) + 8 * j; const float* s = scr + (8 * c) * 33 + n;
        u32x4 o; o.x = pk2(s[0 * 33], s[1 * 33]); o.y = pk2(s[2 * 33], s[3 * 33]); o.z = pk2(s[4 * 33], s[5 * 33]); o.w = pk2(s[6 * 33], s[7 * 33]);
        *reinterpret_cast<u32x4*>(WT + (size_t)(n0 + n) * ldt + k0 + 8 * c) = o;
    }
    __builtin_amdgcn_s_waitcnt(0xc07f); asm volatile("" ::: "memory");
}
__device__ __forceinline__ void xposef8_item(const float* __restrict__ W, int K, int N, char* __restrict__ WT8, int ldt, float* scr, int item, int lane, float mul,
                                             const float* __restrict__ rowscale = nullptr) {
    const int nblk = N / 32, kb = item / nblk, nb = item % nblk, k0 = 64 * kb, n0 = 32 * nb;
#pragma unroll 8
    for (int i = 0; i < 32; ++i) {
        const int kk = 2 * i + (lane >> 5);
        float w = W[(size_t)(k0 + kk) * N + n0 + (lane & 31)] * mul;
        if (rowscale) w *= rowscale[k0 + kk];
        scr[kk * 33 + (lane & 31)] = w;
    }
    __builtin_amdgcn_s_waitcnt(0xc07f); asm volatile("" ::: "memory");
    const int c = lane & 7;
#pragma unroll
    for (int j = 0; j < 4; ++j) {
        const int n = (lane >> 3) + 8 * j; const float* s = scr + (8 * c) * 33 + n;
        u32x2 o;
        o.x = (unsigned)pk_fp8x4(s[0 * 33], s[1 * 33], s[2 * 33], s[3 * 33]); o.y = (unsigned)pk_fp8x4(s[4 * 33], s[5 * 33], s[6 * 33], s[7 * 33]);
        *reinterpret_cast<u32x2*>(WT8 + (size_t)(n0 + n) * ldt + k0 + 8 * c) = o;
    }
    __builtin_amdgcn_s_waitcnt(0xc07f); asm volatile("" ::: "memory");
}
__device__ __forceinline__ void xpose8_item(const float* __restrict__ W, int N, char* __restrict__ WT8, float* scr, int item, int lane,
                                            const unsigned* __restrict__ cmax, float* __restrict__ wsc) {
    const int nblk = N / 32, kb = item / nblk, nb = item % nblk, k0 = 64 * kb, n0 = 32 * nb;
    const float cm = __uint_as_float(cmax[n0 + (lane & 31)]);
    const float qm = cm > 0.f ? 127.f / cm : 0.f;
    if (kb == 0 && lane < 32) wsc[n0 + lane] = cm * (1.f / 127.f);
#pragma unroll 8
    for (int i = 0; i < 32; ++i) {
        const int kk = 2 * i + (lane >> 5);
        scr[kk * 33 + (lane & 31)] = W[(size_t)(k0 + kk) * N + n0 + (lane & 31)] * qm;
    }
    __builtin_amdgcn_s_waitcnt(0xc07f); asm volatile("" ::: "memory");
    const int c = lane & 7;
#pragma unroll
    for (int j = 0; j < 4; ++j) {
        const int n = (lane >> 3) + 8 * j; const float* s = scr + (8 * c) * 33 + n;
        u32x2 o;
        o.x = pack_i8x4(s[0 * 33], s[1 * 33], s[2 * 33], s[3 * 33]); o.y = pack_i8x4(s[4 * 33], s[5 * 33], s[6 * 33], s[7 * 33]);
        *reinterpret_cast<u32x2*>(WT8 + (size_t)(n0 + n) * 2048 + k0 + 8 * c) = o;
    }
    __builtin_amdgcn_s_waitcnt(0xc07f); asm volatile("" ::: "memory");
}
__device__ __forceinline__ void cvt_bf16_range(const float* __restrict__ src, bf16_t* __restrict__ dst, size_t n8, size_t gtid, size_t gthreads) {
    for (size_t i = gtid; i < n8; i += gthreads) {
        f32x4 a = *reinterpret_cast<const f32x4*>(src + i * 8), b = *reinterpret_cast<const f32x4*>(src + i * 8 + 4);
        u32x4 o; o.x = pk2(a[0], a[1]); o.y = pk2(a[2], a[3]); o.z = pk2(b[0], b[1]); o.w = pk2(b[2], b[3]);
        *reinterpret_cast<u32x4*>(dst + i * 8) = o;
    }
}
__device__ __forceinline__ void phase0(const Params& p, char* shm, int bid, int nb) {
    const int tid = TIDX(p.wave_s), wave = tid >> 6, lane = tid & 63;
    char* ws = p.ws;
#ifndef DUP_P0
#define DUP_P0 (-1)
#endif
    for (int rp_ = 0; rp_ < (DUP_P0 == 0 ? 2 : 1); ++rp_)
    {
        float* sl = (float*)shm;
        float* red = (float*)(shm + 65536);
        float* mod = (float*)(ws + WS_MOD);
        if (bid < 192 || nb != 256) {
            for (int i = tid; i < 8 * DM; i += NTHREADS) { float cv = p.c[i]; sl[i] = cv / (1.f + __expf(-cv)); }
            __syncthreads();
            for (int it = bid; it < 192; it += nb) {
                const int col = it * 64 + lane;
                float acc[8];
#pragma unroll
                for (int b = 0; b < 8; ++b) acc[b] = 0.f;
                const float* wp = p.ada_w + (size_t)(wave * 256) * 12288 + col;
                const float* sp = sl + wave * 256;
#pragma unroll 1
                for (int r0 = 0; r0 < 256; r0 += 32) {
                    float w[32];
#pragma unroll
                    for (int i = 0; i < 32; ++i) w[i] = wp[(size_t)(r0 + i) * 12288];
#pragma unroll
                    for (int q = 0; q < 8; ++q)
#pragma unroll
                        for (int b = 0; b < 8; ++b) {
                            const f32x4 s4 = *reinterpret_cast<const f32x4*>(sp + b * DM + r0 + 4 * q);
                            acc[b] += w[4 * q] * s4[0] + w[4 * q + 1] * s4[1] + w[4 * q + 2] * s4[2] + w[4 * q + 3] * s4[3];
                        }
                }
#pragma unroll
                for (int b = 0; b < 8; ++b) red[(wave * 8 + b) * 64 + lane] = acc[b];
                __syncthreads();
                {
                    const int b = tid >> 6, cl = tid & 63;
                    float sum = 0.f;
#pragma unroll
                    for (int w = 0; w < 8; ++w) sum += red[(w * 8 + b) * 64 + cl];
                    mod[b * 12288 + it * 64 + cl] = sum + p.ada_b[it * 64 + cl];
                }
                __syncthreads();
            }
        }
    }
    const int gw = bid * NWAVES + wave, ngw = nb * NWAVES;
    const size_t gtid = (size_t)bid * NTHREADS + tid, gthreads = (size_t)nb * NTHREADS;
    for (int rp_ = 0; rp_ < (DUP_P0 == 1 ? 2 : 1); ++rp_)
    {
        float* scr = (float*)(shm + wave * 8448);
        constexpr int I_POOL = 4 * 4 * 8, I_UQ = 8 * 48, I_UKV = 4 * 64, I_OUT = 32 * 64;
        constexpr int NIT = I_POOL + I_UQ + I_UKV + I_OUT;
        for (int it = gw; it < NIT; it += ngw) {
            int r = it;
            if (r < I_POOL) { int g = r / 32; xposef8_item(p.pool_w + g * 65536, 256, 256, ws + WS_WPOOL + g * 65536, 256, scr, r % 32, lane, 16.f); continue; } r -= I_POOL;
            if (r < I_UQ) { xposef8_item(p.w_uq, 512, 1536, ws + WS_WUQ, 512, scr, r, lane, 16.f, p.q_norm_g); continue; } r -= I_UQ;
            if (r < I_UKV) { xposef8_item(p.w_ukv, 256, 2048, ws + WS_WUKV, 256, scr, r, lane, 16.f, p.kv_norm_g); continue; } r -= I_UKV;
            xposef8_item(p.w_out, 2048, 2048, ws + WS_WOUT, 2048, scr, r, lane, 32.f);
        }
        unsigned* cmax = (unsigned*)(ws + WS_CMAX);
        for (int it = gw; it < (29 + 32) * 16; it += ngw) {
            const int strip = it >> 4, kc = it & 15;
            const bool isq = strip >= 29;
            const int n = (isq ? strip - 29 : strip) * 64 + lane, N = isq ? 2048 : 1856;
            const float* wp = (isq ? p.peer_wq : p.w_in) + (size_t)(kc * 128) * N + n;
            float m = 0.f;
#pragma unroll 32
            for (int r = 0; r < 128; ++r) m = fmaxf(m, fabsf(wp[(size_t)r * N]));
            atomicMax(cmax + (isq ? 2048 : 0) + n, __float_as_uint(m));
        }
    }
    cvt_bf16_range(p.sub_keys, (bf16_t*)(ws + WS_SK), 262144 / 8, gtid, gthreads);
    for (int rp_ = 0; rp_ < (DUP_P0 == 2 ? 2 : 1); ++rp_)
    {
        float* tile = (float*)shm;
        float* redm = (float*)(shm + 16 * 2052 * 4);
        float* scl = redm + 128;
        int ntl, tfirst, tstep;
        if (nb == 256) { if (bid < 192) { ntl = 7; tfirst = bid * 7; } else { ntl = 11; tfirst = 192 * 7 + (bid - 192) * 11; } tstep = 1; }
        else { ntl = (2048 - bid + nb - 1) / nb; tfirst = bid; tstep = nb; }
#define Q_LOAD(dst, i_) do { const int itl_ = tfirst + (i_) * tstep; \
            const float* src_ = ((itl_ >> 10) ? p.peer_v : p.peer_u) + (size_t)((itl_ & 1023) * 16) * DM; \
            _Pragma("unroll") for (int k = 0; k < 16; ++k) dst[k] = *reinterpret_cast<const f32x4*>(reinterpret_cast<const char*>(src_ + (size_t)k * DM) + qoff); } while (0)
#define Q_TILE(vs, i_) do { \
            const int it = tfirst + (i_) * tstep; \
            const int isv = it >> 10, e0 = (it & 1023) * 16; \
            float mx[16]; \
            _Pragma("unroll") for (int k = 0; k < 16; ++k) { \
                *reinterpret_cast<f32x4*>(tile + k * 2052 + tid * 4) = vs[k]; \
                mx[k] = fmaxf(fmaxf(fabsf(vs[k][0]), fabsf(vs[k][1])), fmaxf(fabsf(vs[k][2]), fabsf(vs[k][3]))); \
            } \
            if ((i_) + 1 < ntl) Q_LOAD(vs, (i_) + 1); \
            _Pragma("unroll") for (int k = 0; k < 16; ++k) { \
                _Pragma("unroll") for (int o = 1; o < 64; o <<= 1) mx[k] = fmaxf(mx[k], __shfl_xor(mx[k], o)); \
            } \
            if (lane == 0) { _Pragma("unroll") for (int k = 0; k < 16; ++k) redm[wave * 16 + k] = mx[k]; } \
            __syncthreads(); \
            if (tid < 16) { \
                float m = 0.f; \
                _Pragma("unroll") for (int w = 0; w < 8; ++w) m = fmaxf(m, redm[w * 16 + tid]); \
                const float top = isv ? 256.f : 127.f; \
                scl[tid] = m > 0.f ? top / m : 0.f; \
                ((float*)(ws + (isv ? WS_SV : WS_SU)))[e0 + tid] = m / top; \
            } \
            __syncthreads(); \
            char* dst = ws + (isv ? WS_V8 : WS_U8); \
            _Pragma("unroll") for (int k = 0; k < 8; ++k) { \
                const int item = tid + k * NTHREADS, e = item & 15, sl = item >> 4; \
                const float* tp = tile + e * 2052 + sl * 8; \
                f32x4 a = *reinterpret_cast<const f32x4*>(tp), c = *reinterpret_cast<const f32x4*>(tp + 4); \
                const float m = scl[e]; \
                u32x2 o; \
                if (isv) { \
                    int w0 = __builtin_amdgcn_cvt_pk_fp8_f32(a[0] * m, a[1] * m, 0, false); \
                    w0 = __builtin_amdgcn_cvt_pk_fp8_f32(a[2] * m, a[3] * m, w0, true); \
                    int w1 = __builtin_amdgcn_cvt_pk_fp8_f32(c[0] * m, c[1] * m, 0, false); \
                    w1 = __builtin_amdgcn_cvt_pk_fp8_f32(c[2] * m, c[3] * m, w1, true); \
                    o.x = (unsigned)w0; o.y = (unsigned)w1; \
                } else { \
                    o.x = pack_i8x4(a[0] * m, a[1] * m, a[2] * m, a[3] * m); o.y = pack_i8x4(c[0] * m, c[1] * m, c[2] * m, c[3] * m); \
                } \
                *reinterpret_cast<u32x2*>(dst + ((size_t)sl * 16384 + e0 + e) * 8) = o; \
                if (k & 1) __builtin_amdgcn_sched_barrier(0); \
            } \
            __syncthreads(); } while (0)
        f32x4 va[16];
        const unsigned qoff = (unsigned)tid * 16u;
        Q_LOAD(va, 0);
        __syncthreads();
#pragma unroll 1
        for (int i = 0; i < ntl; ++i) Q_TILE(va, i);
#undef Q_LOAD
#undef Q_TILE
    }
    {
        float2* cs = (float2*)(ws + WS_CS);
        for (size_t i = gtid; i < (size_t)NTOK * 32; i += gthreads) {
            int t = (int)(i >> 5), k = (int)(i & 31);
            float invf = exp2f(-(float)k * (13.287712379549449f / 32.f));
            float ang = (float)p.pos[t] * invf;
            double sd, cd; sincos((double)ang, &sd, &cd);
            cs[i] = make_float2((float)cd, (float)sd);
        }
    }
}

__device__ __forceinline__ void phase1(const Params& p, char* shm, int bid, int nb) {
    const int tid = TIDX(p.wave_s), wave = tid >> 6, lane = tid & 63;
    const float* mod = (const float*)(p.ws + WS_MOD);
    char* h1 = p.ws + WS_BUF1;
    float* sh1 = (float*)(p.ws + WS_SH1);
    float* lv = (float*)shm;
    for (int item = bid; item < NTOK / 64; item += nb) {
        const int b = item >> 5;
        __syncthreads();
        for (int i = tid; i < 512; i += NTHREADS) {
            *reinterpret_cast<f32x4*>(lv + 0 * DM + i * 4) = *reinterpret_cast<const f32x4*>(p.pre_mix_g + i * 4);
            *reinterpret_cast<f32x4*>(lv + 1 * DM + i * 4) = *reinterpret_cast<const f32x4*>(mod + b * 12288 + i * 4);
            *reinterpret_cast<f32x4*>(lv + 2 * DM + i * 4) = *reinterpret_cast<const f32x4*>(mod + b * 12288 + 2048 + i * 4);
        }
        __syncthreads();
#pragma unroll 1
        for (int rr = 0; rr < 8; ++rr) {
            const int row = item * 64 + rr * 8 + wave;
            const float* xr = p.x + (size_t)row * DM + lane * 4;
            f32x4 v[8]; float ss = 0.f;
#pragma unroll
            for (int i = 0; i < 8; ++i) { v[i] = *reinterpret_cast<const f32x4*>(xr + i * 256); ss += v[i][0] * v[i][0] + v[i][1] * v[i][1] + v[i][2] * v[i][2] + v[i][3] * v[i][3]; }
            const float rstd = rsqrtf(wave_sum(ss) * (1.f / DM) + EPS);
            float hmax = 0.f;
#pragma unroll
            for (int i = 0; i < 8; ++i) {
                const int col = i * 256 + lane * 4;
                f32x4 g = *reinterpret_cast<const f32x4*>(lv + col);
                f32x4 sh = *reinterpret_cast<const f32x4*>(lv + DM + col);
                f32x4 sc = *reinterpret_cast<const f32x4*>(lv + 2 * DM + col);
                v[i] = v[i] * rstd * g * (sc + 1.f) + sh;
                hmax = fmaxf(hmax, fmaxf(fmaxf(fabsf(v[i][0]), fabsf(v[i][1])), fmaxf(fabsf(v[i][2]), fabsf(v[i][3]))));
            }
#pragma unroll
            for (int o = 1; o < 64; o <<= 1) hmax = fmaxf(hmax, __shfl_xor(hmax, o));
            const float qm = hmax > 0.f ? 127.f / hmax : 0.f;
            if (lane == 0) sh1[row] = hmax * (1.f / 127.f);
#pragma unroll
            for (int i = 0; i < 8; ++i) {
                *reinterpret_cast<unsigned*>(h1 + (size_t)row * DM + i * 256 + lane * 4) = pack_i8x4(v[i][0] * qm, v[i][1] * qm, v[i][2] * qm, v[i][3] * qm);
            }
        }
    }
    {
        __syncthreads();
        float* scr = (float*)(shm + wave * 8448);
        const unsigned* cmax = (const unsigned*)(p.ws + WS_CMAX);
        float* wsc = (float*)(p.ws + WS_WSC);
        const int gw = bid * NWAVES + wave, ngw = nb * NWAVES;
        constexpr int I_IN = 32 * 58, I_PQ = 32 * 64;
        for (int it = gw; it < I_IN + I_PQ; it += ngw) {
            if (it < I_IN) xpose8_item(p.w_in, 1856, p.ws + WS_WIN, scr, it, lane, cmax, wsc);
            else xpose8_item(p.peer_wq, 2048, p.ws + WS_WPQ, scr, it - I_IN, lane, cmax + 2048, wsc + 2048);
        }
        const size_t gtid = (size_t)bid * NTHREADS + tid, gthreads = (size_t)nb * NTHREADS;
        for (size_t i = gtid; i < 24576; i += gthreads) *reinterpret_cast<u32x4*>(p.ws + WS_WIN + (size_t)1856 * 2048 + i * 16) = u32x4{0u, 0u, 0u, 0u};
        for (size_t i = gtid; i < 192; i += gthreads) wsc[1856 + i] = 0.f;
        __syncthreads();
    }
}

template <bool VT1, bool I8, bool F8 = false, class Epi>
__device__ __forceinline__ void gemm_phase(const bf16_t* A, int lda, const bf16_t* Bt, int ldb, int K, int nN, int ntiles, int tile0, int vcu, int nb,
                                           char* shm, const Epi& epi, int ws_) {
    int first = ((vcu - tile0) % nb + nb) % nb;
    bool pre = false;
    for (int t = first; t < ntiles; t += nb) {
        const int pm = t / nN, pn = t % nN;
        const int tn = t + nb;
        const bool has = tn < ntiles;
        const NextTile nx{A, Bt, lda, ldb, has ? (tn / nN) * 256 : -1, (tn % nN) * 256};
        gemm_tile<VT1, I8, F8>(A, lda, Bt, ldb, K / 64, pm * 256, pn * 256, shm, epi, pre, nx, ws_);
        pre = has;
    }
}

__device__ __forceinline__ void phase3(const Params& p, int bid, int nb) {
    const int tid = TIDX(p.wave_s), wave = tid >> 6, lane = tid & 63;
    const bf16_t* proj = (const bf16_t*)(p.ws + WS_BUF2);
    bf16_t* z = (bf16_t*)(p.ws + WS_Z);
    for (int it = bid * NTHREADS + tid; it < 1024 * 128; it += nb * NTHREADS) {
        const int strip = it >> 7, c8 = it & 127, g = c8 >> 5, w = 2 << g;
        const int t0 = strip * 16, s0 = t0 & 2047;
        const bf16_t* up = proj + (size_t)t0 * DM + c8 * 8;
        float sum[8];
#pragma unroll
        for (int j = 0; j < 8; ++j) sum[j] = 0.f;
        for (int i = 1; i <= w; ++i) {
            if (s0 - i >= 0) {
                u32x4 r = *reinterpret_cast<const u32x4*>(up - (ptrdiff_t)i * DM);
#pragma unroll
                for (int j = 0; j < 4; ++j) { sum[2 * j] += bflo(r[j]); sum[2 * j + 1] += bfhi(r[j]); }
            }
        }
        for (int tt = 0; tt < 16; ++tt) {
            const int s = s0 + tt;
            u32x4 r = *reinterpret_cast<const u32x4*>(up + (size_t)tt * DM);
            float cur[8];
#pragma unroll
            for (int j = 0; j < 4; ++j) { cur[2 * j] = bflo(r[j]); cur[2 * j + 1] = bfhi(r[j]); }
#pragma unroll
            for (int j = 0; j < 8; ++j) sum[j] += cur[j];
            if (s >= w) {
                u32x4 o = *reinterpret_cast<const u32x4*>(up + (ptrdiff_t)(tt - w) * DM);
#pragma unroll
                for (int j = 0; j < 4; ++j) { sum[2 * j] -= bflo(o[j]); sum[2 * j + 1] -= bfhi(o[j]); }
            }
            const float inv = 1.f / (float)min(s + 1, w);
            u32x2 o;
            o.x = (unsigned)pk_fp8x4(sum[0] * inv - cur[0], sum[1] * inv - cur[1], sum[2] * inv - cur[2], sum[3] * inv - cur[3]);
            o.y = (unsigned)pk_fp8x4(sum[4] * inv - cur[4], sum[5] * inv - cur[5], sum[6] * inv - cur[6], sum[7] * inv - cur[7]);
            *reinterpret_cast<u32x2*>((char*)z + (size_t)(t0 + tt) * 1024 + c8 * 8) = o;
        }
    }
    float* rq = (float*)(p.ws + WS_RSTDQ); float* rkv = (float*)(p.ws + WS_RSTDKV);
    bf16_t* kpe = (bf16_t*)(p.ws + WS_KPE);
    const float2* cs = (const float2*)(p.ws + WS_CS);
    for (int t = bid * NWAVES + wave; t < NTOK; t += nb * NWAVES) {
        const bf16_t* pr = proj + (size_t)t * DM;
        u32x4 a = *reinterpret_cast<const u32x4*>(pr + 1024 + lane * 8);
        float s1 = 0.f;
#pragma unroll
        for (int j = 0; j < 4; ++j) { float lo = bflo(a[j]), hi = bfhi(a[j]); s1 += lo * lo + hi * hi; }
        u32x2 bq = *reinterpret_cast<const u32x2*>(pr + 1536 + lane * 4);
        float s2 = 0.f;
#pragma unroll
        for (int j = 0; j < 2; ++j) { float lo = bflo(bq[j]), hi = bfhi(bq[j]); s2 += lo * lo + hi * hi; }
        s1 = wave_sum(s1); s2 = wave_sum(s2);
        if (lane == 0) { rq[t] = rsqrtf(s1 * (1.f / 512.f) + EPS); rkv[t] = rsqrtf(s2 * (1.f / 256.f) + EPS); }
        if (lane < 32) {
            float x1 = bf2f((short)pr[1792 + lane]), x2 = bf2f((short)pr[1792 + 32 + lane]);
            float2 c = cs[(size_t)t * 32 + lane];
            unsigned char* k8 = (unsigned char*)kpe + (size_t)t * 64 + 32 * (lane >> 4) + (lane & 15);
            const int w = pk_fp8x4(x1 * c.x - x2 * c.y, x2 * c.x + x1 * c.y, 0.f, 0.f);
            k8[0] = (unsigned char)(w & 0xff); k8[16] = (unsigned char)((w >> 8) & 0xff);
        }
    }
}

constexpr int KS_STRIDE = 208, VS_STRIDE = 80;
constexpr int KS_BYTES = 64 * KS_STRIDE, VS_BYTES = 128 * VS_STRIDE, AT_STAGE = KS_BYTES + VS_BYTES;
__device__ __forceinline__ void attn_unit(const Params& p, char* shm, int b, int head, int qb) {
    int tid = TIDX(p.wave_s); asm volatile("" : "+v"(tid));
    const int wave = __builtin_amdgcn_readfirstlane(tid >> 6), lane = tid & 63, l31 = lane & 31, hh = lane >> 5;
    const bool grpB = wave >= 4;
    const int rowblk = (wave & 3) * 2 + (wave >> 2);
    const bf16_t* Q = (const bf16_t*)(p.ws + WS_Q);
    const bf16_t* Kn = (const bf16_t*)(p.ws + WS_KN);
    const bf16_t* Kpe = (const bf16_t*)(p.ws + WS_KPE);
    const bf16_t* Vt = (const bf16_t*)(p.ws + WS_VT);
    const float2* cs = (const float2*)(p.ws + WS_CS);
    bf16_t* ycat = (bf16_t*)(p.ws + WS_BUF1);
    const int q0 = qb * 256 + rowblk * 32, mychunk = q0 >> 6, nkt = 4 * qb + 4;
    const int tq = b * SEQ + q0 + l31;
    i32x8 qf[3];
    {
        const bf16_t* qrow = Q + (size_t)tq * 1536 + head * 192;
#pragma unroll
        for (int ks = 0; ks < 2; ++ks)
#pragma unroll
            for (int i = 0; i < 4; ++i) {
                const bf16x8 v = *reinterpret_cast<const bf16x8*>(qrow + ks * 64 + hh * 32 + 8 * i);
                qf[ks][2 * i] = pk_fp8x4(bf2f(v[0]) * 8.f, bf2f(v[1]) * 8.f, bf2f(v[2]) * 8.f, bf2f(v[3]) * 8.f);
                qf[ks][2 * i + 1] = pk_fp8x4(bf2f(v[4]) * 8.f, bf2f(v[5]) * 8.f, bf2f(v[6]) * 8.f, bf2f(v[7]) * 8.f);
            }
#pragma unroll
        for (int i = 0; i < 2; ++i) {
            const bf16x8 a = *reinterpret_cast<const bf16x8*>(qrow + 128 + 16 * hh + 8 * i);
            const bf16x8 c2 = *reinterpret_cast<const bf16x8*>(qrow + 160 + 16 * hh + 8 * i);
            const float2* cp = cs + (size_t)tq * 32 + 16 * hh + 8 * i;
            float o1[8], o2[8];
#pragma unroll
            for (int j = 0; j < 8; ++j) {
                const float2 c = cp[j];
                const float x1 = bf2f(a[j]) * 8.f, x2 = bf2f(c2[j]) * 8.f;
                o1[j] = x1 * c.x - x2 * c.y; o2[j] = x2 * c.x + x1 * c.y;
            }
            qf[2][2 * i] = pk_fp8x4(o1[0], o1[1], o1[2], o1[3]); qf[2][2 * i + 1] = pk_fp8x4(o1[4], o1[5], o1[6], o1[7]);
            qf[2][4 + 2 * i] = pk_fp8x4(o2[0], o2[1], o2[2], o2[3]); qf[2][4 + 2 * i + 1] = pk_fp8x4(o2[4], o2[5], o2[6], o2[7]);
        }
    }
    f32x16 O[4];
#pragma unroll
    for (int dt = 0; dt < 4; ++dt)
#pragma unroll
        for (int r = 0; r < 16; ++r) O[dt][r] = 0.f;
    float mrun = -1e30f, lsum = 0.f;
    f32x16 s0, s1;
    const int kkey = tid >> 3, kch = tid & 7;
    const int pk_key = tid >> 2, pk_ch = tid & 3;
    const int vd = tid >> 2, vch = tid & 3;
    const size_t tokb = (size_t)b * SEQ;
    const char* Kn8 = (const char*)Kn; const char* Kpe8 = (const char*)Kpe;
    const char* vbase = (const char*)Vt + (size_t)((b * 8 + head) * 128) * SEQ;
    u32x4 r0, r2, r3;
#define AT_LOAD(kt) do { const int k0_ = (kt) * 64; \
        r0 = *reinterpret_cast<const u32x4*>(Kn8 + (tokb + k0_ + kkey) * 1024 + head * 128 + kch * 16); \
        if (wave < 4) r2 = *reinterpret_cast<const u32x4*>(Kpe8 + (tokb + k0_ + pk_key) * 64 + pk_ch * 16); \
        r3 = *reinterpret_cast<const u32x4*>(vbase + (size_t)vd * SEQ + k0_ + vch * 16); } while (0)
#define AT_WRITE(buf) do { char* ks_ = shm + (buf) * AT_STAGE; char* vs_ = ks_ + KS_BYTES; \
        *reinterpret_cast<u32x4*>(ks_ + kkey * KS_STRIDE + kch * 16) = r0; \
        if (wave < 4) *reinterpret_cast<u32x4*>(ks_ + pk_key * KS_STRIDE + 128 + pk_ch * 16) = r2; \
        *reinterpret_cast<u32x4*>(vs_ + vd * VS_STRIDE + vch * 16) = r3; } while (0)
#define LDK(ks_, t_) __builtin_shufflevector(*reinterpret_cast<const i32x4*>(kb + (t_) * 32 * KS_STRIDE + (ks_) * 64), \
                                             *reinterpret_cast<const i32x4*>(kb + (t_) * 32 * KS_STRIDE + (ks_) * 64 + 16), 0, 1, 2, 3, 4, 5, 6, 7)
#define MXQK(a_, b_, c_) __builtin_amdgcn_mfma_scale_f32_32x32x64_f8f6f4(a_, b_, c_, 0, 0, 0, 0x7F7F7F7F, 0, 0x7F7F7F7F)
#define QK(buf) do { \
        const char* kb = shm + (buf) * AT_STAGE + l31 * KS_STRIDE + hh * 32; \
        i32x8 ka0 = LDK(0, 0), ka1 = LDK(0, 1), kb0 = LDK(1, 0), kb1 = LDK(1, 1); \
        _Pragma("unroll") for (int r = 0; r < 16; ++r) { s0[r] = 0.f; s1[r] = 0.f; } \
        __builtin_amdgcn_sched_barrier(0); \
        s0 = MXQK(ka0, qf[0], s0); \
        s1 = MXQK(ka1, qf[0], s1); \
        ka0 = LDK(2, 0); ka1 = LDK(2, 1); \
        __builtin_amdgcn_sched_barrier(0); \
        s0 = MXQK(kb0, qf[1], s0); \
        s1 = MXQK(kb1, qf[1], s1); \
        __builtin_amdgcn_sched_barrier(0); \
        s0 = MXQK(ka0, qf[2], s0); \
        s1 = MXQK(ka1, qf[2], s1); \
        __builtin_amdgcn_sched_barrier(0); } while (0)
#define LDV(dt_) __builtin_shufflevector(*reinterpret_cast<const i32x4*>(vb + (dt_) * 32 * VS_STRIDE), *reinterpret_cast<const i32x4*>(vb + (dt_) * 32 * VS_STRIDE + 16), 0, 1, 2, 3, 4, 5, 6, 7)
#define SMPV(buf) do { \
        const char* vb = shm + (buf) * AT_STAGE + KS_BYTES + l31 * VS_STRIDE + hh * 32; \
        i32x8 va[4]; \
        _Pragma("unroll") for (int dt = 0; dt < 4; ++dt) va[dt] = LDV(dt); \
        float mx = s0[0]; \
        _Pragma("unroll") for (int r = 1; r < 16; ++r) mx = fmaxf(mx, s0[r]); \
        _Pragma("unroll") for (int r = 0; r < 16; ++r) mx = fmaxf(mx, s1[r]); \
        mx = fmaxf(mx, __shfl_xor(mx, 32)); \
        const float mnew = fmaxf(mrun, mx * 0.125f); \
        const float alpha = __builtin_amdgcn_exp2f(mrun - mnew); \
        mrun = mnew; \
        const float moff = 6.f - mnew;        \
        float ps = 0.f; \
        _Pragma("unroll") for (int r = 0; r < 16; ++r) { s0[r] = __builtin_amdgcn_exp2f(fmaf(s0[r], 0.125f, moff)); ps += s0[r]; } \
        _Pragma("unroll") for (int r = 0; r < 16; ++r) { s1[r] = __builtin_amdgcn_exp2f(fmaf(s1[r], 0.125f, moff)); ps += s1[r]; } \
        lsum = lsum * alpha + ps; \
        _Pragma("unroll") for (int dt = 0; dt < 4; ++dt) _Pragma("unroll") for (int r = 0; r < 16; ++r) O[dt][r] *= alpha; \
        i32x8 pf; \
        _Pragma("unroll") for (int g = 0; g < 4; ++g) { \
            pf[g] = pk_fp8x4(s0[4 * g], s0[4 * g + 1], s0[4 * g + 2], s0[4 * g + 3]); \
            pf[4 + g] = pk_fp8x4(s1[4 * g], s1[4 * g + 1], s1[4 * g + 2], s1[4 * g + 3]); \
        } \
        __builtin_amdgcn_sched_barrier(0); \
        _Pragma("unroll") for (int dt = 0; dt < 4; ++dt) O[dt] = MXQK(va[dt], pf, O[dt]); \
        __builtin_amdgcn_sched_barrier(0); } while (0)
    __syncthreads();
    AT_LOAD(0); AT_WRITE(0);
    AT_LOAD(1);
    __syncthreads();
    if (grpB) __syncthreads();
    int bcur = 0, bnext = 1;
    for (int kt = 0; kt < nkt; ++kt) {
        if (kt + 1 < nkt) AT_WRITE(bnext);
        if (kt + 2 < nkt) AT_LOAD(kt + 2);
        __builtin_amdgcn_sched_barrier(0);
        if (kt <= mychunk) QK(bcur);
        __syncthreads();
        if (kt <= mychunk) SMPV(bcur);
        __syncthreads();
        bcur = bnext; bnext = (bnext == 2) ? 0 : bnext + 1;
    }
    if (!grpB) __syncthreads();
#undef AT_LOAD
#undef AT_WRITE
#undef QK
#undef SMPV
#undef LDK
#undef MXQK
#undef LDV
    lsum += __shfl_xor(lsum, 32);
    const float inv = 1.f / lsum;
    char* orow = (char*)ycat + (size_t)tq * DM + 1024 + head * 128 + 4 * hh;
#pragma unroll
    for (int dt = 0; dt < 4; ++dt)
#pragma unroll
        for (int g = 0; g < 4; ++g)
            *reinterpret_cast<int*>(orow + dt * 32 + 8 * g) = pk_fp8x4(O[dt][4 * g] * inv, O[dt][4 * g + 1] * inv, O[dt][4 * g + 2] * inv, O[dt][4 * g + 3] * inv);
}
__device__ __forceinline__ void phase5(const Params& p, char* shm, int bid, int nb) {
    for (int it = bid; it < 256; it += nb) {
        const int bh = it >> 2, pr = it & 3, b = bh >> 3, head = bh & 7;
        attn_unit(p, shm, b, head, 7 - pr);
        attn_unit(p, shm, b, head, pr);
    }
}

__device__ __forceinline__ void phase7(const Params& p, char* shm, int bid, int nb) {
    const int tid = TIDX(p.wave_s), wave = tid >> 6, lane = tid & 63;
    const float* mod = (const float*)(p.ws + WS_MOD);
    const bf16_t* y = (const bf16_t*)(p.ws + WS_BUF2);
    bf16_t* x1 = (bf16_t*)(p.ws + WS_X1);
    float* lv = (float*)shm;
    for (int item = bid; item < NTOK / 64; item += nb) {
        const int b = item >> 5;
        const float* md = mod + b * 12288;
        __syncthreads();
        for (int i = tid; i < 512; i += NTHREADS) {
            *reinterpret_cast<f32x4*>(lv + 0 * DM + i * 4) = *reinterpret_cast<const f32x4*>(p.post_mix_g + i * 4);
            *reinterpret_cast<f32x4*>(lv + 1 * DM + i * 4) = *reinterpret_cast<const f32x4*>(md + 4096 + i * 4);
            *reinterpret_cast<f32x4*>(lv + 2 * DM + i * 4) = *reinterpret_cast<const f32x4*>(p.pre_ffn_g + i * 4);
            *reinterpret_cast<f32x4*>(lv + 3 * DM + i * 4) = *reinterpret_cast<const f32x4*>(md + 6144 + i * 4);
            *reinterpret_cast<f32x4*>(lv + 4 * DM + i * 4) = *reinterpret_cast<const f32x4*>(md + 8192 + i * 4);
        }
        __syncthreads();
#pragma unroll 1
        for (int rr = 0; rr < 8; ++rr) {
            const int row = item * 64 + rr * 8 + wave;
            f32x4 yv[8]; float ss = 0.f;
#pragma unroll
            for (int i = 0; i < 8; ++i) {
                u32x2 r = *reinterpret_cast<const u32x2*>(y + (size_t)row * DM + i * 256 + lane * 4);
                yv[i] = f32x4{bflo(r.x), bfhi(r.x), bflo(r.y), bfhi(r.y)};
                ss += yv[i][0] * yv[i][0] + yv[i][1] * yv[i][1] + yv[i][2] * yv[i][2] + yv[i][3] * yv[i][3];
            }
            const float rstd = rsqrtf(wave_sum(ss) * (1.f / DM) + EPS);
            float s2 = 0.f;
#pragma unroll
            for (int i = 0; i < 8; ++i) {
                const int col = i * 256 + lane * 4;
                f32x4 xv = *reinterpret_cast<const f32x4*>(p.x + (size_t)row * DM + col);
                f32x4 g = *reinterpret_cast<const f32x4*>(lv + col);
                f32x4 gt = *reinterpret_cast<const f32x4*>(lv + DM + col);
                f32x4 v = xv + gt * (yv[i] * rstd * g);
                st4bf(x1 + (size_t)row * DM + col, v);
                yv[i] = v;
                s2 += v[0] * v[0] + v[1] * v[1] + v[2] * v[2] + v[3] * v[3];
            }
            const float rstd2 = rsqrtf(wave_sum(s2) * (1.f / DM) + EPS);
            float hmax = 0.f;
#pragma unroll
            for (int i = 0; i < 8; ++i) {
                const int col = i * 256 + lane * 4;
                f32x4 g = *reinterpret_cast<const f32x4*>(lv + 2 * DM + col);
                f32x4 sh = *reinterpret_cast<const f32x4*>(lv + 3 * DM + col);
                f32x4 sc = *reinterpret_cast<const f32x4*>(lv + 4 * DM + col);
                yv[i] = yv[i] * rstd2 * g * (sc + 1.f) + sh;
                hmax = fmaxf(hmax, fmaxf(fmaxf(fabsf(yv[i][0]), fabsf(yv[i][1])), fmaxf(fabsf(yv[i][2]), fabsf(yv[i][3]))));
            }
#pragma unroll
            for (int o = 1; o < 64; o <<= 1) hmax = fmaxf(hmax, __shfl_xor(hmax, o));
            const float qm = hmax > 0.f ? 127.f / hmax : 0.f;
            if (lane == 0) ((float*)(p.ws + WS_SH))[row] = hmax * (1.f / 127.f);
#pragma unroll
            for (int i = 0; i < 8; ++i) {
                *reinterpret_cast<unsigned*>(p.ws + WS_H8 + (size_t)row * DM + i * 256 + lane * 4) = pack_i8x4(yv[i][0] * qm, yv[i][1] * qm, yv[i][2] * qm, yv[i][3] * qm);
            }
        }
    }
}

__device__ __forceinline__ int fmap(float f) { int i = __float_as_int(f); return i ^ ((i >> 31) & 0x7fffffff); }
__device__ __forceinline__ float funmap(int i) { return __int_as_float(i ^ ((i >> 31) & 0x7fffffff)); }
__device__ __forceinline__ void ins16(int (&top)[16], int k) {
#pragma unroll
    for (int i = 0; i < 16; ++i) { int hi = max(top[i], k); k = min(top[i], k); top[i] = hi; }
}
__device__ __forceinline__ int bsel(int m, int a, int b) { return (a & ~m) | (b & m); }
__device__ __forceinline__ int sel16(const int (&a)[16], int i) {
    const int m0 = -(i & 1), m1 = -((i >> 1) & 1), m2 = -((i >> 2) & 1), m3 = -((i >> 3) & 1);
    int t8[8], t4[4], t2[2];
#pragma unroll
    for (int k = 0; k < 8; ++k) t8[k] = bsel(m0, a[2 * k], a[2 * k + 1]);
#pragma unroll
    for (int k = 0; k < 4; ++k) t4[k] = bsel(m1, t8[2 * k], t8[2 * k + 1]);
#pragma unroll
    for (int k = 0; k < 2; ++k) t2[k] = bsel(m2, t4[2 * k], t4[2 * k + 1]);
    return bsel(m3, t2[0], t2[1]);
}
#define BITONIC_CE(x, K, J) _Pragma("unroll") for (int i_ = 0; i_ < 16; ++i_) { const int l_ = i_ ^ (J); if (l_ > i_) { const int a_ = x[i_], b_ = x[l_]; \
        if ((i_ & (K)) == 0) { x[i_] = max(a_, b_); x[l_] = min(a_, b_); } else { x[i_] = min(a_, b_); x[l_] = max(a_, b_); } } }
#define BITONIC_MERGE16(x) BITONIC_CE(x, 16, 8) BITONIC_CE(x, 16, 4) BITONIC_CE(x, 16, 2) BITONIC_CE(x, 16, 1)
#define BITONIC_SORT16(x) BITONIC_CE(x, 2, 1) BITONIC_CE(x, 4, 2) BITONIC_CE(x, 4, 1) BITONIC_CE(x, 8, 4) BITONIC_CE(x, 8, 2) BITONIC_CE(x, 8, 1) BITONIC_MERGE16(x)
#define SCE(x, i, j) { const int a_ = x[i], b_ = x[j]; x[i] = max(a_, b_); x[j] = min(a_, b_); }
#define SORT16_60(x) SCE(x,0,13) SCE(x,1,12) SCE(x,2,15) SCE(x,3,14) SCE(x,4,8) SCE(x,5,6) SCE(x,7,11) SCE(x,9,10) SCE(x,0,5) SCE(x,1,7) SCE(x,2,9) SCE(x,3,4) SCE(x,6,13) SCE(x,8,14) SCE(x,10,15) SCE(x,11,12) SCE(x,0,1) SCE(x,2,3) SCE(x,4,5) SCE(x,6,8) SCE(x,7,9) SCE(x,10,11) SCE(x,12,13) SCE(x,14,15) SCE(x,0,2) SCE(x,1,3) SCE(x,4,10) SCE(x,5,11) SCE(x,6,7) SCE(x,8,9) SCE(x,12,14) SCE(x,13,15) SCE(x,1,2) SCE(x,3,12) SCE(x,4,6) SCE(x,5,7) SCE(x,8,10) SCE(x,9,11) SCE(x,13,14) SCE(x,1,4) SCE(x,2,6) SCE(x,5,8) SCE(x,7,10) SCE(x,9,13) SCE(x,11,14) SCE(x,2,4) SCE(x,3,6) SCE(x,9,12) SCE(x,11,13) SCE(x,3,5) SCE(x,6,8) SCE(x,7,9) SCE(x,10,12) SCE(x,3,4) SCE(x,5,6) SCE(x,7,8) SCE(x,9,10) SCE(x,11,12) SCE(x,6,7) SCE(x,8,9)
__device__ __forceinline__ void pk_half_list(const bf16_t* __restrict__ qrow, const char* kl, int hh, int (&out)[16]) {
    bf16x8 qf[8];
#pragma unroll
    for (int ks = 0; ks < 8; ++ks) qf[ks] = *reinterpret_cast<const bf16x8*>(qrow + ks * 16);
    int top[16];
#pragma unroll 1
    for (int kt = 0; kt < 4; ++kt) {
        f32x16 acc;
#pragma unroll
        for (int r = 0; r < 16; ++r) acc[r] = 0.f;
#pragma unroll
        for (int ks = 0; ks < 8; ++ks) {
            bf16x8 kf = *reinterpret_cast<const bf16x8*>(kl + kt * 32 * 272 + ks * 32);
            acc = __builtin_amdgcn_mfma_f32_32x32x16_bf16(kf, qf[ks], acc, 0, 0, 0);
        }
        int nw[16];
#pragma unroll
        for (int r = 0; r < 16; ++r) {
            const int n = kt * 32 + (r & 3) + 8 * (r >> 2) + 4 * hh;
            nw[r] = (fmap(acc[r]) & ~127) | (127 - n);
        }
        SORT16_60(nw)
        if (kt == 0) {
#pragma unroll
            for (int i = 0; i < 16; ++i) top[i] = nw[i];
        } else {
#pragma unroll
            for (int i = 0; i < 16; ++i) top[i] = max(top[i], nw[15 - i]);
            BITONIC_MERGE16(top)
        }
    }
#pragma unroll
    for (int i = 0; i < 16; ++i) out[i] = __shfl_xor(top[15 - i], 32);
#pragma unroll
    for (int i = 0; i < 16; ++i) out[i] = max(out[i], top[i]);
    BITONIC_MERGE16(out)
}
__device__ __forceinline__ void phase9(const Params& p, char* shm, int bid, int nb) {
    int tid = TIDX(p.wave_s); asm volatile("" : "+v"(tid));
    const int wave = tid >> 6, lane = tid & 63, l31 = lane & 31, hh = lane >> 5;
    const bf16_t* pq = (const bf16_t*)(p.ws + WS_BUF2);
    const bf16_t* sk = (const bf16_t*)(p.ws + WS_SK);
    int* idxo = (int*)(p.ws + WS_IDX); float* gateo = (float*)(p.ws + WS_GATE);
    for (int item = bid; item < 8 * 64; item += nb) {
        const int head = item & 7, tt = (item >> 3) * 8 + wave, tok = tt * 32 + l31;
        __syncthreads();
        for (int c = tid; c < 4096; c += NTHREADS) {
            const int row = c >> 4, ch = c & 15;
            *reinterpret_cast<u32x4*>(shm + row * 272 + ch * 16) = *reinterpret_cast<const u32x4*>(sk + (size_t)(head * 256 + row) * 128 + ch * 8);
        }
        __syncthreads();
        int la[16], lb[16];
        pk_half_list(pq + (size_t)tok * DM + head * 256 + hh * 8, shm + l31 * 272 + hh * 16, hh, la);
        pk_half_list(pq + (size_t)tok * DM + head * 256 + 128 + hh * 8, shm + (128 + l31) * 272 + hh * 16, hh, lb);
        float va[16], vb[16]; int ia[16], ib[16];
#pragma unroll
        for (int i = 0; i < 16; ++i) {
            va[i] = funmap(la[i] & ~127); ia[i] = 127 - (la[i] & 127);
            vb[i] = funmap(lb[i] & ~127); ib[i] = 127 - (lb[i] & 127);
        }
#define CKEY(i, j) ((fmap(va[i] + vb[j]) & ~255) | (255 - ((i) * 16 + (j))))
        int top2[16], ga[16], gb[16];
#pragma unroll
        for (int j = 0; j < 16; ++j) top2[j] = CKEY(0, j);
#pragma unroll
        for (int j = 0; j < 8; ++j) { ga[j] = CKEY(1, j); ga[8 + j] = CKEY(15 - j, 0); }
        BITONIC_MERGE16(ga)
        gb[0] = CKEY(2, 0); gb[1] = CKEY(2, 1); gb[2] = CKEY(2, 2); gb[3] = CKEY(2, 3); gb[4] = CKEY(2, 4);
        gb[5] = CKEY(3, 0); gb[6] = CKEY(3, 1); gb[7] = CKEY(3, 2); gb[8] = CKEY(3, 3);
        gb[9] = CKEY(4, 0); gb[10] = CKEY(4, 1); gb[11] = CKEY(4, 2);
        gb[12] = CKEY(5, 0); gb[13] = CKEY(5, 1); gb[14] = CKEY(6, 0); gb[15] = CKEY(6, 1);
        SORT16_60(gb)
#pragma unroll
        for (int i = 0; i < 16; ++i) top2[i] = max(top2[i], ga[15 - i]);
        BITONIC_MERGE16(top2)
#pragma unroll
        for (int i = 0; i < 16; ++i) top2[i] = max(top2[i], gb[15 - i]);
        BITONIC_MERGE16(top2)
        ins16(top2, CKEY(7, 0)); ins16(top2, CKEY(7, 1));
#undef CKEY
        float bv[16], mxv, sum = 0.f; int ex[16];
        {
            LAS int* tA = (LAS int*)(uintptr_t)(69632 + wave * 8192) + lane;
            LAS int* tB = tA + 16 * 64;
#pragma unroll
            for (int i = 0; i < 16; ++i) { tA[i * 64] = ia[i] * 128; tB[i * 64] = ib[i]; }
#pragma unroll
            for (int r = 0; r < 16; ++r) {
                const int code = 255 - (top2[r] & 255);
                ex[r] = tA[(code >> 4) * 64] + tB[(code & 15) * 64];
                bv[r] = funmap(top2[r] & ~255);
            }
        }
        mxv = bv[0];
#pragma unroll
        for (int r = 0; r < 16; ++r) { bv[r] = __expf(bv[r] - mxv); sum += bv[r]; }
        const float inv = 1.f / sum;
        if (hh == 0) {
            const size_t ob = ((size_t)(tok >> 6) * 128 + head * 16) * 64 + (tok & 63);
#pragma unroll
            for (int r = 0; r < 16; ++r) { idxo[ob + r * 64] = ex[r]; gateo[ob + r * 64] = bv[r] * inv; }
        }
    }
}

__device__ __forceinline__ void phase10(const Params& p, char* shm, int bid, int nb) {
    int tid = TIDX(p.wave_s); asm volatile("" : "+v"(tid));
    const int wave = tid >> 6, lane = tid & 63;
    const int* idxT = (const int*)(p.ws + WS_IDX);
    const char* U8 = p.ws + WS_U8;
    const char* H8 = p.ws + WS_H8;
    int* part = (int*)(p.ws + WS_PART);
    for (int task = bid; task < 256; task += nb) {
        const int tg = task >> 3, cg = task & 7;
        const int tt = tg * 8 + wave, t = tt * 64 + lane;
        unsigned ip[64]; int acc[128];
#pragma unroll
        for (int k = 0; k < 64; ++k) {
            const unsigned lo = (unsigned)idxT[((size_t)tt * 128 + 2 * k) * 64 + lane], hi = (unsigned)idxT[((size_t)tt * 128 + 2 * k + 1) * 64 + lane];
            ip[k] = lo | (hi << 16);
        }
#pragma unroll
        for (int j = 0; j < 128; ++j) acc[j] = 0;
#pragma unroll 1
        for (int s = 0; s < 32; ++s) {
            const int slice = cg * 32 + s;
            __syncthreads();
            const char* sbase = U8 + (size_t)slice * 131072;
            const unsigned toff = (unsigned)tid * 16u;
#pragma unroll
            for (int k = 0; k < 16; ++k)
                __builtin_amdgcn_global_load_lds((const unsigned*)(sbase + k * 8192 + toff), (unsigned*)(shm + k * 8192 + tid * 16), 16, 0, 0);
            const u32x2 h = *reinterpret_cast<const u32x2*>(H8 + (size_t)t * DM + slice * 8);
            asm volatile("s_waitcnt vmcnt(0)" ::: "memory");
            __syncthreads();
#define U_LOAD(g, dst) _Pragma("unroll") for (int q = 0; q < 4; ++q) { unsigned w = ip[(g) * 4 + q]; asm volatile("" : "+v"(w)); \
                dst[2 * q] = *reinterpret_cast<const u32x2*>(shm + ((w & 0xffffu) << 3)); dst[2 * q + 1] = *reinterpret_cast<const u32x2*>(shm + ((w >> 16) << 3)); }
#define U_DOT(g, srcv) _Pragma("unroll") for (int q = 0; q < 8; ++q) { \
                acc[(g) * 8 + q] = __builtin_amdgcn_sdot4((int)srcv[q].x, (int)h.x, acc[(g) * 8 + q], false); \
                acc[(g) * 8 + q] = __builtin_amdgcn_sdot4((int)srcv[q].y, (int)h.y, acc[(g) * 8 + q], false); }
            u32x2 ua[8], ub[8];
            U_LOAD(0, ua)
#pragma unroll
            for (int g = 0; g < 16; g += 2) {
                U_LOAD(g + 1, ub)
                U_DOT(g, ua)
                __builtin_amdgcn_sched_barrier(0);
                if (g + 2 < 16) { U_LOAD(g + 2, ua) }
                U_DOT(g + 1, ub)
                __builtin_amdgcn_sched_barrier(0);
            }
#undef U_LOAD
#undef U_DOT
        }
#pragma unroll
        for (int k = 0; k < 64; ++k) part[((size_t)cg * 64 + k) * NTOK + t] = (int)pk2((float)acc[2 * k], (float)acc[2 * k + 1]);
    }
}

__device__ __forceinline__ void phase11(const Params& p, int bid, int nb) {
    const int* part = (const int*)(p.ws + WS_PART);
    const int* idxT = (const int*)(p.ws + WS_IDX); const float* gateT = (const float*)(p.ws + WS_GATE);
    const float* su = (const float*)(p.ws + WS_SU); const float* sv = (const float*)(p.ws + WS_SV); const float* sh = (const float*)(p.ws + WS_SH);
    unsigned* pack = (unsigned*)(p.ws + WS_PACK);
    int t11 = TIDX(p.wave_s); asm volatile("" : "+v"(t11));
    for (int item = bid * NTHREADS + t11; item < NTOK * 128; item += nb * NTHREADS) {
        const int lane = item & 63, j = (item >> 6) & 127, tt = item >> 13, t = tt * 64 + lane;
        float sum = 0.f;
#pragma unroll
        for (int cg = 0; cg < 8; ++cg) { const unsigned w = (unsigned)part[((size_t)cg * 64 + (j >> 1)) * NTOK + t]; sum += (j & 1) ? bfhi(w) : bflo(w); }
        const int e = idxT[item];
        const float a = sum * sh[t] * su[e];
        const float act = 0.5f * a * (1.f + erff(a * 0.70710678118654752f)) * gateT[item] * sv[e];
        { const _Float16 ah = (_Float16)(act * 256.f); pack[item] = ((unsigned)__builtin_bit_cast(unsigned short, ah) << 16) | ((unsigned)e << 2); }
    }
}

__device__ __forceinline__ void phase12(const Params& p, char* shm, int bid, int nb) {
    int tid = TIDX(p.wave_s); asm volatile("" : "+v"(tid));
    const int wave = tid >> 6, lane = tid & 63;
    const unsigned* pack = (const unsigned*)(p.ws + WS_PACK);
    const char* V8 = p.ws + WS_V8;
    bf16_t* y2 = (bf16_t*)(p.ws + WS_Y2);
    for (int slice = bid; slice < 256; slice += nb) {
        __syncthreads();
        const char* src = V8 + (size_t)slice * 131072 + tid * 16;
#pragma unroll
        for (int k = 0; k < 16; ++k)
            __builtin_amdgcn_global_load_lds((const unsigned*)(src + k * 8192), (unsigned*)(shm + k * 8192 + tid * 16), 16, 0, 0);
        asm volatile("s_waitcnt vmcnt(0)" ::: "memory");
        __syncthreads();
#define V_LOAD(ptr, g, dst) _Pragma("unroll") for (int q = 0; q < 16; ++q) dst[q] = *reinterpret_cast<const unsigned*>(reinterpret_cast<const char*>((ptr) + (g) * 1024) + lane4 + q * 256);
#define V_LDS(srcp, dstv) _Pragma("unroll") for (int q = 0; q < 16; ++q) { unsigned ad_; \
            asm("v_lshlrev_b32_sdwa %0, %1, %2 dst_sel:DWORD dst_unused:UNUSED_PAD src0_sel:DWORD src1_sel:WORD_0" : "=v"(ad_) : "v"(one_), "v"(srcp[q])); \
            dstv[q] = *reinterpret_cast<const LAS u32x2*>((uintptr_t)ad_); }
#define V_CVT(w_, hi_) __builtin_bit_cast(h2v, __builtin_amdgcn_cvt_scalef32_pk_f16_fp8(w_, __uint_as_float(0x3F80007Fu), hi_))
#define V_FMAS(srcp, srcv) _Pragma("unroll") for (int q = 0; q < 16; ++q) { const h2v ph = __builtin_bit_cast(h2v, srcp[q]); const h2v act = {ph[1], ph[1]}; \
                y[0] = __builtin_elementwise_fma(act, V_CVT(srcv[q].x, false), y[0]); y[1] = __builtin_elementwise_fma(act, V_CVT(srcv[q].x, true), y[1]); \
                y[2] = __builtin_elementwise_fma(act, V_CVT(srcv[q].y, false), y[2]); y[3] = __builtin_elementwise_fma(act, V_CVT(srcv[q].y, true), y[3]); }
#define V_STEP(ptr, g, pkLoad, pkLds, vLds, pkCur, vCur) V_LOAD(ptr, g, pkLoad) V_LDS(pkLds, vLds) V_FMAS(pkCur, vCur) __builtin_amdgcn_sched_barrier(0);
        unsigned pkA[16], pkB[16], pkC[16]; u32x2 vA[16], vB[16];
        unsigned one_ = 1u; asm volatile("" : "+v"(one_));
        const int wave_u = __builtin_amdgcn_readfirstlane(wave);
        const unsigned lane4 = (unsigned)lane * 4u;
        {
            const unsigned* pp0 = pack + (size_t)wave_u * 8192;
            V_LOAD(pp0, 0, pkA) V_LOAD(pp0, 1, pkB) V_LDS(pkA, vA)
        }
#pragma unroll 1
        for (int tt = wave_u; tt < 256; tt += NWAVES) {
            h2v y[4];
#pragma unroll
            for (int c = 0; c < 4; ++c) y[c] = h2v{(_Float16)0.f, (_Float16)0.f};
            const unsigned* pp = pack + (size_t)tt * 8192;
            const int ttn = (tt + NWAVES < 256) ? tt + NWAVES : tt;
            const unsigned* pn = pack + (size_t)ttn * 8192;
            V_STEP(pp, 2, pkC, pkB, vB, pkA, vA)
            V_STEP(pp, 3, pkA, pkC, vA, pkB, vB)
            V_STEP(pp, 4, pkB, pkA, vB, pkC, vA)
            V_STEP(pp, 5, pkC, pkB, vA, pkA, vB)
            V_STEP(pp, 6, pkA, pkC, vB, pkB, vA)
            V_STEP(pp, 7, pkB, pkA, vA, pkC, vB)
            V_STEP(pn, 0, pkC, pkB, vB, pkA, vA)
            V_STEP(pn, 1, pkA, pkC, vA, pkB, vB)
#pragma unroll
            for (int q = 0; q < 16; ++q) { const unsigned t0_ = pkA[q]; pkA[q] = pkC[q]; pkB[q] = t0_; }
            *reinterpret_cast<u32x4*>(y2 + (size_t)(tt * 64 + lane) * DM + slice * 8) =
                u32x4{__builtin_bit_cast(unsigned, y[0]), __builtin_bit_cast(unsigned, y[1]), __builtin_bit_cast(unsigned, y[2]), __builtin_bit_cast(unsigned, y[3])};
        }
#undef V_LOAD
#undef V_LDS
#undef V_CVT
#undef V_FMAS
#undef V_STEP
    }
}

__device__ __forceinline__ float h16f(unsigned h) {
    const unsigned s_ = (h & 0x8000u) << 16, e_ = (h >> 10) & 31u, m_ = h & 0x3ffu;
    return e_ == 0u ? __uint_as_float(s_) : __uint_as_float(s_ | ((e_ + 112u) << 23) | (m_ << 13));
}
__device__ __forceinline__ void phase13(const Params& p, char* shm, int bid, int nb) {
    const int tid = TIDX(p.wave_s), wave = tid >> 6, lane = tid & 63;
    const float* mod = (const float*)(p.ws + WS_MOD);
    const bf16_t* y2 = (const bf16_t*)(p.ws + WS_Y2);
    const bf16_t* x1 = (const bf16_t*)(p.ws + WS_X1);
    float* lv = (float*)shm;
    for (int item = bid; item < NTOK / 64; item += nb) {
        const int b = item >> 5;
        __syncthreads();
        for (int i = tid; i < 512; i += NTHREADS) {
            *reinterpret_cast<f32x4*>(lv + 0 * DM + i * 4) = *reinterpret_cast<const f32x4*>(p.post_ffn_g + i * 4);
            *reinterpret_cast<f32x4*>(lv + 1 * DM + i * 4) = *reinterpret_cast<const f32x4*>(mod + b * 12288 + 10240 + i * 4);
        }
        __syncthreads();
#pragma unroll 1
        for (int rr = 0; rr < 8; ++rr) {
            const int row = item * 64 + rr * 8 + wave;
            f32x4 yv[8]; u32x2 xr[8]; float ss = 0.f;
#pragma unroll
            for (int i = 0; i < 8; ++i) {
                u32x2 r = *reinterpret_cast<const u32x2*>(y2 + (size_t)row * DM + i * 256 + lane * 4);
                xr[i] = *reinterpret_cast<const u32x2*>(x1 + (size_t)row * DM + i * 256 + lane * 4);
                yv[i] = f32x4{h16f(r.x & 0xffffu), h16f(r.x >> 16), h16f(r.y & 0xffffu), h16f(r.y >> 16)};
                ss += yv[i][0] * yv[i][0] + yv[i][1] * yv[i][1] + yv[i][2] * yv[i][2] + yv[i][3] * yv[i][3];
            }
            const float rstd = rsqrtf(wave_sum(ss) * (1.f / DM) + EPS);
#pragma unroll
            for (int i = 0; i < 8; ++i) {
                const int col = i * 256 + lane * 4;
                f32x4 xv = f32x4{bflo(xr[i].x), bfhi(xr[i].x), bflo(xr[i].y), bfhi(xr[i].y)};
                f32x4 g = *reinterpret_cast<const f32x4*>(lv + col);
                f32x4 gt = *reinterpret_cast<const f32x4*>(lv + DM + col);
                *reinterpret_cast<f32x4*>(p.out + (size_t)row * DM + col) = xv + gt * (yv[i] * rstd * g);
            }
        }
    }
}

constexpr int NPHASE = 14;
__global__ void __launch_bounds__(NTHREADS, 2) mega(Params p, int ph_lo, int ph_hi) {
    extern __shared__ __attribute__((aligned(16))) char shm[];
    p.wave_s = __builtin_amdgcn_readfirstlane((int)(threadIdx.x >> 6));
    const int bid = blockIdx.x, nb = gridDim.x;
    const int vcu = vcu_of(bid, nb);
    char* ws = p.ws;
    volatile LAS unsigned* xbw = (volatile LAS unsigned*)(shm + XB_OFF);
    if (TIDX(p.wave_s) == 0) { xbw[0] = 0u; xbw[1] = 0u; }
    __syncthreads();
    XcdBarrier bar; bar.bar = (unsigned*)(ws + WS_BAR); bar.x = 0; bar.st = xbw; bar.ws = p.wave_s;
    if (ph_hi - ph_lo > 1) bar = xcd_barrier_post((unsigned*)(ws + WS_BAR), xbw, p.wave_s);
#ifndef DUP_PH
#define DUP_PH (-1)
#endif
#define REP(k) for (int rep_ = 0; rep_ < ((k) == DUP_PH ? 2 : 1); ++rep_)
#ifdef ONLY_PH
#define PH(k) ((k) == ONLY_PH && ph_lo <= (k) && (k) < ph_hi)
#else
#define PH(k) (ph_lo <= (k) && (k) < ph_hi)
#endif
#define SEAM(k) do { if (ph_lo <= (k) && (k) + 1 < ph_hi) xcd_barrier(bar); } while (0)
    if (PH(0)) REP(0) phase0(p, shm, bid, nb);
    SEAM(0);
    if (PH(1)) REP(1) phase1(p, shm, bid, nb);
    SEAM(1);
    if (PH(2)) REP(2) {
        EpiI8 e{(bf16_t*)(ws + WS_BUF2), DM, (const float*)(ws + WS_SH1), (const float*)(ws + WS_WSC), ws + WS_PROJ8};
        gemm_phase<false, true>((const bf16_t*)(ws + WS_BUF1), DM / 2, (const bf16_t*)(ws + WS_WIN), DM / 2, 1024, 8, 512, 0, vcu, nb, shm, e, p.wave_s);
    }
    SEAM(2);
    if (PH(3)) REP(3) phase3(p, bid, nb);
    SEAM(3);
    if (PH(4)) REP(4) {
        EpiQ eq{(bf16_t*)(ws + WS_Q), (const float*)(ws + WS_RSTDQ)};
        EpiKV ekv{(bf16_t*)(ws + WS_KN), (bf16_t*)(ws + WS_VT), (const float*)(ws + WS_RSTDKV)};
        const bf16_t* qA = (const bf16_t*)(ws + WS_PROJ8); const bf16_t* qB = (const bf16_t*)(ws + WS_WUQ);
        const bf16_t* kA = (const bf16_t*)(ws + WS_PROJ8 + 512); const bf16_t* kB = (const bf16_t*)(ws + WS_WUKV);
        if (nb == 256) {
            const int nq = vcu < 128 ? 2 : 1, q0 = vcu < 128 ? 2 * vcu : vcu + 128;
            const int nkv = vcu < 128 ? 1 : 3, kv0 = vcu < 128 ? vcu : 128 + 3 * (vcu - 128);
            const int g = vcu >> 6, pmp = vcu & 63;
            const bf16_t* pA = (const bf16_t*)(ws + WS_Z + g * 256); const bf16_t* pB = (const bf16_t*)(ws + WS_WPOOL + g * 65536);
            const NextTile kvfirst{kA, kB, 384, 128, (kv0 >> 3) * 256, (kv0 & 7) * 256};
            const NextTile poolt{pA, pB, 512, 128, pmp * 256, 0};
#pragma unroll 1
            for (int i = 0; i < nq; ++i) {
                const int t = q0 + i;
                const NextTile nx = (i + 1 < nq) ? NextTile{qA, qB, 384, 256, ((t + 1) / 6) * 256, ((t + 1) % 6) * 256} : kvfirst;
                gemm_tile<false, false, true>(qA, 384, qB, 256, 4, (t / 6) * 256, (t % 6) * 256, shm, eq, i > 0, nx, p.wave_s);
            }
#pragma unroll 1
            for (int i = 0; i < nkv; ++i) {
                const int t = kv0 + i;
                const NextTile nx = (i + 1 < nkv) ? NextTile{kA, kB, 384, 128, ((t + 1) >> 3) * 256, ((t + 1) & 7) * 256} : poolt;
                gemm_tile<true, false, true>(kA, 384, kB, 128, 2, (t >> 3) * 256, (t & 7) * 256, shm, ekv, true, nx, p.wave_s);
            }
            {
                EpiPool e{(bf16_t*)(ws + WS_BUF1), p.pool_scale, g * 256};
                gemm_tile<false, false, true>(pA, 512, pB, 128, 2, pmp * 256, 0, shm, e, true, NextTile{pA, pB, 512, 128, -1, 0}, p.wave_s);
            }
        } else {
            gemm_phase<false, false, true>(qA, 384, qB, 256, 256, 6, 384, 0, vcu, nb, shm, eq, p.wave_s);
            gemm_phase<true, false, true>(kA, 384, kB, 128, 128, 8, 512, 384, vcu, nb, shm, ekv, p.wave_s);
            const int first = ((vcu - 896) % nb + nb) % nb;
            for (int t = first; t < 256; t += nb) {
                const int g = t >> 6, pm = t & 63;
                EpiPool e{(bf16_t*)(ws + WS_BUF1), p.pool_scale, g * 256};
                gemm_tile<false, false, true>((const bf16_t*)(ws + WS_Z + g * 256), 512, (const bf16_t*)(ws + WS_WPOOL + g * 65536), 128, 2, pm * 256, 0, shm, e, false, NextTile{nullptr, nullptr, 0, 0, -1, 0}, p.wave_s);
            }
        }
    }
    SEAM(4);
    if (PH(5)) REP(5) phase5(p, shm, vcu, nb);
    SEAM(5);
    if (PH(6)) REP(6) {
        EpiBf16 e{(bf16_t*)(ws + WS_BUF2), DM, 1.f / 32.f};
        gemm_phase<false, false, true>((const bf16_t*)(ws + WS_BUF1), DM / 2, (const bf16_t*)(ws + WS_WOUT), DM / 2, 1024, 8, 512, 0, vcu, nb, shm, e, p.wave_s);
    }
    SEAM(6);
    if (PH(7)) REP(7) phase7(p, shm, bid, nb);
    SEAM(7);
    if (PH(8)) REP(8) {
        EpiI8 e{(bf16_t*)(ws + WS_BUF2), DM, (const float*)(ws + WS_SH), (const float*)(ws + WS_WSC) + 2048};
        gemm_phase<false, true>((const bf16_t*)(ws + WS_H8), DM / 2, (const bf16_t*)(ws + WS_WPQ), DM / 2, 1024, 8, 512, 0, vcu, nb, shm, e, p.wave_s);
    }
    SEAM(8);
    if (PH(9)) REP(9) phase9(p, shm, bid, nb);
    SEAM(9);
    if (PH(10)) REP(10) phase10(p, shm, bid, nb);
    SEAM(10);
    if (PH(11)) REP(11) phase11(p, bid, nb);
    SEAM(11);
    if (PH(12)) REP(12) phase12(p, shm, vcu, nb);
    SEAM(12);
    if (PH(13)) REP(13) phase13(p, shm, bid, nb);
#undef PH
#undef SEAM
}

extern "C" void kernel_launch(void* const* d_in, const int* in_sizes, int n_in, void* d_out, int out_size, void* d_ws, size_t ws_size, hipStream_t stream) {
    static int grid = 0;
    if (grid == 0) {
        if (n_in != 21 || ws_size < WS_END) { fprintf(stderr, "kernel_launch: unexpected n_in %d / ws_size %zu (need %zu)\n", n_in, ws_size, (size_t)WS_END); grid = -1; return; }
        int dev = 0, cus = 0;
        if (hipGetDevice(&dev) != hipSuccess || hipDeviceGetAttribute(&cus, hipDeviceAttributeMultiprocessorCount, dev) != hipSuccess) { grid = -1; return; }
        if (hipFuncSetAttribute((const void*)mega, hipFuncAttributeMaxDynamicSharedMemorySize, LDS_BYTES) != hipSuccess) { fprintf(stderr, "hipFuncSetAttribute failed\n"); grid = -1; return; }
        int per_cu = 0;
        if (hipOccupancyMaxActiveBlocksPerMultiprocessor(&per_cu, (const void*)mega, NTHREADS, LDS_BYTES) != hipSuccess || per_cu < 1)
            fprintf(stderr, "kernel_launch: occupancy query reports %d blocks per CU\n", per_cu);
        (void)hipGetLastError();
        grid = cus;
    }
    if (grid < 0) return;
    (void)hipMemsetAsync((char*)d_ws + WS_ZERO, 0, ZERO_BYTES, stream);
    (void)hipMemsetAsync((char*)d_ws + WS_CMAX, 0, CMAX_BYTES, stream);
    Params p{};
    p.x = (const float*)d_in[0]; p.c = (const float*)d_in[1]; p.pos = (const int*)d_in[2];
    p.ada_w = (const float*)d_in[3]; p.ada_b = (const float*)d_in[4];
    p.pre_mix_g = (const float*)d_in[5]; p.post_mix_g = (const float*)d_in[6]; p.pre_ffn_g = (const float*)d_in[7]; p.post_ffn_g = (const float*)d_in[8];
    p.w_in = (const float*)d_in[9]; p.pool_w = (const float*)d_in[10]; p.pool_scale = (const float*)d_in[11];
    p.q_norm_g = (const float*)d_in[12]; p.w_uq = (const float*)d_in[13]; p.kv_norm_g = (const float*)d_in[14]; p.w_ukv = (const float*)d_in[15];
    p.w_out = (const float*)d_in[16]; p.peer_wq = (const float*)d_in[17]; p.sub_keys = (const float*)d_in[18];
    p.peer_u = (const float*)d_in[19]; p.peer_v = (const float*)d_in[20];
    p.out = (float*)d_out; p.ws = (char*)d_ws;
#if MK_MULTI
    for (int k = 0; k < NPHASE; ++k) hipLaunchKernelGGL(mega, dim3(grid), dim3(NTHREADS), LDS_BYTES, stream, p, k, k + 1);
#else
    hipLaunchKernelGGL(mega, dim3(grid), dim3(NTHREADS), LDS_BYTES, stream, p, 0, NPHASE);
#endif
}
```

```cpp
#include <hip/hip_runtime.h>
#include <hip/hip_bf16.h>
#include <stdint.h>
#include <stdio.h>

#ifndef MK_MULTI
#define MK_MULTI 0
#endif

typedef unsigned short bf16_t;
typedef short bf16x8 __attribute__((ext_vector_type(8)));
typedef float f32x4 __attribute__((ext_vector_type(4)));
typedef float f32x16 __attribute__((ext_vector_type(16)));
typedef unsigned u32x4 __attribute__((ext_vector_type(4)));
typedef int i32x4 __attribute__((ext_vector_type(4)));
typedef int i32x8 __attribute__((ext_vector_type(8)));
__device__ __forceinline__ int pk_fp8x4(float a, float b, float c, float d) {
    int w = __builtin_amdgcn_cvt_pk_fp8_f32(a, b, 0, false);
    return __builtin_amdgcn_cvt_pk_fp8_f32(c, d, w, true);
}
template <bool I8> struct AccT { typedef f32x4 type; };
template <> struct AccT<true> { typedef i32x4 type; };
typedef unsigned u32x2 __attribute__((ext_vector_type(2)));
typedef _Float16 h2v __attribute__((ext_vector_type(2)));

constexpr int NTOK = 16384, DM = 2048, SEQ = 2048;
constexpr int NTHREADS = 512, NWAVES = 8;
constexpr int LDS_BYTES = 140 * 1024;
constexpr int XB_OFF = LDS_BYTES - 64;
constexpr float EPS = 1e-6f;

constexpr size_t MiB = 1024 * 1024;
constexpr size_t WS_ZERO   = 0;
constexpr size_t WS_BAR    = 0;
constexpr size_t WS_MOD    = 16384;
constexpr size_t ZERO_BYTES = 16384;
constexpr size_t WS_CS     = 1 * MiB;
constexpr size_t WS_RSTDQ  = 5 * MiB;
constexpr size_t WS_RSTDKV = 5 * MiB + 65536;
constexpr size_t WS_WIN    = 6 * MiB;
constexpr size_t WS_WOUT   = 14 * MiB;
constexpr size_t WS_WPQ    = 22 * MiB;
constexpr size_t WS_WUQ    = 30 * MiB;
constexpr size_t WS_WUKV   = 32 * MiB;
constexpr size_t WS_WPOOL  = 33 * MiB;
constexpr size_t WS_SK     = 34 * MiB;
constexpr size_t WS_U8     = 35 * MiB;
constexpr size_t WS_V8     = 67 * MiB;
constexpr size_t WS_H8     = 99 * MiB;
constexpr size_t WS_PACK   = 131 * MiB;
constexpr size_t WS_SU     = 139 * MiB;
constexpr size_t WS_SV     = 139 * MiB + 65536;
constexpr size_t WS_SH     = 139 * MiB + 131072;
constexpr size_t WS_SH1    = 139 * MiB + 196608;
constexpr size_t WS_CMAX   = 139 * MiB + 262144;
constexpr size_t WS_WSC    = 139 * MiB + 278528;
constexpr size_t CMAX_BYTES = 2 * 2048 * 4;
constexpr size_t WS_BUF1   = 163 * MiB;
constexpr size_t WS_BUF2   = 227 * MiB;
constexpr size_t WS_BIG    = 291 * MiB;
constexpr size_t WS_Z      = WS_BIG;
constexpr size_t WS_Q      = WS_BIG + 32 * MiB;
constexpr size_t WS_KN     = WS_BIG + 80 * MiB;
constexpr size_t WS_VT     = WS_BIG + 112 * MiB;
constexpr size_t WS_KPE    = WS_BIG + 144 * MiB;
constexpr size_t WS_X1     = WS_BIG;
constexpr size_t WS_IDX    = 438 * MiB;
constexpr size_t WS_GATE   = 446 * MiB;
constexpr size_t WS_PART   = WS_BUF1;
constexpr size_t WS_Y2     = WS_BUF2;
constexpr size_t WS_END    = 454 * MiB;

struct Params {
    const float *x, *c; const int* pos;
    const float *ada_w, *ada_b, *pre_mix_g, *post_mix_g, *pre_ffn_g, *post_ffn_g;
    const float *w_in, *pool_w, *pool_scale, *q_norm_g, *w_uq, *kv_norm_g, *w_ukv, *w_out;
    const float *peer_wq, *sub_keys, *peer_u, *peer_v;
    float* out; char* ws;
    int wave_s;
};

__device__ __forceinline__ unsigned pk2(float lo, float hi) {
    typedef __bf16 bf2 __attribute__((ext_vector_type(2)));
    bf2 v; v[0] = (__bf16)lo; v[1] = (__bf16)hi; return __builtin_bit_cast(unsigned, v);
}
__device__ __forceinline__ float bflo(unsigned u) { return __uint_as_float(u << 16); }
__device__ __forceinline__ float bfhi(unsigned u) { return __uint_as_float(u & 0xffff0000u); }
__device__ __forceinline__ float bf2f(short b) { return __uint_as_float(((unsigned)(unsigned short)b) << 16); }
__device__ __forceinline__ short f2bf(float f) { return (short)(pk2(f, 0.f) & 0xffffu); }
__device__ __forceinline__ unsigned pack_i8x4(float a, float b, float c, float d) {
    unsigned r = 0u;
    r = __builtin_amdgcn_cvt_pk_u8_f32(a + 128.f, 0, r); r = __builtin_amdgcn_cvt_pk_u8_f32(b + 128.f, 1, r);
    r = __builtin_amdgcn_cvt_pk_u8_f32(c + 128.f, 2, r); r = __builtin_amdgcn_cvt_pk_u8_f32(d + 128.f, 3, r);
    return r ^ 0x80808080u;
}
__device__ __forceinline__ float wave_sum(float v) {
#pragma unroll
    for (int o = 1; o < 64; o <<= 1) v += __shfl_xor(v, o);
    return v;
}

#define XB_TMO      128
#define XB_XCNT(j)  (256  + 64 * (j))
#define XB_XSUB(j)  (1280 + 64 * (j))
#define XB_XGEN(j)  (2304 + 64 * (j))
#define XB_TOP      3328
#define XB_TOPGEN   3392
#define XCD_BAR_WORDS 3456
#define XB_SPIN_CAP (1u << 20)
#define LAS __attribute__((address_space(3)))
__device__ __forceinline__ int tidx_(int ws) { unsigned l = __builtin_amdgcn_mbcnt_lo(~0u, 0u); asm volatile("" : "+v"(l)); return (int)((unsigned)ws * 64u + __builtin_amdgcn_mbcnt_hi(~0u, l)); }
#define TIDX(ws_) tidx_(ws_)
__device__ __forceinline__ unsigned xb_ld(unsigned* p)              { return __hip_atomic_load(p, __ATOMIC_RELAXED, __HIP_MEMORY_SCOPE_AGENT); }
__device__ __forceinline__ unsigned xb_add(unsigned* p, unsigned v) { return __hip_atomic_fetch_add(p, v, __ATOMIC_RELAXED, __HIP_MEMORY_SCOPE_AGENT); }
__device__ __forceinline__ unsigned xb_xcc_id() { return (unsigned)__builtin_amdgcn_s_getreg((3 << 11) | 20) & 0xFu; }
#define XB_SPIN(cond, bar) do { unsigned _sp = 0; while (cond) { __builtin_amdgcn_s_sleep(1); \
    if ((++_sp & 255u) == 0u) { if (xb_ld(&(bar)[XB_TMO])) break; if (_sp > XB_SPIN_CAP) { atomicAdd(&(bar)[XB_TMO], 1u); break; } } } } while (0)
struct XcdBarrier { unsigned* bar; unsigned x; volatile LAS unsigned* st; int ws; };
__device__ __forceinline__ XcdBarrier xcd_barrier_post(unsigned* bar, volatile LAS unsigned* st, int ws) {
    XcdBarrier b; b.bar = bar; b.x = xb_xcc_id(); b.st = st; b.ws = ws;
    if (TIDX(ws) == 0) (void)xb_add(&bar[XB_XCNT(b.x)], 1u);
    return b;
}
__device__ __forceinline__ void xcd_barrier_complete(unsigned* bar, unsigned x, unsigned& nloc, unsigned& nx) {
    const unsigned G = gridDim.x * gridDim.y * gridDim.z;
    unsigned sum, cnt, mine, sp = 0u;
    for (;;) {
        sum = 0u; cnt = 0u; mine = 0u;
#pragma unroll
        for (unsigned j = 0; j < 16; ++j) { const unsigned c = xb_ld(&bar[XB_XCNT(j)]); sum += c; cnt += (c > 0u) ? 1u : 0u; mine = (j == x) ? c : mine; }
        if (sum == G) break;
        __builtin_amdgcn_s_sleep(1);
        if ((++sp & 255u) == 0u) { if (xb_ld(&bar[XB_TMO])) break; if (sp > XB_SPIN_CAP) { atomicAdd(&bar[XB_TMO], 1u); break; } }
    }
    nloc = mine > 0u ? mine : 1u; nx = cnt > 0u ? cnt : 1u;
}
__device__ __forceinline__ void xcd_barrier(const XcdBarrier& b) {
    asm volatile("s_waitcnt vmcnt(0)" ::: "memory");
    __syncthreads();
    if (TIDX(b.ws) == 0) {
        unsigned* bar = b.bar;
        __builtin_amdgcn_s_waitcnt(0);
        unsigned nloc = b.st[0], nx = b.st[1];
        if (nloc == 0u) { xcd_barrier_complete(bar, b.x, nloc, nx); b.st[0] = nloc; b.st[1] = nx; }
        const unsigned old = xb_add(&bar[XB_XSUB(b.x)], 1u);
        const unsigned gen = old / nloc;
        if (old + 1u == (gen + 1u) * nloc) {
            __builtin_amdgcn_fence(__ATOMIC_RELEASE, "agent");
            asm volatile("s_waitcnt vmcnt(0)" ::: "memory");
            const unsigned og = xb_add(&bar[XB_TOP], 1u);
            const unsigned tg = og / nx;
            if (og + 1u == (tg + 1u) * nx) xb_add(&bar[XB_TOPGEN], 1u);
            else XB_SPIN(xb_ld(&bar[XB_TOPGEN]) == tg, bar);
            __builtin_amdgcn_fence(__ATOMIC_ACQUIRE, "agent");
            xb_add(&bar[XB_XGEN(b.x)], 1u);
            asm volatile("s_waitcnt vmcnt(0)" ::: "memory");
        } else {
            XB_SPIN(xb_ld(&bar[XB_XGEN(b.x)]) == gen, bar);
            __builtin_amdgcn_fence(__ATOMIC_ACQUIRE, "agent");
            asm volatile("s_waitcnt vmcnt(0)" ::: "memory");
        }
    }
    __syncthreads();
}

constexpr int G_BK = 64, G_HALF = 128, G_HT = G_HALF * G_BK;
__device__ __forceinline__ int lds_byte(int r, int c) {
    int st = (r >> 4) * 2 + (c >> 5), rr = r & 15, cc = c & 31, ob = rr * 64 + cc * 2;
    return st * 1024 + (ob ^ (((ob >> 9) & 1) << 5));
}
__device__ __forceinline__ void stage_rc(int b, int& R, int& C) {
    int st = b / 1024, sb = b % 1024, swz = sb ^ (((sb >> 9) & 1) << 5);
    R = (st >> 1) * 16 + swz / 64; C = (st & 1) * 32 + (swz % 64) / 2;
}

template <bool NOSWAP, bool I8, class A_>
__device__ __forceinline__ A_ mma1(bf16x8 a, bf16x8 b, A_ c);
template <> __device__ __forceinline__ f32x4 mma1<false, false, f32x4>(bf16x8 a, bf16x8 b, f32x4 c) { return __builtin_amdgcn_mfma_f32_16x16x32_bf16(b, a, c, 0, 0, 0); }
template <> __device__ __forceinline__ f32x4 mma1<true, false, f32x4>(bf16x8 a, bf16x8 b, f32x4 c) { return __builtin_amdgcn_mfma_f32_16x16x32_bf16(a, b, c, 0, 0, 0); }
template <> __device__ __forceinline__ i32x4 mma1<false, true, i32x4>(bf16x8 a, bf16x8 b, i32x4 c) { return __builtin_amdgcn_mfma_i32_16x16x64_i8(__builtin_bit_cast(i32x4, b), __builtin_bit_cast(i32x4, a), c, 0, 0, 0); }
template <> __device__ __forceinline__ i32x4 mma1<true, true, i32x4>(bf16x8 a, bf16x8 b, i32x4 c) { return __builtin_amdgcn_mfma_i32_16x16x64_i8(__builtin_bit_cast(i32x4, a), __builtin_bit_cast(i32x4, b), c, 0, 0, 0); }

template <bool NOSWAP, bool I8, bool F8, class A_>
__device__ __forceinline__ A_ mma2(i32x8 a, i32x8 b, A_ c) {
    if constexpr (F8) {
        if constexpr (NOSWAP) return __builtin_amdgcn_mfma_scale_f32_16x16x128_f8f6f4(a, b, c, 0, 0, 0, 0, 0, 0);
        else return __builtin_amdgcn_mfma_scale_f32_16x16x128_f8f6f4(b, a, c, 0, 0, 0, 0, 0, 0);
    } else {
        const bf16x8 a0 = __builtin_bit_cast(bf16x8, __builtin_shufflevector(a, a, 0, 1, 2, 3)), a1 = __builtin_bit_cast(bf16x8, __builtin_shufflevector(a, a, 4, 5, 6, 7));
        const bf16x8 b0 = __builtin_bit_cast(bf16x8, __builtin_shufflevector(b, b, 0, 1, 2, 3)), b1 = __builtin_bit_cast(bf16x8, __builtin_shufflevector(b, b, 4, 5, 6, 7));
        c = mma1<NOSWAP, I8, A_>(a0, b0, c);
        return mma1<NOSWAP, I8, A_>(a1, b1, c);
    }
}
struct NextTile { const bf16_t* A; const bf16_t* Bt; int lda, ldb, brow, bcol; };
template <bool VT1, bool I8, bool F8 = false, class Epi>
__device__ __forceinline__ void gemm_tile(const bf16_t* __restrict__ A, int lda, const bf16_t* __restrict__ Bt, int ldb, int nt,
                                          int brow, int bcol, char* shmc, const Epi& epi, bool pre, const NextTile nx, int ws_) {
    bf16_t* shm = (bf16_t*)shmc;
    asm volatile("" : "+s"(nt));
#define SA(b,h) (shm+((b)*2+(h))*G_HT)
#define SB(b,h) (shm+(4+(b)*2+(h))*G_HT)
#define STAGE_X(OFF,LOFF,P,RS,LD,br,kt) do{ const int _so=((br)*(LD)+(kt)*G_BK)*2; \
    __builtin_amdgcn_raw_ptr_buffer_load_lds(RS, (__attribute__((address_space(3))) void*)((char*)(P)+(LOFF)),16,(int)(OFF),_so,0,0); \
    __builtin_amdgcn_raw_ptr_buffer_load_lds(RS, (__attribute__((address_space(3))) void*)((char*)(P)+(LOFF)+8192),16,(int)(OFF),_so+128*(LD),0,0);}while(0)
#define STAGE_A(P,br,kt) STAGE_X(offA,lwv,P,rsA,lda,br,kt)
#define STAGE_B(P,br,kt) STAGE_X(offB,lwv,P,rsB,ldb,br,kt)
#define LDF(base_,off_) (*reinterpret_cast<const i32x4*>((base_)+(off_)))
#define LDA(dst,b,h) _Pragma("unroll") for(int m=0;m<4;++m) \
    dst[m]=__builtin_shufflevector(LDF(fa_base,((b)*2+(h))*16384+m*2048),LDF(fa_base,((b)*2+(h))*16384+m*2048+1024),0,1,2,3,4,5,6,7)
#define LDB(dst,b,h) _Pragma("unroll") for(int n=0;n<2;++n) \
    dst[n]=__builtin_shufflevector(LDF(fb_base,((b)*2+(h))*16384+n*2048),LDF(fb_base,((b)*2+(h))*16384+n*2048+1024),0,1,2,3,4,5,6,7)
#define MMA(ai,bj,At_,Bt_) do{__builtin_amdgcn_s_setprio(1); \
    _Pragma("unroll") for(int m=0;m<4;++m) _Pragma("unroll") for(int n=0;n<2;++n) \
      acc[ai][bj][m][n]=mma2<VT1 && (bj)==1, I8, F8, typename AccT<I8>::type>(At_[m],Bt_[n],acc[ai][bj][m][n]); \
    __builtin_amdgcn_s_setprio(0);}while(0)
#define WAIT_V(n) asm volatile("s_waitcnt vmcnt(" #n ")":::"memory")
#define WAIT_L(n) asm volatile("s_waitcnt lgkmcnt(" #n ")":::"memory")
#define BAR __builtin_amdgcn_s_barrier()
#define SCHED __builtin_amdgcn_sched_barrier(0)
    int t0 = TIDX(ws_); asm volatile("" : "+v"(t0));
    int wid = t0 >> 6, lane = t0 & 63, wr = wid >> 2, wc = wid & 3, fr = lane & 15, fq = lane >> 4;
    typename AccT<I8>::type acc[2][2][4][2] = {};
    const char* fa_base = (const char*)shm + lds_byte(wr * 64 + fr, fq * 8);
    const char* fb_base = (const char*)shm + 65536 + lds_byte(wc * 32 + fr, fq * 8);
    i32x8 At[4], B0[2], B1[2];
    int loff = t0 * 16;
    const int lwv = __builtin_amdgcn_readfirstlane(t0 >> 6) * 1024;
    unsigned offA, offB;
    const __amdgpu_buffer_rsrc_t rsA = __builtin_amdgcn_make_buffer_rsrc((void*)A, (short)0, -1, 0x00020000);
    const __amdgpu_buffer_rsrc_t rsB = __builtin_amdgcn_make_buffer_rsrc((void*)Bt, (short)0, -1, 0x00020000);
    { int r_, c_; stage_rc(loff, r_, c_); offA = (unsigned)(r_ * lda + c_) * 2;
      const int i_ = r_ & 15, n_ = (r_ >> 4) & 1;
      offB = (unsigned)(((r_ & ~31) + 8 * (i_ >> 2) + 4 * n_ + (i_ & 3)) * ldb + c_) * 2; }
    if (!pre) {
        STAGE_B(SB(0,0),bcol,0); STAGE_A(SA(0,0),brow,0);
        STAGE_B(SB(0,1),bcol+G_HALF,0); STAGE_A(SA(0,1),brow+G_HALF,0);
        if (wr == 1) BAR;
        WAIT_V(4); BAR;
        STAGE_B(SB(1,0),bcol,1); STAGE_A(SA(1,0),brow,1); STAGE_B(SB(1,1),bcol+G_HALF,1);
        WAIT_V(6); BAR;
    } else {
        if (wr == 1) BAR;
        WAIT_V(4); BAR;
        BAR;
    }
    for (int t = 0; t < nt - 2; t += 2) {
        LDB(B0,0,0); SCHED; LDA(At,0,0); STAGE_A(SA(1,1),brow+G_HALF,t+1);
        WAIT_L(8); BAR; WAIT_L(0); MMA(0,0,At,B0); BAR; SCHED;
        LDB(B1,0,1); STAGE_B(SB(0,0),bcol,t+2);
        BAR; WAIT_L(0); MMA(0,1,At,B1); BAR;
        LDA(At,0,1); STAGE_A(SA(0,0),brow,t+2);
        BAR; WAIT_L(0); MMA(1,0,At,B0); BAR; SCHED;
        STAGE_B(SB(0,1),bcol+G_HALF,t+2);
        WAIT_V(6); BAR; MMA(1,1,At,B1); BAR;
        LDB(B0,1,0); SCHED; LDA(At,1,0); STAGE_A(SA(0,1),brow+G_HALF,t+2);
        WAIT_L(8); BAR; WAIT_L(0); MMA(0,0,At,B0); BAR; SCHED;
        LDB(B1,1,1); STAGE_B(SB(1,0),bcol,t+3);
        BAR; WAIT_L(0); MMA(0,1,At,B1); BAR;
        LDA(At,1,1); STAGE_A(SA(1,0),brow,t+3);
        BAR; WAIT_L(0); MMA(1,0,At,B0); BAR; SCHED;
        STAGE_B(SB(1,1),bcol+G_HALF,t+3);
        WAIT_V(6); BAR; MMA(1,1,At,B1); BAR;
    }
    int tz = TIDX(ws_); asm volatile("" : "+v"(tz)); wid = tz >> 6; lane = tz & 63; wr = wid >> 2; wc = wid & 3; fr = lane & 15; fq = lane >> 4;
    loff = tz * 16;
    fa_base = (const char*)shm + lds_byte(wr * 64 + fr, fq * 8); fb_base = (const char*)shm + 65536 + lds_byte(wc * 32 + fr, fq * 8);
    { int r_, c_; stage_rc(loff, r_, c_); offA = (unsigned)(r_ * lda + c_) * 2; }
    { LDB(B0,0,0); WAIT_V(0); LDA(At,0,0); STAGE_A(SA(1,1),brow+G_HALF,nt-1);
      BAR; WAIT_L(0); MMA(0,0,At,B0); BAR;
      LDB(B1,0,1); BAR; WAIT_L(0); MMA(0,1,At,B1); BAR;
      LDA(At,0,1); WAIT_V(4); BAR; WAIT_L(0); MMA(1,0,At,B0); MMA(1,1,At,B1); BAR; }
    { LDB(B0,1,0); LDA(At,1,0); WAIT_V(2); BAR; WAIT_L(0); MMA(0,0,At,B0); BAR;
      LDB(B1,1,1); WAIT_V(0); BAR; WAIT_L(0); MMA(0,1,At,B1); BAR;
      LDA(At,1,1); BAR; WAIT_L(0); MMA(1,0,At,B0); MMA(1,1,At,B1); BAR; }
    if (wr == 0) BAR;
    { int te = TIDX(ws_); asm volatile("" : "+v"(te)); wid = te >> 6; lane = te & 63; wr = wid >> 2; wc = wid & 3; fr = lane & 15; fq = lane >> 4; loff = te * 16; }
    typename Epi::Pre pre_;
    epi.preload(pre_, brow + wr * 64 + fr, bcol + wc * 32 + fq * 8, brow + wr * 64 + fq * 4);
    if (nx.brow >= 0) {
        int r_, c_; stage_rc(loff, r_, c_);
        const int i_ = r_ & 15, n_ = (r_ >> 4) & 1;
        const unsigned offA2 = (unsigned)(r_ * nx.lda + c_) * 2;
        const unsigned offB2 = (unsigned)(((r_ & ~31) + 8 * (i_ >> 2) + 4 * n_ + (i_ & 3)) * nx.ldb + c_) * 2;
        const __amdgpu_buffer_rsrc_t rsA2 = __builtin_amdgcn_make_buffer_rsrc((void*)nx.A, (short)0, -1, 0x00020000);
        const __amdgpu_buffer_rsrc_t rsB2 = __builtin_amdgcn_make_buffer_rsrc((void*)nx.Bt, (short)0, -1, 0x00020000);
#define NXT_A(P,h,k) STAGE_X(offA2,lwv,P,rsA2,nx.lda,nx.brow+(h),k)
#define NXT_B(P,h,k) STAGE_X(offB2,lwv,P,rsB2,nx.ldb,nx.bcol+(h),k)
        NXT_B(SB(0,0),0,0); NXT_A(SA(0,0),0,0); NXT_B(SB(0,1),G_HALF,0); NXT_A(SA(0,1),G_HALF,0);
        NXT_B(SB(1,0),0,1); NXT_A(SA(1,0),0,1); NXT_B(SB(1,1),G_HALF,1);
#undef NXT_A
#undef NXT_B
    }
#pragma unroll
    for (int ai = 0; ai < 2; ++ai)
#pragma unroll
    for (int m = 0; m < 4; ++m) {
#pragma unroll
        for (int bj = 0; bj < 2; ++bj) {
            if (VT1 && bj == 1) {
#pragma unroll
                for (int n = 0; n < 2; ++n)
                    epi.storeT(pre_, ai, m, brow + ai * G_HALF + wr * 64 + m * 16 + fq * 4, bcol + bj * G_HALF + wc * 32 + 8 * (fr >> 2) + 4 * n + (fr & 3), fq, acc[ai][bj][m][n]);
            } else {
                epi.store8(pre_, ai, m, bj, brow + ai * G_HALF + wr * 64 + m * 16 + fr, bcol + bj * G_HALF + wc * 32 + fq * 8, acc[ai][bj][m][0], acc[ai][bj][m][1]);
            }
        }
        asm volatile("" ::: "memory");
    }
    __syncthreads();
#undef SA
#undef SB
#undef STAGE_X
#undef STAGE_A
#undef STAGE_B
#undef LDA
#undef LDF
#undef LDB
#undef MMA
#undef WAIT_V
#undef WAIT_L
#undef BAR
#undef SCHED
}

__device__ __forceinline__ void st4bf(bf16_t* p, f32x4 v) {
    u32x2 o; o.x = pk2(v[0], v[1]); o.y = pk2(v[2], v[3]); *reinterpret_cast<u32x2*>(p) = o;
}
__device__ __forceinline__ void st8bf(bf16_t* p, f32x4 a, f32x4 b) {
    u32x4 o; o.x = pk2(a[0], a[1]); o.y = pk2(a[2], a[3]); o.z = pk2(b[0], b[1]); o.w = pk2(b[2], b[3]); *reinterpret_cast<u32x4*>(p) = o;
}
struct EpiBf16 {
    bf16_t* C; int ldc; float sc;
    struct Pre {};
    __device__ __forceinline__ void preload(Pre&, int, int, int) const {}
    __device__ __forceinline__ void store8(const Pre&, int, int, int, int row, int col, f32x4 a, f32x4 b) const { st8bf(C + (size_t)row * ldc + col, a * sc, b * sc); }
    __device__ __forceinline__ void storeT(const Pre&, int, int, int, int, int, f32x4) const {}
};
struct EpiI8 {
    bf16_t* C; int ldc; const float* rs; const float* cs;
    struct Pre { float r[8]; f32x4 c[2][2]; };
    __device__ __forceinline__ void preload(Pre& q, int rowb, int colb, int) const {
#pragma unroll
        for (int i = 0; i < 8; ++i) q.r[i] = rs[rowb + (i >> 2) * 128 + (i & 3) * 16];
#pragma unroll
        for (int bj = 0; bj < 2; ++bj) { q.c[bj][0] = *reinterpret_cast<const f32x4*>(cs + colb + bj * 128); q.c[bj][1] = *reinterpret_cast<const f32x4*>(cs + colb + bj * 128 + 4); }
    }
    __device__ __forceinline__ void store8(const Pre& q, int ai, int m, int bj, int row, int col, i32x4 a, i32x4 b) const {
        const float r = q.r[ai * 4 + m];
        f32x4 fa = {(float)a[0], (float)a[1], (float)a[2], (float)a[3]}, fb = {(float)b[0], (float)b[1], (float)b[2], (float)b[3]};
        st8bf(C + (size_t)row * ldc + col, fa * q.c[bj][0] * r, fb * q.c[bj][1] * r);
    }
    __device__ __forceinline__ void storeT(const Pre&, int, int, int, int, int, i32x4) const {}
};
struct EpiPool {
    bf16_t* C; const float* scale; int gcol0;
    struct Pre { f32x4 s[2][2]; };
    __device__ __forceinline__ void preload(Pre& q, int, int colb, int) const {
#pragma unroll
        for (int bj = 0; bj < 2; ++bj) { q.s[bj][0] = *reinterpret_cast<const f32x4*>(scale + gcol0 + colb + bj * 128); q.s[bj][1] = *reinterpret_cast<const f32x4*>(scale + gcol0 + colb + bj * 128 + 4); }
    }
    __device__ __forceinline__ void store8(const Pre& q, int, int, int bj, int row, int col, f32x4 a, f32x4 b) const {
        a = a * q.s[bj][0]; b = b * q.s[bj][1];
        u32x2 w = {(unsigned)pk_fp8x4(a[0], a[1], a[2], a[3]), (unsigned)pk_fp8x4(b[0], b[1], b[2], b[3])};
        *reinterpret_cast<u32x2*>((char*)C + (size_t)row * DM + gcol0 + col) = w;
    }
    __device__ __forceinline__ void storeT(const Pre&, int, int, int, int, int, f32x4) const {}
};
struct EpiQ {
    bf16_t* C; const float* rstd;
    struct Pre { float r[8]; };
    __device__ __forceinline__ void preload(Pre& q, int rowb, int, int) const {
#pragma unroll
        for (int i = 0; i < 8; ++i) q.r[i] = rstd[rowb + (i >> 2) * 128 + (i & 3) * 16] * (0.07216878364870322f * 1.4426950408889634f);
    }
    __device__ __forceinline__ void store8(const Pre& q, int ai, int m, int, int row, int col, f32x4 a, f32x4 b) const {
        const float s = q.r[ai * 4 + m];
        st8bf(C + (size_t)row * 1536 + col, a * s, b * s);
    }
    __device__ __forceinline__ void storeT(const Pre&, int, int, int, int, int, f32x4) const {}
};
struct EpiKV {
    bf16_t* Kn; bf16_t* Vt; const float* rstd;
    struct Pre { float r[8]; f32x4 rt[8]; };
    __device__ __forceinline__ void preload(Pre& q, int rowb, int, int rowbT) const {
#pragma unroll
        for (int i = 0; i < 8; ++i) { q.r[i] = rstd[rowb + (i >> 2) * 128 + (i & 3) * 16]; q.rt[i] = *reinterpret_cast<const f32x4*>(rstd + rowbT + (i >> 2) * 128 + (i & 3) * 16); }
    }
    __device__ __forceinline__ void store8(const Pre& q, int ai, int m, int, int row, int col, f32x4 a, f32x4 b) const {
        int head = col >> 8, d = col & 127; const float r = q.r[ai * 4 + m];
        u32x2 w = {(unsigned)pk_fp8x4(a[0] * r, a[1] * r, a[2] * r, a[3] * r), (unsigned)pk_fp8x4(b[0] * r, b[1] * r, b[2] * r, b[3] * r)};
        *reinterpret_cast<u32x2*>((char*)Kn + (size_t)row * 1024 + head * 128 + d) = w;
    }
    __device__ __forceinline__ void storeT(const Pre& q, int ai, int m, int row0, int col, int fq, f32x4 v) const {
        int head = col >> 8, d = col & 127, b = row0 >> 11, s = row0 & 2047;
        const f32x4 r = q.rt[ai * 4 + m];
        const int kk = s & 63;
        const int pos = (s & ~63) + 32 * ((kk >> 2) & 1) + 16 * (kk >> 5) + 4 * ((kk & 31) >> 3);
        *reinterpret_cast<int*>((char*)Vt + ((size_t)((b * 8 + head) * 128 + d)) * SEQ + pos) = pk_fp8x4(v[0] * r[0], v[1] * r[1], v[2] * r[2], v[3] * r[3]);
    }
};

__device__ __forceinline__ int vcu_of(int bid, int nb) { return (nb % 8 == 0) ? (bid % 8) * (nb / 8) + bid / 8 : bid; }

__device__ __forceinline__ void xpose_item(const float* __restrict__ W, int K, int N, bf16_t* __restrict__ WT, int ldt, float* scr, int item, int lane,
                                           const float* __restrict__ rowscale) {
    const int nblk = N / 32, kb = item / nblk, nb = item % nblk, k0 = 64 * kb, n0 = 32 * nb;
#pragma unroll 8
    for (int i = 0; i < 32; ++i) {
        const int kk = 2 * i + (lane >> 5);
        float w = W[(size_t)(k0 + kk) * N + n0 + (lane & 31)];
        if (rowscale) w *= rowscale[k0 + kk];
        scr[kk * 33 + (lane & 31)] = w;
    }
    __builtin_amdgcn_s_waitcnt(0xc07f); asm volatile("" ::: "memory");
    const int c = lane & 7;
#pragma unroll
    for (int j = 0; j < 4; ++j) {
        const int n = (lane >> 3) + 8 * j; const float* s = scr + (8 * c) * 33 + n;
        u32x4 o; o.x = pk2(s[0 * 33], s[1 * 33]); o.y = pk2(s[2 * 33], s[3 * 33]); o.z = pk2(s[4 * 33], s[5 * 33]); o.w = pk2(s[6 * 33], s[7 * 33]);
        *reinterpret_cast<u32x4*>(WT + (size_t)(n0 + n) * ldt + k0 + 8 * c) = o;
    }
    __builtin_amdgcn_s_waitcnt(0xc07f); asm volatile("" ::: "memory");
}
__device__ __forceinline__ void xposef8_item(const float* __restrict__ W, int K, int N, char* __restrict__ WT8, int ldt, float* scr, int item, int lane, float mul) {
    const int nblk = N / 32, kb = item / nblk, nb = item % nblk, k0 = 64 * kb, n0 = 32 * nb;
#pragma unroll 8
    for (int i = 0; i < 32; ++i) {
        const int kk = 2 * i + (lane >> 5);
        scr[kk * 33 + (lane & 31)] = W[(size_t)(k0 + kk) * N + n0 + (lane & 31)] * mul;
    }
    __builtin_amdgcn_s_waitcnt(0xc07f); asm volatile("" ::: "memory");
    const int c = lane & 7;
#pragma unroll
    for (int j = 0; j < 4; ++j) {
        const int n = (lane >> 3) + 8 * j; const float* s = scr + (8 * c) * 33 + n;
        u32x2 o;
        o.x = (unsigned)pk_fp8x4(s[0 * 33], s[1 * 33], s[2 * 33], s[3 * 33]); o.y = (unsigned)pk_fp8x4(s[4 * 33], s[5 * 33], s[6 * 33], s[7 * 33]);
        *reinterpret_cast<u32x2*>(WT8 + (size_t)(n0 + n) * ldt + k0 + 8 * c) = o;
    }
    __builtin_amdgcn_s_waitcnt(0xc07f); asm volatile("" ::: "memory");
}
__device__ __forceinline__ void xpose8_item(const float* __restrict__ W, int N, char* __restrict__ WT8, float* scr, int item, int lane,
                                            const unsigned* __restrict__ cmax, float* __restrict__ wsc) {
    const int nblk = N / 32, kb = item / nblk, nb = item % nblk, k0 = 64 * kb, n0 = 32 * nb;
    const float cm = __uint_as_float(cmax[n0 + (lane & 31)]);
    const float qm = cm > 0.f ? 127.f / cm : 0.f;
    if (kb == 0 && lane < 32) wsc[n0 + lane] = cm * (1.f / 127.f);
#pragma unroll 8
    for (int i = 0; i < 32; ++i) {
        const int kk = 2 * i + (lane >> 5);
        scr[kk * 33 + (lane & 31)] = W[(size_t)(k0 + kk) * N + n0 + (lane & 31)] * qm;
    }
    __builtin_amdgcn_s_waitcnt(0xc07f); asm volatile("" ::: "memory");
    const int c = lane & 7;
#pragma unroll
    for (int j = 0; j < 4; ++j) {
        const int n = (lane >> 3) + 8 * j; const float* s = scr + (8 * c) * 33 + n;
        u32x2 o;
        o.x = pack_i8x4(s[0 * 33], s[1 * 33], s[2 * 33], s[3 * 33]); o.y = pack_i8x4(s[4 * 33], s[5 * 33], s[6 * 33], s[7 * 33]);
        *reinterpret_cast<u32x2*>(WT8 + (size_t)(n0 + n) * 2048 + k0 + 8 * c) = o;
    }
    __builtin_amdgcn_s_waitcnt(0xc07f); asm volatile("" ::: "memory");
}
__device__ __forceinline__ void cvt_bf16_range(const float* __restrict__ src, bf16_t* __restrict__ dst, size_t n8, size_t gtid, size_t gthreads) {
    for (size_t i = gtid; i < n8; i += gthreads) {
        f32x4 a = *reinterpret_cast<const f32x4*>(src + i * 8), b = *reinterpret_cast<const f32x4*>(src + i * 8 + 4);
        u32x4 o; o.x = pk2(a[0], a[1]); o.y = pk2(a[2], a[3]); o.z = pk2(b[0], b[1]); o.w = pk2(b[2], b[3]);
        *reinterpret_cast<u32x4*>(dst + i * 8) = o;
    }
}
__device__ __forceinline__ void phase0(const Params& p, char* shm, int bid, int nb) {
    const int tid = TIDX(p.wave_s), wave = tid >> 6, lane = tid & 63;
    char* ws = p.ws;
#ifndef DUP_P0
#define DUP_P0 (-1)
#endif
    for (int rp_ = 0; rp_ < (DUP_P0 == 0 ? 2 : 1); ++rp_)
    {
        float* sl = (float*)shm;
        float* red = (float*)(shm + 65536);
        float* mod = (float*)(ws + WS_MOD);
        if (bid < 192 || nb != 256) {
            for (int i = tid; i < 8 * DM; i += NTHREADS) { float cv = p.c[i]; sl[i] = cv / (1.f + __expf(-cv)); }
            __syncthreads();
            for (int it = bid; it < 192; it += nb) {
                const int col = it * 64 + lane;
                float acc[8];
#pragma unroll
                for (int b = 0; b < 8; ++b) acc[b] = 0.f;
                const float* wp = p.ada_w + (size_t)(wave * 256) * 12288 + col;
                const float* sp = sl + wave * 256;
#pragma unroll 1
                for (int r0 = 0; r0 < 256; r0 += 32) {
                    float w[32];
#pragma unroll
                    for (int i = 0; i < 32; ++i) w[i] = wp[(size_t)(r0 + i) * 12288];
#pragma unroll
                    for (int q = 0; q < 8; ++q)
#pragma unroll
                        for (int b = 0; b < 8; ++b) {
                            const f32x4 s4 = *reinterpret_cast<const f32x4*>(sp + b * DM + r0 + 4 * q);
                            acc[b] += w[4 * q] * s4[0] + w[4 * q + 1] * s4[1] + w[4 * q + 2] * s4[2] + w[4 * q + 3] * s4[3];
                        }
                }
#pragma unroll
                for (int b = 0; b < 8; ++b) red[(wave * 8 + b) * 64 + lane] = acc[b];
                __syncthreads();
                {
                    const int b = tid >> 6, cl = tid & 63;
                    float sum = 0.f;
#pragma unroll
                    for (int w = 0; w < 8; ++w) sum += red[(w * 8 + b) * 64 + cl];
                    mod[b * 12288 + it * 64 + cl] = sum + p.ada_b[it * 64 + cl];
                }
                __syncthreads();
            }
        }
    }
    const int gw = bid * NWAVES + wave, ngw = nb * NWAVES;
    const size_t gtid = (size_t)bid * NTHREADS + tid, gthreads = (size_t)nb * NTHREADS;
    for (int rp_ = 0; rp_ < (DUP_P0 == 1 ? 2 : 1); ++rp_)
    {
        float* scr = (float*)(shm + wave * 8448);
        constexpr int I_POOL = 4 * 4 * 8, I_UQ = 8 * 48, I_UKV = 4 * 64, I_OUT = 32 * 64;
        constexpr int NIT = I_POOL + I_UQ + I_UKV + I_OUT;
        for (int it = gw; it < NIT; it += ngw) {
            int r = it;
            if (r < I_POOL) { int g = r / 32; xpose_item(p.pool_w + g * 65536, 256, 256, (bf16_t*)(ws + WS_WPOOL) + g * 65536, 256, scr, r % 32, lane, nullptr); continue; } r -= I_POOL;
            if (r < I_UQ) { xpose_item(p.w_uq, 512, 1536, (bf16_t*)(ws + WS_WUQ), 512, scr, r, lane, p.q_norm_g); continue; } r -= I_UQ;
            if (r < I_UKV) { xpose_item(p.w_ukv, 256, 2048, (bf16_t*)(ws + WS_WUKV), 256, scr, r, lane, p.kv_norm_g); continue; } r -= I_UKV;
            xposef8_item(p.w_out, 2048, 2048, ws + WS_WOUT, 2048, scr, r, lane, 32.f);
        }
        unsigned* cmax = (unsigned*)(ws + WS_CMAX);
        for (int it = gw; it < (29 + 32) * 16; it += ngw) {
            const int strip = it >> 4, kc = it & 15;
            const bool isq = strip >= 29;
            const int n = (isq ? strip - 29 : strip) * 64 + lane, N = isq ? 2048 : 1856;
            const float* wp = (isq ? p.peer_wq : p.w_in) + (size_t)(kc * 128) * N + n;
            float m = 0.f;
#pragma unroll 32
            for (int r = 0; r < 128; ++r) m = fmaxf(m, fabsf(wp[(size_t)r * N]));
            atomicMax(cmax + (isq ? 2048 : 0) + n, __float_as_uint(m));
        }
    }
    cvt_bf16_range(p.sub_keys, (bf16_t*)(ws + WS_SK), 262144 / 8, gtid, gthreads);
    for (int rp_ = 0; rp_ < (DUP_P0 == 2 ? 2 : 1); ++rp_)
    {
        float* tile = (float*)shm;
        float* redm = (float*)(shm + 16 * 2052 * 4);
        float* scl = redm + 128;
        int ntl, tfirst, tstep;
        if (nb == 256) { if (bid < 192) { ntl = 7; tfirst = bid * 7; } else { ntl = 11; tfirst = 192 * 7 + (bid - 192) * 11; } tstep = 1; }
        else { ntl = (2048 - bid + nb - 1) / nb; tfirst = bid; tstep = nb; }
#define Q_LOAD(dst, i_) do { const int itl_ = tfirst + (i_) * tstep; \
            const float* src_ = ((itl_ >> 10) ? p.peer_v : p.peer_u) + (size_t)((itl_ & 1023) * 16) * DM; \
            _Pragma("unroll") for (int k = 0; k < 16; ++k) dst[k] = *reinterpret_cast<const f32x4*>(reinterpret_cast<const char*>(src_ + (size_t)k * DM) + qoff); } while (0)
#define Q_TILE(vs, i_) do { \
            const int it = tfirst + (i_) * tstep; \
            const int isv = it >> 10, e0 = (it & 1023) * 16; \
            float mx[16]; \
            _Pragma("unroll") for (int k = 0; k < 16; ++k) { \
                *reinterpret_cast<f32x4*>(tile + k * 2052 + tid * 4) = vs[k]; \
                mx[k] = fmaxf(fmaxf(fabsf(vs[k][0]), fabsf(vs[k][1])), fmaxf(fabsf(vs[k][2]), fabsf(vs[k][3]))); \
            } \
            if ((i_) + 1 < ntl) Q_LOAD(vs, (i_) + 1); \
            _Pragma("unroll") for (int k = 0; k < 16; ++k) { \
                _Pragma("unroll") for (int o = 1; o < 64; o <<= 1) mx[k] = fmaxf(mx[k], __shfl_xor(mx[k], o)); \
            } \
            if (lane == 0) { _Pragma("unroll") for (int k = 0; k < 16; ++k) redm[wave * 16 + k] = mx[k]; } \
            __syncthreads(); \
            if (tid < 16) { \
                float m = 0.f; \
                _Pragma("unroll") for (int w = 0; w < 8; ++w) m = fmaxf(m, redm[w * 16 + tid]); \
                const float top = isv ? 256.f : 127.f; \
                scl[tid] = m > 0.f ? top / m : 0.f; \
                ((float*)(ws + (isv ? WS_SV : WS_SU)))[e0 + tid] = m / top; \
            } \
            __syncthreads(); \
            char* dst = ws + (isv ? WS_V8 : WS_U8); \
            _Pragma("unroll") for (int k = 0; k < 8; ++k) { \
                const int item = tid + k * NTHREADS, e = item & 15, sl = item >> 4; \
                const float* tp = tile + e * 2052 + sl * 8; \
                f32x4 a = *reinterpret_cast<const f32x4*>(tp), c = *reinterpret_cast<const f32x4*>(tp + 4); \
                const float m = scl[e]; \
                u32x2 o; \
                if (isv) { \
                    int w0 = __builtin_amdgcn_cvt_pk_fp8_f32(a[0] * m, a[1] * m, 0, false); \
                    w0 = __builtin_amdgcn_cvt_pk_fp8_f32(a[2] * m, a[3] * m, w0, true); \
                    int w1 = __builtin_amdgcn_cvt_pk_fp8_f32(c[0] * m, c[1] * m, 0, false); \
                    w1 = __builtin_amdgcn_cvt_pk_fp8_f32(c[2] * m, c[3] * m, w1, true); \
                    o.x = (unsigned)w0; o.y = (unsigned)w1; \
                } else { \
                    o.x = pack_i8x4(a[0] * m, a[1] * m, a[2] * m, a[3] * m); o.y = pack_i8x4(c[0] * m, c[1] * m, c[2] * m, c[3] * m); \
                } \
                *reinterpret_cast<u32x2*>(dst + ((size_t)sl * 16384 + e0 + e) * 8) = o; \
                if (k & 1) __builtin_amdgcn_sched_barrier(0); \
            } \
            __syncthreads(); } while (0)
        f32x4 va[16];
        const unsigned qoff = (unsigned)tid * 16u;
        Q_LOAD(va, 0);
        __syncthreads();
#pragma unroll 1
        for (int i = 0; i < ntl; ++i) Q_TILE(va, i);
#undef Q_LOAD
#undef Q_TILE
    }
    {
        float2* cs = (float2*)(ws + WS_CS);
        for (size_t i = gtid; i < (size_t)NTOK * 32; i += gthreads) {
            int t = (int)(i >> 5), k = (int)(i & 31);
            float invf = exp2f(-(float)k * (13.287712379549449f / 32.f));
            float ang = (float)p.pos[t] * invf;
            double sd, cd; sincos((double)ang, &sd, &cd);
            cs[i] = make_float2((float)cd, (float)sd);
        }
    }
}

__device__ __forceinline__ void phase1(const Params& p, char* shm, int bid, int nb) {
    const int tid = TIDX(p.wave_s), wave = tid >> 6, lane = tid & 63;
    const float* mod = (const float*)(p.ws + WS_MOD);
    char* h1 = p.ws + WS_BUF1;
    float* sh1 = (float*)(p.ws + WS_SH1);
    float* lv = (float*)shm;
    for (int item = bid; item < NTOK / 64; item += nb) {
        const int b = item >> 5;
        __syncthreads();
        for (int i = tid; i < 512; i += NTHREADS) {
            *reinterpret_cast<f32x4*>(lv + 0 * DM + i * 4) = *reinterpret_cast<const f32x4*>(p.pre_mix_g + i * 4);
            *reinterpret_cast<f32x4*>(lv + 1 * DM + i * 4) = *reinterpret_cast<const f32x4*>(mod + b * 12288 + i * 4);
            *reinterpret_cast<f32x4*>(lv + 2 * DM + i * 4) = *reinterpret_cast<const f32x4*>(mod + b * 12288 + 2048 + i * 4);
        }
        __syncthreads();
#pragma unroll 1
        for (int rr = 0; rr < 8; ++rr) {
            const int row = item * 64 + rr * 8 + wave;
            const float* xr = p.x + (size_t)row * DM + lane * 4;
            f32x4 v[8]; float ss = 0.f;
#pragma unroll
            for (int i = 0; i < 8; ++i) { v[i] = *reinterpret_cast<const f32x4*>(xr + i * 256); ss += v[i][0] * v[i][0] + v[i][1] * v[i][1] + v[i][2] * v[i][2] + v[i][3] * v[i][3]; }
            const float rstd = rsqrtf(wave_sum(ss) * (1.f / DM) + EPS);
            float hmax = 0.f;
#pragma unroll
            for (int i = 0; i < 8; ++i) {
                const int col = i * 256 + lane * 4;
                f32x4 g = *reinterpret_cast<const f32x4*>(lv + col);
                f32x4 sh = *reinterpret_cast<const f32x4*>(lv + DM + col);
                f32x4 sc = *reinterpret_cast<const f32x4*>(lv + 2 * DM + col);
                v[i] = v[i] * rstd * g * (sc + 1.f) + sh;
                hmax = fmaxf(hmax, fmaxf(fmaxf(fabsf(v[i][0]), fabsf(v[i][1])), fmaxf(fabsf(v[i][2]), fabsf(v[i][3]))));
            }
#pragma unroll
            for (int o = 1; o < 64; o <<= 1) hmax = fmaxf(hmax, __shfl_xor(hmax, o));
            const float qm = hmax > 0.f ? 127.f / hmax : 0.f;
            if (lane == 0) sh1[row] = hmax * (1.f / 127.f);
#pragma unroll
            for (int i = 0; i < 8; ++i) {
                *reinterpret_cast<unsigned*>(h1 + (size_t)row * DM + i * 256 + lane * 4) = pack_i8x4(v[i][0] * qm, v[i][1] * qm, v[i][2] * qm, v[i][3] * qm);
            }
        }
    }
    {
        __syncthreads();
        float* scr = (float*)(shm + wave * 8448);
        const unsigned* cmax = (const unsigned*)(p.ws + WS_CMAX);
        float* wsc = (float*)(p.ws + WS_WSC);
        const int gw = bid * NWAVES + wave, ngw = nb * NWAVES;
        constexpr int I_IN = 32 * 58, I_PQ = 32 * 64;
        for (int it = gw; it < I_IN + I_PQ; it += ngw) {
            if (it < I_IN) xpose8_item(p.w_in, 1856, p.ws + WS_WIN, scr, it, lane, cmax, wsc);
            else xpose8_item(p.peer_wq, 2048, p.ws + WS_WPQ, scr, it - I_IN, lane, cmax + 2048, wsc + 2048);
        }
        const size_t gtid = (size_t)bid * NTHREADS + tid, gthreads = (size_t)nb * NTHREADS;
        for (size_t i = gtid; i < 24576; i += gthreads) *reinterpret_cast<u32x4*>(p.ws + WS_WIN + (size_t)1856 * 2048 + i * 16) = u32x4{0u, 0u, 0u, 0u};
        for (size_t i = gtid; i < 192; i += gthreads) wsc[1856 + i] = 0.f;
        __syncthreads();
    }
}

template <bool VT1, bool I8, bool F8 = false, class Epi>
__device__ __forceinline__ void gemm_phase(const bf16_t* A, int lda, const bf16_t* Bt, int ldb, int K, int nN, int ntiles, int tile0, int vcu, int nb,
                                           char* shm, const Epi& epi, int ws_) {
    int first = ((vcu - tile0) % nb + nb) % nb;
    bool pre = false;
    for (int t = first; t < ntiles; t += nb) {
        const int pm = t / nN, pn = t % nN;
        const int tn = t + nb;
        const bool has = tn < ntiles;
        const NextTile nx{A, Bt, lda, ldb, has ? (tn / nN) * 256 : -1, (tn % nN) * 256};
        gemm_tile<VT1, I8, F8>(A, lda, Bt, ldb, K / 64, pm * 256, pn * 256, shm, epi, pre, nx, ws_);
        pre = has;
    }
}

__device__ __forceinline__ void phase3(const Params& p, int bid, int nb) {
    const int tid = TIDX(p.wave_s), wave = tid >> 6, lane = tid & 63;
    const bf16_t* proj = (const bf16_t*)(p.ws + WS_BUF2);
    bf16_t* z = (bf16_t*)(p.ws + WS_Z);
    for (int it = bid * NTHREADS + tid; it < 1024 * 128; it += nb * NTHREADS) {
        const int strip = it >> 7, c8 = it & 127, g = c8 >> 5, w = 2 << g;
        const int t0 = strip * 16, s0 = t0 & 2047;
        const bf16_t* up = proj + (size_t)t0 * DM + c8 * 8;
        float sum[8];
#pragma unroll
        for (int j = 0; j < 8; ++j) sum[j] = 0.f;
        for (int i = 1; i <= w; ++i) {
            if (s0 - i >= 0) {
                u32x4 r = *reinterpret_cast<const u32x4*>(up - (ptrdiff_t)i * DM);
#pragma unroll
                for (int j = 0; j < 4; ++j) { sum[2 * j] += bflo(r[j]); sum[2 * j + 1] += bfhi(r[j]); }
            }
        }
        for (int tt = 0; tt < 16; ++tt) {
            const int s = s0 + tt;
            u32x4 r = *reinterpret_cast<const u32x4*>(up + (size_t)tt * DM);
            float cur[8];
#pragma unroll
            for (int j = 0; j < 4; ++j) { cur[2 * j] = bflo(r[j]); cur[2 * j + 1] = bfhi(r[j]); }
#pragma unroll
            for (int j = 0; j < 8; ++j) sum[j] += cur[j];
            if (s >= w) {
                u32x4 o = *reinterpret_cast<const u32x4*>(up + (ptrdiff_t)(tt - w) * DM);
#pragma unroll
                for (int j = 0; j < 4; ++j) { sum[2 * j] -= bflo(o[j]); sum[2 * j + 1] -= bfhi(o[j]); }
            }
            const float inv = 1.f / (float)min(s + 1, w);
            u32x4 o;
#pragma unroll
            for (int j = 0; j < 4; ++j) o[j] = pk2(sum[2 * j] * inv - cur[2 * j], sum[2 * j + 1] * inv - cur[2 * j + 1]);
            *reinterpret_cast<u32x4*>(z + (size_t)(t0 + tt) * 1024 + c8 * 8) = o;
        }
    }
    float* rq = (float*)(p.ws + WS_RSTDQ); float* rkv = (float*)(p.ws + WS_RSTDKV);
    bf16_t* kpe = (bf16_t*)(p.ws + WS_KPE);
    const float2* cs = (const float2*)(p.ws + WS_CS);
    for (int t = bid * NWAVES + wave; t < NTOK; t += nb * NWAVES) {
        const bf16_t* pr = proj + (size_t)t * DM;
        u32x4 a = *reinterpret_cast<const u32x4*>(pr + 1024 + lane * 8);
        float s1 = 0.f;
#pragma unroll
        for (int j = 0; j < 4; ++j) { float lo = bflo(a[j]), hi = bfhi(a[j]); s1 += lo * lo + hi * hi; }
        u32x2 bq = *reinterpret_cast<const u32x2*>(pr + 1536 + lane * 4);
        float s2 = 0.f;
#pragma unroll
        for (int j = 0; j < 2; ++j) { float lo = bflo(bq[j]), hi = bfhi(bq[j]); s2 += lo * lo + hi * hi; }
        s1 = wave_sum(s1); s2 = wave_sum(s2);
        if (lane == 0) { rq[t] = rsqrtf(s1 * (1.f / 512.f) + EPS); rkv[t] = rsqrtf(s2 * (1.f / 256.f) + EPS); }
        if (lane < 32) {
            float x1 = bf2f((short)pr[1792 + lane]), x2 = bf2f((short)pr[1792 + 32 + lane]);
            float2 c = cs[(size_t)t * 32 + lane];
            unsigned char* k8 = (unsigned char*)kpe + (size_t)t * 64 + 32 * (lane >> 4) + (lane & 15);
            const int w = pk_fp8x4(x1 * c.x - x2 * c.y, x2 * c.x + x1 * c.y, 0.f, 0.f);
            k8[0] = (unsigned char)(w & 0xff); k8[16] = (unsigned char)((w >> 8) & 0xff);
        }
    }
}

constexpr int KS_STRIDE = 208, VS_STRIDE = 80;
constexpr int KS_BYTES = 64 * KS_STRIDE, VS_BYTES = 128 * VS_STRIDE, AT_STAGE = KS_BYTES + VS_BYTES;
__device__ __forceinline__ void attn_unit(const Params& p, char* shm, int b, int head, int qb) {
    int tid = TIDX(p.wave_s); asm volatile("" : "+v"(tid));
    const int wave = __builtin_amdgcn_readfirstlane(tid >> 6), lane = tid & 63, l31 = lane & 31, hh = lane >> 5;
    const bool grpB = wave >= 4;
    const int rowblk = (wave & 3) * 2 + (wave >> 2);
    const bf16_t* Q = (const bf16_t*)(p.ws + WS_Q);
    const bf16_t* Kn = (const bf16_t*)(p.ws + WS_KN);
    const bf16_t* Kpe = (const bf16_t*)(p.ws + WS_KPE);
    const bf16_t* Vt = (const bf16_t*)(p.ws + WS_VT);
    const float2* cs = (const float2*)(p.ws + WS_CS);
    bf16_t* ycat = (bf16_t*)(p.ws + WS_BUF1);
    const int q0 = qb * 256 + rowblk * 32, mychunk = q0 >> 6, nkt = 4 * qb + 4;
    const int tq = b * SEQ + q0 + l31;
    i32x8 qf[3];
    {
        const bf16_t* qrow = Q + (size_t)tq * 1536 + head * 192;
#pragma unroll
        for (int ks = 0; ks < 2; ++ks)
#pragma unroll
            for (int i = 0; i < 4; ++i) {
                const bf16x8 v = *reinterpret_cast<const bf16x8*>(qrow + ks * 64 + hh * 32 + 8 * i);
                qf[ks][2 * i] = pk_fp8x4(bf2f(v[0]) * 8.f, bf2f(v[1]) * 8.f, bf2f(v[2]) * 8.f, bf2f(v[3]) * 8.f);
                qf[ks][2 * i + 1] = pk_fp8x4(bf2f(v[4]) * 8.f, bf2f(v[5]) * 8.f, bf2f(v[6]) * 8.f, bf2f(v[7]) * 8.f);
            }
#pragma unroll
        for (int i = 0; i < 2; ++i) {
            const bf16x8 a = *reinterpret_cast<const bf16x8*>(qrow + 128 + 16 * hh + 8 * i);
            const bf16x8 c2 = *reinterpret_cast<const bf16x8*>(qrow + 160 + 16 * hh + 8 * i);
            const float2* cp = cs + (size_t)tq * 32 + 16 * hh + 8 * i;
            float o1[8], o2[8];
#pragma unroll
            for (int j = 0; j < 8; ++j) {
                const float2 c = cp[j];
                const float x1 = bf2f(a[j]) * 8.f, x2 = bf2f(c2[j]) * 8.f;
                o1[j] = x1 * c.x - x2 * c.y; o2[j] = x2 * c.x + x1 * c.y;
            }
            qf[2][2 * i] = pk_fp8x4(o1[0], o1[1], o1[2], o1[3]); qf[2][2 * i + 1] = pk_fp8x4(o1[4], o1[5], o1[6], o1[7]);
            qf[2][4 + 2 * i] = pk_fp8x4(o2[0], o2[1], o2[2], o2[3]); qf[2][4 + 2 * i + 1] = pk_fp8x4(o2[4], o2[5], o2[6], o2[7]);
        }
    }
    f32x16 O[4];
#pragma unroll
    for (int dt = 0; dt < 4; ++dt)
#pragma unroll
        for (int r = 0; r < 16; ++r) O[dt][r] = 0.f;
    float mrun = -1e30f, lsum = 0.f;
    f32x16 s0, s1;
    const int kkey = tid >> 3, kch = tid & 7;
    const int pk_key = tid >> 2, pk_ch = tid & 3;
    const int vd = tid >> 2, vch = tid & 3;
    const size_t tokb = (size_t)b * SEQ;
    const char* Kn8 = (const char*)Kn; const char* Kpe8 = (const char*)Kpe;
    const char* vbase = (const char*)Vt + (size_t)((b * 8 + head) * 128) * SEQ;
    u32x4 r0, r2, r3;
#define AT_LOAD(kt) do { const int k0_ = (kt) * 64; \
        r0 = *reinterpret_cast<const u32x4*>(Kn8 + (tokb + k0_ + kkey) * 1024 + head * 128 + kch * 16); \
        if (wave < 4) r2 = *reinterpret_cast<const u32x4*>(Kpe8 + (tokb + k0_ + pk_key) * 64 + pk_ch * 16); \
        r3 = *reinterpret_cast<const u32x4*>(vbase + (size_t)vd * SEQ + k0_ + vch * 16); } while (0)
#define AT_WRITE(buf) do { char* ks_ = shm + (buf) * AT_STAGE; char* vs_ = ks_ + KS_BYTES; \
        *reinterpret_cast<u32x4*>(ks_ + kkey * KS_STRIDE + kch * 16) = r0; \
        if (wave < 4) *reinterpret_cast<u32x4*>(ks_ + pk_key * KS_STRIDE + 128 + pk_ch * 16) = r2; \
        *reinterpret_cast<u32x4*>(vs_ + vd * VS_STRIDE + vch * 16) = r3; } while (0)
#define LDK(ks_, t_) __builtin_shufflevector(*reinterpret_cast<const i32x4*>(kb + (t_) * 32 * KS_STRIDE + (ks_) * 64), \
                                             *reinterpret_cast<const i32x4*>(kb + (t_) * 32 * KS_STRIDE + (ks_) * 64 + 16), 0, 1, 2, 3, 4, 5, 6, 7)
#define MXQK(a_, b_, c_) __builtin_amdgcn_mfma_scale_f32_32x32x64_f8f6f4(a_, b_, c_, 0, 0, 0, 0x7F7F7F7F, 0, 0x7F7F7F7F)
#define QK(buf) do { \
        const char* kb = shm + (buf) * AT_STAGE + l31 * KS_STRIDE + hh * 32; \
        i32x8 ka0 = LDK(0, 0), ka1 = LDK(0, 1), kb0 = LDK(1, 0), kb1 = LDK(1, 1); \
        _Pragma("unroll") for (int r = 0; r < 16; ++r) { s0[r] = 0.f; s1[r] = 0.f; } \
        __builtin_amdgcn_sched_barrier(0); \
        s0 = MXQK(ka0, qf[0], s0); \
        s1 = MXQK(ka1, qf[0], s1); \
        ka0 = LDK(2, 0); ka1 = LDK(2, 1); \
        __builtin_amdgcn_sched_barrier(0); \
        s0 = MXQK(kb0, qf[1], s0); \
        s1 = MXQK(kb1, qf[1], s1); \
        __builtin_amdgcn_sched_barrier(0); \
        s0 = MXQK(ka0, qf[2], s0); \
        s1 = MXQK(ka1, qf[2], s1); \
        __builtin_amdgcn_sched_barrier(0); } while (0)
#define LDV(dt_) __builtin_shufflevector(*reinterpret_cast<const i32x4*>(vb + (dt_) * 32 * VS_STRIDE), *reinterpret_cast<const i32x4*>(vb + (dt_) * 32 * VS_STRIDE + 16), 0, 1, 2, 3, 4, 5, 6, 7)
#define SMPV(buf) do { \
        const char* vb = shm + (buf) * AT_STAGE + KS_BYTES + l31 * VS_STRIDE + hh * 32; \
        i32x8 va[4]; \
        _Pragma("unroll") for (int dt = 0; dt < 4; ++dt) va[dt] = LDV(dt); \
        float mx = s0[0]; \
        _Pragma("unroll") for (int r = 1; r < 16; ++r) mx = fmaxf(mx, s0[r]); \
        _Pragma("unroll") for (int r = 0; r < 16; ++r) mx = fmaxf(mx, s1[r]); \
        mx = fmaxf(mx, __shfl_xor(mx, 32)); \
        const float mnew = fmaxf(mrun, mx * 0.125f); \
        const float alpha = __builtin_amdgcn_exp2f(mrun - mnew); \
        mrun = mnew; \
        const float moff = 6.f - mnew;        \
        float ps = 0.f; \
        _Pragma("unroll") for (int r = 0; r < 16; ++r) { s0[r] = __builtin_amdgcn_exp2f(fmaf(s0[r], 0.125f, moff)); ps += s0[r]; } \
        _Pragma("unroll") for (int r = 0; r < 16; ++r) { s1[r] = __builtin_amdgcn_exp2f(fmaf(s1[r], 0.125f, moff)); ps += s1[r]; } \
        lsum = lsum * alpha + ps; \
        _Pragma("unroll") for (int dt = 0; dt < 4; ++dt) _Pragma("unroll") for (int r = 0; r < 16; ++r) O[dt][r] *= alpha; \
        i32x8 pf; \
        _Pragma("unroll") for (int g = 0; g < 4; ++g) { \
            pf[g] = pk_fp8x4(s0[4 * g], s0[4 * g + 1], s0[4 * g + 2], s0[4 * g + 3]); \
            pf[4 + g] = pk_fp8x4(s1[4 * g], s1[4 * g + 1], s1[4 * g + 2], s1[4 * g + 3]); \
        } \
        __builtin_amdgcn_sched_barrier(0); \
        _Pragma("unroll") for (int dt = 0; dt < 4; ++dt) O[dt] = MXQK(va[dt], pf, O[dt]); \
        __builtin_amdgcn_sched_barrier(0); } while (0)
    __syncthreads();
    AT_LOAD(0); AT_WRITE(0);
    AT_LOAD(1);
    __syncthreads();
    if (grpB) __syncthreads();
    int bcur = 0, bnext = 1;
    for (int kt = 0; kt < nkt; ++kt) {
        if (kt + 1 < nkt) AT_WRITE(bnext);
        if (kt + 2 < nkt) AT_LOAD(kt + 2);
        __builtin_amdgcn_sched_barrier(0);
        if (kt <= mychunk) QK(bcur);
        __syncthreads();
        if (kt <= mychunk) SMPV(bcur);
        __syncthreads();
        bcur = bnext; bnext = (bnext == 2) ? 0 : bnext + 1;
    }
    if (!grpB) __syncthreads();
#undef AT_LOAD
#undef AT_WRITE
#undef QK
#undef SMPV
#undef LDK
#undef MXQK
#undef LDV
    lsum += __shfl_xor(lsum, 32);
    const float inv = 1.f / lsum;
    char* orow = (char*)ycat + (size_t)tq * DM + 1024 + head * 128 + 4 * hh;
#pragma unroll
    for (int dt = 0; dt < 4; ++dt)
#pragma unroll
        for (int g = 0; g < 4; ++g)
            *reinterpret_cast<int*>(orow + dt * 32 + 8 * g) = pk_fp8x4(O[dt][4 * g] * inv, O[dt][4 * g + 1] * inv, O[dt][4 * g + 2] * inv, O[dt][4 * g + 3] * inv);
}
__device__ __forceinline__ void phase5(const Params& p, char* shm, int bid, int nb) {
    for (int it = bid; it < 256; it += nb) {
        const int bh = it >> 2, pr = it & 3, b = bh >> 3, head = bh & 7;
        attn_unit(p, shm, b, head, 7 - pr);
        attn_unit(p, shm, b, head, pr);
    }
}

__device__ __forceinline__ void phase7(const Params& p, char* shm, int bid, int nb) {
    const int tid = TIDX(p.wave_s), wave = tid >> 6, lane = tid & 63;
    const float* mod = (const float*)(p.ws + WS_MOD);
    const bf16_t* y = (const bf16_t*)(p.ws + WS_BUF2);
    bf16_t* x1 = (bf16_t*)(p.ws + WS_X1);
    float* lv = (float*)shm;
    for (int item = bid; item < NTOK / 64; item += nb) {
        const int b = item >> 5;
        const float* md = mod + b * 12288;
        __syncthreads();
        for (int i = tid; i < 512; i += NTHREADS) {
            *reinterpret_cast<f32x4*>(lv + 0 * DM + i * 4) = *reinterpret_cast<const f32x4*>(p.post_mix_g + i * 4);
            *reinterpret_cast<f32x4*>(lv + 1 * DM + i * 4) = *reinterpret_cast<const f32x4*>(md + 4096 + i * 4);
            *reinterpret_cast<f32x4*>(lv + 2 * DM + i * 4) = *reinterpret_cast<const f32x4*>(p.pre_ffn_g + i * 4);
            *reinterpret_cast<f32x4*>(lv + 3 * DM + i * 4) = *reinterpret_cast<const f32x4*>(md + 6144 + i * 4);
            *reinterpret_cast<f32x4*>(lv + 4 * DM + i * 4) = *reinterpret_cast<const f32x4*>(md + 8192 + i * 4);
        }
        __syncthreads();
#pragma unroll 1
        for (int rr = 0; rr < 8; ++rr) {
            const int row = item * 64 + rr * 8 + wave;
            f32x4 yv[8]; float ss = 0.f;
#pragma unroll
            for (int i = 0; i < 8; ++i) {
                u32x2 r = *reinterpret_cast<const u32x2*>(y + (size_t)row * DM + i * 256 + lane * 4);
                yv[i] = f32x4{bflo(r.x), bfhi(r.x), bflo(r.y), bfhi(r.y)};
                ss += yv[i][0] * yv[i][0] + yv[i][1] * yv[i][1] + yv[i][2] * yv[i][2] + yv[i][3] * yv[i][3];
            }
            const float rstd = rsqrtf(wave_sum(ss) * (1.f / DM) + EPS);
            float s2 = 0.f;
#pragma unroll
            for (int i = 0; i < 8; ++i) {
                const int col = i * 256 + lane * 4;
                f32x4 xv = *reinterpret_cast<const f32x4*>(p.x + (size_t)row * DM + col);
                f32x4 g = *reinterpret_cast<const f32x4*>(lv + col);
                f32x4 gt = *reinterpret_cast<const f32x4*>(lv + DM + col);
                f32x4 v = xv + gt * (yv[i] * rstd * g);
                st4bf(x1 + (size_t)row * DM + col, v);
                yv[i] = v;
                s2 += v[0] * v[0] + v[1] * v[1] + v[2] * v[2] + v[3] * v[3];
            }
            const float rstd2 = rsqrtf(wave_sum(s2) * (1.f / DM) + EPS);
            float hmax = 0.f;
#pragma unroll
            for (int i = 0; i < 8; ++i) {
                const int col = i * 256 + lane * 4;
                f32x4 g = *reinterpret_cast<const f32x4*>(lv + 2 * DM + col);
                f32x4 sh = *reinterpret_cast<const f32x4*>(lv + 3 * DM + col);
                f32x4 sc = *reinterpret_cast<const f32x4*>(lv + 4 * DM + col);
                yv[i] = yv[i] * rstd2 * g * (sc + 1.f) + sh;
                hmax = fmaxf(hmax, fmaxf(fmaxf(fabsf(yv[i][0]), fabsf(yv[i][1])), fmaxf(fabsf(yv[i][2]), fabsf(yv[i][3]))));
            }
#pragma unroll
            for (int o = 1; o < 64; o <<= 1) hmax = fmaxf(hmax, __shfl_xor(hmax, o));
            const float qm = hmax > 0.f ? 127.f / hmax : 0.f;
            if (lane == 0) ((float*)(p.ws + WS_SH))[row] = hmax * (1.f / 127.f);
#pragma unroll
            for (int i = 0; i < 8; ++i) {
                *reinterpret_cast<unsigned*>(p.ws + WS_H8 + (size_t)row * DM + i * 256 + lane * 4) = pack_i8x4(yv[i][0] * qm, yv[i][1] * qm, yv[i][2] * qm, yv[i][3] * qm);
            }
        }
    }
}

__device__ __forceinline__ int fmap(float f) { int i = __float_as_int(f); return i ^ ((i >> 31) & 0x7fffffff); }
__device__ __forceinline__ float funmap(int i) { return __int_as_float(i ^ ((i >> 31) & 0x7fffffff)); }
__device__ __forceinline__ void ins16(int (&top)[16], int k) {
#pragma unroll
    for (int i = 0; i < 16; ++i) { int hi = max(top[i], k); k = min(top[i], k); top[i] = hi; }
}
__device__ __forceinline__ int bsel(int m, int a, int b) { return (a & ~m) | (b & m); }
__device__ __forceinline__ int sel16(const int (&a)[16], int i) {
    const int m0 = -(i & 1), m1 = -((i >> 1) & 1), m2 = -((i >> 2) & 1), m3 = -((i >> 3) & 1);
    int t8[8], t4[4], t2[2];
#pragma unroll
    for (int k = 0; k < 8; ++k) t8[k] = bsel(m0, a[2 * k], a[2 * k + 1]);
#pragma unroll
    for (int k = 0; k < 4; ++k) t4[k] = bsel(m1, t8[2 * k], t8[2 * k + 1]);
#pragma unroll
    for (int k = 0; k < 2; ++k) t2[k] = bsel(m2, t4[2 * k], t4[2 * k + 1]);
    return bsel(m3, t2[0], t2[1]);
}
#define BITONIC_CE(x, K, J) _Pragma("unroll") for (int i_ = 0; i_ < 16; ++i_) { const int l_ = i_ ^ (J); if (l_ > i_) { const int a_ = x[i_], b_ = x[l_]; \
        if ((i_ & (K)) == 0) { x[i_] = max(a_, b_); x[l_] = min(a_, b_); } else { x[i_] = min(a_, b_); x[l_] = max(a_, b_); } } }
#define BITONIC_MERGE16(x) BITONIC_CE(x, 16, 8) BITONIC_CE(x, 16, 4) BITONIC_CE(x, 16, 2) BITONIC_CE(x, 16, 1)
#define BITONIC_SORT16(x) BITONIC_CE(x, 2, 1) BITONIC_CE(x, 4, 2) BITONIC_CE(x, 4, 1) BITONIC_CE(x, 8, 4) BITONIC_CE(x, 8, 2) BITONIC_CE(x, 8, 1) BITONIC_MERGE16(x)
#define SCE(x, i, j) { const int a_ = x[i], b_ = x[j]; x[i] = max(a_, b_); x[j] = min(a_, b_); }
#define SORT16_60(x) SCE(x,0,13) SCE(x,1,12) SCE(x,2,15) SCE(x,3,14) SCE(x,4,8) SCE(x,5,6) SCE(x,7,11) SCE(x,9,10) SCE(x,0,5) SCE(x,1,7) SCE(x,2,9) SCE(x,3,4) SCE(x,6,13) SCE(x,8,14) SCE(x,10,15) SCE(x,11,12) SCE(x,0,1) SCE(x,2,3) SCE(x,4,5) SCE(x,6,8) SCE(x,7,9) SCE(x,10,11) SCE(x,12,13) SCE(x,14,15) SCE(x,0,2) SCE(x,1,3) SCE(x,4,10) SCE(x,5,11) SCE(x,6,7) SCE(x,8,9) SCE(x,12,14) SCE(x,13,15) SCE(x,1,2) SCE(x,3,12) SCE(x,4,6) SCE(x,5,7) SCE(x,8,10) SCE(x,9,11) SCE(x,13,14) SCE(x,1,4) SCE(x,2,6) SCE(x,5,8) SCE(x,7,10) SCE(x,9,13) SCE(x,11,14) SCE(x,2,4) SCE(x,3,6) SCE(x,9,12) SCE(x,11,13) SCE(x,3,5) SCE(x,6,8) SCE(x,7,9) SCE(x,10,12) SCE(x,3,4) SCE(x,5,6) SCE(x,7,8) SCE(x,9,10) SCE(x,11,12) SCE(x,6,7) SCE(x,8,9)
__device__ __forceinline__ void pk_half_list(const bf16_t* __restrict__ qrow, const char* kl, int hh, int (&out)[16]) {
    bf16x8 qf[8];
#pragma unroll
    for (int ks = 0; ks < 8; ++ks) qf[ks] = *reinterpret_cast<const bf16x8*>(qrow + ks * 16);
    int top[16];
#pragma unroll 1
    for (int kt = 0; kt < 4; ++kt) {
        f32x16 acc;
#pragma unroll
        for (int r = 0; r < 16; ++r) acc[r] = 0.f;
#pragma unroll
        for (int ks = 0; ks < 8; ++ks) {
            bf16x8 kf = *reinterpret_cast<const bf16x8*>(kl + kt * 32 * 272 + ks * 32);
            acc = __builtin_amdgcn_mfma_f32_32x32x16_bf16(kf, qf[ks], acc, 0, 0, 0);
        }
        int nw[16];
#pragma unroll
        for (int r = 0; r < 16; ++r) {
            const int n = kt * 32 + (r & 3) + 8 * (r >> 2) + 4 * hh;
            nw[r] = (fmap(acc[r]) & ~127) | (127 - n);
        }
        SORT16_60(nw)
        if (kt == 0) {
#pragma unroll
            for (int i = 0; i < 16; ++i) top[i] = nw[i];
        } else {
#pragma unroll
            for (int i = 0; i < 16; ++i) top[i] = max(top[i], nw[15 - i]);
            BITONIC_MERGE16(top)
        }
    }
#pragma unroll
    for (int i = 0; i < 16; ++i) out[i] = __shfl_xor(top[15 - i], 32);
#pragma unroll
    for (int i = 0; i < 16; ++i) out[i] = max(out[i], top[i]);
    BITONIC_MERGE16(out)
}
__device__ __forceinline__ void phase9(const Params& p, char* shm, int bid, int nb) {
    int tid = TIDX(p.wave_s); asm volatile("" : "+v"(tid));
    const int wave = tid >> 6, lane = tid & 63, l31 = lane & 31, hh = lane >> 5;
    const bf16_t* pq = (const bf16_t*)(p.ws + WS_BUF2);
    const bf16_t* sk = (const bf16_t*)(p.ws + WS_SK);
    int* idxo = (int*)(p.ws + WS_IDX); float* gateo = (float*)(p.ws + WS_GATE);
    for (int item = bid; item < 8 * 64; item += nb) {
        const int head = item & 7, tt = (item >> 3) * 8 + wave, tok = tt * 32 + l31;
        __syncthreads();
        for (int c = tid; c < 4096; c += NTHREADS) {
            const int row = c >> 4, ch = c & 15;
            *reinterpret_cast<u32x4*>(shm + row * 272 + ch * 16) = *reinterpret_cast<const u32x4*>(sk + (size_t)(head * 256 + row) * 128 + ch * 8);
        }
        __syncthreads();
        int la[16], lb[16];
        pk_half_list(pq + (size_t)tok * DM + head * 256 + hh * 8, shm + l31 * 272 + hh * 16, hh, la);
        pk_half_list(pq + (size_t)tok * DM + head * 256 + 128 + hh * 8, shm + (128 + l31) * 272 + hh * 16, hh, lb);
        float va[16], vb[16]; int ia[16], ib[16];
#pragma unroll
        for (int i = 0; i < 16; ++i) {
            va[i] = funmap(la[i] & ~127); ia[i] = 127 - (la[i] & 127);
            vb[i] = funmap(lb[i] & ~127); ib[i] = 127 - (lb[i] & 127);
        }
#define CKEY(i, j) ((fmap(va[i] + vb[j]) & ~255) | (255 - ((i) * 16 + (j))))
        int top2[16], ga[16], gb[16];
#pragma unroll
        for (int j = 0; j < 16; ++j) top2[j] = CKEY(0, j);
#pragma unroll
        for (int j = 0; j < 8; ++j) { ga[j] = CKEY(1, j); ga[8 + j] = CKEY(15 - j, 0); }
        BITONIC_MERGE16(ga)
        gb[0] = CKEY(2, 0); gb[1] = CKEY(2, 1); gb[2] = CKEY(2, 2); gb[3] = CKEY(2, 3); gb[4] = CKEY(2, 4);
        gb[5] = CKEY(3, 0); gb[6] = CKEY(3, 1); gb[7] = CKEY(3, 2); gb[8] = CKEY(3, 3);
        gb[9] = CKEY(4, 0); gb[10] = CKEY(4, 1); gb[11] = CKEY(4, 2);
        gb[12] = CKEY(5, 0); gb[13] = CKEY(5, 1); gb[14] = CKEY(6, 0); gb[15] = CKEY(6, 1);
        SORT16_60(gb)
#pragma unroll
        for (int i = 0; i < 16; ++i) top2[i] = max(top2[i], ga[15 - i]);
        BITONIC_MERGE16(top2)
#pragma unroll
        for (int i = 0; i < 16; ++i) top2[i] = max(top2[i], gb[15 - i]);
        BITONIC_MERGE16(top2)
        ins16(top2, CKEY(7, 0)); ins16(top2, CKEY(7, 1));
#undef CKEY
        float bv[16], mxv, sum = 0.f; int ex[16];
        {
            LAS int* tA = (LAS int*)(uintptr_t)(69632 + wave * 8192) + lane;
            LAS int* tB = tA + 16 * 64;
#pragma unroll
            for (int i = 0; i < 16; ++i) { tA[i * 64] = ia[i] * 128; tB[i * 64] = ib[i]; }
#pragma unroll
            for (int r = 0; r < 16; ++r) {
                const int code = 255 - (top2[r] & 255);
                ex[r] = tA[(code >> 4) * 64] + tB[(code & 15) * 64];
                bv[r] = funmap(top2[r] & ~255);
            }
        }
        mxv = bv[0];
#pragma unroll
        for (int r = 0; r < 16; ++r) { bv[r] = __expf(bv[r] - mxv); sum += bv[r]; }
        const float inv = 1.f / sum;
        if (hh == 0) {
            const size_t ob = ((size_t)(tok >> 6) * 128 + head * 16) * 64 + (tok & 63);
#pragma unroll
            for (int r = 0; r < 16; ++r) { idxo[ob + r * 64] = ex[r]; gateo[ob + r * 64] = bv[r] * inv; }
        }
    }
}

__device__ __forceinline__ void phase10(const Params& p, char* shm, int bid, int nb) {
    int tid = TIDX(p.wave_s); asm volatile("" : "+v"(tid));
    const int wave = tid >> 6, lane = tid & 63;
    const int* idxT = (const int*)(p.ws + WS_IDX);
    const char* U8 = p.ws + WS_U8;
    const char* H8 = p.ws + WS_H8;
    int* part = (int*)(p.ws + WS_PART);
    for (int task = bid; task < 256; task += nb) {
        const int tg = task >> 3, cg = task & 7;
        const int tt = tg * 8 + wave, t = tt * 64 + lane;
        unsigned ip[64]; int acc[128];
#pragma unroll
        for (int k = 0; k < 64; ++k) {
            const unsigned lo = (unsigned)idxT[((size_t)tt * 128 + 2 * k) * 64 + lane], hi = (unsigned)idxT[((size_t)tt * 128 + 2 * k + 1) * 64 + lane];
            ip[k] = lo | (hi << 16);
        }
#pragma unroll
        for (int j = 0; j < 128; ++j) acc[j] = 0;
#pragma unroll 1
        for (int s = 0; s < 32; ++s) {
            const int slice = cg * 32 + s;
            __syncthreads();
            const char* sbase = U8 + (size_t)slice * 131072;
            const unsigned toff = (unsigned)tid * 16u;
#pragma unroll
            for (int k = 0; k < 16; ++k)
                __builtin_amdgcn_global_load_lds((const unsigned*)(sbase + k * 8192 + toff), (unsigned*)(shm + k * 8192 + tid * 16), 16, 0, 0);
            const u32x2 h = *reinterpret_cast<const u32x2*>(H8 + (size_t)t * DM + slice * 8);
            asm volatile("s_waitcnt vmcnt(0)" ::: "memory");
            __syncthreads();
#define U_LOAD(g, dst) _Pragma("unroll") for (int q = 0; q < 4; ++q) { unsigned w = ip[(g) * 4 + q]; asm volatile("" : "+v"(w)); \
                dst[2 * q] = *reinterpret_cast<const u32x2*>(shm + ((w & 0xffffu) << 3)); dst[2 * q + 1] = *reinterpret_cast<const u32x2*>(shm + ((w >> 16) << 3)); }
#define U_DOT(g, srcv) _Pragma("unroll") for (int q = 0; q < 8; ++q) { \
                acc[(g) * 8 + q] = __builtin_amdgcn_sdot4((int)srcv[q].x, (int)h.x, acc[(g) * 8 + q], false); \
                acc[(g) * 8 + q] = __builtin_amdgcn_sdot4((int)srcv[q].y, (int)h.y, acc[(g) * 8 + q], false); }
            u32x2 ua[8], ub[8];
            U_LOAD(0, ua)
#pragma unroll
            for (int g = 0; g < 16; g += 2) {
                U_LOAD(g + 1, ub)
                U_DOT(g, ua)
                __builtin_amdgcn_sched_barrier(0);
                if (g + 2 < 16) { U_LOAD(g + 2, ua) }
                U_DOT(g + 1, ub)
                __builtin_amdgcn_sched_barrier(0);
            }
#undef U_LOAD
#undef U_DOT
        }
#pragma unroll
        for (int k = 0; k < 64; ++k) part[((size_t)cg * 64 + k) * NTOK + t] = (int)pk2((float)acc[2 * k], (float)acc[2 * k + 1]);
    }
}

__device__ __forceinline__ void phase11(const Params& p, int bid, int nb) {
    const int* part = (const int*)(p.ws + WS_PART);
    const int* idxT = (const int*)(p.ws + WS_IDX); const float* gateT = (const float*)(p.ws + WS_GATE);
    const float* su = (const float*)(p.ws + WS_SU); const float* sv = (const float*)(p.ws + WS_SV); const float* sh = (const float*)(p.ws + WS_SH);
    unsigned* pack = (unsigned*)(p.ws + WS_PACK);
    int t11 = TIDX(p.wave_s); asm volatile("" : "+v"(t11));
    for (int item = bid * NTHREADS + t11; item < NTOK * 128; item += nb * NTHREADS) {
        const int lane = item & 63, j = (item >> 6) & 127, tt = item >> 13, t = tt * 64 + lane;
        float sum = 0.f;
#pragma unroll
        for (int cg = 0; cg < 8; ++cg) { const unsigned w = (unsigned)part[((size_t)cg * 64 + (j >> 1)) * NTOK + t]; sum += (j & 1) ? bfhi(w) : bflo(w); }
        const int e = idxT[item];
        const float a = sum * sh[t] * su[e];
        const float act = 0.5f * a * (1.f + erff(a * 0.70710678118654752f)) * gateT[item] * sv[e];
        { const _Float16 ah = (_Float16)(act * 256.f); pack[item] = ((unsigned)__builtin_bit_cast(unsigned short, ah) << 16) | ((unsigned)e << 2); }
    }
}

__device__ __forceinline__ void phase12(const Params& p, char* shm, int bid, int nb) {
    int tid = TIDX(p.wave_s); asm volatile("" : "+v"(tid));
    const int wave = tid >> 6, lane = tid & 63;
    const unsigned* pack = (const unsigned*)(p.ws + WS_PACK);
    const char* V8 = p.ws + WS_V8;
    bf16_t* y2 = (bf16_t*)(p.ws + WS_Y2);
    for (int slice = bid; slice < 256; slice += nb) {
        __syncthreads();
        const char* src = V8 + (size_t)slice * 131072 + tid * 16;
#pragma unroll
        for (int k = 0; k < 16; ++k)
            __builtin_amdgcn_global_load_lds((const unsigned*)(src + k * 8192), (unsigned*)(shm + k * 8192 + tid * 16), 16, 0, 0);
        asm volatile("s_waitcnt vmcnt(0)" ::: "memory");
        __syncthreads();
#define V_LOAD(ptr, g, dst) _Pragma("unroll") for (int q = 0; q < 16; ++q) dst[q] = *reinterpret_cast<const unsigned*>(reinterpret_cast<const char*>((ptr) + (g) * 1024) + lane4 + q * 256);
#define V_LDS(srcp, dstv) _Pragma("unroll") for (int q = 0; q < 16; ++q) { unsigned ad_; \
            asm("v_lshlrev_b32_sdwa %0, %1, %2 dst_sel:DWORD dst_unused:UNUSED_PAD src0_sel:DWORD src1_sel:WORD_0" : "=v"(ad_) : "v"(one_), "v"(srcp[q])); \
            dstv[q] = *reinterpret_cast<const LAS u32x2*>((uintptr_t)ad_); }
#define V_CVT(w_, hi_) __builtin_bit_cast(h2v, __builtin_amdgcn_cvt_scalef32_pk_f16_fp8(w_, __uint_as_float(0x3F80007Fu), hi_))
#define V_FMAS(srcp, srcv) _Pragma("unroll") for (int q = 0; q < 16; ++q) { const h2v ph = __builtin_bit_cast(h2v, srcp[q]); const h2v act = {ph[1], ph[1]}; \
                y[0] = __builtin_elementwise_fma(act, V_CVT(srcv[q].x, false), y[0]); y[1] = __builtin_elementwise_fma(act, V_CVT(srcv[q].x, true), y[1]); \
                y[2] = __builtin_elementwise_fma(act, V_CVT(srcv[q].y, false), y[2]); y[3] = __builtin_elementwise_fma(act, V_CVT(srcv[q].y, true), y[3]); }
#define V_STEP(ptr, g, pkLoad, pkLds, vLds, pkCur, vCur) V_LOAD(ptr, g, pkLoad) V_LDS(pkLds, vLds) V_FMAS(pkCur, vCur) __builtin_amdgcn_sched_barrier(0);
        unsigned pkA[16], pkB[16], pkC[16]; u32x2 vA[16], vB[16];
        unsigned one_ = 1u; asm volatile("" : "+v"(one_));
        const int wave_u = __builtin_amdgcn_readfirstlane(wave);
        const unsigned lane4 = (unsigned)lane * 4u;
        {
            const unsigned* pp0 = pack + (size_t)wave_u * 8192;
            V_LOAD(pp0, 0, pkA) V_LOAD(pp0, 1, pkB) V_LDS(pkA, vA)
        }
#pragma unroll 1
        for (int tt = wave_u; tt < 256; tt += NWAVES) {
            h2v y[4];
#pragma unroll
            for (int c = 0; c < 4; ++c) y[c] = h2v{(_Float16)0.f, (_Float16)0.f};
            const unsigned* pp = pack + (size_t)tt * 8192;
            const int ttn = (tt + NWAVES < 256) ? tt + NWAVES : tt;
            const unsigned* pn = pack + (size_t)ttn * 8192;
            V_STEP(pp, 2, pkC, pkB, vB, pkA, vA)
            V_STEP(pp, 3, pkA, pkC, vA, pkB, vB)
            V_STEP(pp, 4, pkB, pkA, vB, pkC, vA)
            V_STEP(pp, 5, pkC, pkB, vA, pkA, vB)
            V_STEP(pp, 6, pkA, pkC, vB, pkB, vA)
            V_STEP(pp, 7, pkB, pkA, vA, pkC, vB)
            V_STEP(pn, 0, pkC, pkB, vB, pkA, vA)
            V_STEP(pn, 1, pkA, pkC, vA, pkB, vB)
#pragma unroll
            for (int q = 0; q < 16; ++q) { const unsigned t0_ = pkA[q]; pkA[q] = pkC[q]; pkB[q] = t0_; }
            *reinterpret_cast<u32x4*>(y2 + (size_t)(tt * 64 + lane) * DM + slice * 8) =
                u32x4{__builtin_bit_cast(unsigned, y[0]), __builtin_bit_cast(unsigned, y[1]), __builtin_bit_cast(unsigned, y[2]), __builtin_bit_cast(unsigned, y[3])};
        }
#undef V_LOAD
#undef V_LDS
#undef V_CVT
#undef V_FMAS
#undef V_STEP
    }
}

__device__ __forceinline__ float h16f(unsigned h) {
    const unsigned s_ = (h & 0x8000u) << 16, e_ = (h >> 10) & 31u, m_ = h & 0x3ffu;
    return e_ == 0u ? __uint_as_float(s_) : __uint_as_float(s_ | ((e_ + 112u) << 23) | (m_ << 13));
}
__device__ __forceinline__ void phase13(const Params& p, char* shm, int bid, int nb) {
    const int tid = TIDX(p.wave_s), wave = tid >> 6, lane = tid & 63;
    const float* mod = (const float*)(p.ws + WS_MOD);
    const bf16_t* y2 = (const bf16_t*)(p.ws + WS_Y2);
    const bf16_t* x1 = (const bf16_t*)(p.ws + WS_X1);
    float* lv = (float*)shm;
    for (int item = bid; item < NTOK / 64; item += nb) {
        const int b = item >> 5;
        __syncthreads();
        for (int i = tid; i < 512; i += NTHREADS) {
            *reinterpret_cast<f32x4*>(lv + 0 * DM + i * 4) = *reinterpret_cast<const f32x4*>(p.post_ffn_g + i * 4);
            *reinterpret_cast<f32x4*>(lv + 1 * DM + i * 4) = *reinterpret_cast<const f32x4*>(mod + b * 12288 + 10240 + i * 4);
        }
        __syncthreads();
#pragma unroll 1
        for (int rr = 0; rr < 8; ++rr) {
            const int row = item * 64 + rr * 8 + wave;
            f32x4 yv[8]; u32x2 xr[8]; float ss = 0.f;
#pragma unroll
            for (int i = 0; i < 8; ++i) {
                u32x2 r = *reinterpret_cast<const u32x2*>(y2 + (size_t)row * DM + i * 256 + lane * 4);
                xr[i] = *reinterpret_cast<const u32x2*>(x1 + (size_t)row * DM + i * 256 + lane * 4);
                yv[i] = f32x4{h16f(r.x & 0xffffu), h16f(r.x >> 16), h16f(r.y & 0xffffu), h16f(r.y >> 16)};
                ss += yv[i][0] * yv[i][0] + yv[i][1] * yv[i][1] + yv[i][2] * yv[i][2] + yv[i][3] * yv[i][3];
            }
            const float rstd = rsqrtf(wave_sum(ss) * (1.f / DM) + EPS);
#pragma unroll
            for (int i = 0; i < 8; ++i) {
                const int col = i * 256 + lane * 4;
                f32x4 xv = f32x4{bflo(xr[i].x), bfhi(xr[i].x), bflo(xr[i].y), bfhi(xr[i].y)};
                f32x4 g = *reinterpret_cast<const f32x4*>(lv + col);
                f32x4 gt = *reinterpret_cast<const f32x4*>(lv + DM + col);
                *reinterpret_cast<f32x4*>(p.out + (size_t)row * DM + col) = xv + gt * (yv[i] * rstd * g);
            }
        }
    }
}

constexpr int NPHASE = 14;
__global__ void __launch_bounds__(NTHREADS, 2) mega(Params p, int ph_lo, int ph_hi) {
    extern __shared__ __attribute__((aligned(16))) char shm[];
    p.wave_s = __builtin_amdgcn_readfirstlane((int)(threadIdx.x >> 6));
    const int bid = blockIdx.x, nb = gridDim.x;
    const int vcu = vcu_of(bid, nb);
    char* ws = p.ws;
    volatile LAS unsigned* xbw = (volatile LAS unsigned*)(shm + XB_OFF);
    if (TIDX(p.wave_s) == 0) { xbw[0] = 0u; xbw[1] = 0u; }
    __syncthreads();
    XcdBarrier bar; bar.bar = (unsigned*)(ws + WS_BAR); bar.x = 0; bar.st = xbw; bar.ws = p.wave_s;
    if (ph_hi - ph_lo > 1) bar = xcd_barrier_post((unsigned*)(ws + WS_BAR), xbw, p.wave_s);
#ifndef DUP_PH
#define DUP_PH (-1)
#endif
#define REP(k) for (int rep_ = 0; rep_ < ((k) == DUP_PH ? 2 : 1); ++rep_)
#ifdef ONLY_PH
#define PH(k) ((k) == ONLY_PH && ph_lo <= (k) && (k) < ph_hi)
#else
#define PH(k) (ph_lo <= (k) && (k) < ph_hi)
#endif
#define SEAM(k) do { if (ph_lo <= (k) && (k) + 1 < ph_hi) xcd_barrier(bar); } while (0)
    if (PH(0)) REP(0) phase0(p, shm, bid, nb);
    SEAM(0);
    if (PH(1)) REP(1) phase1(p, shm, bid, nb);
    SEAM(1);
    if (PH(2)) REP(2) {
        EpiI8 e{(bf16_t*)(ws + WS_BUF2), DM, (const float*)(ws + WS_SH1), (const float*)(ws + WS_WSC)};
        gemm_phase<false, true>((const bf16_t*)(ws + WS_BUF1), DM / 2, (const bf16_t*)(ws + WS_WIN), DM / 2, 1024, 8, 512, 0, vcu, nb, shm, e, p.wave_s);
    }
    SEAM(2);
    if (PH(3)) REP(3) phase3(p, bid, nb);
    SEAM(3);
    if (PH(4)) REP(4) {
        const bf16_t* projb = (const bf16_t*)(ws + WS_BUF2);
        EpiQ eq{(bf16_t*)(ws + WS_Q), (const float*)(ws + WS_RSTDQ)};
        EpiKV ekv{(bf16_t*)(ws + WS_KN), (bf16_t*)(ws + WS_VT), (const float*)(ws + WS_RSTDKV)};
        if (nb == 256) {
            const int nq = vcu < 128 ? 2 : 1, q0 = vcu < 128 ? 2 * vcu : vcu + 128;
            const int nkv = vcu < 128 ? 1 : 3, kv0 = vcu < 128 ? vcu : 128 + 3 * (vcu - 128);
            const int g = vcu >> 6, pmp = vcu & 63;
            const bf16_t* qA = projb + 1024; const bf16_t* qB = (const bf16_t*)(ws + WS_WUQ);
            const bf16_t* kA = projb + 1536; const bf16_t* kB = (const bf16_t*)(ws + WS_WUKV);
            const bf16_t* pA = (const bf16_t*)(ws + WS_Z) + g * 256; const bf16_t* pB = (const bf16_t*)(ws + WS_WPOOL) + g * 65536;
            const NextTile kvfirst{kA, kB, DM, 256, (kv0 >> 3) * 256, (kv0 & 7) * 256};
            const NextTile poolt{pA, pB, 1024, 256, pmp * 256, 0};
#pragma unroll 1
            for (int i = 0; i < nq; ++i) {
                const int t = q0 + i;
                const NextTile nx = (i + 1 < nq) ? NextTile{qA, qB, DM, 512, ((t + 1) / 6) * 256, ((t + 1) % 6) * 256} : kvfirst;
                gemm_tile<false, false>(qA, DM, qB, 512, 8, (t / 6) * 256, (t % 6) * 256, shm, eq, i > 0, nx, p.wave_s);
            }
#pragma unroll 1
            for (int i = 0; i < nkv; ++i) {
                const int t = kv0 + i;
                const NextTile nx = (i + 1 < nkv) ? NextTile{kA, kB, DM, 256, ((t + 1) >> 3) * 256, ((t + 1) & 7) * 256} : poolt;
                gemm_tile<true, false>(kA, DM, kB, 256, 4, (t >> 3) * 256, (t & 7) * 256, shm, ekv, true, nx, p.wave_s);
            }
            {
                EpiPool e{(bf16_t*)(ws + WS_BUF1), p.pool_scale, g * 256};
                gemm_tile<false, false>(pA, 1024, pB, 256, 4, pmp * 256, 0, shm, e, true, NextTile{pA, pB, 1024, 256, -1, 0}, p.wave_s);
            }
        } else {
            gemm_phase<false, false>(projb + 1024, DM, (const bf16_t*)(ws + WS_WUQ), 512, 512, 6, 384, 0, vcu, nb, shm, eq, p.wave_s);
            gemm_phase<true, false>(projb + 1536, DM, (const bf16_t*)(ws + WS_WUKV), 256, 256, 8, 512, 384, vcu, nb, shm, ekv, p.wave_s);
            const int first = ((vcu - 896) % nb + nb) % nb;
            for (int t = first; t < 256; t += nb) {
                const int g = t >> 6, pm = t & 63;
                EpiPool e{(bf16_t*)(ws + WS_BUF1), p.pool_scale, g * 256};
                gemm_tile<false, false>((const bf16_t*)(ws + WS_Z) + g * 256, 1024, (const bf16_t*)(ws + WS_WPOOL) + g * 65536, 256, 4, pm * 256, 0, shm, e, false, NextTile{nullptr, nullptr, 0, 0, -1, 0}, p.wave_s);
            }
        }
    }
    SEAM(4);
    if (PH(5)) REP(5) phase5(p, shm, vcu, nb);
    SEAM(5);
    if (PH(6)) REP(6) {
        EpiBf16 e{(bf16_t*)(ws + WS_BUF2), DM, 1.f / 32.f};
        gemm_phase<false, false, true>((const bf16_t*)(ws + WS_BUF1), DM / 2, (const bf16_t*)(ws + WS_WOUT), DM / 2, 1024, 8, 512, 0, vcu, nb, shm, e, p.wave_s);
    }
    SEAM(6);
    if (PH(7)) REP(7) phase7(p, shm, bid, nb);
    SEAM(7);
    if (PH(8)) REP(8) {
        EpiI8 e{(bf16_t*)(ws + WS_BUF2), DM, (const float*)(ws + WS_SH), (const float*)(ws + WS_WSC) + 2048};
        gemm_phase<false, true>((const bf16_t*)(ws + WS_H8), DM / 2, (const bf16_t*)(ws + WS_WPQ), DM / 2, 1024, 8, 512, 0, vcu, nb, shm, e, p.wave_s);
    }
    SEAM(8);
    if (PH(9)) REP(9) phase9(p, shm, bid, nb);
    SEAM(9);
    if (PH(10)) REP(10) phase10(p, shm, bid, nb);
    SEAM(10);
    if (PH(11)) REP(11) phase11(p, bid, nb);
    SEAM(11);
    if (PH(12)) REP(12) phase12(p, shm, vcu, nb);
    SEAM(12);
    if (PH(13)) REP(13) phase13(p, shm, bid, nb);
#undef PH
#undef SEAM
}

extern "C" void kernel_launch(void* const* d_in, const int* in_sizes, int n_in, void* d_out, int out_size, void* d_ws, size_t ws_size, hipStream_t stream) {
    static int grid = 0;
    if (grid == 0) {
        if (n_in != 21 || ws_size < WS_END) { fprintf(stderr, "kernel_launch: unexpected n_in %d / ws_size %zu (need %zu)\n", n_in, ws_size, (size_t)WS_END); grid = -1; return; }
        int dev = 0, cus = 0;
        if (hipGetDevice(&dev) != hipSuccess || hipDeviceGetAttribute(&cus, hipDeviceAttributeMultiprocessorCount, dev) != hipSuccess) { grid = -1; return; }
        if (hipFuncSetAttribute((const void*)mega, hipFuncAttributeMaxDynamicSharedMemorySize, LDS_BYTES) != hipSuccess) { fprintf(stderr, "hipFuncSetAttribute failed\n"); grid = -1; return; }
        int per_cu = 0;
        if (hipOccupancyMaxActiveBlocksPerMultiprocessor(&per_cu, (const void*)mega, NTHREADS, LDS_BYTES) != hipSuccess || per_cu < 1)
            fprintf(stderr, "kernel_launch: occupancy query reports %d blocks per CU\n", per_cu);
        (void)hipGetLastError();
        grid = cus;
    }
    if (grid < 0) return;
    (void)hipMemsetAsync((char*)d_ws + WS_ZERO, 0, ZERO_BYTES, stream);
    (void)hipMemsetAsync((char*)d_ws + WS_CMAX, 0, CMAX_BYTES, stream);
    Params p{};
    p.x = (const float*)d_in[0]; p.c = (const float*)d_in[1]; p.pos = (const int*)d_in[2];
    p.ada_w = (const float*)d_in[3]; p.ada_b = (const float*)d_in[4];
    p.pre_mix_g = (const float*)d_in[5]; p.post_mix_g = (const float*)d_in[6]; p.pre_ffn_g = (const float*)d_in[7]; p.post_ffn_g = (const float*)d_in[8];
    p.w_in = (const float*)d_in[9]; p.pool_w = (const float*)d_in[10]; p.pool_scale = (const float*)d_in[11];
    p.q_norm_g = (const float*)d_in[12]; p.w_uq = (const float*)d_in[13]; p.kv_norm_g = (const float*)d_in[14]; p.w_ukv = (const float*)d_in[15];
    p.w_out = (const float*)d_in[16]; p.peer_wq = (const float*)d_in[17]; p.sub_keys = (const float*)d_in[18];
    p.peer_u = (const float*)d_in[19]; p.peer_v = (const float*)d_in[20];
    p.out = (float*)d_out; p.ws = (char*)d_ws;
#if MK_MULTI
    for (int k = 0; k < NPHASE; ++k) hipLaunchKernelGGL(mega, dim3(grid), dim3(NTHREADS), LDS_BYTES, stream, p, k, k + 1);
#else
    hipLaunchKernelGGL(mega, dim3(grid), dim3(NTHREADS), LDS_BYTES, stream, p, 0, NPHASE);
#endif
}
```

```cpp
#include <hip/hip_runtime.h>
#include <hip/hip_bf16.h>
#include <stdint.h>
#include <stdio.h>

#ifndef MK_MULTI
#define MK_MULTI 0
#endif

typedef unsigned short bf16_t;
typedef short bf16x8 __attribute__((ext_vector_type(8)));
typedef float f32x4 __attribute__((ext_vector_type(4)));
typedef float f32x16 __attribute__((ext_vector_type(16)));
typedef unsigned u32x4 __attribute__((ext_vector_type(4)));
typedef int i32x4 __attribute__((ext_vector_type(4)));
typedef int i32x8 __attribute__((ext_vector_type(8)));
__device__ __forceinline__ int pk_fp8x4(float a, float b, float c, float d) {
    int w = __builtin_amdgcn_cvt_pk_fp8_f32(a, b, 0, false);
    return __builtin_amdgcn_cvt_pk_fp8_f32(c, d, w, true);
}
template <bool I8> struct AccT { typedef f32x4 type; };
template <> struct AccT<true> { typedef i32x4 type; };
typedef unsigned u32x2 __attribute__((ext_vector_type(2)));
typedef _Float16 h2v __attribute__((ext_vector_type(2)));

constexpr int NTOK = 16384, DM = 2048, SEQ = 2048;
constexpr int NTHREADS = 512, NWAVES = 8;
constexpr int LDS_BYTES = 140 * 1024;
constexpr int XB_OFF = LDS_BYTES - 64;
constexpr float EPS = 1e-6f;

constexpr size_t MiB = 1024 * 1024;
constexpr size_t WS_ZERO   = 0;
constexpr size_t WS_BAR    = 0;
constexpr size_t WS_MOD    = 16384;
constexpr size_t ZERO_BYTES = 16384;
constexpr size_t WS_CS     = 1 * MiB;
constexpr size_t WS_RSTDQ  = 5 * MiB;
constexpr size_t WS_RSTDKV = 5 * MiB + 65536;
constexpr size_t WS_WIN    = 6 * MiB;
constexpr size_t WS_WOUT   = 14 * MiB;
constexpr size_t WS_WPQ    = 22 * MiB;
constexpr size_t WS_WUQ    = 30 * MiB;
constexpr size_t WS_WUKV   = 32 * MiB;
constexpr size_t WS_WPOOL  = 33 * MiB;
constexpr size_t WS_SK     = 34 * MiB;
constexpr size_t WS_U8     = 35 * MiB;
constexpr size_t WS_V8     = 67 * MiB;
constexpr size_t WS_H8     = 99 * MiB;
constexpr size_t WS_PACK   = 131 * MiB;
constexpr size_t WS_SU     = 139 * MiB;
constexpr size_t WS_SV     = 139 * MiB + 65536;
constexpr size_t WS_SH     = 139 * MiB + 131072;
constexpr size_t WS_SH1    = 139 * MiB + 196608;
constexpr size_t WS_CMAX   = 139 * MiB + 262144;
constexpr size_t WS_WSC    = 139 * MiB + 278528;
constexpr size_t CMAX_BYTES = 2 * 2048 * 4;
constexpr size_t WS_BUF1   = 163 * MiB;
constexpr size_t WS_BUF2   = 227 * MiB;
constexpr size_t WS_BIG    = 291 * MiB;
constexpr size_t WS_Z      = WS_BIG;
constexpr size_t WS_Q      = WS_BIG + 32 * MiB;
constexpr size_t WS_KN     = WS_BIG + 80 * MiB;
constexpr size_t WS_VT     = WS_BIG + 112 * MiB;
constexpr size_t WS_KPE    = WS_BIG + 144 * MiB;
constexpr size_t WS_X1     = WS_BIG;
constexpr size_t WS_IDX    = 438 * MiB;
constexpr size_t WS_GATE   = 446 * MiB;
constexpr size_t WS_PART   = WS_BUF1;
constexpr size_t WS_Y2     = WS_BUF2;
constexpr size_t WS_END    = 454 * MiB;

struct Params {
    const float *x, *c; const int* pos;
    const float *ada_w, *ada_b, *pre_mix_g, *post_mix_g, *pre_ffn_g, *post_ffn_g;
    const float *w_in, *pool_w, *pool_scale, *q_norm_g, *w_uq, *kv_norm_g, *w_ukv, *w_out;
    const float *peer_wq, *sub_keys, *peer_u, *peer_v;
    float* out; char* ws;
    int wave_s;
};

__device__ __forceinline__ unsigned pk2(float lo, float hi) {
    typedef __bf16 bf2 __attribute__((ext_vector_type(2)));
    bf2 v; v[0] = (__bf16)lo; v[1] = (__bf16)hi; return __builtin_bit_cast(unsigned, v);
}
__device__ __forceinline__ float bflo(unsigned u) { return __uint_as_float(u << 16); }
__device__ __forceinline__ float bfhi(unsigned u) { return __uint_as_float(u & 0xffff0000u); }
__device__ __forceinline__ float bf2f(short b) { return __uint_as_float(((unsigned)(unsigned short)b) << 16); }
__device__ __forceinline__ short f2bf(float f) { return (short)(pk2(f, 0.f) & 0xffffu); }
__device__ __forceinline__ unsigned pack_i8x4(float a, float b, float c, float d) {
    unsigned r = 0u;
    r = __builtin_amdgcn_cvt_pk_u8_f32(a + 128.f, 0, r); r = __builtin_amdgcn_cvt_pk_u8_f32(b + 128.f, 1, r);
    r = __builtin_amdgcn_cvt_pk_u8_f32(c + 128.f, 2, r); r = __builtin_amdgcn_cvt_pk_u8_f32(d + 128.f, 3, r);
    return r ^ 0x80808080u;
}
__device__ __forceinline__ float wave_sum(float v) {
#pragma unroll
    for (int o = 1; o < 64; o <<= 1) v += __shfl_xor(v, o);
    return v;
}

#define XB_TMO      128
#define XB_XCNT(j)  (256  + 64 * (j))
#define XB_XSUB(j)  (1280 + 64 * (j))
#define XB_XGEN(j)  (2304 + 64 * (j))
#define XB_TOP      3328
#define XB_TOPGEN   3392
#define XCD_BAR_WORDS 3456
#define XB_SPIN_CAP (1u << 20)
#define LAS __attribute__((address_space(3)))
__device__ __forceinline__ int tidx_(int ws) { unsigned l = __builtin_amdgcn_mbcnt_lo(~0u, 0u); asm volatile("" : "+v"(l)); return (int)((unsigned)ws * 64u + __builtin_amdgcn_mbcnt_hi(~0u, l)); }
#define TIDX(ws_) tidx_(ws_)
__device__ __forceinline__ unsigned xb_ld(unsigned* p)              { return __hip_atomic_load(p, __ATOMIC_RELAXED, __HIP_MEMORY_SCOPE_AGENT); }
__device__ __forceinline__ unsigned xb_add(unsigned* p, unsigned v) { return __hip_atomic_fetch_add(p, v, __ATOMIC_RELAXED, __HIP_MEMORY_SCOPE_AGENT); }
__device__ __forceinline__ unsigned xb_xcc_id() { return (unsigned)__builtin_amdgcn_s_getreg((3 << 11) | 20) & 0xFu; }
#define XB_SPIN(cond, bar) do { unsigned _sp = 0; while (cond) { __builtin_amdgcn_s_sleep(1); \
    if ((++_sp & 255u) == 0u) { if (xb_ld(&(bar)[XB_TMO])) break; if (_sp > XB_SPIN_CAP) { atomicAdd(&(bar)[XB_TMO], 1u); break; } } } } while (0)
struct XcdBarrier { unsigned* bar; unsigned x; volatile LAS unsigned* st; int ws; };
__device__ __forceinline__ XcdBarrier xcd_barrier_post(unsigned* bar, volatile LAS unsigned* st, int ws) {
    XcdBarrier b; b.bar = bar; b.x = xb_xcc_id(); b.st = st; b.ws = ws;
    if (TIDX(ws) == 0) (void)xb_add(&bar[XB_XCNT(b.x)], 1u);
    return b;
}
__device__ __forceinline__ void xcd_barrier_complete(unsigned* bar, unsigned x, unsigned& nloc, unsigned& nx) {
    const unsigned G = gridDim.x * gridDim.y * gridDim.z;
    unsigned sum, cnt, mine, sp = 0u;
    for (;;) {
        sum = 0u; cnt = 0u; mine = 0u;
#pragma unroll
        for (unsigned j = 0; j < 16; ++j) { const unsigned c = xb_ld(&bar[XB_XCNT(j)]); sum += c; cnt += (c > 0u) ? 1u : 0u; mine = (j == x) ? c : mine; }
        if (sum == G) break;
        __builtin_amdgcn_s_sleep(1);
        if ((++sp & 255u) == 0u) { if (xb_ld(&bar[XB_TMO])) break; if (sp > XB_SPIN_CAP) { atomicAdd(&bar[XB_TMO], 1u); break; } }
    }
    nloc = mine > 0u ? mine : 1u; nx = cnt > 0u ? cnt : 1u;
}
__device__ __forceinline__ void xcd_barrier(const XcdBarrier& b) {
    asm volatile("s_waitcnt vmcnt(0)" ::: "memory");
    __syncthreads();
    if (TIDX(b.ws) == 0) {
        unsigned* bar = b.bar;
        __builtin_amdgcn_s_waitcnt(0);
        unsigned nloc = b.st[0], nx = b.st[1];
        if (nloc == 0u) { xcd_barrier_complete(bar, b.x, nloc, nx); b.st[0] = nloc; b.st[1] = nx; }
        const unsigned old = xb_add(&bar[XB_XSUB(b.x)], 1u);
        const unsigned gen = old / nloc;
        if (old + 1u == (gen + 1u) * nloc) {
            __builtin_amdgcn_fence(__ATOMIC_RELEASE, "agent");
            asm volatile("s_waitcnt vmcnt(0)" ::: "memory");
            const unsigned og = xb_add(&bar[XB_TOP], 1u);
            const unsigned tg = og / nx;
            if (og + 1u == (tg + 1u) * nx) xb_add(&bar[XB_TOPGEN], 1u);
            else XB_SPIN(xb_ld(&bar[XB_TOPGEN]) == tg, bar);
            __builtin_amdgcn_fence(__ATOMIC_ACQUIRE, "agent");
            xb_add(&bar[XB_XGEN(b.x)], 1u);
            asm volatile("s_waitcnt vmcnt(0)" ::: "memory");
        } else {
            XB_SPIN(xb_ld(&bar[XB_XGEN(b.x)]) == gen, bar);
            __builtin_amdgcn_fence(__ATOMIC_ACQUIRE, "agent");
            asm volatile("s_waitcnt vmcnt(0)" ::: "memory");
        }
    }
    __syncthreads();
}

constexpr int G_BK = 64, G_HALF = 128, G_HT = G_HALF * G_BK;
__device__ __forceinline__ int lds_byte(int r, int c) {
    int st = (r >> 4) * 2 + (c >> 5), rr = r & 15, cc = c & 31, ob = rr * 64 + cc * 2;
    return st * 1024 + (ob ^ (((ob >> 9) & 1) << 5));
}
__device__ __forceinline__ void stage_rc(int b, int& R, int& C) {
    int st = b / 1024, sb = b % 1024, swz = sb ^ (((sb >> 9) & 1) << 5);
    R = (st >> 1) * 16 + swz / 64; C = (st & 1) * 32 + (swz % 64) / 2;
}

template <bool NOSWAP, bool I8, class A_>
__device__ __forceinline__ A_ mma1(bf16x8 a, bf16x8 b, A_ c);
template <> __device__ __forceinline__ f32x4 mma1<false, false, f32x4>(bf16x8 a, bf16x8 b, f32x4 c) { return __builtin_amdgcn_mfma_f32_16x16x32_bf16(b, a, c, 0, 0, 0); }
template <> __device__ __forceinline__ f32x4 mma1<true, false, f32x4>(bf16x8 a, bf16x8 b, f32x4 c) { return __builtin_amdgcn_mfma_f32_16x16x32_bf16(a, b, c, 0, 0, 0); }
template <> __device__ __forceinline__ i32x4 mma1<false, true, i32x4>(bf16x8 a, bf16x8 b, i32x4 c) { return __builtin_amdgcn_mfma_i32_16x16x64_i8(__builtin_bit_cast(i32x4, b), __builtin_bit_cast(i32x4, a), c, 0, 0, 0); }
template <> __device__ __forceinline__ i32x4 mma1<true, true, i32x4>(bf16x8 a, bf16x8 b, i32x4 c) { return __builtin_amdgcn_mfma_i32_16x16x64_i8(__builtin_bit_cast(i32x4, a), __builtin_bit_cast(i32x4, b), c, 0, 0, 0); }

template <bool NOSWAP, bool I8, bool F8, class A_>
__device__ __forceinline__ A_ mma2(i32x8 a, i32x8 b, A_ c) {
    if constexpr (F8) {
        if constexpr (NOSWAP) return __builtin_amdgcn_mfma_scale_f32_16x16x128_f8f6f4(a, b, c, 0, 0, 0, 0, 0, 0);
        else return __builtin_amdgcn_mfma_scale_f32_16x16x128_f8f6f4(b, a, c, 0, 0, 0, 0, 0, 0);
    } else {
        const bf16x8 a0 = __builtin_bit_cast(bf16x8, __builtin_shufflevector(a, a, 0, 1, 2, 3)), a1 = __builtin_bit_cast(bf16x8, __builtin_shufflevector(a, a, 4, 5, 6, 7));
        const bf16x8 b0 = __builtin_bit_cast(bf16x8, __builtin_shufflevector(b, b, 0, 1, 2, 3)), b1 = __builtin_bit_cast(bf16x8, __builtin_shufflevector(b, b, 4, 5, 6, 7));
        c = mma1<NOSWAP, I8, A_>(a0, b0, c);
        return mma1<NOSWAP, I8, A_>(a1, b1, c);
    }
}
constexpr int EPI_NST_MIN = 12;
struct NextTile { const bf16_t* A; const bf16_t* Bt; int lda, ldb, brow, bcol; };
template <bool VT1, bool I8, bool F8 = false, class Epi>
__device__ __forceinline__ void gemm_tile(const bf16_t* __restrict__ A, int lda, const bf16_t* __restrict__ Bt, int ldb, int nt,
                                          int brow, int bcol, char* shmc, const Epi& epi, bool pre, const NextTile nx, int ws_) {
    bf16_t* shm = (bf16_t*)shmc;
    asm volatile("" : "+s"(nt));
#define SA(b,h) (shm+((b)*2+(h))*G_HT)
#define SB(b,h) (shm+(4+(b)*2+(h))*G_HT)
#define STAGE_X(OFF,LOFF,P,RS,LD,br,kt) do{ const int _so=((br)*(LD)+(kt)*G_BK)*2; \
    __builtin_amdgcn_raw_ptr_buffer_load_lds(RS, (__attribute__((address_space(3))) void*)((char*)(P)+(LOFF)),16,(int)(OFF),_so,0,0); \
    __builtin_amdgcn_raw_ptr_buffer_load_lds(RS, (__attribute__((address_space(3))) void*)((char*)(P)+(LOFF)+8192),16,(int)(OFF),_so+128*(LD),0,0);}while(0)
#define STAGE_A(P,br,kt) STAGE_X(offA,lwv,P,rsA,lda,br,kt)
#define STAGE_B(P,br,kt) STAGE_X(offB,lwv,P,rsB,ldb,br,kt)
#define LDF(base_,off_) (*reinterpret_cast<const i32x4*>((base_)+(off_)))
#define LDA(dst,b,h) _Pragma("unroll") for(int m=0;m<4;++m) \
    dst[m]=__builtin_shufflevector(LDF(fa_base,((b)*2+(h))*16384+m*2048),LDF(fa_base,((b)*2+(h))*16384+m*2048+1024),0,1,2,3,4,5,6,7)
#define LDB(dst,b,h) _Pragma("unroll") for(int n=0;n<2;++n) \
    dst[n]=__builtin_shufflevector(LDF(fb_base,((b)*2+(h))*16384+n*2048),LDF(fb_base,((b)*2+(h))*16384+n*2048+1024),0,1,2,3,4,5,6,7)
#define MMA(ai,bj,At_,Bt_) do{__builtin_amdgcn_s_setprio(1); \
    _Pragma("unroll") for(int m=0;m<4;++m) _Pragma("unroll") for(int n=0;n<2;++n) \
      acc[ai][bj][m][n]=mma2<VT1 && (bj)==1, I8, F8, typename AccT<I8>::type>(At_[m],Bt_[n],acc[ai][bj][m][n]); \
    __builtin_amdgcn_s_setprio(0);}while(0)
#define WAIT_V(n) asm volatile("s_waitcnt vmcnt(" #n ")":::"memory")
#define WAIT_L(n) asm volatile("s_waitcnt lgkmcnt(" #n ")":::"memory")
#define BAR __builtin_amdgcn_s_barrier()
#define SCHED __builtin_amdgcn_sched_barrier(0)
    int t0 = TIDX(ws_); asm volatile("" : "+v"(t0));
    int wid = t0 >> 6, lane = t0 & 63, wr = wid >> 2, wc = wid & 3, fr = lane & 15, fq = lane >> 4;
    typename AccT<I8>::type acc[2][2][4][2] = {};
    const char* fa_base = (const char*)shm + lds_byte(wr * 64 + fr, fq * 8);
    const char* fb_base = (const char*)shm + 65536 + lds_byte(wc * 32 + fr, fq * 8);
    i32x8 At[4], B0[2], B1[2];
    int loff = t0 * 16;
    const int lwv = __builtin_amdgcn_readfirstlane(t0 >> 6) * 1024;
    unsigned offA, offB;
    const __amdgpu_buffer_rsrc_t rsA = __builtin_amdgcn_make_buffer_rsrc((void*)A, (short)0, -1, 0x00020000);
    const __amdgpu_buffer_rsrc_t rsB = __builtin_amdgcn_make_buffer_rsrc((void*)Bt, (short)0, -1, 0x00020000);
    { int r_, c_; stage_rc(loff, r_, c_); offA = (unsigned)(r_ * lda + c_) * 2;
      const int i_ = r_ & 15, n_ = (r_ >> 4) & 1;
      offB = (unsigned)(((r_ & ~31) + 8 * (i_ >> 2) + 4 * n_ + (i_ & 3)) * ldb + c_) * 2; }
    if (!pre) {
        STAGE_B(SB(0,0),bcol,0); STAGE_A(SA(0,0),brow,0);
        STAGE_B(SB(0,1),bcol+G_HALF,0); STAGE_A(SA(0,1),brow+G_HALF,0);
        if (wr == 1) BAR;
        WAIT_V(4); BAR;
        STAGE_B(SB(1,0),bcol,1); STAGE_A(SA(1,0),brow,1); STAGE_B(SB(1,1),bcol+G_HALF,1);
        WAIT_V(6); BAR;
    } else {
        if (wr == 1) BAR;
        asm volatile("s_waitcnt vmcnt(%0)" :: "n"(EPI_NST_MIN + 10) : "memory"); BAR;
        asm volatile("s_waitcnt vmcnt(%0)" :: "n"(EPI_NST_MIN + 6) : "memory"); BAR;
    }
    for (int t = 0; t < nt - 2; t += 2) {
        LDB(B0,0,0); SCHED; LDA(At,0,0); STAGE_A(SA(1,1),brow+G_HALF,t+1);
        WAIT_L(8); BAR; WAIT_L(0); MMA(0,0,At,B0); BAR; SCHED;
        LDB(B1,0,1); STAGE_B(SB(0,0),bcol,t+2);
        BAR; WAIT_L(0); MMA(0,1,At,B1); BAR;
        LDA(At,0,1); STAGE_A(SA(0,0),brow,t+2);
        BAR; WAIT_L(0); MMA(1,0,At,B0); BAR; SCHED;
        STAGE_B(SB(0,1),bcol+G_HALF,t+2);
        WAIT_V(6); BAR; MMA(1,1,At,B1); BAR;
        LDB(B0,1,0); SCHED; LDA(At,1,0); STAGE_A(SA(0,1),brow+G_HALF,t+2);
        WAIT_L(8); BAR; WAIT_L(0); MMA(0,0,At,B0); BAR; SCHED;
        LDB(B1,1,1); STAGE_B(SB(1,0),bcol,t+3);
        BAR; WAIT_L(0); MMA(0,1,At,B1); BAR;
        LDA(At,1,1); STAGE_A(SA(1,0),brow,t+3);
        BAR; WAIT_L(0); MMA(1,0,At,B0); BAR; SCHED;
        STAGE_B(SB(1,1),bcol+G_HALF,t+3);
        WAIT_V(6); BAR; MMA(1,1,At,B1); BAR;
    }
    int tz = TIDX(ws_); asm volatile("" : "+v"(tz)); wid = tz >> 6; lane = tz & 63; wr = wid >> 2; wc = wid & 3; fr = lane & 15; fq = lane >> 4;
    loff = tz * 16;
    fa_base = (const char*)shm + lds_byte(wr * 64 + fr, fq * 8); fb_base = (const char*)shm + 65536 + lds_byte(wc * 32 + fr, fq * 8);
    { int r_, c_; stage_rc(loff, r_, c_); offA = (unsigned)(r_ * lda + c_) * 2; }
    { LDB(B0,0,0); WAIT_V(0); LDA(At,0,0); STAGE_A(SA(1,1),brow+G_HALF,nt-1);
      BAR; WAIT_L(0); MMA(0,0,At,B0); BAR;
      LDB(B1,0,1); BAR; WAIT_L(0); MMA(0,1,At,B1); BAR;
      LDA(At,0,1); WAIT_V(4); BAR; WAIT_L(0); MMA(1,0,At,B0); MMA(1,1,At,B1); BAR; }
    { LDB(B0,1,0); LDA(At,1,0); WAIT_V(2); BAR; WAIT_L(0); MMA(0,0,At,B0); BAR;
      LDB(B1,1,1); WAIT_V(0); BAR; WAIT_L(0); MMA(0,1,At,B1); BAR;
      LDA(At,1,1); BAR; WAIT_L(0); MMA(1,0,At,B0); MMA(1,1,At,B1); BAR; }
    if (wr == 0) BAR;
    { int te = TIDX(ws_); asm volatile("" : "+v"(te)); wid = te >> 6; lane = te & 63; wr = wid >> 2; wc = wid & 3; fr = lane & 15; fq = lane >> 4; loff = te * 16; }
    typename Epi::Pre pre_;
    epi.preload(pre_, brow + wr * 64 + fr, bcol + wc * 32 + fq * 8, brow + wr * 64 + fq * 4);
    if (nx.brow >= 0) {
        int r_, c_; stage_rc(loff, r_, c_);
        const int i_ = r_ & 15, n_ = (r_ >> 4) & 1;
        const unsigned offA2 = (unsigned)(r_ * nx.lda + c_) * 2;
        const unsigned offB2 = (unsigned)(((r_ & ~31) + 8 * (i_ >> 2) + 4 * n_ + (i_ & 3)) * nx.ldb + c_) * 2;
        const __amdgpu_buffer_rsrc_t rsA2 = __builtin_amdgcn_make_buffer_rsrc((void*)nx.A, (short)0, -1, 0x00020000);
        const __amdgpu_buffer_rsrc_t rsB2 = __builtin_amdgcn_make_buffer_rsrc((void*)nx.Bt, (short)0, -1, 0x00020000);
#define NXT_A(P,h,k) STAGE_X(offA2,lwv,P,rsA2,nx.lda,nx.brow+(h),k)
#define NXT_B(P,h,k) STAGE_X(offB2,lwv,P,rsB2,nx.ldb,nx.bcol+(h),k)
        NXT_B(SB(0,0),0,0); NXT_A(SA(0,0),0,0); NXT_B(SB(0,1),G_HALF,0); NXT_A(SA(0,1),G_HALF,0);
        NXT_B(SB(1,0),0,1); NXT_A(SA(1,0),0,1); NXT_B(SB(1,1),G_HALF,1);
#undef NXT_A
#undef NXT_B
    }
#pragma unroll
    for (int ai = 0; ai < 2; ++ai)
#pragma unroll
    for (int m = 0; m < 4; ++m) {
#pragma unroll
        for (int bj = 0; bj < 2; ++bj) {
            if (VT1 && bj == 1) {
                if (m == 3) {
#pragma unroll
                    for (int n = 0; n < 2; ++n)
                        epi.storeT(pre_, ai, brow + ai * G_HALF + wr * 64, bcol + bj * G_HALF + wc * 32 + 8 * (fr >> 2) + 4 * n + (fr & 3), fq,
                                   acc[ai][bj][0][n], acc[ai][bj][1][n], acc[ai][bj][2][n], acc[ai][bj][3][n]);
                }
            } else {
                epi.store8(pre_, ai, m, bj, brow + ai * G_HALF + wr * 64 + m * 16 + fr, bcol + bj * G_HALF + wc * 32 + fq * 8, acc[ai][bj][m][0], acc[ai][bj][m][1]);
            }
        }
        asm volatile("" ::: "memory");
    }
    if (nx.brow < 0) __syncthreads();
#undef SA
#undef SB
#undef STAGE_X
#undef STAGE_A
#undef STAGE_B
#undef LDA
#undef LDF
#undef LDB
#undef MMA
#undef WAIT_V
#undef WAIT_L
#undef BAR
#undef SCHED
}

__device__ __forceinline__ void st4bf(bf16_t* p, f32x4 v) {
    u32x2 o; o.x = pk2(v[0], v[1]); o.y = pk2(v[2], v[3]); *reinterpret_cast<u32x2*>(p) = o;
}
__device__ __forceinline__ void st8bf(bf16_t* p, f32x4 a, f32x4 b) {
    u32x4 o; o.x = pk2(a[0], a[1]); o.y = pk2(a[2], a[3]); o.z = pk2(b[0], b[1]); o.w = pk2(b[2], b[3]); *reinterpret_cast<u32x4*>(p) = o;
}
struct EpiBf16 {
    bf16_t* C; int ldc; float sc;
    static constexpr int NST = 16;
    struct Pre {};
    __device__ __forceinline__ void preload(Pre&, int, int, int) const {}
    __device__ __forceinline__ void store8(const Pre&, int, int, int, int row, int col, f32x4 a, f32x4 b) const { st8bf(C + (size_t)row * ldc + col, a * sc, b * sc); }
    __device__ __forceinline__ void storeT(const Pre&, int, int, int, int, f32x4, f32x4, f32x4, f32x4) const {}
};
struct EpiI8 {
    bf16_t* C; int ldc; const float* rs; const float* cs;
    static constexpr int NST = 16;
    struct Pre { float r[8]; f32x4 c[2][2]; };
    __device__ __forceinline__ void preload(Pre& q, int rowb, int colb, int) const {
#pragma unroll
        for (int i = 0; i < 8; ++i) q.r[i] = rs[rowb + (i >> 2) * 128 + (i & 3) * 16];
#pragma unroll
        for (int bj = 0; bj < 2; ++bj) { q.c[bj][0] = *reinterpret_cast<const f32x4*>(cs + colb + bj * 128); q.c[bj][1] = *reinterpret_cast<const f32x4*>(cs + colb + bj * 128 + 4); }
    }
    __device__ __forceinline__ void store8(const Pre& q, int ai, int m, int bj, int row, int col, i32x4 a, i32x4 b) const {
        const float r = q.r[ai * 4 + m];
        f32x4 fa = {(float)a[0], (float)a[1], (float)a[2], (float)a[3]}, fb = {(float)b[0], (float)b[1], (float)b[2], (float)b[3]};
        st8bf(C + (size_t)row * ldc + col, fa * q.c[bj][0] * r, fb * q.c[bj][1] * r);
    }
    __device__ __forceinline__ void storeT(const Pre&, int, int, int, int, i32x4, i32x4, i32x4, i32x4) const {}
};
struct EpiPool {
    bf16_t* C; const float* scale; int gcol0;
    static constexpr int NST = 16;
    struct Pre { f32x4 s[2][2]; };
    __device__ __forceinline__ void preload(Pre& q, int, int colb, int) const {
#pragma unroll
        for (int bj = 0; bj < 2; ++bj) { q.s[bj][0] = *reinterpret_cast<const f32x4*>(scale + gcol0 + colb + bj * 128); q.s[bj][1] = *reinterpret_cast<const f32x4*>(scale + gcol0 + colb + bj * 128 + 4); }
    }
    __device__ __forceinline__ void store8(const Pre& q, int, int, int bj, int row, int col, f32x4 a, f32x4 b) const {
        a = a * q.s[bj][0]; b = b * q.s[bj][1];
        u32x2 w = {(unsigned)pk_fp8x4(a[0], a[1], a[2], a[3]), (unsigned)pk_fp8x4(b[0], b[1], b[2], b[3])};
        *reinterpret_cast<u32x2*>((char*)C + (size_t)row * DM + gcol0 + col) = w;
    }
    __device__ __forceinline__ void storeT(const Pre&, int, int, int, int, f32x4, f32x4, f32x4, f32x4) const {}
};
struct EpiQ {
    bf16_t* C; const float* rstd;
    static constexpr int NST = 16;
    struct Pre { float r[8]; };
    __device__ __forceinline__ void preload(Pre& q, int rowb, int, int) const {
#pragma unroll
        for (int i = 0; i < 8; ++i) q.r[i] = rstd[rowb + (i >> 2) * 128 + (i & 3) * 16] * (0.07216878364870322f * 1.4426950408889634f);
    }
    __device__ __forceinline__ void store8(const Pre& q, int ai, int m, int, int row, int col, f32x4 a, f32x4 b) const {
        const float s = q.r[ai * 4 + m];
        st8bf(C + (size_t)row * 1536 + col, a * s, b * s);
    }
    __device__ __forceinline__ void storeT(const Pre&, int, int, int, int, f32x4, f32x4, f32x4, f32x4) const {}
};
struct EpiKV {
    bf16_t* Kn; bf16_t* Vt; const float* rstd;
    static constexpr int NST = 12;
    struct Pre { float r[8]; f32x4 rt[8]; };
    __device__ __forceinline__ void preload(Pre& q, int rowb, int, int rowbT) const {
#pragma unroll
        for (int i = 0; i < 8; ++i) { q.r[i] = rstd[rowb + (i >> 2) * 128 + (i & 3) * 16]; q.rt[i] = *reinterpret_cast<const f32x4*>(rstd + rowbT + (i >> 2) * 128 + (i & 3) * 16); }
    }
    __device__ __forceinline__ void store8(const Pre& q, int ai, int m, int, int row, int col, f32x4 a, f32x4 b) const {
        int head = col >> 8, d = col & 127; const float r = q.r[ai * 4 + m];
        u32x2 w = {(unsigned)pk_fp8x4(a[0] * r, a[1] * r, a[2] * r, a[3] * r), (unsigned)pk_fp8x4(b[0] * r, b[1] * r, b[2] * r, b[3] * r)};
        *reinterpret_cast<u32x2*>((char*)Kn + (size_t)row * 1024 + head * 128 + d) = w;
    }
    __device__ __forceinline__ void storeT(const Pre& q, int ai, int rbase, int col, int fq, f32x4 v0, f32x4 v1, f32x4 v2, f32x4 v3) const {
        int head = col >> 8, d = col & 127, b = rbase >> 11, s = rbase & 2047;
        const f32x4 r0 = q.rt[ai * 4 + 0], r1 = q.rt[ai * 4 + 1], r2 = q.rt[ai * 4 + 2], r3 = q.rt[ai * 4 + 3];
        u32x4 w;
        w.x = (unsigned)pk_fp8x4(v0[0] * r0[0], v0[1] * r0[1], v0[2] * r0[2], v0[3] * r0[3]);
        w.y = (unsigned)pk_fp8x4(v1[0] * r1[0], v1[1] * r1[1], v1[2] * r1[2], v1[3] * r1[3]);
        w.z = (unsigned)pk_fp8x4(v2[0] * r2[0], v2[1] * r2[1], v2[2] * r2[2], v2[3] * r2[3]);
        w.w = (unsigned)pk_fp8x4(v3[0] * r3[0], v3[1] * r3[1], v3[2] * r3[2], v3[3] * r3[3]);
        *reinterpret_cast<u32x4*>((char*)Vt + ((size_t)((b * 8 + head) * 128 + d)) * SEQ + s + 32 * (fq & 1) + 16 * (fq >> 1)) = w;
    }
};

__device__ __forceinline__ int vcu_of(int bid, int nb) { return (nb % 8 == 0) ? (bid % 8) * (nb / 8) + bid / 8 : bid; }

__device__ __forceinline__ void xpose_item(const float* __restrict__ W, int K, int N, bf16_t* __restrict__ WT, int ldt, float* scr, int item, int lane,
                                           const float* __restrict__ rowscale) {
    const int nblk = N / 32, kb = item / nblk, nb = item % nblk, k0 = 64 * kb, n0 = 32 * nb;
#pragma unroll 8
    for (int i = 0; i < 32; ++i) {
        const int kk = 2 * i + (lane >> 5);
        float w = W[(size_t)(k0 + kk) * N + n0 + (lane & 31)];
        if (rowscale) w *= rowscale[k0 + kk];
        scr[kk * 33 + (lane & 31)] = w;
    }
    __builtin_amdgcn_s_waitcnt(0xc07f); asm volatile("" ::: "memory");
    const int c = lane & 7;
#pragma unroll
    for (int j = 0; j < 4; ++j) {
        const int n = (lane >> 3) + 8 * j; const float* s = scr + (8 * c) * 33 + n;
        u32x4 o; o.x = pk2(s[0 * 33], s[1 * 33]); o.y = pk2(s[2 * 33], s[3 * 33]); o.z = pk2(s[4 * 33], s[5 * 33]); o.w = pk2(s[6 * 33], s[7 * 33]);
        *reinterpret_cast<u32x4*>(WT + (size_t)(n0 + n) * ldt + k0 + 8 * c) = o;
    }
    __builtin_amdgcn_s_waitcnt(0xc07f); asm volatile("" ::: "memory");
}
__device__ __forceinline__ void xposef8_item(const float* __restrict__ W, int K, int N, char* __restrict__ WT8, int ldt, float* scr, int item, int lane, float mul) {
    const int nblk = N / 32, kb = item / nblk, nb = item % nblk, k0 = 64 * kb, n0 = 32 * nb;
#pragma unroll 8
    for (int i = 0; i < 32; ++i) {
        const int kk = 2 * i + (lane >> 5);
        scr[kk * 33 + (lane & 31)] = W[(size_t)(k0 + kk) * N + n0 + (lane & 31)] * mul;
    }
    __builtin_amdgcn_s_waitcnt(0xc07f); asm volatile("" ::: "memory");
    const int c = lane & 7;
#pragma unroll
    for (int j = 0; j < 4; ++j) {
        const int n = (lane >> 3) + 8 * j; const float* s = scr + (8 * c) * 33 + n;
        u32x2 o;
        o.x = (unsigned)pk_fp8x4(s[0 * 33], s[1 * 33], s[2 * 33], s[3 * 33]); o.y = (unsigned)pk_fp8x4(s[4 * 33], s[5 * 33], s[6 * 33], s[7 * 33]);
        *reinterpret_cast<u32x2*>(WT8 + (size_t)(n0 + n) * ldt + k0 + 8 * c) = o;
    }
    __builtin_amdgcn_s_waitcnt(0xc07f); asm volatile("" ::: "memory");
}
__device__ __forceinline__ void xpose8_item(const float* __restrict__ W, int N, char* __restrict__ WT8, float* scr, int item, int lane,
                                            const unsigned* __restrict__ cmax, float* __restrict__ wsc) {
    const int nblk = N / 32, kb = item / nblk, nb = item % nblk, k0 = 64 * kb, n0 = 32 * nb;
    const float cm = __uint_as_float(cmax[n0 + (lane & 31)]);
    const float qm = cm > 0.f ? 127.f / cm : 0.f;
    if (kb == 0 && lane < 32) wsc[n0 + lane] = cm * (1.f / 127.f);
#pragma unroll 8
    for (int i = 0; i < 32; ++i) {
        const int kk = 2 * i + (lane >> 5);
        scr[kk * 33 + (lane & 31)] = W[(size_t)(k0 + kk) * N + n0 + (lane & 31)] * qm;
    }
    __builtin_amdgcn_s_waitcnt(0xc07f); asm volatile("" ::: "memory");
    const int c = lane & 7;
#pragma unroll
    for (int j = 0; j < 4; ++j) {
        const int n = (lane >> 3) + 8 * j; const float* s = scr + (8 * c) * 33 + n;
        u32x2 o;
        o.x = pack_i8x4(s[0 * 33], s[1 * 33], s[2 * 33], s[3 * 33]); o.y = pack_i8x4(s[4 * 33], s[5 * 33], s[6 * 33], s[7 * 33]);
        *reinterpret_cast<u32x2*>(WT8 + (size_t)(n0 + n) * 2048 + k0 + 8 * c) = o;
    }
    __builtin_amdgcn_s_waitcnt(0xc07f); asm volatile("" ::: "memory");
}
__device__ __forceinline__ void cvt_bf16_range(const float* __restrict__ src, bf16_t* __restrict__ dst, size_t n8, size_t gtid, size_t gthreads) {
    for (size_t i = gtid; i < n8; i += gthreads) {
        f32x4 a = *reinterpret_cast<const f32x4*>(src + i * 8), b = *reinterpret_cast<const f32x4*>(src + i * 8 + 4);
        u32x4 o; o.x = pk2(a[0], a[1]); o.y = pk2(a[2], a[3]); o.z = pk2(b[0], b[1]); o.w = pk2(b[2], b[3]);
        *reinterpret_cast<u32x4*>(dst + i * 8) = o;
    }
}
__device__ __forceinline__ void phase0(const Params& p, char* shm, int bid, int nb) {
    const int tid = TIDX(p.wave_s), wave = tid >> 6, lane = tid & 63;
    char* ws = p.ws;
#ifndef DUP_P0
#define DUP_P0 (-1)
#endif
    for (int rp_ = 0; rp_ < (DUP_P0 == 0 ? 2 : 1); ++rp_)
    {
        float* sl = (float*)shm;
        float* red = (float*)(shm + 65536);
        float* mod = (float*)(ws + WS_MOD);
        if (bid < 192 || nb != 256) {
            for (int i = tid; i < 8 * DM; i += NTHREADS) { float cv = p.c[i]; sl[i] = cv / (1.f + __expf(-cv)); }
            __syncthreads();
            for (int it = bid; it < 192; it += nb) {
                const int col = it * 64 + lane;
                float acc[8];
#pragma unroll
                for (int b = 0; b < 8; ++b) acc[b] = 0.f;
                const float* wp = p.ada_w + (size_t)(wave * 256) * 12288 + col;
                const float* sp = sl + wave * 256;
#pragma unroll 1
                for (int r0 = 0; r0 < 256; r0 += 32) {
                    float w[32];
#pragma unroll
                    for (int i = 0; i < 32; ++i) w[i] = wp[(size_t)(r0 + i) * 12288];
#pragma unroll
                    for (int q = 0; q < 8; ++q)
#pragma unroll
                        for (int b = 0; b < 8; ++b) {
                            const f32x4 s4 = *reinterpret_cast<const f32x4*>(sp + b * DM + r0 + 4 * q);
                            acc[b] += w[4 * q] * s4[0] + w[4 * q + 1] * s4[1] + w[4 * q + 2] * s4[2] + w[4 * q + 3] * s4[3];
                        }
                }
#pragma unroll
                for (int b = 0; b < 8; ++b) red[(wave * 8 + b) * 64 + lane] = acc[b];
                __syncthreads();
                {
                    const int b = tid >> 6, cl = tid & 63;
                    float sum = 0.f;
#pragma unroll
                    for (int w = 0; w < 8; ++w) sum += red[(w * 8 + b) * 64 + cl];
                    mod[b * 12288 + it * 64 + cl] = sum + p.ada_b[it * 64 + cl];
                }
                __syncthreads();
            }
        }
    }
    const int gw = bid * NWAVES + wave, ngw = nb * NWAVES;
    const size_t gtid = (size_t)bid * NTHREADS + tid, gthreads = (size_t)nb * NTHREADS;
    for (int rp_ = 0; rp_ < (DUP_P0 == 1 ? 2 : 1); ++rp_)
    {
        float* scr = (float*)(shm + wave * 8448);
        constexpr int I_POOL = 4 * 4 * 8, I_UQ = 8 * 48, I_UKV = 4 * 64, I_OUT = 32 * 64;
        constexpr int NIT = I_POOL + I_UQ + I_UKV + I_OUT;
        for (int it = gw; it < NIT; it += ngw) {
            int r = it;
            if (r < I_POOL) { int g = r / 32; xpose_item(p.pool_w + g * 65536, 256, 256, (bf16_t*)(ws + WS_WPOOL) + g * 65536, 256, scr, r % 32, lane, nullptr); continue; } r -= I_POOL;
            if (r < I_UQ) { xpose_item(p.w_uq, 512, 1536, (bf16_t*)(ws + WS_WUQ), 512, scr, r, lane, p.q_norm_g); continue; } r -= I_UQ;
            if (r < I_UKV) { xpose_item(p.w_ukv, 256, 2048, (bf16_t*)(ws + WS_WUKV), 256, scr, r, lane, p.kv_norm_g); continue; } r -= I_UKV;
            xposef8_item(p.w_out, 2048, 2048, ws + WS_WOUT, 2048, scr, r, lane, 32.f);
        }
        unsigned* cmax = (unsigned*)(ws + WS_CMAX);
        for (int it = gw; it < (29 + 32) * 16; it += ngw) {
            const int strip = it >> 4, kc = it & 15;
            const bool isq = strip >= 29;
            const int n = (isq ? strip - 29 : strip) * 64 + lane, N = isq ? 2048 : 1856;
            const float* wp = (isq ? p.peer_wq : p.w_in) + (size_t)(kc * 128) * N + n;
            float m = 0.f;
#pragma unroll 32
            for (int r = 0; r < 128; ++r) m = fmaxf(m, fabsf(wp[(size_t)r * N]));
            atomicMax(cmax + (isq ? 2048 : 0) + n, __float_as_uint(m));
        }
    }
    cvt_bf16_range(p.sub_keys, (bf16_t*)(ws + WS_SK), 262144 / 8, gtid, gthreads);
    for (int rp_ = 0; rp_ < (DUP_P0 == 2 ? 2 : 1); ++rp_)
    {
        float* tile = (float*)shm;
        float* redm = (float*)(shm + 16 * 2052 * 4);
        float* scl = redm + 128;
        int ntl, tfirst, tstep;
        if (nb == 256) { if (bid < 192) { ntl = 7; tfirst = bid * 7; } else { ntl = 11; tfirst = 192 * 7 + (bid - 192) * 11; } tstep = 1; }
        else { ntl = (2048 - bid + nb - 1) / nb; tfirst = bid; tstep = nb; }
#define Q_LOAD(dst, i_) do { const int itl_ = tfirst + (i_) * tstep; \
            const float* src_ = ((itl_ >> 10) ? p.peer_v : p.peer_u) + (size_t)((itl_ & 1023) * 16) * DM; \
            _Pragma("unroll") for (int k = 0; k < 16; ++k) dst[k] = *reinterpret_cast<const f32x4*>(reinterpret_cast<const char*>(src_ + (size_t)k * DM) + qoff); } while (0)
#define Q_TILE(vs, i_) do { \
            const int it = tfirst + (i_) * tstep; \
            const int isv = it >> 10, e0 = (it & 1023) * 16; \
            float mx[16]; \
            _Pragma("unroll") for (int k = 0; k < 16; ++k) { \
                *reinterpret_cast<f32x4*>(tile + k * 2052 + tid * 4) = vs[k]; \
                mx[k] = fmaxf(fmaxf(fabsf(vs[k][0]), fabsf(vs[k][1])), fmaxf(fabsf(vs[k][2]), fabsf(vs[k][3]))); \
            } \
            if ((i_) + 1 < ntl) Q_LOAD(vs, (i_) + 1); \
            _Pragma("unroll") for (int k = 0; k < 16; ++k) { \
                _Pragma("unroll") for (int o = 1; o < 64; o <<= 1) mx[k] = fmaxf(mx[k], __shfl_xor(mx[k], o)); \
            } \
            if (lane == 0) { _Pragma("unroll") for (int k = 0; k < 16; ++k) redm[wave * 16 + k] = mx[k]; } \
            __syncthreads(); \
            if (tid < 16) { \
                float m = 0.f; \
                _Pragma("unroll") for (int w = 0; w < 8; ++w) m = fmaxf(m, redm[w * 16 + tid]); \
                const float top = isv ? 256.f : 127.f; \
                scl[tid] = m > 0.f ? top / m : 0.f; \
                ((float*)(ws + (isv ? WS_SV : WS_SU)))[e0 + tid] = m / top; \
            } \
            __syncthreads(); \
            char* dst = ws + (isv ? WS_V8 : WS_U8); \
            _Pragma("unroll") for (int k = 0; k < 8; ++k) { \
                const int item = tid + k * NTHREADS, e = item & 15, sl = item >> 4; \
                const float* tp = tile + e * 2052 + sl * 8; \
                f32x4 a = *reinterpret_cast<const f32x4*>(tp), c = *reinterpret_cast<const f32x4*>(tp + 4); \
                const float m = scl[e]; \
                u32x2 o; \
                if (isv) { \
                    int w0 = __builtin_amdgcn_cvt_pk_fp8_f32(a[0] * m, a[1] * m, 0, false); \
                    w0 = __builtin_amdgcn_cvt_pk_fp8_f32(a[2] * m, a[3] * m, w0, true); \
                    int w1 = __builtin_amdgcn_cvt_pk_fp8_f32(c[0] * m, c[1] * m, 0, false); \
                    w1 = __builtin_amdgcn_cvt_pk_fp8_f32(c[2] * m, c[3] * m, w1, true); \
                    o.x = (unsigned)w0; o.y = (unsigned)w1; \
                } else { \
                    o.x = pack_i8x4(a[0] * m, a[1] * m, a[2] * m, a[3] * m); o.y = pack_i8x4(c[0] * m, c[1] * m, c[2] * m, c[3] * m); \
                } \
                *reinterpret_cast<u32x2*>(dst + ((size_t)sl * 16384 + e0 + e) * 8) = o; \
                if (k & 1) __builtin_amdgcn_sched_barrier(0); \
            } \
            __syncthreads(); } while (0)
        f32x4 va[16];
        const unsigned qoff = (unsigned)tid * 16u;
        Q_LOAD(va, 0);
        __syncthreads();
#pragma unroll 1
        for (int i = 0; i < ntl; ++i) Q_TILE(va, i);
#undef Q_LOAD
#undef Q_TILE
    }
    {
        float2* cs = (float2*)(ws + WS_CS);
        for (size_t i = gtid; i < (size_t)NTOK * 32; i += gthreads) {
            int t = (int)(i >> 5), k = (int)(i & 31);
            float invf = exp2f(-(float)k * (13.287712379549449f / 32.f));
            float ang = (float)p.pos[t] * invf;
            double sd, cd; sincos((double)ang, &sd, &cd);
            cs[i] = make_float2((float)cd, (float)sd);
        }
    }
}

__device__ __forceinline__ void phase1(const Params& p, char* shm, int bid, int nb) {
    const int tid = TIDX(p.wave_s), wave = tid >> 6, lane = tid & 63;
    const float* mod = (const float*)(p.ws + WS_MOD);
    char* h1 = p.ws + WS_BUF1;
    float* sh1 = (float*)(p.ws + WS_SH1);
    float* lv = (float*)shm;
    for (int item = bid; item < NTOK / 64; item += nb) {
        const int b = item >> 5;
        __syncthreads();
        for (int i = tid; i < 512; i += NTHREADS) {
            *reinterpret_cast<f32x4*>(lv + 0 * DM + i * 4) = *reinterpret_cast<const f32x4*>(p.pre_mix_g + i * 4);
            *reinterpret_cast<f32x4*>(lv + 1 * DM + i * 4) = *reinterpret_cast<const f32x4*>(mod + b * 12288 + i * 4);
            *reinterpret_cast<f32x4*>(lv + 2 * DM + i * 4) = *reinterpret_cast<const f32x4*>(mod + b * 12288 + 2048 + i * 4);
        }
        __syncthreads();
#pragma unroll 1
        for (int rr = 0; rr < 8; ++rr) {
            const int row = item * 64 + rr * 8 + wave;
            const float* xr = p.x + (size_t)row * DM + lane * 4;
            f32x4 v[8]; float ss = 0.f;
#pragma unroll
            for (int i = 0; i < 8; ++i) { v[i] = *reinterpret_cast<const f32x4*>(xr + i * 256); ss += v[i][0] * v[i][0] + v[i][1] * v[i][1] + v[i][2] * v[i][2] + v[i][3] * v[i][3]; }
            const float rstd = rsqrtf(wave_sum(ss) * (1.f / DM) + EPS);
            float hmax = 0.f;
#pragma unroll
            for (int i = 0; i < 8; ++i) {
                const int col = i * 256 + lane * 4;
                f32x4 g = *reinterpret_cast<const f32x4*>(lv + col);
                f32x4 sh = *reinterpret_cast<const f32x4*>(lv + DM + col);
                f32x4 sc = *reinterpret_cast<const f32x4*>(lv + 2 * DM + col);
                v[i] = v[i] * rstd * g * (sc + 1.f) + sh;
                hmax = fmaxf(hmax, fmaxf(fmaxf(fabsf(v[i][0]), fabsf(v[i][1])), fmaxf(fabsf(v[i][2]), fabsf(v[i][3]))));
            }
#pragma unroll
            for (int o = 1; o < 64; o <<= 1) hmax = fmaxf(hmax, __shfl_xor(hmax, o));
            const float qm = hmax > 0.f ? 127.f / hmax : 0.f;
            if (lane == 0) sh1[row] = hmax * (1.f / 127.f);
#pragma unroll
            for (int i = 0; i < 8; ++i) {
                *reinterpret_cast<unsigned*>(h1 + (size_t)row * DM + i * 256 + lane * 4) = pack_i8x4(v[i][0] * qm, v[i][1] * qm, v[i][2] * qm, v[i][3] * qm);
            }
        }
    }
    {
        __syncthreads();
        float* scr = (float*)(shm + wave * 8448);
        const unsigned* cmax = (const unsigned*)(p.ws + WS_CMAX);
        float* wsc = (float*)(p.ws + WS_WSC);
        const int gw = bid * NWAVES + wave, ngw = nb * NWAVES;
        constexpr int I_IN = 32 * 58, I_PQ = 32 * 64;
        for (int it = gw; it < I_IN + I_PQ; it += ngw) {
            if (it < I_IN) xpose8_item(p.w_in, 1856, p.ws + WS_WIN, scr, it, lane, cmax, wsc);
            else xpose8_item(p.peer_wq, 2048, p.ws + WS_WPQ, scr, it - I_IN, lane, cmax + 2048, wsc + 2048);
        }
        const size_t gtid = (size_t)bid * NTHREADS + tid, gthreads = (size_t)nb * NTHREADS;
        for (size_t i = gtid; i < 24576; i += gthreads) *reinterpret_cast<u32x4*>(p.ws + WS_WIN + (size_t)1856 * 2048 + i * 16) = u32x4{0u, 0u, 0u, 0u};
        for (size_t i = gtid; i < 192; i += gthreads) wsc[1856 + i] = 0.f;
        __syncthreads();
    }
}

template <bool VT1, bool I8, bool F8 = false, class Epi>
__device__ __forceinline__ void gemm_phase(const bf16_t* A, int lda, const bf16_t* Bt, int ldb, int K, int nN, int ntiles, int tile0, int vcu, int nb,
                                           char* shm, const Epi& epi, int ws_) {
    int first = ((vcu - tile0) % nb + nb) % nb;
    bool pre = false;
    for (int t = first; t < ntiles; t += nb) {
        const int pm = t / nN, pn = t % nN;
        const int tn = t + nb;
        const bool has = tn < ntiles;
        const NextTile nx{A, Bt, lda, ldb, has ? (tn / nN) * 256 : -1, (tn % nN) * 256};
        gemm_tile<VT1, I8, F8>(A, lda, Bt, ldb, K / 64, pm * 256, pn * 256, shm, epi, pre, nx, ws_);
        pre = has;
    }
}

__device__ __forceinline__ void phase3(const Params& p, int bid, int nb) {
    const int tid = TIDX(p.wave_s), wave = tid >> 6, lane = tid & 63;
    const bf16_t* proj = (const bf16_t*)(p.ws + WS_BUF2);
    bf16_t* z = (bf16_t*)(p.ws + WS_Z);
    for (int it = bid * NTHREADS + tid; it < 1024 * 128; it += nb * NTHREADS) {
        const int strip = it >> 7, c8 = it & 127, g = c8 >> 5, w = 2 << g;
        const int t0 = strip * 16, s0 = t0 & 2047;
        const bf16_t* up = proj + (size_t)t0 * DM + c8 * 8;
        float sum[8];
#pragma unroll
        for (int j = 0; j < 8; ++j) sum[j] = 0.f;
        for (int i = 1; i <= w; ++i) {
            if (s0 - i >= 0) {
                u32x4 r = *reinterpret_cast<const u32x4*>(up - (ptrdiff_t)i * DM);
#pragma unroll
                for (int j = 0; j < 4; ++j) { sum[2 * j] += bflo(r[j]); sum[2 * j + 1] += bfhi(r[j]); }
            }
        }
        for (int tt = 0; tt < 16; ++tt) {
            const int s = s0 + tt;
            u32x4 r = *reinterpret_cast<const u32x4*>(up + (size_t)tt * DM);
            float cur[8];
#pragma unroll
            for (int j = 0; j < 4; ++j) { cur[2 * j] = bflo(r[j]); cur[2 * j + 1] = bfhi(r[j]); }
#pragma unroll
            for (int j = 0; j < 8; ++j) sum[j] += cur[j];
            if (s >= w) {
                u32x4 o = *reinterpret_cast<const u32x4*>(up + (ptrdiff_t)(tt - w) * DM);
#pragma unroll
                for (int j = 0; j < 4; ++j) { sum[2 * j] -= bflo(o[j]); sum[2 * j + 1] -= bfhi(o[j]); }
            }
            const float inv = 1.f / (float)min(s + 1, w);
            u32x4 o;
#pragma unroll
            for (int j = 0; j < 4; ++j) o[j] = pk2(sum[2 * j] * inv - cur[2 * j], sum[2 * j + 1] * inv - cur[2 * j + 1]);
            *reinterpret_cast<u32x4*>(z + (size_t)(t0 + tt) * 1024 + c8 * 8) = o;
        }
    }
    float* rq = (float*)(p.ws + WS_RSTDQ); float* rkv = (float*)(p.ws + WS_RSTDKV);
    bf16_t* kpe = (bf16_t*)(p.ws + WS_KPE);
    const float2* cs = (const float2*)(p.ws + WS_CS);
    for (int t = bid * NWAVES + wave; t < NTOK; t += nb * NWAVES) {
        const bf16_t* pr = proj + (size_t)t * DM;
        u32x4 a = *reinterpret_cast<const u32x4*>(pr + 1024 + lane * 8);
        float s1 = 0.f;
#pragma unroll
        for (int j = 0; j < 4; ++j) { float lo = bflo(a[j]), hi = bfhi(a[j]); s1 += lo * lo + hi * hi; }
        u32x2 bq = *reinterpret_cast<const u32x2*>(pr + 1536 + lane * 4);
        float s2 = 0.f;
#pragma unroll
        for (int j = 0; j < 2; ++j) { float lo = bflo(bq[j]), hi = bfhi(bq[j]); s2 += lo * lo + hi * hi; }
        s1 = wave_sum(s1); s2 = wave_sum(s2);
        if (lane == 0) { rq[t] = rsqrtf(s1 * (1.f / 512.f) + EPS); rkv[t] = rsqrtf(s2 * (1.f / 256.f) + EPS); }
        if (lane < 32) {
            float x1 = bf2f((short)pr[1792 + lane]), x2 = bf2f((short)pr[1792 + 32 + lane]);
            float2 c = cs[(size_t)t * 32 + lane];
            unsigned char* k8 = (unsigned char*)kpe + (size_t)t * 64 + 32 * (lane >> 4) + (lane & 15);
            const int w = pk_fp8x4(x1 * c.x - x2 * c.y, x2 * c.x + x1 * c.y, 0.f, 0.f);
            k8[0] = (unsigned char)(w & 0xff); k8[16] = (unsigned char)((w >> 8) & 0xff);
        }
    }
}

constexpr int KS_STRIDE = 208, VS_STRIDE = 80;
constexpr int KS_BYTES = 64 * KS_STRIDE, VS_BYTES = 128 * VS_STRIDE, AT_STAGE = KS_BYTES + VS_BYTES;
__device__ __forceinline__ void attn_unit(const Params& p, char* shm, int b, int head, int qb) {
    int tid = TIDX(p.wave_s); asm volatile("" : "+v"(tid));
    const int wave = __builtin_amdgcn_readfirstlane(tid >> 6), lane = tid & 63, l31 = lane & 31, hh = lane >> 5;
    const bool grpB = wave >= 4;
    const int rowblk = (wave & 3) * 2 + (wave >> 2);
    const bf16_t* Q = (const bf16_t*)(p.ws + WS_Q);
    const bf16_t* Kn = (const bf16_t*)(p.ws + WS_KN);
    const bf16_t* Kpe = (const bf16_t*)(p.ws + WS_KPE);
    const bf16_t* Vt = (const bf16_t*)(p.ws + WS_VT);
    const float2* cs = (const float2*)(p.ws + WS_CS);
    bf16_t* ycat = (bf16_t*)(p.ws + WS_BUF1);
    const int q0 = qb * 256 + rowblk * 32, mychunk = q0 >> 6, nkt = 4 * qb + 4;
    const int tq = b * SEQ + q0 + l31;
    i32x8 qf[3];
    {
        const bf16_t* qrow = Q + (size_t)tq * 1536 + head * 192;
#pragma unroll
        for (int ks = 0; ks < 2; ++ks)
#pragma unroll
            for (int i = 0; i < 4; ++i) {
                const bf16x8 v = *reinterpret_cast<const bf16x8*>(qrow + ks * 64 + hh * 32 + 8 * i);
                qf[ks][2 * i] = pk_fp8x4(bf2f(v[0]) * 8.f, bf2f(v[1]) * 8.f, bf2f(v[2]) * 8.f, bf2f(v[3]) * 8.f);
                qf[ks][2 * i + 1] = pk_fp8x4(bf2f(v[4]) * 8.f, bf2f(v[5]) * 8.f, bf2f(v[6]) * 8.f, bf2f(v[7]) * 8.f);
            }
#pragma unroll
        for (int i = 0; i < 2; ++i) {
            const bf16x8 a = *reinterpret_cast<const bf16x8*>(qrow + 128 + 16 * hh + 8 * i);
            const bf16x8 c2 = *reinterpret_cast<const bf16x8*>(qrow + 160 + 16 * hh + 8 * i);
            const float2* cp = cs + (size_t)tq * 32 + 16 * hh + 8 * i;
            float o1[8], o2[8];
#pragma unroll
            for (int j = 0; j < 8; ++j) {
                const float2 c = cp[j];
                const float x1 = bf2f(a[j]) * 8.f, x2 = bf2f(c2[j]) * 8.f;
                o1[j] = x1 * c.x - x2 * c.y; o2[j] = x2 * c.x + x1 * c.y;
            }
            qf[2][2 * i] = pk_fp8x4(o1[0], o1[1], o1[2], o1[3]); qf[2][2 * i + 1] = pk_fp8x4(o1[4], o1[5], o1[6], o1[7]);
            qf[2][4 + 2 * i] = pk_fp8x4(o2[0], o2[1], o2[2], o2[3]); qf[2][4 + 2 * i + 1] = pk_fp8x4(o2[4], o2[5], o2[6], o2[7]);
        }
    }
    f32x16 O[4];
#pragma unroll
    for (int dt = 0; dt < 4; ++dt)
#pragma unroll
        for (int r = 0; r < 16; ++r) O[dt][r] = 0.f;
    float mrun = -1e30f, lsum = 0.f;
    f32x16 s0, s1;
    const int kkey = tid >> 3, kch = tid & 7;
    const int pk_key = tid >> 2, pk_ch = tid & 3;
    const int vd = tid >> 2, vch = tid & 3;
    const size_t tokb = (size_t)b * SEQ;
    const char* Kn8 = (const char*)Kn; const char* Kpe8 = (const char*)Kpe;
    const char* vbase = (const char*)Vt + (size_t)((b * 8 + head) * 128) * SEQ;
    u32x4 r0, r2, r3;
#define AT_LOAD(kt) do { const int k0_ = (kt) * 64; \
        r0 = *reinterpret_cast<const u32x4*>(Kn8 + (tokb + k0_ + kkey) * 1024 + head * 128 + kch * 16); \
        if (wave < 4) r2 = *reinterpret_cast<const u32x4*>(Kpe8 + (tokb + k0_ + pk_key) * 64 + pk_ch * 16); \
        r3 = *reinterpret_cast<const u32x4*>(vbase + (size_t)vd * SEQ + k0_ + vch * 16); } while (0)
#define AT_WRITE(buf) do { char* ks_ = shm + (buf) * AT_STAGE; char* vs_ = ks_ + KS_BYTES; \
        *reinterpret_cast<u32x4*>(ks_ + kkey * KS_STRIDE + kch * 16) = r0; \
        if (wave < 4) *reinterpret_cast<u32x4*>(ks_ + pk_key * KS_STRIDE + 128 + pk_ch * 16) = r2; \
        *reinterpret_cast<u32x4*>(vs_ + vd * VS_STRIDE + vch * 16) = r3; } while (0)
#define LDK(ks_, t_) __builtin_shufflevector(*reinterpret_cast<const i32x4*>(kb + (t_) * 32 * KS_STRIDE + (ks_) * 64), \
                                             *reinterpret_cast<const i32x4*>(kb + (t_) * 32 * KS_STRIDE + (ks_) * 64 + 16), 0, 1, 2, 3, 4, 5, 6, 7)
#define MXQK(a_, b_, c_) __builtin_amdgcn_mfma_scale_f32_32x32x64_f8f6f4(a_, b_, c_, 0, 0, 0, 0x7F7F7F7F, 0, 0x7F7F7F7F)
#define QK(buf) do { \
        const char* kb = shm + (buf) * AT_STAGE + l31 * KS_STRIDE + hh * 32; \
        i32x8 ka0 = LDK(0, 0), ka1 = LDK(0, 1), kb0 = LDK(1, 0), kb1 = LDK(1, 1); \
        _Pragma("unroll") for (int r = 0; r < 16; ++r) { s0[r] = 0.f; s1[r] = 0.f; } \
        __builtin_amdgcn_sched_barrier(0); \
        s0 = MXQK(ka0, qf[0], s0); \
        s1 = MXQK(ka1, qf[0], s1); \
        ka0 = LDK(2, 0); ka1 = LDK(2, 1); \
        __builtin_amdgcn_sched_barrier(0); \
        s0 = MXQK(kb0, qf[1], s0); \
        s1 = MXQK(kb1, qf[1], s1); \
        __builtin_amdgcn_sched_barrier(0); \
        s0 = MXQK(ka0, qf[2], s0); \
        s1 = MXQK(ka1, qf[2], s1); \
        __builtin_amdgcn_sched_barrier(0); } while (0)
#define LDV(dt_) __builtin_shufflevector(*reinterpret_cast<const i32x4*>(vb + (dt_) * 32 * VS_STRIDE), *reinterpret_cast<const i32x4*>(vb + (dt_) * 32 * VS_STRIDE + 16), 0, 1, 2, 3, 4, 5, 6, 7)
#define SMPV(buf) do { \
        const char* vb = shm + (buf) * AT_STAGE + KS_BYTES + l31 * VS_STRIDE + hh * 32; \
        i32x8 va[4]; \
        _Pragma("unroll") for (int dt = 0; dt < 4; ++dt) va[dt] = LDV(dt); \
        float mx = s0[0]; \
        _Pragma("unroll") for (int r = 1; r < 16; ++r) mx = fmaxf(mx, s0[r]); \
        _Pragma("unroll") for (int r = 0; r < 16; ++r) mx = fmaxf(mx, s1[r]); \
        mx = fmaxf(mx, __shfl_xor(mx, 32)); \
        const float mnew = fmaxf(mrun, mx * 0.125f); \
        const float alpha = __builtin_amdgcn_exp2f(mrun - mnew); \
        mrun = mnew; \
        const float moff = 6.f - mnew;        \
        float ps = 0.f; \
        _Pragma("unroll") for (int r = 0; r < 16; ++r) { s0[r] = __builtin_amdgcn_exp2f(fmaf(s0[r], 0.125f, moff)); ps += s0[r]; } \
        _Pragma("unroll") for (int r = 0; r < 16; ++r) { s1[r] = __builtin_amdgcn_exp2f(fmaf(s1[r], 0.125f, moff)); ps += s1[r]; } \
        lsum = lsum * alpha + ps; \
        _Pragma("unroll") for (int dt = 0; dt < 4; ++dt) _Pragma("unroll") for (int r = 0; r < 16; ++r) O[dt][r] *= alpha; \
        i32x8 pf; \
          \
        _Pragma("unroll") for (int f1 = 0; f1 < 2; ++f1) { \
            pf[f1 * 4 + 0] = pk_fp8x4(s0[4 * f1], s0[4 * f1 + 1], s0[4 * f1 + 2], s0[4 * f1 + 3]); \
            pf[f1 * 4 + 1] = pk_fp8x4(s0[8 + 4 * f1], s0[8 + 4 * f1 + 1], s0[8 + 4 * f1 + 2], s0[8 + 4 * f1 + 3]); \
            pf[f1 * 4 + 2] = pk_fp8x4(s1[4 * f1], s1[4 * f1 + 1], s1[4 * f1 + 2], s1[4 * f1 + 3]); \
            pf[f1 * 4 + 3] = pk_fp8x4(s1[8 + 4 * f1], s1[8 + 4 * f1 + 1], s1[8 + 4 * f1 + 2], s1[8 + 4 * f1 + 3]); \
        } \
        __builtin_amdgcn_sched_barrier(0); \
        _Pragma("unroll") for (int dt = 0; dt < 4; ++dt) O[dt] = MXQK(va[dt], pf, O[dt]); \
        __builtin_amdgcn_sched_barrier(0); } while (0)
    __syncthreads();
    AT_LOAD(0); AT_WRITE(0);
    AT_LOAD(1);
    __syncthreads();
    if (grpB) __syncthreads();
    int bcur = 0, bnext = 1;
    for (int kt = 0; kt < nkt; ++kt) {
        if (kt + 1 < nkt) AT_WRITE(bnext);
        if (kt + 2 < nkt) AT_LOAD(kt + 2);
        __builtin_amdgcn_sched_barrier(0);
        if (kt <= mychunk) QK(bcur);
        __syncthreads();
        if (kt <= mychunk) SMPV(bcur);
        __syncthreads();
        bcur = bnext; bnext = (bnext == 2) ? 0 : bnext + 1;
    }
    if (!grpB) __syncthreads();
#undef AT_LOAD
#undef AT_WRITE
#undef QK
#undef SMPV
#undef LDK
#undef MXQK
#undef LDV
    lsum += __shfl_xor(lsum, 32);
    const float inv = 1.f / lsum;
    char* orow = (char*)ycat + (size_t)tq * DM + 1024 + head * 128 + 4 * hh;
#pragma unroll
    for (int dt = 0; dt < 4; ++dt)
#pragma unroll
        for (int g = 0; g < 4; ++g)
            *reinterpret_cast<int*>(orow + dt * 32 + 8 * g) = pk_fp8x4(O[dt][4 * g] * inv, O[dt][4 * g + 1] * inv, O[dt][4 * g + 2] * inv, O[dt][4 * g + 3] * inv);
}
__device__ __forceinline__ void phase5(const Params& p, char* shm, int bid, int nb) {
    for (int it = bid; it < 256; it += nb) {
        const int bh = it >> 2, pr = it & 3, b = bh >> 3, head = bh & 7;
        attn_unit(p, shm, b, head, 7 - pr);
        attn_unit(p, shm, b, head, pr);
    }
}

__device__ __forceinline__ void phase7(const Params& p, char* shm, int bid, int nb) {
    const int tid = TIDX(p.wave_s), wave = tid >> 6, lane = tid & 63;
    const float* mod = (const float*)(p.ws + WS_MOD);
    const bf16_t* y = (const bf16_t*)(p.ws + WS_BUF2);
    bf16_t* x1 = (bf16_t*)(p.ws + WS_X1);
    float* lv = (float*)shm;
    for (int item = bid; item < NTOK / 64; item += nb) {
        const int b = item >> 5;
        const float* md = mod + b * 12288;
        __syncthreads();
        for (int i = tid; i < 512; i += NTHREADS) {
            *reinterpret_cast<f32x4*>(lv + 0 * DM + i * 4) = *reinterpret_cast<const f32x4*>(p.post_mix_g + i * 4);
            *reinterpret_cast<f32x4*>(lv + 1 * DM + i * 4) = *reinterpret_cast<const f32x4*>(md + 4096 + i * 4);
            *reinterpret_cast<f32x4*>(lv + 2 * DM + i * 4) = *reinterpret_cast<const f32x4*>(p.pre_ffn_g + i * 4);
            *reinterpret_cast<f32x4*>(lv + 3 * DM + i * 4) = *reinterpret_cast<const f32x4*>(md + 6144 + i * 4);
            *reinterpret_cast<f32x4*>(lv + 4 * DM + i * 4) = *reinterpret_cast<const f32x4*>(md + 8192 + i * 4);
        }
        __syncthreads();
#pragma unroll 1
        for (int rr = 0; rr < 8; ++rr) {
            const int row = item * 64 + rr * 8 + wave;
            f32x4 yv[8]; float ss = 0.f;
#pragma unroll
            for (int i = 0; i < 8; ++i) {
                u32x2 r = *reinterpret_cast<const u32x2*>(y + (size_t)row * DM + i * 256 + lane * 4);
                yv[i] = f32x4{bflo(r.x), bfhi(r.x), bflo(r.y), bfhi(r.y)};
                ss += yv[i][0] * yv[i][0] + yv[i][1] * yv[i][1] + yv[i][2] * yv[i][2] + yv[i][3] * yv[i][3];
            }
            const float rstd = rsqrtf(wave_sum(ss) * (1.f / DM) + EPS);
            float s2 = 0.f;
#pragma unroll
            for (int i = 0; i < 8; ++i) {
                const int col = i * 256 + lane * 4;
                f32x4 xv = *reinterpret_cast<const f32x4*>(p.x + (size_t)row * DM + col);
                f32x4 g = *reinterpret_cast<const f32x4*>(lv + col);
                f32x4 gt = *reinterpret_cast<const f32x4*>(lv + DM + col);
                f32x4 v = xv + gt * (yv[i] * rstd * g);
                st4bf(x1 + (size_t)row * DM + col, v);
                yv[i] = v;
                s2 += v[0] * v[0] + v[1] * v[1] + v[2] * v[2] + v[3] * v[3];
            }
            const float rstd2 = rsqrtf(wave_sum(s2) * (1.f / DM) + EPS);
            float hmax = 0.f;
#pragma unroll
            for (int i = 0; i < 8; ++i) {
                const int col = i * 256 + lane * 4;
                f32x4 g = *reinterpret_cast<const f32x4*>(lv + 2 * DM + col);
                f32x4 sh = *reinterpret_cast<const f32x4*>(lv + 3 * DM + col);
                f32x4 sc = *reinterpret_cast<const f32x4*>(lv + 4 * DM + col);
                yv[i] = yv[i] * rstd2 * g * (sc + 1.f) + sh;
                hmax = fmaxf(hmax, fmaxf(fmaxf(fabsf(yv[i][0]), fabsf(yv[i][1])), fmaxf(fabsf(yv[i][2]), fabsf(yv[i][3]))));
            }
#pragma unroll
            for (int o = 1; o < 64; o <<= 1) hmax = fmaxf(hmax, __shfl_xor(hmax, o));
            const float qm = hmax > 0.f ? 127.f / hmax : 0.f;
            if (lane == 0) ((float*)(p.ws + WS_SH))[row] = hmax * (1.f / 127.f);
#pragma unroll
            for (int i = 0; i < 8; ++i) {
                *reinterpret_cast<unsigned*>(p.ws + WS_H8 + (size_t)row * DM + i * 256 + lane * 4) = pack_i8x4(yv[i][0] * qm, yv[i][1] * qm, yv[i][2] * qm, yv[i][3] * qm);
            }
        }
    }
}

__device__ __forceinline__ int fmap(float f) { int i = __float_as_int(f); return i ^ ((i >> 31) & 0x7fffffff); }
__device__ __forceinline__ float funmap(int i) { return __int_as_float(i ^ ((i >> 31) & 0x7fffffff)); }
__device__ __forceinline__ void ins16(int (&top)[16], int k) {
#pragma unroll
    for (int i = 0; i < 16; ++i) { int hi = max(top[i], k); k = min(top[i], k); top[i] = hi; }
}
__device__ __forceinline__ int bsel(int m, int a, int b) { return (a & ~m) | (b & m); }
__device__ __forceinline__ int sel16(const int (&a)[16], int i) {
    const int m0 = -(i & 1), m1 = -((i >> 1) & 1), m2 = -((i >> 2) & 1), m3 = -((i >> 3) & 1);
    int t8[8], t4[4], t2[2];
#pragma unroll
    for (int k = 0; k < 8; ++k) t8[k] = bsel(m0, a[2 * k], a[2 * k + 1]);
#pragma unroll
    for (int k = 0; k < 4; ++k) t4[k] = bsel(m1, t8[2 * k], t8[2 * k + 1]);
#pragma unroll
    for (int k = 0; k < 2; ++k) t2[k] = bsel(m2, t4[2 * k], t4[2 * k + 1]);
    return bsel(m3, t2[0], t2[1]);
}
#define BITONIC_CE(x, K, J) _Pragma("unroll") for (int i_ = 0; i_ < 16; ++i_) { const int l_ = i_ ^ (J); if (l_ > i_) { const int a_ = x[i_], b_ = x[l_]; \
        if ((i_ & (K)) == 0) { x[i_] = max(a_, b_); x[l_] = min(a_, b_); } else { x[i_] = min(a_, b_); x[l_] = max(a_, b_); } } }
#define BITONIC_MERGE16(x) BITONIC_CE(x, 16, 8) BITONIC_CE(x, 16, 4) BITONIC_CE(x, 16, 2) BITONIC_CE(x, 16, 1)
#define BITONIC_SORT16(x) BITONIC_CE(x, 2, 1) BITONIC_CE(x, 4, 2) BITONIC_CE(x, 4, 1) BITONIC_CE(x, 8, 4) BITONIC_CE(x, 8, 2) BITONIC_CE(x, 8, 1) BITONIC_MERGE16(x)
#define SCE(x, i, j) { const int a_ = x[i], b_ = x[j]; x[i] = max(a_, b_); x[j] = min(a_, b_); }
#define SORT16_60(x) SCE(x,0,13) SCE(x,1,12) SCE(x,2,15) SCE(x,3,14) SCE(x,4,8) SCE(x,5,6) SCE(x,7,11) SCE(x,9,10) SCE(x,0,5) SCE(x,1,7) SCE(x,2,9) SCE(x,3,4) SCE(x,6,13) SCE(x,8,14) SCE(x,10,15) SCE(x,11,12) SCE(x,0,1) SCE(x,2,3) SCE(x,4,5) SCE(x,6,8) SCE(x,7,9) SCE(x,10,11) SCE(x,12,13) SCE(x,14,15) SCE(x,0,2) SCE(x,1,3) SCE(x,4,10) SCE(x,5,11) SCE(x,6,7) SCE(x,8,9) SCE(x,12,14) SCE(x,13,15) SCE(x,1,2) SCE(x,3,12) SCE(x,4,6) SCE(x,5,7) SCE(x,8,10) SCE(x,9,11) SCE(x,13,14) SCE(x,1,4) SCE(x,2,6) SCE(x,5,8) SCE(x,7,10) SCE(x,9,13) SCE(x,11,14) SCE(x,2,4) SCE(x,3,6) SCE(x,9,12) SCE(x,11,13) SCE(x,3,5) SCE(x,6,8) SCE(x,7,9) SCE(x,10,12) SCE(x,3,4) SCE(x,5,6) SCE(x,7,8) SCE(x,9,10) SCE(x,11,12) SCE(x,6,7) SCE(x,8,9)
__device__ __forceinline__ void pk_half_list(const bf16_t* __restrict__ qrow, const char* kl, int hh, int (&out)[16]) {
    bf16x8 qf[8];
#pragma unroll
    for (int ks = 0; ks < 8; ++ks) qf[ks] = *reinterpret_cast<const bf16x8*>(qrow + ks * 16);
    int top[16];
#pragma unroll 1
    for (int kt = 0; kt < 4; ++kt) {
        f32x16 acc;
#pragma unroll
        for (int r = 0; r < 16; ++r) acc[r] = 0.f;
#pragma unroll
        for (int ks = 0; ks < 8; ++ks) {
            bf16x8 kf = *reinterpret_cast<const bf16x8*>(kl + kt * 32 * 272 + ks * 32);
            acc = __builtin_amdgcn_mfma_f32_32x32x16_bf16(kf, qf[ks], acc, 0, 0, 0);
        }
        int nw[16];
#pragma unroll
        for (int r = 0; r < 16; ++r) {
            const int n = kt * 32 + (r & 3) + 8 * (r >> 2) + 4 * hh;
            nw[r] = (fmap(acc[r]) & ~127) | (127 - n);
        }
        SORT16_60(nw)
        if (kt == 0) {
#pragma unroll
            for (int i = 0; i < 16; ++i) top[i] = nw[i];
        } else {
#pragma unroll
            for (int i = 0; i < 16; ++i) top[i] = max(top[i], nw[15 - i]);
            BITONIC_MERGE16(top)
        }
    }
#pragma unroll
    for (int i = 0; i < 16; ++i) out[i] = __shfl_xor(top[15 - i], 32);
#pragma unroll
    for (int i = 0; i < 16; ++i) out[i] = max(out[i], top[i]);
    BITONIC_MERGE16(out)
}
__device__ __forceinline__ void phase9(const Params& p, char* shm, int bid, int nb) {
    int tid = TIDX(p.wave_s); asm volatile("" : "+v"(tid));
    const int wave = tid >> 6, lane = tid & 63, l31 = lane & 31, hh = lane >> 5;
    const bf16_t* pq = (const bf16_t*)(p.ws + WS_BUF2);
    const bf16_t* sk = (const bf16_t*)(p.ws + WS_SK);
    int* idxo = (int*)(p.ws + WS_IDX); float* gateo = (float*)(p.ws + WS_GATE);
    for (int item = bid; item < 8 * 64; item += nb) {
        const int head = item & 7, tt = (item >> 3) * 8 + wave, tok = tt * 32 + l31;
        __syncthreads();
        for (int c = tid; c < 4096; c += NTHREADS) {
            const int row = c >> 4, ch = c & 15;
            *reinterpret_cast<u32x4*>(shm + row * 272 + ch * 16) = *reinterpret_cast<const u32x4*>(sk + (size_t)(head * 256 + row) * 128 + ch * 8);
        }
        __syncthreads();
        int la[16], lb[16];
        pk_half_list(pq + (size_t)tok * DM + head * 256 + hh * 8, shm + l31 * 272 + hh * 16, hh, la);
        pk_half_list(pq + (size_t)tok * DM + head * 256 + 128 + hh * 8, shm + (128 + l31) * 272 + hh * 16, hh, lb);
        float va[16], vb[16]; int ia[16], ib[16];
#pragma unroll
        for (int i = 0; i < 16; ++i) {
            va[i] = funmap(la[i] & ~127); ia[i] = 127 - (la[i] & 127);
            vb[i] = funmap(lb[i] & ~127); ib[i] = 127 - (lb[i] & 127);
        }
#define CKEY(i, j) ((fmap(va[i] + vb[j]) & ~255) | (255 - ((i) * 16 + (j))))
        int top2[16], ga[16], gb[16];
#pragma unroll
        for (int j = 0; j < 16; ++j) top2[j] = CKEY(0, j);
#pragma unroll
        for (int j = 0; j < 8; ++j) { ga[j] = CKEY(1, j); ga[8 + j] = CKEY(15 - j, 0); }
        BITONIC_MERGE16(ga)
        gb[0] = CKEY(2, 0); gb[1] = CKEY(2, 1); gb[2] = CKEY(2, 2); gb[3] = CKEY(2, 3); gb[4] = CKEY(2, 4);
        gb[5] = CKEY(3, 0); gb[6] = CKEY(3, 1); gb[7] = CKEY(3, 2); gb[8] = CKEY(3, 3);
        gb[9] = CKEY(4, 0); gb[10] = CKEY(4, 1); gb[11] = CKEY(4, 2);
        gb[12] = CKEY(5, 0); gb[13] = CKEY(5, 1); gb[14] = CKEY(6, 0); gb[15] = CKEY(6, 1);
        SORT16_60(gb)
#pragma unroll
        for (int i = 0; i < 16; ++i) top2[i] = max(top2[i], ga[15 - i]);
        BITONIC_MERGE16(top2)
#pragma unroll
        for (int i = 0; i < 16; ++i) top2[i] = max(top2[i], gb[15 - i]);
        BITONIC_MERGE16(top2)
        ins16(top2, CKEY(7, 0)); ins16(top2, CKEY(7, 1));
#undef CKEY
        float bv[16], mxv, sum = 0.f; int ex[16];
        {
            LAS int* tA = (LAS int*)(uintptr_t)(69632 + wave * 8192) + lane;
            LAS int* tB = tA + 16 * 64;
#pragma unroll
            for (int i = 0; i < 16; ++i) { tA[i * 64] = ia[i] * 128; tB[i * 64] = ib[i]; }
#pragma unroll
            for (int r = 0; r < 16; ++r) {
                const int code = 255 - (top2[r] & 255);
                ex[r] = tA[(code >> 4) * 64] + tB[(code & 15) * 64];
                bv[r] = funmap(top2[r] & ~255);
            }
        }
        mxv = bv[0];
#pragma unroll
        for (int r = 0; r < 16; ++r) { bv[r] = __expf(bv[r] - mxv); sum += bv[r]; }
        const float inv = 1.f / sum;
        if (hh == 0) {
            const size_t ob = ((size_t)(tok >> 6) * 128 + head * 16) * 64 + (tok & 63);
#pragma unroll
            for (int r = 0; r < 16; ++r) { idxo[ob + r * 64] = ex[r]; gateo[ob + r * 64] = bv[r] * inv; }
        }
    }
}

__device__ __forceinline__ void phase10(const Params& p, char* shm, int bid, int nb) {
    int tid = TIDX(p.wave_s); asm volatile("" : "+v"(tid));
    const int wave = tid >> 6, lane = tid & 63;
    const int* idxT = (const int*)(p.ws + WS_IDX);
    const char* U8 = p.ws + WS_U8;
    const char* H8 = p.ws + WS_H8;
    int* part = (int*)(p.ws + WS_PART);
    for (int task = bid; task < 256; task += nb) {
        const int tg = task >> 3, cg = task & 7;
        const int tt = tg * 8 + wave, t = tt * 64 + lane;
        unsigned ip[64]; int acc[128];
#pragma unroll
        for (int k = 0; k < 64; ++k) {
            const unsigned lo = (unsigned)idxT[((size_t)tt * 128 + 2 * k) * 64 + lane], hi = (unsigned)idxT[((size_t)tt * 128 + 2 * k + 1) * 64 + lane];
            ip[k] = lo | (hi << 16);
        }
#pragma unroll
        for (int j = 0; j < 128; ++j) acc[j] = 0;
#pragma unroll 1
        for (int s = 0; s < 32; ++s) {
            const int slice = cg * 32 + s;
            __syncthreads();
            const char* sbase = U8 + (size_t)slice * 131072;
            const unsigned toff = (unsigned)tid * 16u;
#pragma unroll
            for (int k = 0; k < 16; ++k)
                __builtin_amdgcn_global_load_lds((const unsigned*)(sbase + k * 8192 + toff), (unsigned*)(shm + k * 8192 + tid * 16), 16, 0, 0);
            const u32x2 h = *reinterpret_cast<const u32x2*>(H8 + (size_t)t * DM + slice * 8);
            asm volatile("s_waitcnt vmcnt(0)" ::: "memory");
            __syncthreads();
#define U_LOAD(g, dst) _Pragma("unroll") for (int q = 0; q < 4; ++q) { unsigned w = ip[(g) * 4 + q]; asm volatile("" : "+v"(w)); \
                dst[2 * q] = *reinterpret_cast<const u32x2*>(shm + ((w & 0xffffu) << 3)); dst[2 * q + 1] = *reinterpret_cast<const u32x2*>(shm + ((w >> 16) << 3)); }
#define U_DOT(g, srcv) _Pragma("unroll") for (int q = 0; q < 8; ++q) { \
                acc[(g) * 8 + q] = __builtin_amdgcn_sdot4((int)srcv[q].x, (int)h.x, acc[(g) * 8 + q], false); \
                acc[(g) * 8 + q] = __builtin_amdgcn_sdot4((int)srcv[q].y, (int)h.y, acc[(g) * 8 + q], false); }
            u32x2 ua[8], ub[8];
            U_LOAD(0, ua)
#pragma unroll
            for (int g = 0; g < 16; g += 2) {
                U_LOAD(g + 1, ub)
                U_DOT(g, ua)
                __builtin_amdgcn_sched_barrier(0);
                if (g + 2 < 16) { U_LOAD(g + 2, ua) }
                U_DOT(g + 1, ub)
                __builtin_amdgcn_sched_barrier(0);
            }
#undef U_LOAD
#undef U_DOT
        }
#pragma unroll
        for (int k = 0; k < 64; ++k) part[((size_t)cg * 64 + k) * NTOK + t] = (int)pk2((float)acc[2 * k], (float)acc[2 * k + 1]);
    }
}

__device__ __forceinline__ void phase11(const Params& p, int bid, int nb) {
    const int* part = (const int*)(p.ws + WS_PART);
    const int* idxT = (const int*)(p.ws + WS_IDX); const float* gateT = (const float*)(p.ws + WS_GATE);
    const float* su = (const float*)(p.ws + WS_SU); const float* sv = (const float*)(p.ws + WS_SV); const float* sh = (const float*)(p.ws + WS_SH);
    unsigned* pack = (unsigned*)(p.ws + WS_PACK);
    int t11 = TIDX(p.wave_s); asm volatile("" : "+v"(t11));
    for (int item = bid * NTHREADS + t11; item < NTOK * 128; item += nb * NTHREADS) {
        const int lane = item & 63, j = (item >> 6) & 127, tt = item >> 13, t = tt * 64 + lane;
        float sum = 0.f;
#pragma unroll
        for (int cg = 0; cg < 8; ++cg) { const unsigned w = (unsigned)part[((size_t)cg * 64 + (j >> 1)) * NTOK + t]; sum += (j & 1) ? bfhi(w) : bflo(w); }
        const int e = idxT[item];
        const float a = sum * sh[t] * su[e];
        const float act = 0.5f * a * (1.f + erff(a * 0.70710678118654752f)) * gateT[item] * sv[e];
        { const _Float16 ah = (_Float16)(act * 256.f); pack[item] = ((unsigned)__builtin_bit_cast(unsigned short, ah) << 16) | ((unsigned)e << 2); }
    }
}

__device__ __forceinline__ void phase12(const Params& p, char* shm, int bid, int nb) {
    int tid = TIDX(p.wave_s); asm volatile("" : "+v"(tid));
    const int wave = tid >> 6, lane = tid & 63;
    const unsigned* pack = (const unsigned*)(p.ws + WS_PACK);
    const char* V8 = p.ws + WS_V8;
    bf16_t* y2 = (bf16_t*)(p.ws + WS_Y2);
    for (int slice = bid; slice < 256; slice += nb) {
        __syncthreads();
        const char* src = V8 + (size_t)slice * 131072 + tid * 16;
#pragma unroll
        for (int k = 0; k < 16; ++k)
            __builtin_amdgcn_global_load_lds((const unsigned*)(src + k * 8192), (unsigned*)(shm + k * 8192 + tid * 16), 16, 0, 0);
        asm volatile("s_waitcnt vmcnt(0)" ::: "memory");
        __syncthreads();
#define V_LOAD(ptr, g, dst) _Pragma("unroll") for (int q = 0; q < 16; ++q) dst[q] = *reinterpret_cast<const unsigned*>(reinterpret_cast<const char*>((ptr) + (g) * 1024) + lane4 + q * 256);
#define V_LDS(srcp, dstv) _Pragma("unroll") for (int q = 0; q < 16; ++q) { unsigned ad_; \
            asm("v_lshlrev_b32_sdwa %0, %1, %2 dst_sel:DWORD dst_unused:UNUSED_PAD src0_sel:DWORD src1_sel:WORD_0" : "=v"(ad_) : "v"(one_), "v"(srcp[q])); \
            dstv[q] = *reinterpret_cast<const LAS u32x2*>((uintptr_t)ad_); }
#define V_CVT(w_, hi_) __builtin_bit_cast(h2v, __builtin_amdgcn_cvt_scalef32_pk_f16_fp8(w_, __uint_as_float(0x3F80007Fu), hi_))
#define V_FMAS(srcp, srcv) _Pragma("unroll") for (int q = 0; q < 16; ++q) { const h2v ph = __builtin_bit_cast(h2v, srcp[q]); const h2v act = {ph[1], ph[1]}; \
                y[0] = __builtin_elementwise_fma(act, V_CVT(srcv[q].x, false), y[0]); y[1] = __builtin_elementwise_fma(act, V_CVT(srcv[q].x, true), y[1]); \
                y[2] = __builtin_elementwise_fma(act, V_CVT(srcv[q].y, false), y[2]); y[3] = __builtin_elementwise_fma(act, V_CVT(srcv[q].y, true), y[3]); }
#define V_STEP(ptr, g, pkLoad, pkLds, vLds, pkCur, vCur) V_LOAD(ptr, g, pkLoad) V_LDS(pkLds, vLds) V_FMAS(pkCur, vCur) __builtin_amdgcn_sched_barrier(0);
        unsigned pkA[16], pkB[16], pkC[16]; u32x2 vA[16], vB[16];
        unsigned one_ = 1u; asm volatile("" : "+v"(one_));
        const int wave_u = __builtin_amdgcn_readfirstlane(wave);
        const unsigned lane4 = (unsigned)lane * 4u;
        {
            const unsigned* pp0 = pack + (size_t)wave_u * 8192;
            V_LOAD(pp0, 0, pkA) V_LOAD(pp0, 1, pkB) V_LDS(pkA, vA)
        }
#pragma unroll 1
        for (int tt = wave_u; tt < 256; tt += NWAVES) {
            h2v y[4];
#pragma unroll
            for (int c = 0; c < 4; ++c) y[c] = h2v{(_Float16)0.f, (_Float16)0.f};
            const unsigned* pp = pack + (size_t)tt * 8192;
            const int ttn = (tt + NWAVES < 256) ? tt + NWAVES : tt;
            const unsigned* pn = pack + (size_t)ttn * 8192;
            V_STEP(pp, 2, pkC, pkB, vB, pkA, vA)
            V_STEP(pp, 3, pkA, pkC, vA, pkB, vB)
            V_STEP(pp, 4, pkB, pkA, vB, pkC, vA)
            V_STEP(pp, 5, pkC, pkB, vA, pkA, vB)
            V_STEP(pp, 6, pkA, pkC, vB, pkB, vA)
            V_STEP(pp, 7, pkB, pkA, vA, pkC, vB)
            V_STEP(pn, 0, pkC, pkB, vB, pkA, vA)
            V_STEP(pn, 1, pkA, pkC, vA, pkB, vB)
#pragma unroll
            for (int q = 0; q < 16; ++q) { const unsigned t0_ = pkA[q]; pkA[q] = pkC[q]; pkB[q] = t0_; }
            *reinterpret_cast<u32x4*>(y2 + (size_t)(tt * 64 + lane) * DM + slice * 8) =
                u32x4{__builtin_bit_cast(unsigned, y[0]), __builtin_bit_cast(unsigned, y[1]), __builtin_bit_cast(unsigned, y[2]), __builtin_bit_cast(unsigned, y[3])};
        }
#undef V_LOAD
#undef V_LDS
#undef V_CVT
#undef V_FMAS
#undef V_STEP
    }
}

__device__ __forceinline__ float h16f(unsigned h) {
    const unsigned s_ = (h & 0x8000u) << 16, e_ = (h >> 10) & 31u, m_ = h & 0x3ffu;
    return e_ == 0u ? __uint_as_float(s_) : __uint_as_float(s_ | ((e_ + 112u) << 23) | (m_ << 13));
}
__device__ __forceinline__ void phase13(const Params& p, char* shm, int bid, int nb) {
    const int tid = TIDX(p.wave_s), wave = tid >> 6, lane = tid & 63;
    const float* mod = (const float*)(p.ws + WS_MOD);
    const bf16_t* y2 = (const bf16_t*)(p.ws + WS_Y2);
    const bf16_t* x1 = (const bf16_t*)(p.ws + WS_X1);
    float* lv = (float*)shm;
    for (int item = bid; item < NTOK / 64; item += nb) {
        const int b = item >> 5;
        __syncthreads();
        for (int i = tid; i < 512; i += NTHREADS) {
            *reinterpret_cast<f32x4*>(lv + 0 * DM + i * 4) = *reinterpret_cast<const f32x4*>(p.post_ffn_g + i * 4);
            *reinterpret_cast<f32x4*>(lv + 1 * DM + i * 4) = *reinterpret_cast<const f32x4*>(mod + b * 12288 + 10240 + i * 4);
        }
        __syncthreads();
#pragma unroll 1
        for (int rr = 0; rr < 8; ++rr) {
            const int row = item * 64 + rr * 8 + wave;
            f32x4 yv[8]; u32x2 xr[8]; float ss = 0.f;
#pragma unroll
            for (int i = 0; i < 8; ++i) {
                u32x2 r = *reinterpret_cast<const u32x2*>(y2 + (size_t)row * DM + i * 256 + lane * 4);
                xr[i] = *reinterpret_cast<const u32x2*>(x1 + (size_t)row * DM + i * 256 + lane * 4);
                yv[i] = f32x4{h16f(r.x & 0xffffu), h16f(r.x >> 16), h16f(r.y & 0xffffu), h16f(r.y >> 16)};
                ss += yv[i][0] * yv[i][0] + yv[i][1] * yv[i][1] + yv[i][2] * yv[i][2] + yv[i][3] * yv[i][3];
            }
            const float rstd = rsqrtf(wave_sum(ss) * (1.f / DM) + EPS);
#pragma unroll
            for (int i = 0; i < 8; ++i) {
                const int col = i * 256 + lane * 4;
                f32x4 xv = f32x4{bflo(xr[i].x), bfhi(xr[i].x), bflo(xr[i].y), bfhi(xr[i].y)};
                f32x4 g = *reinterpret_cast<const f32x4*>(lv + col);
                f32x4 gt = *reinterpret_cast<const f32x4*>(lv + DM + col);
                *reinterpret_cast<f32x4*>(p.out + (size_t)row * DM + col) = xv + gt * (yv[i] * rstd * g);
            }
        }
    }
}

constexpr int NPHASE = 14;
__global__ void __launch_bounds__(NTHREADS, 2) mega(Params p, int ph_lo, int ph_hi) {
    extern __shared__ __attribute__((aligned(16))) char shm[];
    p.wave_s = __builtin_amdgcn_readfirstlane((int)(threadIdx.x >> 6));
    const int bid = blockIdx.x, nb = gridDim.x;
    const int vcu = vcu_of(bid, nb);
    char* ws = p.ws;
    volatile LAS unsigned* xbw = (volatile LAS unsigned*)(shm + XB_OFF);
    if (TIDX(p.wave_s) == 0) { xbw[0] = 0u; xbw[1] = 0u; }
    __syncthreads();
    XcdBarrier bar; bar.bar = (unsigned*)(ws + WS_BAR); bar.x = 0; bar.st = xbw; bar.ws = p.wave_s;
    if (ph_hi - ph_lo > 1) bar = xcd_barrier_post((unsigned*)(ws + WS_BAR), xbw, p.wave_s);
#ifndef DUP_PH
#define DUP_PH (-1)
#endif
#define REP(k) for (int rep_ = 0; rep_ < ((k) == DUP_PH ? 2 : 1); ++rep_)
#ifdef ONLY_PH
#define PH(k) ((k) == ONLY_PH && ph_lo <= (k) && (k) < ph_hi)
#else
#define PH(k) (ph_lo <= (k) && (k) < ph_hi)
#endif
#define SEAM(k) do { if (ph_lo <= (k) && (k) + 1 < ph_hi) xcd_barrier(bar); } while (0)
    if (PH(0)) REP(0) phase0(p, shm, bid, nb);
    SEAM(0);
    if (PH(1)) REP(1) phase1(p, shm, bid, nb);
    SEAM(1);
    if (PH(2)) REP(2) {
        EpiI8 e{(bf16_t*)(ws + WS_BUF2), DM, (const float*)(ws + WS_SH1), (const float*)(ws + WS_WSC)};
        gemm_phase<false, true>((const bf16_t*)(ws + WS_BUF1), DM / 2, (const bf16_t*)(ws + WS_WIN), DM / 2, 1024, 8, 512, 0, vcu, nb, shm, e, p.wave_s);
    }
    SEAM(2);
    if (PH(3)) REP(3) phase3(p, bid, nb);
    SEAM(3);
    if (PH(4)) REP(4) {
        const bf16_t* projb = (const bf16_t*)(ws + WS_BUF2);
        EpiQ eq{(bf16_t*)(ws + WS_Q), (const float*)(ws + WS_RSTDQ)};
        EpiKV ekv{(bf16_t*)(ws + WS_KN), (bf16_t*)(ws + WS_VT), (const float*)(ws + WS_RSTDKV)};
        if (nb == 256) {
            const int nq = vcu < 128 ? 2 : 1, q0 = vcu < 128 ? 2 * vcu : vcu + 128;
            const int nkv = vcu < 128 ? 1 : 3, kv0 = vcu < 128 ? vcu : 128 + 3 * (vcu - 128);
            const int g = vcu >> 6, pmp = vcu & 63;
            const bf16_t* qA = projb + 1024; const bf16_t* qB = (const bf16_t*)(ws + WS_WUQ);
            const bf16_t* kA = projb + 1536; const bf16_t* kB = (const bf16_t*)(ws + WS_WUKV);
            const bf16_t* pA = (const bf16_t*)(ws + WS_Z) + g * 256; const bf16_t* pB = (const bf16_t*)(ws + WS_WPOOL) + g * 65536;
            const NextTile kvfirst{kA, kB, DM, 256, (kv0 >> 3) * 256, (kv0 & 7) * 256};
            const NextTile poolt{pA, pB, 1024, 256, pmp * 256, 0};
#pragma unroll 1
            for (int i = 0; i < nq; ++i) {
                const int t = q0 + i;
                const NextTile nx = (i + 1 < nq) ? NextTile{qA, qB, DM, 512, ((t + 1) / 6) * 256, ((t + 1) % 6) * 256} : kvfirst;
                gemm_tile<false, false>(qA, DM, qB, 512, 8, (t / 6) * 256, (t % 6) * 256, shm, eq, i > 0, nx, p.wave_s);
            }
#pragma unroll 1
            for (int i = 0; i < nkv; ++i) {
                const int t = kv0 + i;
                const NextTile nx = (i + 1 < nkv) ? NextTile{kA, kB, DM, 256, ((t + 1) >> 3) * 256, ((t + 1) & 7) * 256} : poolt;
                gemm_tile<true, false>(kA, DM, kB, 256, 4, (t >> 3) * 256, (t & 7) * 256, shm, ekv, true, nx, p.wave_s);
            }
            {
                EpiPool e{(bf16_t*)(ws + WS_BUF1), p.pool_scale, g * 256};
                gemm_tile<false, false>(pA, 1024, pB, 256, 4, pmp * 256, 0, shm, e, true, NextTile{pA, pB, 1024, 256, -1, 0}, p.wave_s);
            }
        } else {
            gemm_phase<false, false>(projb + 1024, DM, (const bf16_t*)(ws + WS_WUQ), 512, 512, 6, 384, 0, vcu, nb, shm, eq, p.wave_s);
            gemm_phase<true, false>(projb + 1536, DM, (const bf16_t*)(ws + WS_WUKV), 256, 256, 8, 512, 384, vcu, nb, shm, ekv, p.wave_s);
            const int first = ((vcu - 896) % nb + nb) % nb;
            for (int t = first; t < 256; t += nb) {
                const int g = t >> 6, pm = t & 63;
                EpiPool e{(bf16_t*)(ws + WS_BUF1), p.pool_scale, g * 256};
                gemm_tile<false, false>((const bf16_t*)(ws + WS_Z) + g * 256, 1024, (const bf16_t*)(ws + WS_WPOOL) + g * 65536, 256, 4, pm * 256, 0, shm, e, false, NextTile{nullptr, nullptr, 0, 0, -1, 0}, p.wave_s);
            }
        }
    }
    SEAM(4);
    if (PH(5)) REP(5) phase5(p, shm, vcu, nb);
    SEAM(5);
    if (PH(6)) REP(6) {
        EpiBf16 e{(bf16_t*)(ws + WS_BUF2), DM, 1.f / 32.f};
        gemm_phase<false, false, true>((const bf16_t*)(ws + WS_BUF1), DM / 2, (const bf16_t*)(ws + WS_WOUT), DM / 2, 1024, 8, 512, 0, vcu, nb, shm, e, p.wave_s);
    }
    SEAM(6);
    if (PH(7)) REP(7) phase7(p, shm, bid, nb);
    SEAM(7);
    if (PH(8)) REP(8) {
        EpiI8 e{(bf16_t*)(ws + WS_BUF2), DM, (const float*)(ws + WS_SH), (const float*)(ws + WS_WSC) + 2048};
        gemm_phase<false, true>((const bf16_t*)(ws + WS_H8), DM / 2, (const bf16_t*)(ws + WS_WPQ), DM / 2, 1024, 8, 512, 0, vcu, nb, shm, e, p.wave_s);
    }
    SEAM(8);
    if (PH(9)) REP(9) phase9(p, shm, bid, nb);
    SEAM(9);
    if (PH(10)) REP(10) phase10(p, shm, bid, nb);
    SEAM(10);
    if (PH(11)) REP(11) phase11(p, bid, nb);
    SEAM(11);
    if (PH(12)) REP(12) phase12(p, shm, vcu, nb);
    SEAM(12);
    if (PH(13)) REP(13) phase13(p, shm, bid, nb);
#undef PH
#undef SEAM
}

extern "C" void kernel_launch(void* const* d_in, const int* in_sizes, int n_in, void* d_out, int out_size, void* d_ws, size_t ws_size, hipStream_t stream) {
    static int grid = 0;
    if (grid == 0) {
        if (n_in != 21 || ws_size < WS_END) { fprintf(stderr, "kernel_launch: unexpected n_in %d / ws_size %zu (need %zu)\n", n_in, ws_size, (size_t)WS_END); grid = -1; return; }
        int dev = 0, cus = 0;
        if (hipGetDevice(&dev) != hipSuccess || hipDeviceGetAttribute(&cus, hipDeviceAttributeMultiprocessorCount, dev) != hipSuccess) { grid = -1; return; }
        if (hipFuncSetAttribute((const void*)mega, hipFuncAttributeMaxDynamicSharedMemorySize, LDS_BYTES) != hipSuccess) { fprintf(stderr, "hipFuncSetAttribute failed\n"); grid = -1; return; }
        int per_cu = 0;
        if (hipOccupancyMaxActiveBlocksPerMultiprocessor(&per_cu, (const void*)mega, NTHREADS, LDS_BYTES) != hipSuccess || per_cu < 1)
            fprintf(stderr, "kernel_launch: occupancy query reports %d blocks per CU\n", per_cu);
        (void)hipGetLastError();
        grid = cus;
    }
    if (grid < 0) return;
    (void)hipMemsetAsync((char*)d_ws + WS_ZERO, 0, ZERO_BYTES, stream);
    (void)hipMemsetAsync((char*)d_ws + WS_CMAX, 0, CMAX_BYTES, stream);
    Params p{};
    p.x = (const float*)d_in[0]; p.c = (const float*)d_in[1]; p.pos = (const int*)d_in[2];
    p.ada_w = (const float*)d_in[3]; p.ada_b = (const float*)d_in[4];
    p.pre_mix_g = (const float*)d_in[5]; p.post_mix_g = (const float*)d_in[6]; p.pre_ffn_g = (const float*)d_in[7]; p.post_ffn_g = (const float*)d_in[8];
    p.w_in = (const float*)d_in[9]; p.pool_w = (const float*)d_in[10]; p.pool_scale = (const float*)d_in[11];
    p.q_norm_g = (const float*)d_in[12]; p.w_uq = (const float*)d_in[13]; p.kv_norm_g = (const float*)d_in[14]; p.w_ukv = (const float*)d_in[15];
    p.w_out = (const float*)d_in[16]; p.peer_wq = (const float*)d_in[17]; p.sub_keys = (const float*)d_in[18];
    p.peer_u = (const float*)d_in[19]; p.peer_v = (const float*)d_in[20];
    p.out = (float*)d_out; p.ws = (char*)d_ws;
#if MK_MULTI
    for (int k = 0; k < NPHASE; ++k) hipLaunchKernelGGL(mega, dim3(grid), dim3(NTHREADS), LDS_BYTES, stream, p, k, k + 1);
#else
    hipLaunchKernelGGL(mega, dim3(grid), dim3(NTHREADS), LDS_BYTES, stream, p, 0, NPHASE);
#endif
}
```

```cpp
#include <hip/hip_runtime.h>
#include <hip/hip_bf16.h>
#include <stdint.h>
#include <stdio.h>

#ifndef MK_MULTI
#define MK_MULTI 0
#endif

typedef unsigned short bf16_t;
typedef short bf16x8 __attribute__((ext_vector_type(8)));
typedef float f32x4 __attribute__((ext_vector_type(4)));
typedef float f32x16 __attribute__((ext_vector_type(16)));
typedef unsigned u32x4 __attribute__((ext_vector_type(4)));
typedef int i32x4 __attribute__((ext_vector_type(4)));
typedef int i32x8 __attribute__((ext_vector_type(8)));
__device__ __forceinline__ int pk_fp8x4(float a, float b, float c, float d) {
    int w = __builtin_amdgcn_cvt_pk_fp8_f32(a, b, 0, false);
    return __builtin_amdgcn_cvt_pk_fp8_f32(c, d, w, true);
}
template <bool I8> struct AccT { typedef f32x4 type; };
template <> struct AccT<true> { typedef i32x4 type; };
typedef unsigned u32x2 __attribute__((ext_vector_type(2)));
typedef _Float16 h2v __attribute__((ext_vector_type(2)));

constexpr int NTOK = 16384, DM = 2048, SEQ = 2048;
constexpr int NTHREADS = 512, NWAVES = 8;
constexpr int LDS_BYTES = 140 * 1024;
constexpr int XB_OFF = LDS_BYTES - 64;
constexpr float EPS = 1e-6f;

constexpr size_t MiB = 1024 * 1024;
constexpr size_t WS_ZERO   = 0;
constexpr size_t WS_BAR    = 0;
constexpr size_t WS_MOD    = 16384;
constexpr size_t ZERO_BYTES = 16384;
constexpr size_t WS_CS     = 1 * MiB;
constexpr size_t WS_RSTDQ  = 5 * MiB;
constexpr size_t WS_RSTDKV = 5 * MiB + 65536;
constexpr size_t WS_WIN    = 6 * MiB;
constexpr size_t WS_WOUT   = 14 * MiB;
constexpr size_t WS_WPQ    = 22 * MiB;
constexpr size_t WS_WUQ    = 30 * MiB;
constexpr size_t WS_WUKV   = 32 * MiB;
constexpr size_t WS_WPOOL  = 33 * MiB;
constexpr size_t WS_SK     = 34 * MiB;
constexpr size_t WS_U8     = 35 * MiB;
constexpr size_t WS_V8     = 67 * MiB;
constexpr size_t WS_H8     = 99 * MiB;
constexpr size_t WS_PACK   = 131 * MiB;
constexpr size_t WS_SU     = 139 * MiB;
constexpr size_t WS_SV     = 139 * MiB + 65536;
constexpr size_t WS_SH     = 139 * MiB + 131072;
constexpr size_t WS_SH1    = 139 * MiB + 196608;
constexpr size_t WS_CMAX   = 139 * MiB + 262144;
constexpr size_t WS_WSC    = 139 * MiB + 278528;
constexpr size_t CMAX_BYTES = 2 * 2048 * 4;
constexpr size_t WS_BUF1   = 163 * MiB;
constexpr size_t WS_BUF2   = 227 * MiB;
constexpr size_t WS_BIG    = 291 * MiB;
constexpr size_t WS_Z      = WS_BIG;
constexpr size_t WS_PROJ8  = WS_BIG + 16 * MiB;
constexpr size_t WS_Q      = WS_BIG + 32 * MiB;
constexpr size_t WS_KN     = WS_BIG + 80 * MiB;
constexpr size_t WS_VT     = WS_BIG + 112 * MiB;
constexpr size_t WS_KPE    = WS_BIG + 144 * MiB;
constexpr size_t WS_X1     = WS_BIG;
constexpr size_t WS_IDX    = 438 * MiB;
constexpr size_t WS_GATE   = 446 * MiB;
constexpr size_t WS_PART   = WS_BUF1;
constexpr size_t WS_Y2     = WS_BUF2;
constexpr size_t WS_END    = 454 * MiB;

struct Params {
    const float *x, *c; const int* pos;
    const float *ada_w, *ada_b, *pre_mix_g, *post_mix_g, *pre_ffn_g, *post_ffn_g;
    const float *w_in, *pool_w, *pool_scale, *q_norm_g, *w_uq, *kv_norm_g, *w_ukv, *w_out;
    const float *peer_wq, *sub_keys, *peer_u, *peer_v;
    float* out; char* ws;
    int wave_s;
};

__device__ __forceinline__ unsigned pk2(float lo, float hi) {
    typedef __bf16 bf2 __attribute__((ext_vector_type(2)));
    bf2 v; v[0] = (__bf16)lo; v[1] = (__bf16)hi; return __builtin_bit_cast(unsigned, v);
}
__device__ __forceinline__ float bflo(unsigned u) { return __uint_as_float(u << 16); }
__device__ __forceinline__ float bfhi(unsigned u) { return __uint_as_float(u & 0xffff0000u); }
__device__ __forceinline__ float bf2f(short b) { return __uint_as_float(((unsigned)(unsigned short)b) << 16); }
__device__ __forceinline__ short f2bf(float f) { return (short)(pk2(f, 0.f) & 0xffffu); }
__device__ __forceinline__ unsigned pack_i8x4(float a, float b, float c, float d) {
    unsigned r = 0u;
    r = __builtin_amdgcn_cvt_pk_u8_f32(a + 128.f, 0, r); r = __builtin_amdgcn_cvt_pk_u8_f32(b + 128.f, 1, r);
    r = __builtin_amdgcn_cvt_pk_u8_f32(c + 128.f, 2, r); r = __builtin_amdgcn_cvt_pk_u8_f32(d + 128.f, 3, r);
    return r ^ 0x80808080u;
}
__device__ __forceinline__ float wave_sum(float v) {
#pragma unroll
    for (int o = 1; o < 64; o <<= 1) v += __shfl_xor(v, o);
    return v;
}

#define XB_TMO      128
#define XB_XCNT(j)  (256  + 64 * (j))
#define XB_XSUB(j)  (1280 + 64 * (j))
#define XB_XGEN(j)  (2304 + 64 * (j))
#define XB_TOP      3328
#define XB_TOPGEN   3392
#define XCD_BAR_WORDS 3456
#define XB_SPIN_CAP (1u << 20)
#define LAS __attribute__((address_space(3)))
__device__ __forceinline__ int tidx_(int ws) { unsigned l = __builtin_amdgcn_mbcnt_lo(~0u, 0u); asm volatile("" : "+v"(l)); return (int)((unsigned)ws * 64u + __builtin_amdgcn_mbcnt_hi(~0u, l)); }
#define TIDX(ws_) tidx_(ws_)
__device__ __forceinline__ unsigned xb_ld(unsigned* p)              { return __hip_atomic_load(p, __ATOMIC_RELAXED, __HIP_MEMORY_SCOPE_AGENT); }
__device__ __forceinline__ unsigned xb_add(unsigned* p, unsigned v) { return __hip_atomic_fetch_add(p, v, __ATOMIC_RELAXED, __HIP_MEMORY_SCOPE_AGENT); }
__device__ __forceinline__ unsigned xb_xcc_id() { return (unsigned)__builtin_amdgcn_s_getreg((3 << 11) | 20) & 0xFu; }
#define XB_SPIN(cond, bar) do { unsigned _sp = 0; while (cond) { __builtin_amdgcn_s_sleep(1); \
    if ((++_sp & 255u) == 0u) { if (xb_ld(&(bar)[XB_TMO])) break; if (_sp > XB_SPIN_CAP) { atomicAdd(&(bar)[XB_TMO], 1u); break; } } } } while (0)
struct XcdBarrier { unsigned* bar; unsigned x; volatile LAS unsigned* st; int ws; };
__device__ __forceinline__ XcdBarrier xcd_barrier_post(unsigned* bar, volatile LAS unsigned* st, int ws) {
    XcdBarrier b; b.bar = bar; b.x = xb_xcc_id(); b.st = st; b.ws = ws;
    if (TIDX(ws) == 0) (void)xb_add(&bar[XB_XCNT(b.x)], 1u);
    return b;
}
__device__ __forceinline__ void xcd_barrier_complete(unsigned* bar, unsigned x, unsigned& nloc, unsigned& nx) {
    const unsigned G = gridDim.x * gridDim.y * gridDim.z;
    unsigned sum, cnt, mine, sp = 0u;
    for (;;) {
        sum = 0u; cnt = 0u; mine = 0u;
#pragma unroll
        for (unsigned j = 0; j < 16; ++j) { const unsigned c = xb_ld(&bar[XB_XCNT(j)]); sum += c; cnt += (c > 0u) ? 1u : 0u; mine = (j == x) ? c : mine; }
        if (sum == G) break;
        __builtin_amdgcn_s_sleep(1);
        if ((++sp & 255u) == 0u) { if (xb_ld(&bar[XB_TMO])) break; if (sp > XB_SPIN_CAP) { atomicAdd(&bar[XB_TMO], 1u); break; } }
    }
    nloc = mine > 0u ? mine : 1u; nx = cnt > 0u ? cnt : 1u;
}
__device__ __forceinline__ void xcd_barrier(const XcdBarrier& b) {
    asm volatile("s_waitcnt vmcnt(0)" ::: "memory");
    __syncthreads();
    if (TIDX(b.ws) == 0) {
        unsigned* bar = b.bar;
        __builtin_amdgcn_s_waitcnt(0);
        unsigned nloc = b.st[0], nx = b.st[1];
        if (nloc == 0u) { xcd_barrier_complete(bar, b.x, nloc, nx); b.st[0] = nloc; b.st[1] = nx; }
        const unsigned old = xb_add(&bar[XB_XSUB(b.x)], 1u);
        const unsigned gen = old / nloc;
        if (old + 1u == (gen + 1u) * nloc) {
            __builtin_amdgcn_fence(__ATOMIC_RELEASE, "agent");
            asm volatile("s_waitcnt vmcnt(0)" ::: "memory");
            const unsigned og = xb_add(&bar[XB_TOP], 1u);
            const unsigned tg = og / nx;
            if (og + 1u == (tg + 1u) * nx) xb_add(&bar[XB_TOPGEN], 1u);
            else XB_SPIN(xb_ld(&bar[XB_TOPGEN]) == tg, bar);
            __builtin_amdgcn_fence(__ATOMIC_ACQUIRE, "agent");
            xb_add(&bar[XB_XGEN(b.x)], 1u);
            asm volatile("s_waitcnt vmcnt(0)" ::: "memory");
        } else {
            XB_SPIN(xb_ld(&bar[XB_XGEN(b.x)]) == gen, bar);
            __builtin_amdgcn_fence(__ATOMIC_ACQUIRE, "agent");
            asm volatile("s_waitcnt vmcnt(0)" ::: "memory");
        }
    }
    __syncthreads();
}

constexpr int G_BK = 64, G_HALF = 128, G_HT = G_HALF * G_BK;
__device__ __forceinline__ int lds_byte(int r, int c) {
    int st = (r >> 4) * 2 + (c >> 5), rr = r & 15, cc = c & 31, ob = rr * 64 + cc * 2;
    return st * 1024 + (ob ^ (((ob >> 9) & 1) << 5));
}
__device__ __forceinline__ void stage_rc(int b, int& R, int& C) {
    int st = b / 1024, sb = b % 1024, swz = sb ^ (((sb >> 9) & 1) << 5);
    R = (st >> 1) * 16 + swz / 64; C = (st & 1) * 32 + (swz % 64) / 2;
}

template <bool NOSWAP, bool I8, class A_>
__device__ __forceinline__ A_ mma1(bf16x8 a, bf16x8 b, A_ c);
template <> __device__ __forceinline__ f32x4 mma1<false, false, f32x4>(bf16x8 a, bf16x8 b, f32x4 c) { return __builtin_amdgcn_mfma_f32_16x16x32_bf16(b, a, c, 0, 0, 0); }
template <> __device__ __forceinline__ f32x4 mma1<true, false, f32x4>(bf16x8 a, bf16x8 b, f32x4 c) { return __builtin_amdgcn_mfma_f32_16x16x32_bf16(a, b, c, 0, 0, 0); }
template <> __device__ __forceinline__ i32x4 mma1<false, true, i32x4>(bf16x8 a, bf16x8 b, i32x4 c) { return __builtin_amdgcn_mfma_i32_16x16x64_i8(__builtin_bit_cast(i32x4, b), __builtin_bit_cast(i32x4, a), c, 0, 0, 0); }
template <> __device__ __forceinline__ i32x4 mma1<true, true, i32x4>(bf16x8 a, bf16x8 b, i32x4 c) { return __builtin_amdgcn_mfma_i32_16x16x64_i8(__builtin_bit_cast(i32x4, a), __builtin_bit_cast(i32x4, b), c, 0, 0, 0); }

template <bool NOSWAP, bool I8, bool F8, class A_>
__device__ __forceinline__ A_ mma2(i32x8 a, i32x8 b, A_ c) {
    if constexpr (F8) {
        if constexpr (NOSWAP) return __builtin_amdgcn_mfma_scale_f32_16x16x128_f8f6f4(a, b, c, 0, 0, 0, 0, 0, 0);
        else return __builtin_amdgcn_mfma_scale_f32_16x16x128_f8f6f4(b, a, c, 0, 0, 0, 0, 0, 0);
    } else {
        const bf16x8 a0 = __builtin_bit_cast(bf16x8, __builtin_shufflevector(a, a, 0, 1, 2, 3)), a1 = __builtin_bit_cast(bf16x8, __builtin_shufflevector(a, a, 4, 5, 6, 7));
        const bf16x8 b0 = __builtin_bit_cast(bf16x8, __builtin_shufflevector(b, b, 0, 1, 2, 3)), b1 = __builtin_bit_cast(bf16x8, __builtin_shufflevector(b, b, 4, 5, 6, 7));
        c = mma1<NOSWAP, I8, A_>(a0, b0, c);
        return mma1<NOSWAP, I8, A_>(a1, b1, c);
    }
}
constexpr int EPI_NST_MIN = 12;
struct NextTile { const bf16_t* A; const bf16_t* Bt; int lda, ldb, brow, bcol; };
template <bool VT1, bool I8, bool F8 = false, class Epi>
__device__ __forceinline__ void gemm_tile(const bf16_t* __restrict__ A, int lda, const bf16_t* __restrict__ Bt, int ldb, int nt,
                                          int brow, int bcol, char* shmc, const Epi& epi, bool pre, const NextTile nx, int ws_) {
    bf16_t* shm = (bf16_t*)shmc;
    asm volatile("" : "+s"(nt));
#define SA(b,h) (shm+((b)*2+(h))*G_HT)
#define SB(b,h) (shm+(4+(b)*2+(h))*G_HT)
#define STAGE_X(OFF,LOFF,P,RS,LD,br,kt) do{ const int _so=((br)*(LD)+(kt)*G_BK)*2; \
    __builtin_amdgcn_raw_ptr_buffer_load_lds(RS, (__attribute__((address_space(3))) void*)((char*)(P)+(LOFF)),16,(int)(OFF),_so,0,0); \
    __builtin_amdgcn_raw_ptr_buffer_load_lds(RS, (__attribute__((address_space(3))) void*)((char*)(P)+(LOFF)+8192),16,(int)(OFF),_so+128*(LD),0,0);}while(0)
#define STAGE_A(P,br,kt) STAGE_X(offA,lwv,P,rsA,lda,br,kt)
#define STAGE_B(P,br,kt) STAGE_X(offB,lwv,P,rsB,ldb,br,kt)
#define LDF(base_,off_) (*reinterpret_cast<const i32x4*>((base_)+(off_)))
#define LDA(dst,b,h) _Pragma("unroll") for(int m=0;m<4;++m) \
    dst[m]=__builtin_shufflevector(LDF(fa_base,((b)*2+(h))*16384+m*2048),LDF(fa_base,((b)*2+(h))*16384+m*2048+1024),0,1,2,3,4,5,6,7)
#define LDB(dst,b,h) _Pragma("unroll") for(int n=0;n<2;++n) \
    dst[n]=__builtin_shufflevector(LDF(fb_base,((b)*2+(h))*16384+n*2048),LDF(fb_base,((b)*2+(h))*16384+n*2048+1024),0,1,2,3,4,5,6,7)
#define MMA(ai,bj,At_,Bt_) do{__builtin_amdgcn_s_setprio(1); \
    _Pragma("unroll") for(int m=0;m<4;++m) _Pragma("unroll") for(int n=0;n<2;++n) \
      acc[ai][bj][m][n]=mma2<VT1 && (bj)==1, I8, F8, typename AccT<I8>::type>(At_[m],Bt_[n],acc[ai][bj][m][n]); \
    __builtin_amdgcn_s_setprio(0);}while(0)
#define WAIT_V(n) asm volatile("s_waitcnt vmcnt(" #n ")":::"memory")
#define WAIT_L(n) asm volatile("s_waitcnt lgkmcnt(" #n ")":::"memory")
#define BAR __builtin_amdgcn_s_barrier()
#define SCHED __builtin_amdgcn_sched_barrier(0)
    int t0 = TIDX(ws_); asm volatile("" : "+v"(t0));
    int wid = t0 >> 6, lane = t0 & 63, wr = wid >> 2, wc = wid & 3, fr = lane & 15, fq = lane >> 4;
    typename AccT<I8>::type acc[2][2][4][2] = {};
    const char* fa_base = (const char*)shm + lds_byte(wr * 64 + fr, fq * 8);
    const char* fb_base = (const char*)shm + 65536 + lds_byte(wc * 32 + fr, fq * 8);
    i32x8 At[4], B0[2], B1[2];
    int loff = t0 * 16;
    const int lwv = __builtin_amdgcn_readfirstlane(t0 >> 6) * 1024;
    unsigned offA, offB;
    const __amdgpu_buffer_rsrc_t rsA = __builtin_amdgcn_make_buffer_rsrc((void*)A, (short)0, -1, 0x00020000);
    const __amdgpu_buffer_rsrc_t rsB = __builtin_amdgcn_make_buffer_rsrc((void*)Bt, (short)0, -1, 0x00020000);
    { int r_, c_; stage_rc(loff, r_, c_); offA = (unsigned)(r_ * lda + c_) * 2;
      const int i_ = r_ & 15, n_ = (r_ >> 4) & 1;
      offB = (unsigned)(((r_ & ~31) + 8 * (i_ >> 2) + 4 * n_ + (i_ & 3)) * ldb + c_) * 2; }
    if (!pre) {
        STAGE_B(SB(0,0),bcol,0); STAGE_A(SA(0,0),brow,0);
        STAGE_B(SB(0,1),bcol+G_HALF,0); STAGE_A(SA(0,1),brow+G_HALF,0);
        if (wr == 1) BAR;
        WAIT_V(4); BAR;
        STAGE_B(SB(1,0),bcol,1); STAGE_A(SA(1,0),brow,1); STAGE_B(SB(1,1),bcol+G_HALF,1);
        WAIT_V(6); BAR;
    } else {
        if (wr == 1) BAR;
        asm volatile("s_waitcnt vmcnt(%0)" :: "n"(EPI_NST_MIN + 10) : "memory"); BAR;
        asm volatile("s_waitcnt vmcnt(%0)" :: "n"(EPI_NST_MIN + 6) : "memory"); BAR;
    }
    for (int t = 0; t < nt - 2; t += 2) {
        LDB(B0,0,0); SCHED; LDA(At,0,0); STAGE_A(SA(1,1),brow+G_HALF,t+1);
        WAIT_L(8); BAR; WAIT_L(0); MMA(0,0,At,B0); BAR; SCHED;
        LDB(B1,0,1); STAGE_B(SB(0,0),bcol,t+2);
        BAR; WAIT_L(0); MMA(0,1,At,B1); BAR;
        LDA(At,0,1); STAGE_A(SA(0,0),brow,t+2);
        BAR; WAIT_L(0); MMA(1,0,At,B0); BAR; SCHED;
        STAGE_B(SB(0,1),bcol+G_HALF,t+2);
        WAIT_V(6); BAR; MMA(1,1,At,B1); BAR;
        LDB(B0,1,0); SCHED; LDA(At,1,0); STAGE_A(SA(0,1),brow+G_HALF,t+2);
        WAIT_L(8); BAR; WAIT_L(0); MMA(0,0,At,B0); BAR; SCHED;
        LDB(B1,1,1); STAGE_B(SB(1,0),bcol,t+3);
        BAR; WAIT_L(0); MMA(0,1,At,B1); BAR;
        LDA(At,1,1); STAGE_A(SA(1,0),brow,t+3);
        BAR; WAIT_L(0); MMA(1,0,At,B0); BAR; SCHED;
        STAGE_B(SB(1,1),bcol+G_HALF,t+3);
        WAIT_V(6); BAR; MMA(1,1,At,B1); BAR;
    }
    int tz = TIDX(ws_); asm volatile("" : "+v"(tz)); wid = tz >> 6; lane = tz & 63; wr = wid >> 2; wc = wid & 3; fr = lane & 15; fq = lane >> 4;
    loff = tz * 16;
    fa_base = (const char*)shm + lds_byte(wr * 64 + fr, fq * 8); fb_base = (const char*)shm + 65536 + lds_byte(wc * 32 + fr, fq * 8);
    { int r_, c_; stage_rc(loff, r_, c_); offA = (unsigned)(r_ * lda + c_) * 2; }
    { LDB(B0,0,0); WAIT_V(0); LDA(At,0,0); STAGE_A(SA(1,1),brow+G_HALF,nt-1);
      BAR; WAIT_L(0); MMA(0,0,At,B0); BAR;
      LDB(B1,0,1); BAR; WAIT_L(0); MMA(0,1,At,B1); BAR;
      LDA(At,0,1); WAIT_V(4); BAR; WAIT_L(0); MMA(1,0,At,B0); MMA(1,1,At,B1); BAR; }
    { LDB(B0,1,0); LDA(At,1,0); WAIT_V(2); BAR; WAIT_L(0); MMA(0,0,At,B0); BAR;
      LDB(B1,1,1); WAIT_V(0); BAR; WAIT_L(0); MMA(0,1,At,B1); BAR;
      LDA(At,1,1); BAR; WAIT_L(0); MMA(1,0,At,B0); MMA(1,1,At,B1); BAR; }
    if (wr == 0) BAR;
    { int te = TIDX(ws_); asm volatile("" : "+v"(te)); wid = te >> 6; lane = te & 63; wr = wid >> 2; wc = wid & 3; fr = lane & 15; fq = lane >> 4; loff = te * 16; }
    typename Epi::Pre pre_;
    epi.preload(pre_, brow + wr * 64 + fr, bcol + wc * 32 + fq * 8, brow + wr * 64 + fq * 4);
    if (nx.brow >= 0) {
        int r_, c_; stage_rc(loff, r_, c_);
        const int i_ = r_ & 15, n_ = (r_ >> 4) & 1;
        const unsigned offA2 = (unsigned)(r_ * nx.lda + c_) * 2;
        const unsigned offB2 = (unsigned)(((r_ & ~31) + 8 * (i_ >> 2) + 4 * n_ + (i_ & 3)) * nx.ldb + c_) * 2;
        const __amdgpu_buffer_rsrc_t rsA2 = __builtin_amdgcn_make_buffer_rsrc((void*)nx.A, (short)0, -1, 0x00020000);
        const __amdgpu_buffer_rsrc_t rsB2 = __builtin_amdgcn_make_buffer_rsrc((void*)nx.Bt, (short)0, -1, 0x00020000);
#define NXT_A(P,h,k) STAGE_X(offA2,lwv,P,rsA2,nx.lda,nx.brow+(h),k)
#define NXT_B(P,h,k) STAGE_X(offB2,lwv,P,rsB2,nx.ldb,nx.bcol+(h),k)
        NXT_B(SB(0,0),0,0); NXT_A(SA(0,0),0,0); NXT_B(SB(0,1),G_HALF,0); NXT_A(SA(0,1),G_HALF,0);
        NXT_B(SB(1,0),0,1); NXT_A(SA(1,0),0,1); NXT_B(SB(1,1),G_HALF,1);
#undef NXT_A
#undef NXT_B
    }
#pragma unroll
    for (int ai = 0; ai < 2; ++ai)
#pragma unroll
    for (int m = 0; m < 4; ++m) {
#pragma unroll
        for (int bj = 0; bj < 2; ++bj) {
            if (VT1 && bj == 1) {
                if (m == 3) {
#pragma unroll
                    for (int n = 0; n < 2; ++n)
                        epi.storeT(pre_, ai, brow + ai * G_HALF + wr * 64, bcol + bj * G_HALF + wc * 32 + 8 * (fr >> 2) + 4 * n + (fr & 3), fq,
                                   acc[ai][bj][0][n], acc[ai][bj][1][n], acc[ai][bj][2][n], acc[ai][bj][3][n]);
                }
            } else {
                epi.store8(pre_, ai, m, bj, brow + ai * G_HALF + wr * 64 + m * 16 + fr, bcol + bj * G_HALF + wc * 32 + fq * 8, acc[ai][bj][m][0], acc[ai][bj][m][1]);
            }
        }
        asm volatile("" ::: "memory");
    }
    if (nx.brow < 0) __syncthreads();
#undef SA
#undef SB
#undef STAGE_X
#undef STAGE_A
#undef STAGE_B
#undef LDA
#undef LDF
#undef LDB
#undef MMA
#undef WAIT_V
#undef WAIT_L
#undef BAR
#undef SCHED
}

__device__ __forceinline__ void st4bf(bf16_t* p, f32x4 v) {
    u32x2 o; o.x = pk2(v[0], v[1]); o.y = pk2(v[2], v[3]); *reinterpret_cast<u32x2*>(p) = o;
}
__device__ __forceinline__ void st8bf(bf16_t* p, f32x4 a, f32x4 b) {
    u32x4 o; o.x = pk2(a[0], a[1]); o.y = pk2(a[2], a[3]); o.z = pk2(b[0], b[1]); o.w = pk2(b[2], b[3]); *reinterpret_cast<u32x4*>(p) = o;
}
struct EpiBf16 {
    bf16_t* C; int ldc; float sc;
    static constexpr int NST = 16;
    struct Pre {};
    __device__ __forceinline__ void preload(Pre&, int, int, int) const {}
    __device__ __forceinline__ void store8(const Pre&, int, int, int, int row, int col, f32x4 a, f32x4 b) const { st8bf(C + (size_t)row * ldc + col, a * sc, b * sc); }
    __device__ __forceinline__ void storeT(const Pre&, int, int, int, int, f32x4, f32x4, f32x4, f32x4) const {}
};
struct EpiI8 {
    bf16_t* C; int ldc; const float* rs; const float* cs; char* c8;
    static constexpr int NST = 16;
    struct Pre { float r[8]; f32x4 c[2][2]; };
    __device__ __forceinline__ void preload(Pre& q, int rowb, int colb, int) const {
#pragma unroll
        for (int i = 0; i < 8; ++i) q.r[i] = rs[rowb + (i >> 2) * 128 + (i & 3) * 16];
#pragma unroll
        for (int bj = 0; bj < 2; ++bj) { q.c[bj][0] = *reinterpret_cast<const f32x4*>(cs + colb + bj * 128); q.c[bj][1] = *reinterpret_cast<const f32x4*>(cs + colb + bj * 128 + 4); }
    }
    __device__ __forceinline__ void store8(const Pre& q, int ai, int m, int bj, int row, int col, i32x4 a, i32x4 b) const {
        const float r = q.r[ai * 4 + m];
        f32x4 fa = {(float)a[0], (float)a[1], (float)a[2], (float)a[3]}, fb = {(float)b[0], (float)b[1], (float)b[2], (float)b[3]};
        fa = fa * q.c[bj][0] * r; fb = fb * q.c[bj][1] * r;
        st8bf(C + (size_t)row * ldc + col, fa, fb);
        const int pn = __builtin_amdgcn_readfirstlane(col >> 8);
        if (c8 != nullptr && pn >= 4 && pn < 7) {
            u32x2 w = {(unsigned)pk_fp8x4(fa[0], fa[1], fa[2], fa[3]), (unsigned)pk_fp8x4(fb[0], fb[1], fb[2], fb[3])};
            *reinterpret_cast<u32x2*>(c8 + (size_t)row * 768 + (col - 1024)) = w;
        }
    }
    __device__ __forceinline__ void storeT(const Pre&, int, int, int, int, i32x4, i32x4, i32x4, i32x4) const {}
};
struct EpiPool {
    bf16_t* C; const float* scale; int gcol0;
    static constexpr int NST = 16;
    struct Pre { f32x4 s[2][2]; };
    __device__ __forceinline__ void preload(Pre& q, int, int colb, int) const {
#pragma unroll
        for (int bj = 0; bj < 2; ++bj) { q.s[bj][0] = *reinterpret_cast<const f32x4*>(scale + gcol0 + colb + bj * 128); q.s[bj][1] = *reinterpret_cast<const f32x4*>(scale + gcol0 + colb + bj * 128 + 4); }
    }
    __device__ __forceinline__ void store8(const Pre& q, int, int, int bj, int row, int col, f32x4 a, f32x4 b) const {
        a = a * q.s[bj][0] * (1.f / 16.f); b = b * q.s[bj][1] * (1.f / 16.f);
        u32x2 w = {(unsigned)pk_fp8x4(a[0], a[1], a[2], a[3]), (unsigned)pk_fp8x4(b[0], b[1], b[2], b[3])};
        *reinterpret_cast<u32x2*>((char*)C + (size_t)row * DM + gcol0 + col) = w;
    }
    __device__ __forceinline__ void storeT(const Pre&, int, int, int, int, f32x4, f32x4, f32x4, f32x4) const {}
};
struct EpiQ {
    bf16_t* C; const float* rstd;
    static constexpr int NST = 16;
    struct Pre { float r[8]; };
    __device__ __forceinline__ void preload(Pre& q, int rowb, int, int) const {
#pragma unroll
        for (int i = 0; i < 8; ++i) q.r[i] = rstd[rowb + (i >> 2) * 128 + (i & 3) * 16] * (0.07216878364870322f * 1.4426950408889634f / 16.f);
    }
    __device__ __forceinline__ void store8(const Pre& q, int ai, int m, int, int row, int col, f32x4 a, f32x4 b) const {
        const float s = q.r[ai * 4 + m];
        st8bf(C + (size_t)row * 1536 + col, a * s, b * s);
    }
    __device__ __forceinline__ void storeT(const Pre&, int, int, int, int, f32x4, f32x4, f32x4, f32x4) const {}
};
struct EpiKV {
    bf16_t* Kn; bf16_t* Vt; const float* rstd;
    static constexpr int NST = 12;
    struct Pre { float r[8]; f32x4 rt[8]; };
    __device__ __forceinline__ void preload(Pre& q, int rowb, int, int rowbT) const {
#pragma unroll
        for (int i = 0; i < 8; ++i) { q.r[i] = rstd[rowb + (i >> 2) * 128 + (i & 3) * 16] * (1.f / 16.f); q.rt[i] = *reinterpret_cast<const f32x4*>(rstd + rowbT + (i >> 2) * 128 + (i & 3) * 16) * (1.f / 16.f); }
    }
    __device__ __forceinline__ void store8(const Pre& q, int ai, int m, int, int row, int col, f32x4 a, f32x4 b) const {
        int head = col >> 8, d = col & 127; const float r = q.r[ai * 4 + m];
        u32x2 w = {(unsigned)pk_fp8x4(a[0] * r, a[1] * r, a[2] * r, a[3] * r), (unsigned)pk_fp8x4(b[0] * r, b[1] * r, b[2] * r, b[3] * r)};
        *reinterpret_cast<u32x2*>((char*)Kn + (size_t)row * 1024 + head * 128 + d) = w;
    }
    __device__ __forceinline__ void storeT(const Pre& q, int ai, int rbase, int col, int fq, f32x4 v0, f32x4 v1, f32x4 v2, f32x4 v3) const {
        int head = col >> 8, d = col & 127, b = rbase >> 11, s = rbase & 2047;
        const f32x4 r0 = q.rt[ai * 4 + 0], r1 = q.rt[ai * 4 + 1], r2 = q.rt[ai * 4 + 2], r3 = q.rt[ai * 4 + 3];
        u32x4 w;
        w.x = (unsigned)pk_fp8x4(v0[0] * r0[0], v0[1] * r0[1], v0[2] * r0[2], v0[3] * r0[3]);
        w.y = (unsigned)pk_fp8x4(v1[0] * r1[0], v1[1] * r1[1], v1[2] * r1[2], v1[3] * r1[3]);
        w.z = (unsigned)pk_fp8x4(v2[0] * r2[0], v2[1] * r2[1], v2[2] * r2[2], v2[3] * r2[3]);
        w.w = (unsigned)pk_fp8x4(v3[0] * r3[0], v3[1] * r3[1], v3[2] * r3[2], v3[3] * r3[3]);
        *reinterpret_cast<u32x4*>((char*)Vt + ((size_t)((b * 8 + head) * 128 + d)) * SEQ + s + 32 * (fq & 1) + 16 * (fq >> 1)) = w;
    }
};

__device__ __forceinline__ int vcu_of(int bid, int nb) { return (nb % 8 == 0) ? (bid % 8) * (nb / 8) + bid / 8 : bid; }

__device__ __forceinline__ void xpose_item(const float* __restrict__ W, int K, int N, bf16_t* __restrict__ WT, int ldt, float* scr, int item, int lane,
                                           const float* __restrict__ rowscale) {
    const int nblk = N / 32, kb = item / nblk, nb = item % nblk, k0 = 64 * kb, n0 = 32 * nb;
#pragma unroll 8
    for (int i = 0; i < 32; ++i) {
        const int kk = 2 * i + (lane >> 5);
        float w = W[(size_t)(k0 + kk) * N + n0 + (lane & 31)];
        if (rowscale) w *= rowscale[k0 + kk];
        scr[kk * 33 + (lane & 31)] = w;
    }
    __builtin_amdgcn_s_waitcnt(0xc07f); asm volatile("" ::: "memory");
    const int c = lane & 7;
#pragma unroll
    for (int j = 0; j < 4; ++j) {
        const int n = (lane >> 3) + 8 * j; const float* s = scr + (8 * c) * 33 + n;
        u32x4 o; o.x = pk2(s[0 * 33], s[1 * 33]); o.y = pk2(s[2 * 33], s[3 * 33]); o.z = pk2(s[4 * 33], s[5 * 33]); o.w = pk2(s[6 * 33], s[7 * 33]);
        *reinterpret_cast<u32x4*>(WT + (size_t)(n0 + n) * ldt + k0 + 8 * c) = o;
    }
    __builtin_amdgcn_s_waitcnt(0xc07f); asm volatile("" ::: "memory");
}
__device__ __forceinline__ void xposef8_item(const float* __restrict__ W, int K, int N, char* __restrict__ WT8, int ldt, float* scr, int item, int lane, float mul,
                                             const float* __restrict__ rowscale = nullptr) {
    const int nblk = N / 32, kb = item / nblk, nb = item % nblk, k0 = 64 * kb, n0 = 32 * nb;
#pragma unroll 8
    for (int i = 0; i < 32; ++i) {
        const int kk = 2 * i + (lane >> 5);
        float w = W[(size_t)(k0 + kk) * N + n0 + (lane & 31)] * mul;
        if (rowscale) w *= rowscale[k0 + kk];
        scr[kk * 33 + (lane & 31)] = w;
    }
    __builtin_amdgcn_s_waitcnt(0xc07f); asm volatile("" ::: "memory");
    const int c = lane & 7;
#pragma unroll
    for (int j = 0; j < 4; ++j) {
        const int n = (lane >> 3) + 8 * j; const float* s = scr + (8 * c) * 33 + n;
        u32x2 o;
        o.x = (unsigned)pk_fp8x4(s[0 * 33], s[1 * 33], s[2 * 33], s[3 * 33]); o.y = (unsigned)pk_fp8x4(s[4 * 33], s[5 * 33], s[6 * 33], s[7 * 33]);
        *reinterpret_cast<u32x2*>(WT8 + (size_t)(n0 + n) * ldt + k0 + 8 * c) = o;
    }
    __builtin_amdgcn_s_waitcnt(0xc07f); asm volatile("" ::: "memory");
}
__device__ __forceinline__ void xpose8_item(const float* __restrict__ W, int N, char* __restrict__ WT8, float* scr, int item, int lane,
                                            const unsigned* __restrict__ cmax, float* __restrict__ wsc) {
    const int nblk = N / 32, kb = item / nblk, nb = item % nblk, k0 = 64 * kb, n0 = 32 * nb;
    const float cm = __uint_as_float(cmax[n0 + (lane & 31)]);
    const float qm = cm > 0.f ? 127.f / cm : 0.f;
    if (kb == 0 && lane < 32) wsc[n0 + lane] = cm * (1.f / 127.f);
#pragma unroll 8
    for (int i = 0; i < 32; ++i) {
        const int kk = 2 * i + (lane >> 5);
        scr[kk * 33 + (lane & 31)] = W[(size_t)(k0 + kk) * N + n0 + (lane & 31)] * qm;
    }
    __builtin_amdgcn_s_waitcnt(0xc07f); asm volatile("" ::: "memory");
    const int c = lane & 7;
#pragma unroll
    for (int j = 0; j < 4; ++j) {
        const int n = (lane >> 3) + 8 * j; const float* s = scr + (8 * c) * 33 + n;
        u32x2 o;
        o.x = pack_i8x4(s[0 * 33], s[1 * 33], s[2 * 33], s[3 * 33]); o.y = pack_i8x4(s[4 * 33], s[5 * 33], s[6 * 33], s[7 * 33]);
        *reinterpret_cast<u32x2*>(WT8 + (size_t)(n0 + n) * 2048 + k0 + 8 * c) = o;
    }
    __builtin_amdgcn_s_waitcnt(0xc07f); asm volatile("" ::: "memory");
}
__device__ __forceinline__ void cvt_bf16_range(const float* __restrict__ src, bf16_t* __restrict__ dst, size_t n8, size_t gtid, size_t gthreads) {
    for (size_t i = gtid; i < n8; i += gthreads) {
        f32x4 a = *reinterpret_cast<const f32x4*>(src + i * 8), b = *reinterpret_cast<const f32x4*>(src + i * 8 + 4);
        u32x4 o; o.x = pk2(a[0], a[1]); o.y = pk2(a[2], a[3]); o.z = pk2(b[0], b[1]); o.w = pk2(b[2], b[3]);
        *reinterpret_cast<u32x4*>(dst + i * 8) = o;
    }
}
__device__ __forceinline__ void phase0(const Params& p, char* shm, int bid, int nb) {
    const int tid = TIDX(p.wave_s), wave = tid >> 6, lane = tid & 63;
    char* ws = p.ws;
#ifndef DUP_P0
#define DUP_P0 (-1)
#endif
    for (int rp_ = 0; rp_ < (DUP_P0 == 0 ? 2 : 1); ++rp_)
    {
        float* sl = (float*)shm;
        float* red = (float*)(shm + 65536);
        float* mod = (float*)(ws + WS_MOD);
        if (bid < 192 || nb != 256) {
            for (int i = tid; i < 8 * DM; i += NTHREADS) { float cv = p.c[i]; sl[i] = cv / (1.f + __expf(-cv)); }
            __syncthreads();
            for (int it = bid; it < 192; it += nb) {
                const int col = it * 64 + lane;
                float acc[8];
#pragma unroll
                for (int b = 0; b < 8; ++b) acc[b] = 0.f;
                const float* wp = p.ada_w + (size_t)(wave * 256) * 12288 + col;
                const float* sp = sl + wave * 256;
#pragma unroll 1
                for (int r0 = 0; r0 < 256; r0 += 32) {
                    float w[32];
#pragma unroll
                    for (int i = 0; i < 32; ++i) w[i] = wp[(size_t)(r0 + i) * 12288];
#pragma unroll
                    for (int q = 0; q < 8; ++q)
#pragma unroll
                        for (int b = 0; b < 8; ++b) {
                            const f32x4 s4 = *reinterpret_cast<const f32x4*>(sp + b * DM + r0 + 4 * q);
                            acc[b] += w[4 * q] * s4[0] + w[4 * q + 1] * s4[1] + w[4 * q + 2] * s4[2] + w[4 * q + 3] * s4[3];
                        }
                }
#pragma unroll
                for (int b = 0; b < 8; ++b) red[(wave * 8 + b) * 64 + lane] = acc[b];
                __syncthreads();
                {
                    const int b = tid >> 6, cl = tid & 63;
                    float sum = 0.f;
#pragma unroll
                    for (int w = 0; w < 8; ++w) sum += red[(w * 8 + b) * 64 + cl];
                    mod[b * 12288 + it * 64 + cl] = sum + p.ada_b[it * 64 + cl];
                }
                __syncthreads();
            }
        }
    }
    const int gw = bid * NWAVES + wave, ngw = nb * NWAVES;
    const size_t gtid = (size_t)bid * NTHREADS + tid, gthreads = (size_t)nb * NTHREADS;
    for (int rp_ = 0; rp_ < (DUP_P0 == 1 ? 2 : 1); ++rp_)
    {
        float* scr = (float*)(shm + wave * 8448);
        constexpr int I_POOL = 4 * 4 * 8, I_UQ = 8 * 48, I_UKV = 4 * 64, I_OUT = 32 * 64;
        constexpr int NIT = I_POOL + I_UQ + I_UKV + I_OUT;
        for (int it = gw; it < NIT; it += ngw) {
            int r = it;
            if (r < I_POOL) { int g = r / 32; xposef8_item(p.pool_w + g * 65536, 256, 256, ws + WS_WPOOL + g * 65536, 256, scr, r % 32, lane, 16.f); continue; } r -= I_POOL;
            if (r < I_UQ) { xposef8_item(p.w_uq, 512, 1536, ws + WS_WUQ, 512, scr, r, lane, 16.f, p.q_norm_g); continue; } r -= I_UQ;
            if (r < I_UKV) { xposef8_item(p.w_ukv, 256, 2048, ws + WS_WUKV, 256, scr, r, lane, 16.f, p.kv_norm_g); continue; } r -= I_UKV;
            xposef8_item(p.w_out, 2048, 2048, ws + WS_WOUT, 2048, scr, r, lane, 32.f);
        }
        unsigned* cmax = (unsigned*)(ws + WS_CMAX);
        for (int it = gw; it < (29 + 32) * 16; it += ngw) {
            const int strip = it >> 4, kc = it & 15;
            const bool isq = strip >= 29;
            const int n = (isq ? strip - 29 : strip) * 64 + lane, N = isq ? 2048 : 1856;
            const float* wp = (isq ? p.peer_wq : p.w_in) + (size_t)(kc * 128) * N + n;
            float m = 0.f;
#pragma unroll 32
            for (int r = 0; r < 128; ++r) m = fmaxf(m, fabsf(wp[(size_t)r * N]));
            atomicMax(cmax + (isq ? 2048 : 0) + n, __float_as_uint(m));
        }
    }
    cvt_bf16_range(p.sub_keys, (bf16_t*)(ws + WS_SK), 262144 / 8, gtid, gthreads);
    for (int rp_ = 0; rp_ < (DUP_P0 == 2 ? 2 : 1); ++rp_)
    {
        float* tile = (float*)shm;
        float* redm = (float*)(shm + 16 * 2052 * 4);
        float* scl = redm + 128;
        int ntl, tfirst, tstep;
        if (nb == 256) { if (bid < 192) { ntl = 7; tfirst = bid * 7; } else { ntl = 11; tfirst = 192 * 7 + (bid - 192) * 11; } tstep = 1; }
        else { ntl = (2048 - bid + nb - 1) / nb; tfirst = bid; tstep = nb; }
#define Q_LOAD(dst, i_) do { const int itl_ = tfirst + (i_) * tstep; \
            const float* src_ = ((itl_ >> 10) ? p.peer_v : p.peer_u) + (size_t)((itl_ & 1023) * 16) * DM; \
            _Pragma("unroll") for (int k = 0; k < 16; ++k) dst[k] = *reinterpret_cast<const f32x4*>(reinterpret_cast<const char*>(src_ + (size_t)k * DM) + qoff); } while (0)
#define Q_TILE(vs, i_) do { \
            const int it = tfirst + (i_) * tstep; \
            const int isv = it >> 10, e0 = (it & 1023) * 16; \
            float mx[16]; \
            _Pragma("unroll") for (int k = 0; k < 16; ++k) { \
                *reinterpret_cast<f32x4*>(tile + k * 2052 + tid * 4) = vs[k]; \
                mx[k] = fmaxf(fmaxf(fabsf(vs[k][0]), fabsf(vs[k][1])), fmaxf(fabsf(vs[k][2]), fabsf(vs[k][3]))); \
            } \
            if ((i_) + 1 < ntl) Q_LOAD(vs, (i_) + 1); \
            _Pragma("unroll") for (int k = 0; k < 16; ++k) { \
                _Pragma("unroll") for (int o = 1; o < 64; o <<= 1) mx[k] = fmaxf(mx[k], __shfl_xor(mx[k], o)); \
            } \
            if (lane == 0) { _Pragma("unroll") for (int k = 0; k < 16; ++k) redm[wave * 16 + k] = mx[k]; } \
            __syncthreads(); \
            if (tid < 16) { \
                float m = 0.f; \
                _Pragma("unroll") for (int w = 0; w < 8; ++w) m = fmaxf(m, redm[w * 16 + tid]); \
                const float top = isv ? 256.f : 127.f; \
                scl[tid] = m > 0.f ? top / m : 0.f; \
                ((float*)(ws + (isv ? WS_SV : WS_SU)))[e0 + tid] = m / top; \
            } \
            __syncthreads(); \
            char* dst = ws + (isv ? WS_V8 : WS_U8); \
            _Pragma("unroll") for (int k = 0; k < 8; ++k) { \
                const int item = tid + k * NTHREADS, e = item & 15, sl = item >> 4; \
                const float* tp = tile + e * 2052 + sl * 8; \
                f32x4 a = *reinterpret_cast<const f32x4*>(tp), c = *reinterpret_cast<const f32x4*>(tp + 4); \
                const float m = scl[e]; \
                u32x2 o; \
                if (isv) { \
                    int w0 = __builtin_amdgcn_cvt_pk_fp8_f32(a[0] * m, a[1] * m, 0, false); \
                    w0 = __builtin_amdgcn_cvt_pk_fp8_f32(a[2] * m, a[3] * m, w0, true); \
                    int w1 = __builtin_amdgcn_cvt_pk_fp8_f32(c[0] * m, c[1] * m, 0, false); \
                    w1 = __builtin_amdgcn_cvt_pk_fp8_f32(c[2] * m, c[3] * m, w1, true); \
                    o.x = (unsigned)w0; o.y = (unsigned)w1; \
                } else { \
                    o.x = pack_i8x4(a[0] * m, a[1] * m, a[2] * m, a[3] * m); o.y = pack_i8x4(c[0] * m, c[1] * m, c[2] * m, c[3] * m); \
                } \
                *reinterpret_cast<u32x2*>(dst + ((size_t)sl * 16384 + e0 + e) * 8) = o; \
                if (k & 1) __builtin_amdgcn_sched_barrier(0); \
            } \
            __syncthreads(); } while (0)
        f32x4 va[16];
        const unsigned qoff = (unsigned)tid * 16u;
        Q_LOAD(va, 0);
        __syncthreads();
#pragma unroll 1
        for (int i = 0; i < ntl; ++i) Q_TILE(va, i);
#undef Q_LOAD
#undef Q_TILE
    }
    {
        float2* cs = (float2*)(ws + WS_CS);
        for (size_t i = gtid; i < (size_t)NTOK * 32; i += gthreads) {
            int t = (int)(i >> 5), k = (int)(i & 31);
            float invf = exp2f(-(float)k * (13.287712379549449f / 32.f));
            float ang = (float)p.pos[t] * invf;
            double sd, cd; sincos((double)ang, &sd, &cd);
            cs[i] = make_float2((float)cd, (float)sd);
        }
    }
}

__device__ __forceinline__ void phase1(const Params& p, char* shm, int bid, int nb) {
    const int tid = TIDX(p.wave_s), wave = tid >> 6, lane = tid & 63;
    const float* mod = (const float*)(p.ws + WS_MOD);
    char* h1 = p.ws + WS_BUF1;
    float* sh1 = (float*)(p.ws + WS_SH1);
    float* lv = (float*)shm;
    for (int item = bid; item < NTOK / 64; item += nb) {
        const int b = item >> 5;
        __syncthreads();
        for (int i = tid; i < 512; i += NTHREADS) {
            *reinterpret_cast<f32x4*>(lv + 0 * DM + i * 4) = *reinterpret_cast<const f32x4*>(p.pre_mix_g + i * 4);
            *reinterpret_cast<f32x4*>(lv + 1 * DM + i * 4) = *reinterpret_cast<const f32x4*>(mod + b * 12288 + i * 4);
            *reinterpret_cast<f32x4*>(lv + 2 * DM + i * 4) = *reinterpret_cast<const f32x4*>(mod + b * 12288 + 2048 + i * 4);
        }
        __syncthreads();
#pragma unroll 1
        for (int rr = 0; rr < 8; ++rr) {
            const int row = item * 64 + rr * 8 + wave;
            const float* xr = p.x + (size_t)row * DM + lane * 4;
            f32x4 v[8]; float ss = 0.f;
#pragma unroll
            for (int i = 0; i < 8; ++i) { v[i] = *reinterpret_cast<const f32x4*>(xr + i * 256); ss += v[i][0] * v[i][0] + v[i][1] * v[i][1] + v[i][2] * v[i][2] + v[i][3] * v[i][3]; }
            const float rstd = rsqrtf(wave_sum(ss) * (1.f / DM) + EPS);
            float hmax = 0.f;
#pragma unroll
            for (int i = 0; i < 8; ++i) {
                const int col = i * 256 + lane * 4;
                f32x4 g = *reinterpret_cast<const f32x4*>(lv + col);
                f32x4 sh = *reinterpret_cast<const f32x4*>(lv + DM + col);
                f32x4 sc = *reinterpret_cast<const f32x4*>(lv + 2 * DM + col);
                v[i] = v[i] * rstd * g * (sc + 1.f) + sh;
                hmax = fmaxf(hmax, fmaxf(fmaxf(fabsf(v[i][0]), fabsf(v[i][1])), fmaxf(fabsf(v[i][2]), fabsf(v[i][3]))));
            }
#pragma unroll
            for (int o = 1; o < 64; o <<= 1) hmax = fmaxf(hmax, __shfl_xor(hmax, o));
            const float qm = hmax > 0.f ? 127.f / hmax : 0.f;
            if (lane == 0) sh1[row] = hmax * (1.f / 127.f);
#pragma unroll
            for (int i = 0; i < 8; ++i) {
                *reinterpret_cast<unsigned*>(h1 + (size_t)row * DM + i * 256 + lane * 4) = pack_i8x4(v[i][0] * qm, v[i][1] * qm, v[i][2] * qm, v[i][3] * qm);
            }
        }
    }
    {
        __syncthreads();
        float* scr = (float*)(shm + wave * 8448);
        const unsigned* cmax = (const unsigned*)(p.ws + WS_CMAX);
        float* wsc = (float*)(p.ws + WS_WSC);
        const int gw = bid * NWAVES + wave, ngw = nb * NWAVES;
        constexpr int I_IN = 32 * 58, I_PQ = 32 * 64;
        for (int it = gw; it < I_IN + I_PQ; it += ngw) {
            if (it < I_IN) xpose8_item(p.w_in, 1856, p.ws + WS_WIN, scr, it, lane, cmax, wsc);
            else xpose8_item(p.peer_wq, 2048, p.ws + WS_WPQ, scr, it - I_IN, lane, cmax + 2048, wsc + 2048);
        }
        const size_t gtid = (size_t)bid * NTHREADS + tid, gthreads = (size_t)nb * NTHREADS;
        for (size_t i = gtid; i < 24576; i += gthreads) *reinterpret_cast<u32x4*>(p.ws + WS_WIN + (size_t)1856 * 2048 + i * 16) = u32x4{0u, 0u, 0u, 0u};
        for (size_t i = gtid; i < 192; i += gthreads) wsc[1856 + i] = 0.f;
        __syncthreads();
    }
}

template <bool VT1, bool I8, bool F8 = false, class Epi>
__device__ __forceinline__ void gemm_phase(const bf16_t* A, int lda, const bf16_t* Bt, int ldb, int K, int nN, int ntiles, int tile0, int vcu, int nb,
                                           char* shm, const Epi& epi, int ws_) {
    int first = ((vcu - tile0) % nb + nb) % nb;
    bool pre = false;
    for (int t = first; t < ntiles; t += nb) {
        const int pm = t / nN, pn = t % nN;
        const int tn = t + nb;
        const bool has = tn < ntiles;
        const NextTile nx{A, Bt, lda, ldb, has ? (tn / nN) * 256 : -1, (tn % nN) * 256};
        gemm_tile<VT1, I8, F8>(A, lda, Bt, ldb, K / 64, pm * 256, pn * 256, shm, epi, pre, nx, ws_);
        pre = has;
    }
}

__device__ __forceinline__ void phase3(const Params& p, int bid, int nb) {
    const int tid = TIDX(p.wave_s), wave = tid >> 6, lane = tid & 63;
    const bf16_t* proj = (const bf16_t*)(p.ws + WS_BUF2);
    bf16_t* z = (bf16_t*)(p.ws + WS_Z);
    for (int it = bid * NTHREADS + tid; it < 1024 * 128; it += nb * NTHREADS) {
        const int strip = it >> 7, c8 = it & 127, g = c8 >> 5, w = 2 << g;
        const int t0 = strip * 16, s0 = t0 & 2047;
        const bf16_t* up = proj + (size_t)t0 * DM + c8 * 8;
        float sum[8];
#pragma unroll
        for (int j = 0; j < 8; ++j) sum[j] = 0.f;
        for (int i = 1; i <= w; ++i) {
            if (s0 - i >= 0) {
                u32x4 r = *reinterpret_cast<const u32x4*>(up - (ptrdiff_t)i * DM);
#pragma unroll
                for (int j = 0; j < 4; ++j) { sum[2 * j] += bflo(r[j]); sum[2 * j + 1] += bfhi(r[j]); }
            }
        }
        for (int tt = 0; tt < 16; ++tt) {
            const int s = s0 + tt;
            u32x4 r = *reinterpret_cast<const u32x4*>(up + (size_t)tt * DM);
            float cur[8];
#pragma unroll
            for (int j = 0; j < 4; ++j) { cur[2 * j] = bflo(r[j]); cur[2 * j + 1] = bfhi(r[j]); }
#pragma unroll
            for (int j = 0; j < 8; ++j) sum[j] += cur[j];
            if (s >= w) {
                u32x4 o = *reinterpret_cast<const u32x4*>(up + (ptrdiff_t)(tt - w) * DM);
#pragma unroll
                for (int j = 0; j < 4; ++j) { sum[2 * j] -= bflo(o[j]); sum[2 * j + 1] -= bfhi(o[j]); }
            }
            const float inv = 1.f / (float)min(s + 1, w);
            u32x2 o;
            o.x = (unsigned)pk_fp8x4(sum[0] * inv - cur[0], sum[1] * inv - cur[1], sum[2] * inv - cur[2], sum[3] * inv - cur[3]);
            o.y = (unsigned)pk_fp8x4(sum[4] * inv - cur[4], sum[5] * inv - cur[5], sum[6] * inv - cur[6], sum[7] * inv - cur[7]);
            *reinterpret_cast<u32x2*>((char*)z + (size_t)(t0 + tt) * 1024 + c8 * 8) = o;
        }
    }
    float* rq = (float*)(p.ws + WS_RSTDQ); float* rkv = (float*)(p.ws + WS_RSTDKV);
    bf16_t* kpe = (bf16_t*)(p.ws + WS_KPE);
    const float2* cs = (const float2*)(p.ws + WS_CS);
    for (int t = bid * NWAVES + wave; t < NTOK; t += nb * NWAVES) {
        const bf16_t* pr = proj + (size_t)t * DM;
        u32x4 a = *reinterpret_cast<const u32x4*>(pr + 1024 + lane * 8);
        float s1 = 0.f;
#pragma unroll
        for (int j = 0; j < 4; ++j) { float lo = bflo(a[j]), hi = bfhi(a[j]); s1 += lo * lo + hi * hi; }
        u32x2 bq = *reinterpret_cast<const u32x2*>(pr + 1536 + lane * 4);
        float s2 = 0.f;
#pragma unroll
        for (int j = 0; j < 2; ++j) { float lo = bflo(bq[j]), hi = bfhi(bq[j]); s2 += lo * lo + hi * hi; }
        s1 = wave_sum(s1); s2 = wave_sum(s2);
        if (lane == 0) { rq[t] = rsqrtf(s1 * (1.f / 512.f) + EPS); rkv[t] = rsqrtf(s2 * (1.f / 256.f) + EPS); }
        if (lane < 32) {
            float x1 = bf2f((short)pr[1792 + lane]), x2 = bf2f((short)pr[1792 + 32 + lane]);
            float2 c = cs[(size_t)t * 32 + lane];
            unsigned char* k8 = (unsigned char*)kpe + (size_t)t * 64 + 32 * (lane >> 4) + (lane & 15);
            const int w = pk_fp8x4(x1 * c.x - x2 * c.y, x2 * c.x + x1 * c.y, 0.f, 0.f);
            k8[0] = (unsigned char)(w & 0xff); k8[16] = (unsigned char)((w >> 8) & 0xff);
        }
    }
}

constexpr int KS_STRIDE = 208, VS_STRIDE = 80;
constexpr int KS_BYTES = 64 * KS_STRIDE, VS_BYTES = 128 * VS_STRIDE, AT_STAGE = KS_BYTES + VS_BYTES;
__device__ __forceinline__ void attn_unit(const Params& p, char* shm, int b, int head, int qb) {
    int tid = TIDX(p.wave_s); asm volatile("" : "+v"(tid));
    const int wave = __builtin_amdgcn_readfirstlane(tid >> 6), lane = tid & 63, l31 = lane & 31, hh = lane >> 5;
    const bool grpB = wave >= 4;
    const int rowblk = (wave & 3) * 2 + (wave >> 2);
    const bf16_t* Q = (const bf16_t*)(p.ws + WS_Q);
    const bf16_t* Kn = (const bf16_t*)(p.ws + WS_KN);
    const bf16_t* Kpe = (const bf16_t*)(p.ws + WS_KPE);
    const bf16_t* Vt = (const bf16_t*)(p.ws + WS_VT);
    const float2* cs = (const float2*)(p.ws + WS_CS);
    bf16_t* ycat = (bf16_t*)(p.ws + WS_BUF1);
    const int q0 = qb * 256 + rowblk * 32, mychunk = q0 >> 6, nkt = 4 * qb + 4;
    const int tq = b * SEQ + q0 + l31;
    i32x8 qf[3];
    {
        const bf16_t* qrow = Q + (size_t)tq * 1536 + head * 192;
#pragma unroll
        for (int ks = 0; ks < 2; ++ks)
#pragma unroll
            for (int i = 0; i < 4; ++i) {
                const bf16x8 v = *reinterpret_cast<const bf16x8*>(qrow + ks * 64 + hh * 32 + 8 * i);
                qf[ks][2 * i] = pk_fp8x4(bf2f(v[0]) * 8.f, bf2f(v[1]) * 8.f, bf2f(v[2]) * 8.f, bf2f(v[3]) * 8.f);
                qf[ks][2 * i + 1] = pk_fp8x4(bf2f(v[4]) * 8.f, bf2f(v[5]) * 8.f, bf2f(v[6]) * 8.f, bf2f(v[7]) * 8.f);
            }
#pragma unroll
        for (int i = 0; i < 2; ++i) {
            const bf16x8 a = *reinterpret_cast<const bf16x8*>(qrow + 128 + 16 * hh + 8 * i);
            const bf16x8 c2 = *reinterpret_cast<const bf16x8*>(qrow + 160 + 16 * hh + 8 * i);
            const float2* cp = cs + (size_t)tq * 32 + 16 * hh + 8 * i;
            float o1[8], o2[8];
#pragma unroll
            for (int j = 0; j < 8; ++j) {
                const float2 c = cp[j];
                const float x1 = bf2f(a[j]) * 8.f, x2 = bf2f(c2[j]) * 8.f;
                o1[j] = x1 * c.x - x2 * c.y; o2[j] = x2 * c.x + x1 * c.y;
            }
            qf[2][2 * i] = pk_fp8x4(o1[0], o1[1], o1[2], o1[3]); qf[2][2 * i + 1] = pk_fp8x4(o1[4], o1[5], o1[6], o1[7]);
            qf[2][4 + 2 * i] = pk_fp8x4(o2[0], o2[1], o2[2], o2[3]); qf[2][4 + 2 * i + 1] = pk_fp8x4(o2[4], o2[5], o2[6], o2[7]);
        }
    }
    f32x16 O[4];
#pragma unroll
    for (int dt = 0; dt < 4; ++dt)
#pragma unroll
        for (int r = 0; r < 16; ++r) O[dt][r] = 0.f;
    float mrun = -1e30f, lsum = 0.f;
    f32x16 s0, s1;
    const int kkey = tid >> 3, kch = tid & 7;
    const int pk_key = tid >> 2, pk_ch = tid & 3;
    const int vd = tid >> 2, vch = tid & 3;
    const size_t tokb = (size_t)b * SEQ;
    const char* Kn8 = (const char*)Kn; const char* Kpe8 = (const char*)Kpe;
    const char* vbase = (const char*)Vt + (size_t)((b * 8 + head) * 128) * SEQ;
    u32x4 r0, r2, r3;
#define AT_LOAD(kt) do { const int k0_ = (kt) * 64; \
        r0 = *reinterpret_cast<const u32x4*>(Kn8 + (tokb + k0_ + kkey) * 1024 + head * 128 + kch * 16); \
        if (wave < 4) r2 = *reinterpret_cast<const u32x4*>(Kpe8 + (tokb + k0_ + pk_key) * 64 + pk_ch * 16); \
        r3 = *reinterpret_cast<const u32x4*>(vbase + (size_t)vd * SEQ + k0_ + vch * 16); } while (0)
#define AT_WRITE(buf) do { char* ks_ = shm + (buf) * AT_STAGE; char* vs_ = ks_ + KS_BYTES; \
        *reinterpret_cast<u32x4*>(ks_ + kkey * KS_STRIDE + kch * 16) = r0; \
        if (wave < 4) *reinterpret_cast<u32x4*>(ks_ + pk_key * KS_STRIDE + 128 + pk_ch * 16) = r2; \
        *reinterpret_cast<u32x4*>(vs_ + vd * VS_STRIDE + vch * 16) = r3; } while (0)
#define LDK(ks_, t_) __builtin_shufflevector(*reinterpret_cast<const i32x4*>(kb + (t_) * 32 * KS_STRIDE + (ks_) * 64), \
                                             *reinterpret_cast<const i32x4*>(kb + (t_) * 32 * KS_STRIDE + (ks_) * 64 + 16), 0, 1, 2, 3, 4, 5, 6, 7)
#define MXQK(a_, b_, c_) __builtin_amdgcn_mfma_scale_f32_32x32x64_f8f6f4(a_, b_, c_, 0, 0, 0, 0x7F7F7F7F, 0, 0x7F7F7F7F)
#define QK(buf) do { \
        const char* kb = shm + (buf) * AT_STAGE + l31 * KS_STRIDE + hh * 32; \
        i32x8 ka0 = LDK(0, 0), ka1 = LDK(0, 1), kb0 = LDK(1, 0), kb1 = LDK(1, 1); \
        _Pragma("unroll") for (int r = 0; r < 16; ++r) { s0[r] = 0.f; s1[r] = 0.f; } \
        __builtin_amdgcn_sched_barrier(0); \
        s0 = MXQK(ka0, qf[0], s0); \
        s1 = MXQK(ka1, qf[0], s1); \
        ka0 = LDK(2, 0); ka1 = LDK(2, 1); \
        __builtin_amdgcn_sched_barrier(0); \
        s0 = MXQK(kb0, qf[1], s0); \
        s1 = MXQK(kb1, qf[1], s1); \
        __builtin_amdgcn_sched_barrier(0); \
        s0 = MXQK(ka0, qf[2], s0); \
        s1 = MXQK(ka1, qf[2], s1); \
        __builtin_amdgcn_sched_barrier(0); } while (0)
#define LDV(dt_) __builtin_shufflevector(*reinterpret_cast<const i32x4*>(vb + (dt_) * 32 * VS_STRIDE), *reinterpret_cast<const i32x4*>(vb + (dt_) * 32 * VS_STRIDE + 16), 0, 1, 2, 3, 4, 5, 6, 7)
#define SMPV(buf) do { \
        const char* vb = shm + (buf) * AT_STAGE + KS_BYTES + l31 * VS_STRIDE + hh * 32; \
        i32x8 va[4]; \
        _Pragma("unroll") for (int dt = 0; dt < 4; ++dt) va[dt] = LDV(dt); \
        float mx = s0[0]; \
        _Pragma("unroll") for (int r = 1; r < 16; ++r) mx = fmaxf(mx, s0[r]); \
        _Pragma("unroll") for (int r = 0; r < 16; ++r) mx = fmaxf(mx, s1[r]); \
        mx = fmaxf(mx, __shfl_xor(mx, 32)); \
        const float mnew = fmaxf(mrun, mx * 0.125f); \
        const float alpha = __builtin_amdgcn_exp2f(mrun - mnew); \
        mrun = mnew; \
        const float moff = 6.f - mnew;        \
        float ps = 0.f; \
        _Pragma("unroll") for (int r = 0; r < 16; ++r) { s0[r] = __builtin_amdgcn_exp2f(fmaf(s0[r], 0.125f, moff)); ps += s0[r]; } \
        _Pragma("unroll") for (int r = 0; r < 16; ++r) { s1[r] = __builtin_amdgcn_exp2f(fmaf(s1[r], 0.125f, moff)); ps += s1[r]; } \
        lsum = lsum * alpha + ps; \
        _Pragma("unroll") for (int dt = 0; dt < 4; ++dt) _Pragma("unroll") for (int r = 0; r < 16; ++r) O[dt][r] *= alpha; \
        i32x8 pf; \
          \
        _Pragma("unroll") for (int f1 = 0; f1 < 2; ++f1) { \
            pf[f1 * 4 + 0] = pk_fp8x4(s0[4 * f1], s0[4 * f1 + 1], s0[4 * f1 + 2], s0[4 * f1 + 3]); \
            pf[f1 * 4 + 1] = pk_fp8x4(s0[8 + 4 * f1], s0[8 + 4 * f1 + 1], s0[8 + 4 * f1 + 2], s0[8 + 4 * f1 + 3]); \
            pf[f1 * 4 + 2] = pk_fp8x4(s1[4 * f1], s1[4 * f1 + 1], s1[4 * f1 + 2], s1[4 * f1 + 3]); \
            pf[f1 * 4 + 3] = pk_fp8x4(s1[8 + 4 * f1], s1[8 + 4 * f1 + 1], s1[8 + 4 * f1 + 2], s1[8 + 4 * f1 + 3]); \
        } \
        __builtin_amdgcn_sched_barrier(0); \
        _Pragma("unroll") for (int dt = 0; dt < 4; ++dt) O[dt] = MXQK(va[dt], pf, O[dt]); \
        __builtin_amdgcn_sched_barrier(0); } while (0)
    __syncthreads();
    AT_LOAD(0); AT_WRITE(0);
    AT_LOAD(1);
    __syncthreads();
    if (grpB) __syncthreads();
    int bcur = 0, bnext = 1;
    for (int kt = 0; kt < nkt; ++kt) {
        if (kt + 1 < nkt) AT_WRITE(bnext);
        if (kt + 2 < nkt) AT_LOAD(kt + 2);
        __builtin_amdgcn_sched_barrier(0);
        if (kt <= mychunk) QK(bcur);
        __syncthreads();
        if (kt <= mychunk) SMPV(bcur);
        __syncthreads();
        bcur = bnext; bnext = (bnext == 2) ? 0 : bnext + 1;
    }
    if (!grpB) __syncthreads();
#undef AT_LOAD
#undef AT_WRITE
#undef QK
#undef SMPV
#undef LDK
#undef MXQK
#undef LDV
    lsum += __shfl_xor(lsum, 32);
    const float inv = 1.f / lsum;
    char* orow = (char*)ycat + (size_t)tq * DM + 1024 + head * 128 + 4 * hh;
#pragma unroll
    for (int dt = 0; dt < 4; ++dt)
#pragma unroll
        for (int g = 0; g < 4; ++g)
            *reinterpret_cast<int*>(orow + dt * 32 + 8 * g) = pk_fp8x4(O[dt][4 * g] * inv, O[dt][4 * g + 1] * inv, O[dt][4 * g + 2] * inv, O[dt][4 * g + 3] * inv);
}
__device__ __forceinline__ void phase5(const Params& p, char* shm, int bid, int nb) {
    for (int it = bid; it < 256; it += nb) {
        const int bh = it >> 2, pr = it & 3, b = bh >> 3, head = bh & 7;
        attn_unit(p, shm, b, head, 7 - pr);
        attn_unit(p, shm, b, head, pr);
    }
}

__device__ __forceinline__ void phase7(const Params& p, char* shm, int bid, int nb) {
    const int tid = TIDX(p.wave_s), wave = tid >> 6, lane = tid & 63;
    const float* mod = (const float*)(p.ws + WS_MOD);
    const bf16_t* y = (const bf16_t*)(p.ws + WS_BUF2);
    bf16_t* x1 = (bf16_t*)(p.ws + WS_X1);
    float* lv = (float*)shm;
    for (int item = bid; item < NTOK / 64; item += nb) {
        const int b = item >> 5;
        const float* md = mod + b * 12288;
        __syncthreads();
        for (int i = tid; i < 512; i += NTHREADS) {
            *reinterpret_cast<f32x4*>(lv + 0 * DM + i * 4) = *reinterpret_cast<const f32x4*>(p.post_mix_g + i * 4);
            *reinterpret_cast<f32x4*>(lv + 1 * DM + i * 4) = *reinterpret_cast<const f32x4*>(md + 4096 + i * 4);
            *reinterpret_cast<f32x4*>(lv + 2 * DM + i * 4) = *reinterpret_cast<const f32x4*>(p.pre_ffn_g + i * 4);
            *reinterpret_cast<f32x4*>(lv + 3 * DM + i * 4) = *reinterpret_cast<const f32x4*>(md + 6144 + i * 4);
            *reinterpret_cast<f32x4*>(lv + 4 * DM + i * 4) = *reinterpret_cast<const f32x4*>(md + 8192 + i * 4);
        }
        __syncthreads();
#pragma unroll 1
        for (int rr = 0; rr < 8; ++rr) {
            const int row = item * 64 + rr * 8 + wave;
            f32x4 yv[8]; float ss = 0.f;
#pragma unroll
            for (int i = 0; i < 8; ++i) {
                u32x2 r = *reinterpret_cast<const u32x2*>(y + (size_t)row * DM + i * 256 + lane * 4);
                yv[i] = f32x4{bflo(r.x), bfhi(r.x), bflo(r.y), bfhi(r.y)};
                ss += yv[i][0] * yv[i][0] + yv[i][1] * yv[i][1] + yv[i][2] * yv[i][2] + yv[i][3] * yv[i][3];
            }
            const float rstd = rsqrtf(wave_sum(ss) * (1.f / DM) + EPS);
            float s2 = 0.f;
#pragma unroll
            for (int i = 0; i < 8; ++i) {
                const int col = i * 256 + lane * 4;
                f32x4 xv = *reinterpret_cast<const f32x4*>(p.x + (size_t)row * DM + col);
                f32x4 g = *reinterpret_cast<const f32x4*>(lv + col);
                f32x4 gt = *reinterpret_cast<const f32x4*>(lv + DM + col);
                f32x4 v = xv + gt * (yv[i] * rstd * g);
                st4bf(x1 + (size_t)row * DM + col, v);
                yv[i] = v;
                s2 += v[0] * v[0] + v[1] * v[1] + v[2] * v[2] + v[3] * v[3];
            }
            const float rstd2 = rsqrtf(wave_sum(s2) * (1.f / DM) + EPS);
            float hmax = 0.f;
#pragma unroll
            for (int i = 0; i < 8; ++i) {
                const int col = i * 256 + lane * 4;
                f32x4 g = *reinterpret_cast<const f32x4*>(lv + 2 * DM + col);
                f32x4 sh = *reinterpret_cast<const f32x4*>(lv + 3 * DM + col);
                f32x4 sc = *reinterpret_cast<const f32x4*>(lv + 4 * DM + col);
                yv[i] = yv[i] * rstd2 * g * (sc + 1.f) + sh;
                hmax = fmaxf(hmax, fmaxf(fmaxf(fabsf(yv[i][0]), fabsf(yv[i][1])), fmaxf(fabsf(yv[i][2]), fabsf(yv[i][3]))));
            }
#pragma unroll
            for (int o = 1; o < 64; o <<= 1) hmax = fmaxf(hmax, __shfl_xor(hmax, o));
            const float qm = hmax > 0.f ? 127.f / hmax : 0.f;
            if (lane == 0) ((float*)(p.ws + WS_SH))[row] = hmax * (1.f / 127.f);
#pragma unroll
            for (int i = 0; i < 8; ++i) {
                *reinterpret_cast<unsigned*>(p.ws + WS_H8 + (size_t)row * DM + i * 256 + lane * 4) = pack_i8x4(yv[i][0] * qm, yv[i][1] * qm, yv[i][2] * qm, yv[i][3] * qm);
            }
        }
    }
}

__device__ __forceinline__ int fmap(float f) { int i = __float_as_int(f); return i ^ ((i >> 31) & 0x7fffffff); }
__device__ __forceinline__ float funmap(int i) { return __int_as_float(i ^ ((i >> 31) & 0x7fffffff)); }
__device__ __forceinline__ void ins16(int (&top)[16], int k) {
#pragma unroll
    for (int i = 0; i < 16; ++i) { int hi = max(top[i], k); k = min(top[i], k); top[i] = hi; }
}
__device__ __forceinline__ int bsel(int m, int a, int b) { return (a & ~m) | (b & m); }
__device__ __forceinline__ int sel16(const int (&a)[16], int i) {
    const int m0 = -(i & 1), m1 = -((i >> 1) & 1), m2 = -((i >> 2) & 1), m3 = -((i >> 3) & 1);
    int t8[8], t4[4], t2[2];
#pragma unroll
    for (int k = 0; k < 8; ++k) t8[k] = bsel(m0, a[2 * k], a[2 * k + 1]);
#pragma unroll
    for (int k = 0; k < 4; ++k) t4[k] = bsel(m1, t8[2 * k], t8[2 * k + 1]);
#pragma unroll
    for (int k = 0; k < 2; ++k) t2[k] = bsel(m2, t4[2 * k], t4[2 * k + 1]);
    return bsel(m3, t2[0], t2[1]);
}
#define BITONIC_CE(x, K, J) _Pragma("unroll") for (int i_ = 0; i_ < 16; ++i_) { const int l_ = i_ ^ (J); if (l_ > i_) { const int a_ = x[i_], b_ = x[l_]; \
        if ((i_ & (K)) == 0) { x[i_] = max(a_, b_); x[l_] = min(a_, b_); } else { x[i_] = min(a_, b_); x[l_] = max(a_, b_); } } }
#define BITONIC_MERGE16(x) BITONIC_CE(x, 16, 8) BITONIC_CE(x, 16, 4) BITONIC_CE(x, 16, 2) BITONIC_CE(x, 16, 1)
#define BITONIC_SORT16(x) BITONIC_CE(x, 2, 1) BITONIC_CE(x, 4, 2) BITONIC_CE(x, 4, 1) BITONIC_CE(x, 8, 4) BITONIC_CE(x, 8, 2) BITONIC_CE(x, 8, 1) BITONIC_MERGE16(x)
#define SCE(x, i, j) { const int a_ = x[i], b_ = x[j]; x[i] = max(a_, b_); x[j] = min(a_, b_); }
#define SORT16_60(x) SCE(x,0,13) SCE(x,1,12) SCE(x,2,15) SCE(x,3,14) SCE(x,4,8) SCE(x,5,6) SCE(x,7,11) SCE(x,9,10) SCE(x,0,5) SCE(x,1,7) SCE(x,2,9) SCE(x,3,4) SCE(x,6,13) SCE(x,8,14) SCE(x,10,15) SCE(x,11,12) SCE(x,0,1) SCE(x,2,3) SCE(x,4,5) SCE(x,6,8) SCE(x,7,9) SCE(x,10,11) SCE(x,12,13) SCE(x,14,15) SCE(x,0,2) SCE(x,1,3) SCE(x,4,10) SCE(x,5,11) SCE(x,6,7) SCE(x,8,9) SCE(x,12,14) SCE(x,13,15) SCE(x,1,2) SCE(x,3,12) SCE(x,4,6) SCE(x,5,7) SCE(x,8,10) SCE(x,9,11) SCE(x,13,14) SCE(x,1,4) SCE(x,2,6) SCE(x,5,8) SCE(x,7,10) SCE(x,9,13) SCE(x,11,14) SCE(x,2,4) SCE(x,3,6) SCE(x,9,12) SCE(x,11,13) SCE(x,3,5) SCE(x,6,8) SCE(x,7,9) SCE(x,10,12) SCE(x,3,4) SCE(x,5,6) SCE(x,7,8) SCE(x,9,10) SCE(x,11,12) SCE(x,6,7) SCE(x,8,9)
__device__ __forceinline__ void pk_half_list(const bf16_t* __restrict__ qrow, const char* kl, int hh, int (&out)[16]) {
    bf16x8 qf[8];
#pragma unroll
    for (int ks = 0; ks < 8; ++ks) qf[ks] = *reinterpret_cast<const bf16x8*>(qrow + ks * 16);
    int top[16];
#pragma unroll 1
    for (int kt = 0; kt < 4; ++kt) {
        f32x16 acc;
#pragma unroll
        for (int r = 0; r < 16; ++r) acc[r] = 0.f;
#pragma unroll
        for (int ks = 0; ks < 8; ++ks) {
            bf16x8 kf = *reinterpret_cast<const bf16x8*>(kl + kt * 32 * 272 + ks * 32);
            acc = __builtin_amdgcn_mfma_f32_32x32x16_bf16(kf, qf[ks], acc, 0, 0, 0);
        }
        int nw[16];
#pragma unroll
        for (int r = 0; r < 16; ++r) {
            const int n = kt * 32 + (r & 3) + 8 * (r >> 2) + 4 * hh;
            nw[r] = (fmap(acc[r]) & ~127) | (127 - n);
        }
        SORT16_60(nw)
        if (kt == 0) {
#pragma unroll
            for (int i = 0; i < 16; ++i) top[i] = nw[i];
        } else {
#pragma unroll
            for (int i = 0; i < 16; ++i) top[i] = max(top[i], nw[15 - i]);
            BITONIC_MERGE16(top)
        }
    }
#pragma unroll
    for (int i = 0; i < 16; ++i) out[i] = __shfl_xor(top[15 - i], 32);
#pragma unroll
    for (int i = 0; i < 16; ++i) out[i] = max(out[i], top[i]);
    BITONIC_MERGE16(out)
}
__device__ __forceinline__ void phase9(const Params& p, char* shm, int bid, int nb) {
    int tid = TIDX(p.wave_s); asm volatile("" : "+v"(tid));
    const int wave = tid >> 6, lane = tid & 63, l31 = lane & 31, hh = lane >> 5;
    const bf16_t* pq = (const bf16_t*)(p.ws + WS_BUF2);
    const bf16_t* sk = (const bf16_t*)(p.ws + WS_SK);
    int* idxo = (int*)(p.ws + WS_IDX); float* gateo = (float*)(p.ws + WS_GATE);
    for (int item = bid; item < 8 * 64; item += nb) {
        const int head = item & 7, tt = (item >> 3) * 8 + wave, tok = tt * 32 + l31;
        __syncthreads();
        for (int c = tid; c < 4096; c += NTHREADS) {
            const int row = c >> 4, ch = c & 15;
            *reinterpret_cast<u32x4*>(shm + row * 272 + ch * 16) = *reinterpret_cast<const u32x4*>(sk + (size_t)(head * 256 + row) * 128 + ch * 8);
        }
        __syncthreads();
        int la[16], lb[16];
        pk_half_list(pq + (size_t)tok * DM + head * 256 + hh * 8, shm + l31 * 272 + hh * 16, hh, la);
        pk_half_list(pq + (size_t)tok * DM + head * 256 + 128 + hh * 8, shm + (128 + l31) * 272 + hh * 16, hh, lb);
        float va[16], vb[16]; int ia[16], ib[16];
#pragma unroll
        for (int i = 0; i < 16; ++i) {
            va[i] = funmap(la[i] & ~127); ia[i] = 127 - (la[i] & 127);
            vb[i] = funmap(lb[i] & ~127); ib[i] = 127 - (lb[i] & 127);
        }
#define CKEY(i, j) ((fmap(va[i] + vb[j]) & ~255) | (255 - ((i) * 16 + (j))))
        int top2[16], ga[16], gb[16];
#pragma unroll
        for (int j = 0; j < 16; ++j) top2[j] = CKEY(0, j);
#pragma unroll
        for (int j = 0; j < 8; ++j) { ga[j] = CKEY(1, j); ga[8 + j] = CKEY(15 - j, 0); }
        BITONIC_MERGE16(ga)
        gb[0] = CKEY(2, 0); gb[1] = CKEY(2, 1); gb[2] = CKEY(2, 2); gb[3] = CKEY(2, 3); gb[4] = CKEY(2, 4);
        gb[5] = CKEY(3, 0); gb[6] = CKEY(3, 1); gb[7] = CKEY(3, 2); gb[8] = CKEY(3, 3);
        gb[9] = CKEY(4, 0); gb[10] = CKEY(4, 1); gb[11] = CKEY(4, 2);
        gb[12] = CKEY(5, 0); gb[13] = CKEY(5, 1); gb[14] = CKEY(6, 0); gb[15] = CKEY(6, 1);
        SORT16_60(gb)
#pragma unroll
        for (int i = 0; i < 16; ++i) top2[i] = max(top2[i], ga[15 - i]);
        BITONIC_MERGE16(top2)
#pragma unroll
        for (int i = 0; i < 16; ++i) top2[i] = max(top2[i], gb[15 - i]);
        BITONIC_MERGE16(top2)
        ins16(top2, CKEY(7, 0)); ins16(top2, CKEY(7, 1));
#undef CKEY
        float bv[16], mxv, sum = 0.f; int ex[16];
        {
            LAS int* tA = (LAS int*)(uintptr_t)(69632 + wave * 8192) + lane;
            LAS int* tB = tA + 16 * 64;
#pragma unroll
            for (int i = 0; i < 16; ++i) { tA[i * 64] = ia[i] * 128; tB[i * 64] = ib[i]; }
#pragma unroll
            for (int r = 0; r < 16; ++r) {
                const int code = 255 - (top2[r] & 255);
                ex[r] = tA[(code >> 4) * 64] + tB[(code & 15) * 64];
                bv[r] = funmap(top2[r] & ~255);
            }
        }
        mxv = bv[0];
#pragma unroll
        for (int r = 0; r < 16; ++r) { bv[r] = __expf(bv[r] - mxv); sum += bv[r]; }
        const float inv = 1.f / sum;
        if (hh == 0) {
            const size_t ob = ((size_t)(tok >> 6) * 128 + head * 16) * 64 + (tok & 63);
#pragma unroll
            for (int r = 0; r < 16; ++r) { idxo[ob + r * 64] = ex[r]; gateo[ob + r * 64] = bv[r] * inv; }
        }
    }
}

__device__ __forceinline__ void phase10(const Params& p, char* shm, int bid, int nb) {
    int tid = TIDX(p.wave_s); asm volatile("" : "+v"(tid));
    const int wave = tid >> 6, lane = tid & 63;
    const int* idxT = (const int*)(p.ws + WS_IDX);
    const char* U8 = p.ws + WS_U8;
    const char* H8 = p.ws + WS_H8;
    int* part = (int*)(p.ws + WS_PART);
    for (int task = bid; task < 256; task += nb) {
        const int tg = task >> 3, cg = task & 7;
        const int tt = tg * 8 + wave, t = tt * 64 + lane;
        unsigned ip[64]; int acc[128];
#pragma unroll
        for (int k = 0; k < 64; ++k) {
            const unsigned lo = (unsigned)idxT[((size_t)tt * 128 + 2 * k) * 64 + lane], hi = (unsigned)idxT[((size_t)tt * 128 + 2 * k + 1) * 64 + lane];
            ip[k] = lo | (hi << 16);
        }
#pragma unroll
        for (int j = 0; j < 128; ++j) acc[j] = 0;
#pragma unroll 1
        for (int s = 0; s < 32; ++s) {
            const int slice = cg * 32 + s;
            __syncthreads();
            const char* sbase = U8 + (size_t)slice * 131072;
            const unsigned toff = (unsigned)tid * 16u;
#pragma unroll
            for (int k = 0; k < 16; ++k)
                __builtin_amdgcn_global_load_lds((const unsigned*)(sbase + k * 8192 + toff), (unsigned*)(shm + k * 8192 + tid * 16), 16, 0, 0);
            const u32x2 h = *reinterpret_cast<const u32x2*>(H8 + (size_t)t * DM + slice * 8);
            asm volatile("s_waitcnt vmcnt(0)" ::: "memory");
            __syncthreads();
#define U_LOAD(g, dst) _Pragma("unroll") for (int q = 0; q < 4; ++q) { unsigned w = ip[(g) * 4 + q]; asm volatile("" : "+v"(w)); \
                dst[2 * q] = *reinterpret_cast<const u32x2*>(shm + ((w & 0xffffu) << 3)); dst[2 * q + 1] = *reinterpret_cast<const u32x2*>(shm + ((w >> 16) << 3)); }
#define U_DOT(g, srcv) _Pragma("unroll") for (int q = 0; q < 8; ++q) { \
                acc[(g) * 8 + q] = __builtin_amdgcn_sdot4((int)srcv[q].x, (int)h.x, acc[(g) * 8 + q], false); \
                acc[(g) * 8 + q] = __builtin_amdgcn_sdot4((int)srcv[q].y, (int)h.y, acc[(g) * 8 + q], false); }
            u32x2 ua[8], ub[8];
            U_LOAD(0, ua)
#pragma unroll
            for (int g = 0; g < 16; g += 2) {
                U_LOAD(g + 1, ub)
                U_DOT(g, ua)
                __builtin_amdgcn_sched_barrier(0);
                if (g + 2 < 16) { U_LOAD(g + 2, ua) }
                U_DOT(g + 1, ub)
                __builtin_amdgcn_sched_barrier(0);
            }
#undef U_LOAD
#undef U_DOT
        }
#pragma unroll
        for (int k = 0; k < 64; ++k) part[((size_t)cg * 64 + k) * NTOK + t] = (int)pk2((float)acc[2 * k], (float)acc[2 * k + 1]);
    }
}

__device__ __forceinline__ void phase11(const Params& p, int bid, int nb) {
    const int* part = (const int*)(p.ws + WS_PART);
    const int* idxT = (const int*)(p.ws + WS_IDX); const float* gateT = (const float*)(p.ws + WS_GATE);
    const float* su = (const float*)(p.ws + WS_SU); const float* sv = (const float*)(p.ws + WS_SV); const float* sh = (const float*)(p.ws + WS_SH);
    unsigned* pack = (unsigned*)(p.ws + WS_PACK);
    int t11 = TIDX(p.wave_s); asm volatile("" : "+v"(t11));
    for (int item = bid * NTHREADS + t11; item < NTOK * 128; item += nb * NTHREADS) {
        const int lane = item & 63, j = (item >> 6) & 127, tt = item >> 13, t = tt * 64 + lane;
        float sum = 0.f;
#pragma unroll
        for (int cg = 0; cg < 8; ++cg) { const unsigned w = (unsigned)part[((size_t)cg * 64 + (j >> 1)) * NTOK + t]; sum += (j & 1) ? bfhi(w) : bflo(w); }
        const int e = idxT[item];
        const float a = sum * sh[t] * su[e];
        const float act = 0.5f * a * (1.f + erff(a * 0.70710678118654752f)) * gateT[item] * sv[e];
        { const _Float16 ah = (_Float16)(act * 256.f); pack[item] = ((unsigned)__builtin_bit_cast(unsigned short, ah) << 16) | ((unsigned)e << 2); }
    }
}

__device__ __forceinline__ void phase12(const Params& p, char* shm, int bid, int nb) {
    int tid = TIDX(p.wave_s); asm volatile("" : "+v"(tid));
    const int wave = tid >> 6, lane = tid & 63;
    const unsigned* pack = (const unsigned*)(p.ws + WS_PACK);
    const char* V8 = p.ws + WS_V8;
    bf16_t* y2 = (bf16_t*)(p.ws + WS_Y2);
    for (int slice = bid; slice < 256; slice += nb) {
        __syncthreads();
        const char* src = V8 + (size_t)slice * 131072 + tid * 16;
#pragma unroll
        for (int k = 0; k < 16; ++k)
            __builtin_amdgcn_global_load_lds((const unsigned*)(src + k * 8192), (unsigned*)(shm + k * 8192 + tid * 16), 16, 0, 0);
        asm volatile("s_waitcnt vmcnt(0)" ::: "memory");
        __syncthreads();
#define V_LOAD(ptr, g, dst) _Pragma("unroll") for (int q = 0; q < 16; ++q) dst[q] = *reinterpret_cast<const unsigned*>(reinterpret_cast<const char*>((ptr) + (g) * 1024) + lane4 + q * 256);
#define V_LDS(srcp, dstv) _Pragma("unroll") for (int q = 0; q < 16; ++q) { unsigned ad_; \
            asm("v_lshlrev_b32_sdwa %0, %1, %2 dst_sel:DWORD dst_unused:UNUSED_PAD src0_sel:DWORD src1_sel:WORD_0" : "=v"(ad_) : "v"(one_), "v"(srcp[q])); \
            dstv[q] = *reinterpret_cast<const LAS u32x2*>((uintptr_t)ad_); }
#define V_CVT(w_, hi_) __builtin_bit_cast(h2v, __builtin_amdgcn_cvt_scalef32_pk_f16_fp8(w_, __uint_as_float(0x3F80007Fu), hi_))
#define V_FMAS(srcp, srcv) _Pragma("unroll") for (int q = 0; q < 16; ++q) { const h2v ph = __builtin_bit_cast(h2v, srcp[q]); const h2v act = {ph[1], ph[1]}; \
                y[0] = __builtin_elementwise_fma(act, V_CVT(srcv[q].x, false), y[0]); y[1] = __builtin_elementwise_fma(act, V_CVT(srcv[q].x, true), y[1]); \
                y[2] = __builtin_elementwise_fma(act, V_CVT(srcv[q].y, false), y[2]); y[3] = __builtin_elementwise_fma(act, V_CVT(srcv[q].y, true), y[3]); }
#define V_STEP(ptr, g, pkLoad, pkLds, vLds, pkCur, vCur) V_LOAD(ptr, g, pkLoad) V_LDS(pkLds, vLds) V_FMAS(pkCur, vCur) __builtin_amdgcn_sched_barrier(0);
        unsigned pkA[16], pkB[16], pkC[16]; u32x2 vA[16], vB[16];
        unsigned one_ = 1u; asm volatile("" : "+v"(one_));
        const int wave_u = __builtin_amdgcn_readfirstlane(wave);
        const unsigned lane4 = (unsigned)lane * 4u;
        {
            const unsigned* pp0 = pack + (size_t)wave_u * 8192;
            V_LOAD(pp0, 0, pkA) V_LOAD(pp0, 1, pkB) V_LDS(pkA, vA)
        }
#pragma unroll 1
        for (int tt = wave_u; tt < 256; tt += NWAVES) {
            h2v y[4];
#pragma unroll
            for (int c = 0; c < 4; ++c) y[c] = h2v{(_Float16)0.f, (_Float16)0.f};
            const unsigned* pp = pack + (size_t)tt * 8192;
            const int ttn = (tt + NWAVES < 256) ? tt + NWAVES : tt;
            const unsigned* pn = pack + (size_t)ttn * 8192;
            V_STEP(pp, 2, pkC, pkB, vB, pkA, vA)
            V_STEP(pp, 3, pkA, pkC, vA, pkB, vB)
            V_STEP(pp, 4, pkB, pkA, vB, pkC, vA)
            V_STEP(pp, 5, pkC, pkB, vA, pkA, vB)
            V_STEP(pp, 6, pkA, pkC, vB, pkB, vA)
            V_STEP(pp, 7, pkB, pkA, vA, pkC, vB)
            V_STEP(pn, 0, pkC, pkB, vB, pkA, vA)
            V_STEP(pn, 1, pkA, pkC, vA, pkB, vB)
#pragma unroll
            for (int q = 0; q < 16; ++q) { const unsigned t0_ = pkA[q]; pkA[q] = pkC[q]; pkB[q] = t0_; }
            *reinterpret_cast<u32x4*>(y2 + (size_t)(tt * 64 + lane) * DM + slice * 8) =
                u32x4{__builtin_bit_cast(unsigned, y[0]), __builtin_bit_cast(unsigned, y[1]), __builtin_bit_cast(unsigned, y[2]), __builtin_bit_cast(unsigned, y[3])};
        }
#undef V_LOAD
#undef V_LDS
#undef V_CVT
#undef V_FMAS
#undef V_STEP
    }
}

__device__ __forceinline__ float h16f(unsigned h) {
    const unsigned s_ = (h & 0x8000u) << 16, e_ = (h >> 10) & 31u, m_ = h & 0x3ffu;
    return e_ == 0u ? __uint_as_float(s_) : __uint_as_float(s_ | ((e_ + 112u) << 23) | (m_ << 13));
}
__device__ __forceinline__ void phase13(const Params& p, char* shm, int bid, int nb) {
    const int tid = TIDX(p.wave_s), wave = tid >> 6, lane = tid & 63;
    const float* mod = (const float*)(p.ws + WS_MOD);
    const bf16_t* y2 = (const bf16_t*)(p.ws + WS_Y2);
    const bf16_t* x1 = (const bf16_t*)(p.ws + WS_X1);
    float* lv = (float*)shm;
    for (int item = bid; item < NTOK / 64; item += nb) {
        const int b = item >> 5;
        __syncthreads();
        for (int i = tid; i < 512; i += NTHREADS) {
            *reinterpret_cast<f32x4*>(lv + 0 * DM + i * 4) = *reinterpret_cast<const f32x4*>(p.post_ffn_g + i * 4);
            *reinterpret_cast<f32x4*>(lv + 1 * DM + i * 4) = *reinterpret_cast<const f32x4*>(mod + b * 12288 + 10240 + i * 4);
        }
        __syncthreads();
#pragma unroll 1
        for (int rr = 0; rr < 8; ++rr) {
            const int row = item * 64 + rr * 8 + wave;
            f32x4 yv[8]; u32x2 xr[8]; float ss = 0.f;
#pragma unroll
            for (int i = 0; i < 8; ++i) {
                u32x2 r = *reinterpret_cast<const u32x2*>(y2 + (size_t)row * DM + i * 256 + lane * 4);
                xr[i] = *reinterpret_cast<const u32x2*>(x1 + (size_t)row * DM + i * 256 + lane * 4);
                yv[i] = f32x4{h16f(r.x & 0xffffu), h16f(r.x >> 16), h16f(r.y & 0xffffu), h16f(r.y >> 16)};
                ss += yv[i][0] * yv[i][0] + yv[i][1] * yv[i][1] + yv[i][2] * yv[i][2] + yv[i][3] * yv[i][3];
            }
            const float rstd = rsqrtf(wave_sum(ss) * (1.f / DM) + EPS);
#pragma unroll
            for (int i = 0; i < 8; ++i) {
                const int col = i * 256 + lane * 4;
                f32x4 xv = f32x4{bflo(xr[i].x), bfhi(xr[i].x), bflo(xr[i].y), bfhi(xr[i].y)};
                f32x4 g = *reinterpret_cast<const f32x4*>(lv + col);
                f32x4 gt = *reinterpret_cast<const f32x4*>(lv + DM + col);
                *reinterpret_cast<f32x4*>(p.out + (size_t)row * DM + col) = xv + gt * (yv[i] * rstd * g);
            }
        }
    }
}

constexpr int NPHASE = 14;
__global__ void __launch_bounds__(NTHREADS, 2) mega(Params p, int ph_lo, int ph_hi) {
    extern __shared__ __attribute__((aligned(16))) char shm[];
    p.wave_s = __builtin_amdgcn_readfirstlane((int)(threadIdx.x >> 6));
    const int bid = blockIdx.x, nb = gridDim.x;
    const int vcu = vcu_of(bid, nb);
    char* ws = p.ws;
    volatile LAS unsigned* xbw = (volatile LAS unsigned*)(shm + XB_OFF);
    if (TIDX(p.wave_s) == 0) { xbw[0] = 0u; xbw[1] = 0u; }
    __syncthreads();
    XcdBarrier bar; bar.bar = (unsigned*)(ws + WS_BAR); bar.x = 0; bar.st = xbw; bar.ws = p.wave_s;
    if (ph_hi - ph_lo > 1) bar = xcd_barrier_post((unsigned*)(ws + WS_BAR), xbw, p.wave_s);
#ifndef DUP_PH
#define DUP_PH (-1)
#endif
#define REP(k) for (int rep_ = 0; rep_ < ((k) == DUP_PH ? 2 : 1); ++rep_)
#ifdef ONLY_PH
#define PH(k) ((k) == ONLY_PH && ph_lo <= (k) && (k) < ph_hi)
#else
#define PH(k) (ph_lo <= (k) && (k) < ph_hi)
#endif
#define SEAM(k) do { if (ph_lo <= (k) && (k) + 1 < ph_hi) xcd_barrier(bar); } while (0)
    if (PH(0)) REP(0) phase0(p, shm, bid, nb);
    SEAM(0);
    if (PH(1)) REP(1) phase1(p, shm, bid, nb);
    SEAM(1);
    if (PH(2)) REP(2) {
        EpiI8 e{(bf16_t*)(ws + WS_BUF2), DM, (const float*)(ws + WS_SH1), (const float*)(ws + WS_WSC), ws + WS_PROJ8};
        gemm_phase<false, true>((const bf16_t*)(ws + WS_BUF1), DM / 2, (const bf16_t*)(ws + WS_WIN), DM / 2, 1024, 8, 512, 0, vcu, nb, shm, e, p.wave_s);
    }
    SEAM(2);
    if (PH(3)) REP(3) phase3(p, bid, nb);
    SEAM(3);
    if (PH(4)) REP(4) {
        EpiQ eq{(bf16_t*)(ws + WS_Q), (const float*)(ws + WS_RSTDQ)};
        EpiKV ekv{(bf16_t*)(ws + WS_KN), (bf16_t*)(ws + WS_VT), (const float*)(ws + WS_RSTDKV)};
        const bf16_t* qA = (const bf16_t*)(ws + WS_PROJ8); const bf16_t* qB = (const bf16_t*)(ws + WS_WUQ);
        const bf16_t* kA = (const bf16_t*)(ws + WS_PROJ8 + 512); const bf16_t* kB = (const bf16_t*)(ws + WS_WUKV);
        if (nb == 256) {
            const int nq = vcu < 128 ? 2 : 1, q0 = vcu < 128 ? 2 * vcu : vcu + 128;
            const int nkv = vcu < 128 ? 1 : 3, kv0 = vcu < 128 ? vcu : 128 + 3 * (vcu - 128);
            const int g = vcu >> 6, pmp = vcu & 63;
            const bf16_t* pA = (const bf16_t*)(ws + WS_Z + g * 256); const bf16_t* pB = (const bf16_t*)(ws + WS_WPOOL + g * 65536);
            const NextTile kvfirst{kA, kB, 384, 128, (kv0 >> 3) * 256, (kv0 & 7) * 256};
            const NextTile poolt{pA, pB, 512, 128, pmp * 256, 0};
#pragma unroll 1
            for (int i = 0; i < nq; ++i) {
                const int t = q0 + i;
                const NextTile nx = (i + 1 < nq) ? NextTile{qA, qB, 384, 256, ((t + 1) / 6) * 256, ((t + 1) % 6) * 256} : kvfirst;
                gemm_tile<false, false, true>(qA, 384, qB, 256, 4, (t / 6) * 256, (t % 6) * 256, shm, eq, i > 0, nx, p.wave_s);
            }
#pragma unroll 1
            for (int i = 0; i < nkv; ++i) {
                const int t = kv0 + i;
                const NextTile nx = (i + 1 < nkv) ? NextTile{kA, kB, 384, 128, ((t + 1) >> 3) * 256, ((t + 1) & 7) * 256} : poolt;
                gemm_tile<true, false, true>(kA, 384, kB, 128, 2, (t >> 3) * 256, (t & 7) * 256, shm, ekv, true, nx, p.wave_s);
            }
            {
                EpiPool e{(bf16_t*)(ws + WS_BUF1), p.pool_scale, g * 256};
                gemm_tile<false, false, true>(pA, 512, pB, 128, 2, pmp * 256, 0, shm, e, true, NextTile{pA, pB, 512, 128, -1, 0}, p.wave_s);
            }
        } else {
            gemm_phase<false, false, true>(qA, 384, qB, 256, 256, 6, 384, 0, vcu, nb, shm, eq, p.wave_s);
            gemm_phase<true, false, true>(kA, 384, kB, 128, 128, 8, 512, 384, vcu, nb, shm, ekv, p.wave_s);
            const int first = ((vcu - 896) % nb + nb) % nb;
            for (int t = first; t < 256; t += nb) {
                const int g = t >> 6, pm = t & 63;
                EpiPool e{(bf16_t*)(ws + WS_BUF1), p.pool_scale, g * 256};
                gemm_tile<false, false, true>((const bf16_t*)(ws + WS_Z + g * 256), 512, (const bf16_t*)(ws + WS_WPOOL + g * 65536), 128, 2, pm * 256, 0, shm, e, false, NextTile{nullptr, nullptr, 0, 0, -1, 0}, p.wave_s);
            }
        }
    }
    SEAM(4);
    if (PH(5)) REP(5) phase5(p, shm, vcu, nb);
    SEAM(5);
    if (PH(6)) REP(6) {
        EpiBf16 e{(bf16_t*)(ws + WS_BUF2), DM, 1.f / 32.f};
        gemm_phase<false, false, true>((const bf16_t*)(ws + WS_BUF1), DM / 2, (const bf16_t*)(ws + WS_WOUT), DM / 2, 1024, 8, 512, 0, vcu, nb, shm, e, p.wave_s);
    }
    SEAM(6);
    if (PH(7)) REP(7) phase7(p, shm, bid, nb);
    SEAM(7);
    if (PH(8)) REP(8) {
        EpiI8 e{(bf16_t*)(ws + WS_BUF2), DM, (const float*)(ws + WS_SH), (const float*)(ws + WS_WSC) + 2048, nullptr};
        gemm_phase<false, true>((const bf16_t*)(ws + WS_H8), DM / 2, (const bf16_t*)(ws + WS_WPQ), DM / 2, 1024, 8, 512, 0, vcu, nb, shm, e, p.wave_s);
    }
    SEAM(8);
    if (PH(9)) REP(9) phase9(p, shm, bid, nb);
    SEAM(9);
    if (PH(10)) REP(10) phase10(p, shm, bid, nb);
    SEAM(10);
    if (PH(11)) REP(11) phase11(p, bid, nb);
    SEAM(11);
    if (PH(12)) REP(12) phase12(p, shm, vcu, nb);
    SEAM(12);
    if (PH(13)) REP(13) phase13(p, shm, bid, nb);
#undef PH
#undef SEAM
}

extern "C" void kernel_launch(void* const* d_in, const int* in_sizes, int n_in, void* d_out, int out_size, void* d_ws, size_t ws_size, hipStream_t stream) {
    static int grid = 0;
    if (grid == 0) {
        if (n_in != 21 || ws_size < WS_END) { fprintf(stderr, "kernel_launch: unexpected n_in %d / ws_size %zu (need %zu)\n", n_in, ws_size, (size_t)WS_END); grid = -1; return; }
        int dev = 0, cus = 0;
        if (hipGetDevice(&dev) != hipSuccess || hipDeviceGetAttribute(&cus, hipDeviceAttributeMultiprocessorCount, dev) != hipSuccess) { grid = -1; return; }
        if (hipFuncSetAttribute((const void*)mega, hipFuncAttributeMaxDynamicSharedMemorySize, LDS_BYTES) != hipSuccess) { fprintf(stderr, "hipFuncSetAttribute failed\n"); grid = -1; return; }
        int per_cu = 0;
        if (hipOccupancyMaxActiveBlocksPerMultiprocessor(&per_cu, (const void*)mega, NTHREADS, LDS_BYTES) != hipSuccess || per_cu < 1)
            fprintf(stderr, "kernel_launch: occupancy query reports %d blocks per CU\n", per_cu);
        (void)hipGetLastError();
        grid = cus;
    }
    if (grid < 0) return;
    (void)hipMemsetAsync((char*)d_ws + WS_ZERO, 0, ZERO_BYTES, stream);
    (void)hipMemsetAsync((char*)d_ws + WS_CMAX, 0, CMAX_BYTES, stream);
    Params p{};
    p.x = (const float*)d_in[0]; p.c = (const float*)d_in[1]; p.pos = (const int*)d_in[2];
    p.ada_w = (const float*)d_in[3]; p.ada_b = (const float*)d_in[4];
    p.pre_mix_g = (const float*)d_in[5]; p.post_mix_g = (const float*)d_in[6]; p.pre_ffn_g = (const float*)d_in[7]; p.post_ffn_g = (const float*)d_in[8];
    p.w_in = (const float*)d_in[9]; p.pool_w = (const float*)d_in[10]; p.pool_scale = (const float*)d_in[11];
    p.q_norm_g = (const float*)d_in[12]; p.w_uq = (const float*)d_in[13]; p.kv_norm_g = (const float*)d_in[14]; p.w_ukv = (const float*)d_in[15];
    p.w_out = (const float*)d_in[16]; p.peer_wq = (const float*)d_in[17]; p.sub_keys = (const float*)d_in[18];
    p.peer_u = (const float*)d_in[19]; p.peer_v = (const float*)d_in[20];
    p.out = (float*)d_out; p.ws = (char*)d_ws;
#if MK_MULTI
    for (int k = 0; k < NPHASE; ++k) hipLaunchKernelGGL(mega, dim3(grid), dim3(NTHREADS), LDS_BYTES, stream, p, k, k + 1);
#else
    hipLaunchKernelGGL(mega, dim3(grid), dim3(NTHREADS), LDS_BYTES, stream, p, 0, NPHASE);
#endif
}
```

```cpp
#include <hip/hip_runtime.h>
#include <hip/hip_bf16.h>
#include <stdint.h>
#include <stdio.h>

#ifndef MK_MULTI
#define MK_MULTI 0
#endif

typedef unsigned short bf16_t;
typedef short bf16x8 __attribute__((ext_vector_type(8)));
typedef float f32x4 __attribute__((ext_vector_type(4)));
typedef float f32x16 __attribute__((ext_vector_type(16)));
typedef unsigned u32x4 __attribute__((ext_vector_type(4)));
typedef int i32x4 __attribute__((ext_vector_type(4)));
typedef int i32x8 __attribute__((ext_vector_type(8)));
__device__ __forceinline__ int pk_fp8x4(float a, float b, float c, float d) {
    int w = __builtin_amdgcn_cvt_pk_fp8_f32(a, b, 0, false);
    return __builtin_amdgcn_cvt_pk_fp8_f32(c, d, w, true);
}
template <bool I8> struct AccT { typedef f32x4 type; };
template <> struct AccT<true> { typedef i32x4 type; };
typedef unsigned u32x2 __attribute__((ext_vector_type(2)));
typedef _Float16 h2v __attribute__((ext_vector_type(2)));

constexpr int NTOK = 16384, DM = 2048, SEQ = 2048;
constexpr int NTHREADS = 512, NWAVES = 8;
constexpr int LDS_BYTES = 140 * 1024;
constexpr int XB_OFF = LDS_BYTES - 64;
constexpr float EPS = 1e-6f;

constexpr size_t MiB = 1024 * 1024;
constexpr size_t WS_ZERO   = 0;
constexpr size_t WS_BAR    = 0;
constexpr size_t WS_MOD    = 16384;
constexpr size_t ZERO_BYTES = 16384;
constexpr size_t WS_CS     = 1 * MiB;
constexpr size_t WS_RSTDQ  = 5 * MiB;
constexpr size_t WS_RSTDKV = 5 * MiB + 65536;
constexpr size_t WS_WIN    = 6 * MiB;
constexpr size_t WS_WOUT   = 14 * MiB;
constexpr size_t WS_WPQ    = 22 * MiB;
constexpr size_t WS_WUQ    = 30 * MiB;
constexpr size_t WS_WUKV   = 32 * MiB;
constexpr size_t WS_WPOOL  = 33 * MiB;
constexpr size_t WS_SK     = 34 * MiB;
constexpr size_t WS_U8     = 35 * MiB;
constexpr size_t WS_V8     = 67 * MiB;
constexpr size_t WS_H8     = 99 * MiB;
constexpr size_t WS_PACK   = 131 * MiB;
constexpr size_t WS_SU     = 139 * MiB;
constexpr size_t WS_SV     = 139 * MiB + 65536;
constexpr size_t WS_SH     = 139 * MiB + 131072;
constexpr size_t WS_SH1    = 139 * MiB + 196608;
constexpr size_t WS_CMAX   = 139 * MiB + 262144;
constexpr size_t WS_WSC    = 139 * MiB + 278528;
constexpr size_t CMAX_BYTES = 2 * 2048 * 4;
constexpr size_t WS_BUF1   = 163 * MiB;
constexpr size_t WS_BUF2   = 227 * MiB;
constexpr size_t WS_BIG    = 291 * MiB;
constexpr size_t WS_Z      = WS_BIG;
constexpr size_t WS_PROJ8  = WS_BIG + 16 * MiB;
constexpr size_t WS_Q      = WS_BIG + 32 * MiB;
constexpr size_t WS_KN     = WS_BIG + 80 * MiB;
constexpr size_t WS_VT     = WS_BIG + 112 * MiB;
constexpr size_t WS_KPE    = WS_BIG + 144 * MiB;
constexpr size_t WS_X1     = WS_BIG;
constexpr size_t WS_IDX    = 438 * MiB;
constexpr size_t WS_GATE   = 446 * MiB;
constexpr size_t WS_PART   = WS_BUF1;
constexpr size_t WS_Y2     = WS_BUF2;
constexpr size_t WS_END    = 454 * MiB;

struct Params {
    const float *x, *c; const int* pos;
    const float *ada_w, *ada_b, *pre_mix_g, *post_mix_g, *pre_ffn_g, *post_ffn_g;
    const float *w_in, *pool_w, *pool_scale, *q_norm_g, *w_uq, *kv_norm_g, *w_ukv, *w_out;
    const float *peer_wq, *sub_keys, *peer_u, *peer_v;
    float* out; char* ws;
    int wave_s;
};

__device__ __forceinline__ unsigned pk2(float lo, float hi) {
    typedef __bf16 bf2 __attribute__((ext_vector_type(2)));
    bf2 v; v[0] = (__bf16)lo; v[1] = (__bf16)hi; return __builtin_bit_cast(unsigned, v);
}
__device__ __forceinline__ float bflo(unsigned u) { return __uint_as_float(u << 16); }
__device__ __forceinline__ float bfhi(unsigned u) { return __uint_as_float(u & 0xffff0000u); }
__device__ __forceinline__ float bf2f(short b) { return __uint_as_float(((unsigned)(unsigned short)b) << 16); }
__device__ __forceinline__ short f2bf(float f) { return (short)(pk2(f, 0.f) & 0xffffu); }
__device__ __forceinline__ unsigned pack_i8x4(float a, float b, float c, float d) {
    unsigned r = 0u;
    r = __builtin_amdgcn_cvt_pk_u8_f32(a + 128.f, 0, r); r = __builtin_amdgcn_cvt_pk_u8_f32(b + 128.f, 1, r);
    r = __builtin_amdgcn_cvt_pk_u8_f32(c + 128.f, 2, r); r = __builtin_amdgcn_cvt_pk_u8_f32(d + 128.f, 3, r);
    return r ^ 0x80808080u;
}
__device__ __forceinline__ float wave_sum(float v) {
#pragma unroll
    for (int o = 1; o < 64; o <<= 1) v += __shfl_xor(v, o);
    return v;
}

#define XB_TMO      128
#define XB_XCNT(j)  (256  + 64 * (j))
#define XB_XSUB(j)  (1280 + 64 * (j))
#define XB_XGEN(j)  (2304 + 64 * (j))
#define XB_TOP      3328
#define XB_TOPGEN   3392
#define XCD_BAR_WORDS 3456
#define XB_SPIN_CAP (1u << 20)
#define LAS __attribute__((address_space(3)))
__device__ __forceinline__ int tidx_(int ws) { unsigned l = __builtin_amdgcn_mbcnt_lo(~0u, 0u); asm volatile("" : "+v"(l)); return (int)((unsigned)ws * 64u + __builtin_amdgcn_mbcnt_hi(~0u, l)); }
#define TIDX(ws_) tidx_(ws_)
__device__ __forceinline__ unsigned xb_ld(unsigned* p)              { return __hip_atomic_load(p, __ATOMIC_RELAXED, __HIP_MEMORY_SCOPE_AGENT); }
__device__ __forceinline__ unsigned xb_add(unsigned* p, unsigned v) { return __hip_atomic_fetch_add(p, v, __ATOMIC_RELAXED, __HIP_MEMORY_SCOPE_AGENT); }
__device__ __forceinline__ unsigned xb_xcc_id() { return (unsigned)__builtin_amdgcn_s_getreg((3 << 11) | 20) & 0xFu; }
#define XB_SPIN(cond, bar) do { unsigned _sp = 0; while (cond) { __builtin_amdgcn_s_sleep(1); \
    if ((++_sp & 255u) == 0u) { if (xb_ld(&(bar)[XB_TMO])) break; if (_sp > XB_SPIN_CAP) { atomicAdd(&(bar)[XB_TMO], 1u); break; } } } } while (0)
struct XcdBarrier { unsigned* bar; unsigned x; volatile LAS unsigned* st; int ws; };
__device__ __forceinline__ XcdBarrier xcd_barrier_post(unsigned* bar, volatile LAS unsigned* st, int ws) {
    XcdBarrier b; b.bar = bar; b.x = xb_xcc_id(); b.st = st; b.ws = ws;
    if (TIDX(ws) == 0) (void)xb_add(&bar[XB_XCNT(b.x)], 1u);
    return b;
}
__device__ __forceinline__ void xcd_barrier_complete(unsigned* bar, unsigned x, unsigned& nloc, unsigned& nx) {
    const unsigned G = gridDim.x * gridDim.y * gridDim.z;
    unsigned sum, cnt, mine, sp = 0u;
    for (;;) {
        sum = 0u; cnt = 0u; mine = 0u;
#pragma unroll
        for (unsigned j = 0; j < 16; ++j) { const unsigned c = xb_ld(&bar[XB_XCNT(j)]); sum += c; cnt += (c > 0u) ? 1u : 0u; mine = (j == x) ? c : mine; }
        if (sum == G) break;
        __builtin_amdgcn_s_sleep(1);
        if ((++sp & 255u) == 0u) { if (xb_ld(&bar[XB_TMO])) break; if (sp > XB_SPIN_CAP) { atomicAdd(&bar[XB_TMO], 1u); break; } }
    }
    nloc = mine > 0u ? mine : 1u; nx = cnt > 0u ? cnt : 1u;
}
__device__ __forceinline__ void xcd_barrier(const XcdBarrier& b) {
    asm volatile("s_waitcnt vmcnt(0)" ::: "memory");
    __syncthreads();
    if (TIDX(b.ws) == 0) {
        unsigned* bar = b.bar;
        __builtin_amdgcn_s_waitcnt(0);
        unsigned nloc = b.st[0], nx = b.st[1];
        if (nloc == 0u) { xcd_barrier_complete(bar, b.x, nloc, nx); b.st[0] = nloc; b.st[1] = nx; }
        const unsigned old = xb_add(&bar[XB_XSUB(b.x)], 1u);
        const unsigned gen = old / nloc;
        if (old + 1u == (gen + 1u) * nloc) {
            __builtin_amdgcn_fence(__ATOMIC_RELEASE, "agent");
            asm volatile("s_waitcnt vmcnt(0)" ::: "memory");
            const unsigned og = xb_add(&bar[XB_TOP], 1u);
            const unsigned tg = og / nx;
            if (og + 1u == (tg + 1u) * nx) xb_add(&bar[XB_TOPGEN], 1u);
            else XB_SPIN(xb_ld(&bar[XB_TOPGEN]) == tg, bar);
            __builtin_amdgcn_fence(__ATOMIC_ACQUIRE, "agent");
            xb_add(&bar[XB_XGEN(b.x)], 1u);
            asm volatile("s_waitcnt vmcnt(0)" ::: "memory");
        } else {
            XB_SPIN(xb_ld(&bar[XB_XGEN(b.x)]) == gen, bar);
            __builtin_amdgcn_fence(__ATOMIC_ACQUIRE, "agent");
            asm volatile("s_waitcnt vmcnt(0)" ::: "memory");
        }
    }
    __syncthreads();
}

constexpr int G_BK = 64, G_HALF = 128, G_HT = G_HALF * G_BK;
__device__ __forceinline__ int lds_byte(int r, int c) {
    int st = (r >> 4) * 2 + (c >> 5), rr = r & 15, cc = c & 31, ob = rr * 64 + cc * 2;
    return st * 1024 + (ob ^ (((ob >> 9) & 1) << 5));
}
__device__ __forceinline__ void stage_rc(int b, int& R, int& C) {
    int st = b / 1024, sb = b % 1024, swz = sb ^ (((sb >> 9) & 1) << 5);
    R = (st >> 1) * 16 + swz / 64; C = (st & 1) * 32 + (swz % 64) / 2;
}

template <bool NOSWAP, bool I8, class A_>
__device__ __forceinline__ A_ mma1(bf16x8 a, bf16x8 b, A_ c);
template <> __device__ __forceinline__ f32x4 mma1<false, false, f32x4>(bf16x8 a, bf16x8 b, f32x4 c) { return __builtin_amdgcn_mfma_f32_16x16x32_bf16(b, a, c, 0, 0, 0); }
template <> __device__ __forceinline__ f32x4 mma1<true, false, f32x4>(bf16x8 a, bf16x8 b, f32x4 c) { return __builtin_amdgcn_mfma_f32_16x16x32_bf16(a, b, c, 0, 0, 0); }
template <> __device__ __forceinline__ i32x4 mma1<false, true, i32x4>(bf16x8 a, bf16x8 b, i32x4 c) { return __builtin_amdgcn_mfma_i32_16x16x64_i8(__builtin_bit_cast(i32x4, b), __builtin_bit_cast(i32x4, a), c, 0, 0, 0); }
template <> __device__ __forceinline__ i32x4 mma1<true, true, i32x4>(bf16x8 a, bf16x8 b, i32x4 c) { return __builtin_amdgcn_mfma_i32_16x16x64_i8(__builtin_bit_cast(i32x4, a), __builtin_bit_cast(i32x4, b), c, 0, 0, 0); }

template <bool NOSWAP, bool I8, bool F8, class A_>
__device__ __forceinline__ A_ mma2(i32x8 a, i32x8 b, A_ c) {
    if constexpr (F8) {
        if constexpr (NOSWAP) return __builtin_amdgcn_mfma_scale_f32_16x16x128_f8f6f4(a, b, c, 0, 0, 0, 0, 0, 0);
        else return __builtin_amdgcn_mfma_scale_f32_16x16x128_f8f6f4(b, a, c, 0, 0, 0, 0, 0, 0);
    } else {
        const bf16x8 a0 = __builtin_bit_cast(bf16x8, __builtin_shufflevector(a, a, 0, 1, 2, 3)), a1 = __builtin_bit_cast(bf16x8, __builtin_shufflevector(a, a, 4, 5, 6, 7));
        const bf16x8 b0 = __builtin_bit_cast(bf16x8, __builtin_shufflevector(b, b, 0, 1, 2, 3)), b1 = __builtin_bit_cast(bf16x8, __builtin_shufflevector(b, b, 4, 5, 6, 7));
        c = mma1<NOSWAP, I8, A_>(a0, b0, c);
        return mma1<NOSWAP, I8, A_>(a1, b1, c);
    }
}
constexpr int EPI_NST_MIN = 12;
struct NextTile { const bf16_t* A; const bf16_t* Bt; int lda, ldb, brow, bcol; };
template <bool VT1, bool I8, bool F8 = false, class Epi>
__device__ __forceinline__ void gemm_tile(const bf16_t* __restrict__ A, int lda, const bf16_t* __restrict__ Bt, int ldb, int nt,
                                          int brow, int bcol, char* shmc, const Epi& epi, bool pre, const NextTile nx, int ws_) {
    bf16_t* shm = (bf16_t*)shmc;
    asm volatile("" : "+s"(nt));
#define SA(b,h) (shm+((b)*2+(h))*G_HT)
#define SB(b,h) (shm+(4+(b)*2+(h))*G_HT)
#define STAGE_X(OFF,LOFF,P,RS,LD,br,kt) do{ const int _so=((br)*(LD)+(kt)*G_BK)*2; \
    __builtin_amdgcn_raw_ptr_buffer_load_lds(RS, (__attribute__((address_space(3))) void*)((char*)(P)+(LOFF)),16,(int)(OFF),_so,0,0); \
    __builtin_amdgcn_raw_ptr_buffer_load_lds(RS, (__attribute__((address_space(3))) void*)((char*)(P)+(LOFF)+8192),16,(int)(OFF),_so+128*(LD),0,0);}while(0)
#define STAGE_A(P,br,kt) STAGE_X(offA,lwv,P,rsA,lda,br,kt)
#define STAGE_B(P,br,kt) STAGE_X(offB,lwv,P,rsB,ldb,br,kt)
#define LDF(base_,off_) (*reinterpret_cast<const i32x4*>((base_)+(off_)))
#define LDA(dst,b,h) _Pragma("unroll") for(int m=0;m<4;++m) \
    dst[m]=__builtin_shufflevector(LDF(fa_base,((b)*2+(h))*16384+m*2048),LDF(fa_base,((b)*2+(h))*16384+m*2048+1024),0,1,2,3,4,5,6,7)
#define LDB(dst,b,h) _Pragma("unroll") for(int n=0;n<2;++n) \
    dst[n]=__builtin_shufflevector(LDF(fb_base,((b)*2+(h))*16384+n*2048),LDF(fb_base,((b)*2+(h))*16384+n*2048+1024),0,1,2,3,4,5,6,7)
#define MMA(ai,bj,At_,Bt_) do{__builtin_amdgcn_s_setprio(1); \
    _Pragma("unroll") for(int m=0;m<4;++m) _Pragma("unroll") for(int n=0;n<2;++n) \
      acc[ai][bj][m][n]=mma2<VT1 && (bj)==1, I8, F8, typename AccT<I8>::type>(At_[m],Bt_[n],acc[ai][bj][m][n]); \
    __builtin_amdgcn_s_setprio(0);}while(0)
#define WAIT_V(n) asm volatile("s_waitcnt vmcnt(" #n ")":::"memory")
#define WAIT_L(n) asm volatile("s_waitcnt lgkmcnt(" #n ")":::"memory")
#define BAR __builtin_amdgcn_s_barrier()
#define SCHED __builtin_amdgcn_sched_barrier(0)
    int t0 = TIDX(ws_); asm volatile("" : "+v"(t0));
    int wid = t0 >> 6, lane = t0 & 63, wr = wid >> 2, wc = wid & 3, fr = lane & 15, fq = lane >> 4;
    typename AccT<I8>::type acc[2][2][4][2] = {};
    const char* fa_base = (const char*)shm + lds_byte(wr * 64 + fr, fq * 8);
    const char* fb_base = (const char*)shm + 65536 + lds_byte(wc * 32 + fr, fq * 8);
    i32x8 At[4], B0[2], B1[2];
    int loff = t0 * 16;
    const int lwv = __builtin_amdgcn_readfirstlane(t0 >> 6) * 1024;
    unsigned offA, offB;
    const __amdgpu_buffer_rsrc_t rsA = __builtin_amdgcn_make_buffer_rsrc((void*)A, (short)0, -1, 0x00020000);
    const __amdgpu_buffer_rsrc_t rsB = __builtin_amdgcn_make_buffer_rsrc((void*)Bt, (short)0, -1, 0x00020000);
    { int r_, c_; stage_rc(loff, r_, c_); offA = (unsigned)(r_ * lda + c_) * 2;
      const int i_ = r_ & 15, n_ = (r_ >> 4) & 1;
      offB = (unsigned)(((r_ & ~31) + 8 * (i_ >> 2) + 4 * n_ + (i_ & 3)) * ldb + c_) * 2; }
    if (!pre) {
        STAGE_B(SB(0,0),bcol,0); STAGE_A(SA(0,0),brow,0);
        STAGE_B(SB(0,1),bcol+G_HALF,0); STAGE_A(SA(0,1),brow+G_HALF,0);
        if (wr == 1) BAR;
        WAIT_V(4); BAR;
        STAGE_B(SB(1,0),bcol,1); STAGE_A(SA(1,0),brow,1); STAGE_B(SB(1,1),bcol+G_HALF,1);
        WAIT_V(6); BAR;
    } else {
        if (wr == 1) BAR;
        asm volatile("s_waitcnt vmcnt(%0)" :: "n"(EPI_NST_MIN + 10) : "memory"); BAR;
        asm volatile("s_waitcnt vmcnt(%0)" :: "n"(EPI_NST_MIN + 6) : "memory"); BAR;
    }
    for (int t = 0; t < nt - 2; t += 2) {
        LDB(B0,0,0); SCHED; LDA(At,0,0); STAGE_A(SA(1,1),brow+G_HALF,t+1);
        WAIT_L(8); BAR; WAIT_L(0); MMA(0,0,At,B0); BAR; SCHED;
        LDB(B1,0,1); STAGE_B(SB(0,0),bcol,t+2);
        BAR; WAIT_L(0); MMA(0,1,At,B1); BAR;
        LDA(At,0,1); STAGE_A(SA(0,0),brow,t+2);
        BAR; WAIT_L(0); MMA(1,0,At,B0); BAR; SCHED;
        STAGE_B(SB(0,1),bcol+G_HALF,t+2);
        WAIT_V(6); BAR; MMA(1,1,At,B1); BAR;
        LDB(B0,1,0); SCHED; LDA(At,1,0); STAGE_A(SA(0,1),brow+G_HALF,t+2);
        WAIT_L(8); BAR; WAIT_L(0); MMA(0,0,At,B0); BAR; SCHED;
        LDB(B1,1,1); STAGE_B(SB(1,0),bcol,t+3);
        BAR; WAIT_L(0); MMA(0,1,At,B1); BAR;
        LDA(At,1,1); STAGE_A(SA(1,0),brow,t+3);
        BAR; WAIT_L(0); MMA(1,0,At,B0); BAR; SCHED;
        STAGE_B(SB(1,1),bcol+G_HALF,t+3);
        WAIT_V(6); BAR; MMA(1,1,At,B1); BAR;
    }
    int tz = TIDX(ws_); asm volatile("" : "+v"(tz)); wid = tz >> 6; lane = tz & 63; wr = wid >> 2; wc = wid & 3; fr = lane & 15; fq = lane >> 4;
    loff = tz * 16;
    fa_base = (const char*)shm + lds_byte(wr * 64 + fr, fq * 8); fb_base = (const char*)shm + 65536 + lds_byte(wc * 32 + fr, fq * 8);
    { int r_, c_; stage_rc(loff, r_, c_); offA = (unsigned)(r_ * lda + c_) * 2; }
    { LDB(B0,0,0); WAIT_V(0); LDA(At,0,0); STAGE_A(SA(1,1),brow+G_HALF,nt-1);
      BAR; WAIT_L(0); MMA(0,0,At,B0); BAR;
      LDB(B1,0,1); BAR; WAIT_L(0); MMA(0,1,At,B1); BAR;
      LDA(At,0,1); WAIT_V(4); BAR; WAIT_L(0); MMA(1,0,At,B0); MMA(1,1,At,B1); BAR; }
    { LDB(B0,1,0); LDA(At,1,0); WAIT_V(2); BAR; WAIT_L(0); MMA(0,0,At,B0); BAR;
      LDB(B1,1,1); WAIT_V(0); BAR; WAIT_L(0); MMA(0,1,At,B1); BAR;
      LDA(At,1,1); BAR; WAIT_L(0); MMA(1,0,At,B0); MMA(1,1,At,B1); BAR; }
    if (wr == 0) BAR;
    { int te = TIDX(ws_); asm volatile("" : "+v"(te)); wid = te >> 6; lane = te & 63; wr = wid >> 2; wc = wid & 3; fr = lane & 15; fq = lane >> 4; loff = te * 16; }
    typename Epi::Pre pre_;
    epi.preload(pre_, brow + wr * 64 + fr, bcol + wc * 32 + fq * 8, brow + wr * 64 + fq * 4);
    if (nx.brow >= 0) {
        int r_, c_; stage_rc(loff, r_, c_);
        const int i_ = r_ & 15, n_ = (r_ >> 4) & 1;
        const unsigned offA2 = (unsigned)(r_ * nx.lda + c_) * 2;
        const unsigned offB2 = (unsigned)(((r_ & ~31) + 8 * (i_ >> 2) + 4 * n_ + (i_ & 3)) * nx.ldb + c_) * 2;
        const __amdgpu_buffer_rsrc_t rsA2 = __builtin_amdgcn_make_buffer_rsrc((void*)nx.A, (short)0, -1, 0x00020000);
        const __amdgpu_buffer_rsrc_t rsB2 = __builtin_amdgcn_make_buffer_rsrc((void*)nx.Bt, (short)0, -1, 0x00020000);
#define NXT_A(P,h,k) STAGE_X(offA2,lwv,P,rsA2,nx.lda,nx.brow+(h),k)
#define NXT_B(P,h,k) STAGE_X(offB2,lwv,P,rsB2,nx.ldb,nx.bcol+(h),k)
        NXT_B(SB(0,0),0,0); NXT_A(SA(0,0),0,0); NXT_B(SB(0,1),G_HALF,0); NXT_A(SA(0,1),G_HALF,0);
        NXT_B(SB(1,0),0,1); NXT_A(SA(1,0),0,1); NXT_B(SB(1,1),G_HALF,1);
#undef NXT_A
#undef NXT_B
    }
#pragma unroll
    for (int ai = 0; ai < 2; ++ai)
#pragma unroll
    for (int m = 0; m < 4; ++m) {
#pragma unroll
        for (int bj = 0; bj < 2; ++bj) {
            if (VT1 && bj == 1) {
                if (m == 3) {
#pragma unroll
                    for (int n = 0; n < 2; ++n)
                        epi.storeT(pre_, ai, brow + ai * G_HALF + wr * 64, bcol + bj * G_HALF + wc * 32 + 8 * (fr >> 2) + 4 * n + (fr & 3), fq,
                                   acc[ai][bj][0][n], acc[ai][bj][1][n], acc[ai][bj][2][n], acc[ai][bj][3][n]);
                }
            } else {
                epi.store8(pre_, ai, m, bj, brow + ai * G_HALF + wr * 64 + m * 16 + fr, bcol + bj * G_HALF + wc * 32 + fq * 8, acc[ai][bj][m][0], acc[ai][bj][m][1]);
            }
        }
        asm volatile("" ::: "memory");
    }
    if (nx.brow < 0) __syncthreads();
#undef SA
#undef SB
#undef STAGE_X
#undef STAGE_A
#undef STAGE_B
#undef LDA
#undef LDF
#undef LDB
#undef MMA
#undef WAIT_V
#undef WAIT_L
#undef BAR
#undef SCHED
}

__device__ __forceinline__ void st4bf(bf16_t* p, f32x4 v) {
    u32x2 o; o.x = pk2(v[0], v[1]); o.y = pk2(v[2], v[3]); *reinterpret_cast<u32x2*>(p) = o;
}
__device__ __forceinline__ void st8bf(bf16_t* p, f32x4 a, f32x4 b) {
    u32x4 o; o.x = pk2(a[0], a[1]); o.y = pk2(a[2], a[3]); o.z = pk2(b[0], b[1]); o.w = pk2(b[2], b[3]); *reinterpret_cast<u32x4*>(p) = o;
}
struct EpiBf16 {
    bf16_t* C; int ldc; float sc;
    static constexpr int NST = 16;
    struct Pre {};
    __device__ __forceinline__ void preload(Pre&, int, int, int) const {}
    __device__ __forceinline__ void store8(const Pre&, int, int, int, int row, int col, f32x4 a, f32x4 b) const { st8bf(C + (size_t)row * ldc + col, a * sc, b * sc); }
    __device__ __forceinline__ void storeT(const Pre&, int, int, int, int, f32x4, f32x4, f32x4, f32x4) const {}
};
struct EpiI8 {
    bf16_t* C; int ldc; const float* rs; const float* cs; char* c8;
    static constexpr int NST = 16;
    struct Pre { float r[8]; f32x4 c[2][2]; };
    __device__ __forceinline__ void preload(Pre& q, int rowb, int colb, int) const {
#pragma unroll
        for (int i = 0; i < 8; ++i) q.r[i] = rs[rowb + (i >> 2) * 128 + (i & 3) * 16];
#pragma unroll
        for (int bj = 0; bj < 2; ++bj) { q.c[bj][0] = *reinterpret_cast<const f32x4*>(cs + colb + bj * 128); q.c[bj][1] = *reinterpret_cast<const f32x4*>(cs + colb + bj * 128 + 4); }
    }
    __device__ __forceinline__ void store8(const Pre& q, int ai, int m, int bj, int row, int col, i32x4 a, i32x4 b) const {
        const float r = q.r[ai * 4 + m];
        f32x4 fa = {(float)a[0], (float)a[1], (float)a[2], (float)a[3]}, fb = {(float)b[0], (float)b[1], (float)b[2], (float)b[3]};
        fa = fa * q.c[bj][0] * r; fb = fb * q.c[bj][1] * r;
        st8bf(C + (size_t)row * ldc + col, fa, fb);
        const int pn = __builtin_amdgcn_readfirstlane(col >> 8);
        if (c8 != nullptr && pn >= 4 && pn < 7) {
            u32x2 w = {(unsigned)pk_fp8x4(fa[0], fa[1], fa[2], fa[3]), (unsigned)pk_fp8x4(fb[0], fb[1], fb[2], fb[3])};
            *reinterpret_cast<u32x2*>(c8 + (size_t)row * 768 + (col - 1024)) = w;
        }
    }
    __device__ __forceinline__ void storeT(const Pre&, int, int, int, int, i32x4, i32x4, i32x4, i32x4) const {}
};
struct EpiPool {
    bf16_t* C; const float* scale; int gcol0;
    static constexpr int NST = 16;
    struct Pre { f32x4 s[2][2]; };
    __device__ __forceinline__ void preload(Pre& q, int, int colb, int) const {
#pragma unroll
        for (int bj = 0; bj < 2; ++bj) { q.s[bj][0] = *reinterpret_cast<const f32x4*>(scale + gcol0 + colb + bj * 128); q.s[bj][1] = *reinterpret_cast<const f32x4*>(scale + gcol0 + colb + bj * 128 + 4); }
    }
    __device__ __forceinline__ void store8(const Pre& q, int, int, int bj, int row, int col, f32x4 a, f32x4 b) const {
        a = a * q.s[bj][0] * (1.f / 16.f); b = b * q.s[bj][1] * (1.f / 16.f);
        u32x2 w = {(unsigned)pk_fp8x4(a[0], a[1], a[2], a[3]), (unsigned)pk_fp8x4(b[0], b[1], b[2], b[3])};
        *reinterpret_cast<u32x2*>((char*)C + (size_t)row * DM + gcol0 + col) = w;
    }
    __device__ __forceinline__ void storeT(const Pre&, int, int, int, int, f32x4, f32x4, f32x4, f32x4) const {}
};
struct EpiQ {
    bf16_t* C; const float* rstd;
    static constexpr int NST = 16;
    struct Pre { float r[8]; };
    __device__ __forceinline__ void preload(Pre& q, int rowb, int, int) const {
#pragma unroll
        for (int i = 0; i < 8; ++i) q.r[i] = rstd[rowb + (i >> 2) * 128 + (i & 3) * 16] * (0.07216878364870322f * 1.4426950408889634f / 16.f);
    }
    __device__ __forceinline__ void store8(const Pre& q, int ai, int m, int, int row, int col, f32x4 a, f32x4 b) const {
        const float s = q.r[ai * 4 + m];
        st8bf(C + (size_t)row * 1536 + col, a * s, b * s);
    }
    __device__ __forceinline__ void storeT(const Pre&, int, int, int, int, f32x4, f32x4, f32x4, f32x4) const {}
};
struct EpiKV {
    bf16_t* Kn; bf16_t* Vt; const float* rstd;
    static constexpr int NST = 12;
    struct Pre { float r[8]; f32x4 rt[8]; };
    __device__ __forceinline__ void preload(Pre& q, int rowb, int, int rowbT) const {
#pragma unroll
        for (int i = 0; i < 8; ++i) { q.r[i] = rstd[rowb + (i >> 2) * 128 + (i & 3) * 16] * (1.f / 16.f); q.rt[i] = *reinterpret_cast<const f32x4*>(rstd + rowbT + (i >> 2) * 128 + (i & 3) * 16) * (1.f / 16.f); }
    }
    __device__ __forceinline__ void store8(const Pre& q, int ai, int m, int, int row, int col, f32x4 a, f32x4 b) const {
        int head = col >> 8, d = col & 127; const float r = q.r[ai * 4 + m];
        u32x2 w = {(unsigned)pk_fp8x4(a[0] * r, a[1] * r, a[2] * r, a[3] * r), (unsigned)pk_fp8x4(b[0] * r, b[1] * r, b[2] * r, b[3] * r)};
        *reinterpret_cast<u32x2*>((char*)Kn + (size_t)row * 1024 + head * 128 + d) = w;
    }
    __device__ __forceinline__ void storeT(const Pre& q, int ai, int rbase, int col, int fq, f32x4 v0, f32x4 v1, f32x4 v2, f32x4 v3) const {
        int head = col >> 8, d = col & 127, b = rbase >> 11, s = rbase & 2047;
        const f32x4 r0 = q.rt[ai * 4 + 0], r1 = q.rt[ai * 4 + 1], r2 = q.rt[ai * 4 + 2], r3 = q.rt[ai * 4 + 3];
        u32x4 w;
        w.x = (unsigned)pk_fp8x4(v0[0] * r0[0], v0[1] * r0[1], v0[2] * r0[2], v0[3] * r0[3]);
        w.y = (unsigned)pk_fp8x4(v1[0] * r1[0], v1[1] * r1[1], v1[2] * r1[2], v1[3] * r1[3]);
        w.z = (unsigned)pk_fp8x4(v2[0] * r2[0], v2[1] * r2[1], v2[2] * r2[2], v2[3] * r2[3]);
        w.w = (unsigned)pk_fp8x4(v3[0] * r3[0], v3[1] * r3[1], v3[2] * r3[2], v3[3] * r3[3]);
        *reinterpret_cast<u32x4*>((char*)Vt + ((size_t)((b * 8 + head) * 128 + d)) * SEQ + s + 32 * (fq & 1) + 16 * (fq >> 1)) = w;
    }
};

__device__ __forceinline__ int vcu_of(int bid, int nb) { return (nb % 8 == 0) ? (bid % 8) * (nb / 8) + bid / 8 : bid; }

__device__ __forceinline__ void xpose_item(const float* __restrict__ W, int K, int N, bf16_t* __restrict__ WT, int ldt, float* scr, int item, int lane,
                                           const float* __restrict__ rowscale) {
    const int nblk = N / 32, kb = item / nblk, nb = item % nblk, k0 = 64 * kb, n0 = 32 * nb;
#pragma unroll 8
    for (int i = 0; i < 32; ++i) {
        const int kk = 2 * i + (lane >> 5);
        float w = W[(size_t)(k0 + kk) * N + n0 + (lane & 31)];
        if (rowscale) w *= rowscale[k0 + kk];
        scr[kk * 33 + (lane & 31)] = w;
    }
    __builtin_amdgcn_s_waitcnt(0xc07f); asm volatile("" ::: "memory");
    const int c = lane & 7;
#pragma unroll
    for (int j = 0; j < 4; ++j) {
        const int n = (lane >> 3) + 8 * j; const float* s = scr + (8 * c) * 33 + n;
        u32x4 o; o.x = pk2(s[0 * 33], s[1 * 33]); o.y = pk2(s[2 * 33], s[3 * 33]); o.z = pk2(s[4 * 33], s[5 * 33]); o.w = pk2(s[6 * 33], s[7 * 33]);
        *reinterpret_cast<u32x4*>(WT + (size_t)(n0 + n) * ldt + k0 + 8 * c) = o;
    }
    __builtin_amdgcn_s_waitcnt(0xc07f); asm volatile("" ::: "memory");
}
__device__ __forceinline__ void xposef8_item(const float* __restrict__ W, int K, int N, char* __restrict__ WT8, int ldt, float* scr, int item, int lane, float mul,
                                             const float* __restrict__ rowscale = nullptr) {
    const int nblk = N / 32, kb = item / nblk, nb = item % nblk, k0 = 64 * kb, n0 = 32 * nb;
#pragma unroll 8
    for (int i = 0; i < 32; ++i) {
        const int kk = 2 * i + (lane >> 5);
        float w = W[(size_t)(k0 + kk) * N + n0 + (lane & 31)] * mul;
        if (rowscale) w *= rowscale[k0 + kk];
        scr[kk * 33 + (lane & 31)] = w;
    }
    __builtin_amdgcn_s_waitcnt(0xc07f); asm volatile("" ::: "memory");
    const int c = lane & 7;
#pragma unroll
    for (int j = 0; j < 4; ++j) {
        const int n = (lane >> 3) + 8 * j; const float* s = scr + (8 * c) * 33 + n;
        u32x2 o;
        o.x = (unsigned)pk_fp8x4(s[0 * 33], s[1 * 33], s[2 * 33], s[3 * 33]); o.y = (unsigned)pk_fp8x4(s[4 * 33], s[5 * 33], s[6 * 33], s[7 * 33]);
        *reinterpret_cast<u32x2*>(WT8 + (size_t)(n0 + n) * ldt + k0 + 8 * c) = o;
    }
    __builtin_amdgcn_s_waitcnt(0xc07f); asm volatile("" ::: "memory");
}
__device__ __forceinline__ void xpose8_item(const float* __restrict__ W, int N, char* __restrict__ WT8, float* scr, int item, int lane,
                                            const unsigned* __restrict__ cmax, float* __restrict__ wsc) {
    const int nblk = N / 32, kb = item / nblk, nb = item % nblk, k0 = 64 * kb, n0 = 32 * nb;
    const float cm = __uint_as_float(cmax[n0 + (lane & 31)]);
    const float qm = cm > 0.f ? 127.f / cm : 0.f;
    if (kb == 0 && lane < 32) wsc[n0 + lane] = cm * (1.f / 127.f);
#pragma unroll 8
    for (int i = 0; i < 32; ++i) {
        const int kk = 2 * i + (lane >> 5);
        scr[kk * 33 + (lane & 31)] = W[(size_t)(k0 + kk) * N + n0 + (lane & 31)] * qm;
    }
    __builtin_amdgcn_s_waitcnt(0xc07f); asm volatile("" ::: "memory");
    const int c = lane & 7;
#pragma unroll
    for (int j = 0; j < 4; ++j) {
        const int n = (lane >> 3) + 8 * j; const float* s = scr + (8 * c) * 33 + n;
        u32x2 o;
        o.x = pack_i8x4(s[0 * 33], s[1 * 33], s[2 * 33], s[3 * 33]); o.y = pack_i8x4(s[4 * 33], s[5 * 33], s[6 * 33], s[7 * 33]);
        *reinterpret_cast<u32x2*>(WT8 + (size_t)(n0 + n) * 2048 + k0 + 8 * c) = o;
    }
    __builtin_amdgcn_s_waitcnt(0xc07f); asm volatile("" ::: "memory");
}
__device__ __forceinline__ void cvt_bf16_range(const float* __restrict__ src, bf16_t* __restrict__ dst, size_t n8, size_t gtid, size_t gthreads) {
    for (size_t i = gtid; i < n8; i += gthreads) {
        f32x4 a = *reinterpret_cast<const f32x4*>(src + i * 8), b = *reinterpret_cast<const f32x4*>(src + i * 8 + 4);
        u32x4 o; o.x = pk2(a[0], a[1]); o.y = pk2(a[2], a[3]); o.z = pk2(b[0], b[1]); o.w = pk2(b[2], b[3]);
        *reinterpret_cast<u32x4*>(dst + i * 8) = o;
    }
}
__device__ __forceinline__ void phase0(const Params& p, char* shm, int bid, int nb) {
    const int tid = TIDX(p.wave_s), wave = tid >> 6, lane = tid & 63;
    char* ws = p.ws;
#ifndef DUP_P0
#define DUP_P0 (-1)
#endif
    for (int rp_ = 0; rp_ < (DUP_P0 == 0 ? 2 : 1); ++rp_)
    {
        float* sl = (float*)shm;
        float* red = (float*)(shm + 65536);
        float* mod = (float*)(ws + WS_MOD);
        if (bid < 192 || nb != 256) {
            for (int i = tid; i < 8 * DM; i += NTHREADS) { float cv = p.c[i]; sl[i] = cv / (1.f + __expf(-cv)); }
            __syncthreads();
            for (int it = bid; it < 192; it += nb) {
                const int col = it * 64 + lane;
                float acc[8];
#pragma unroll
                for (int b = 0; b < 8; ++b) acc[b] = 0.f;
                const float* wp = p.ada_w + (size_t)(wave * 256) * 12288 + col;
                const float* sp = sl + wave * 256;
#pragma unroll 1
                for (int r0 = 0; r0 < 256; r0 += 32) {
                    float w[32];
#pragma unroll
                    for (int i = 0; i < 32; ++i) w[i] = wp[(size_t)(r0 + i) * 12288];
#pragma unroll
                    for (int q = 0; q < 8; ++q)
#pragma unroll
                        for (int b = 0; b < 8; ++b) {
                            const f32x4 s4 = *reinterpret_cast<const f32x4*>(sp + b * DM + r0 + 4 * q);
                            acc[b] += w[4 * q] * s4[0] + w[4 * q + 1] * s4[1] + w[4 * q + 2] * s4[2] + w[4 * q + 3] * s4[3];
                        }
                }
#pragma unroll
                for (int b = 0; b < 8; ++b) red[(wave * 8 + b) * 64 + lane] = acc[b];
                __syncthreads();
                {
                    const int b = tid >> 6, cl = tid & 63;
                    float sum = 0.f;
#pragma unroll
                    for (int w = 0; w < 8; ++w) sum += red[(w * 8 + b) * 64 + cl];
                    mod[b * 12288 + it * 64 + cl] = sum + p.ada_b[it * 64 + cl];
                }
                __syncthreads();
            }
        }
    }
    const int gw = bid * NWAVES + wave, ngw = nb * NWAVES;
    const size_t gtid = (size_t)bid * NTHREADS + tid, gthreads = (size_t)nb * NTHREADS;
    for (int rp_ = 0; rp_ < (DUP_P0 == 1 ? 2 : 1); ++rp_)
    {
        float* scr = (float*)(shm + wave * 8448);
        constexpr int I_POOL = 4 * 4 * 8, I_UQ = 8 * 48, I_UKV = 4 * 64, I_OUT = 32 * 64;
        constexpr int NIT = I_POOL + I_UQ + I_UKV + I_OUT;
        for (int it = gw; it < NIT; it += ngw) {
            int r = it;
            if (r < I_POOL) { int g = r / 32; xposef8_item(p.pool_w + g * 65536, 256, 256, ws + WS_WPOOL + g * 65536, 256, scr, r % 32, lane, 16.f); continue; } r -= I_POOL;
            if (r < I_UQ) { xposef8_item(p.w_uq, 512, 1536, ws + WS_WUQ, 512, scr, r, lane, 16.f, p.q_norm_g); continue; } r -= I_UQ;
            if (r < I_UKV) { xposef8_item(p.w_ukv, 256, 2048, ws + WS_WUKV, 256, scr, r, lane, 16.f, p.kv_norm_g); continue; } r -= I_UKV;
            xposef8_item(p.w_out, 2048, 2048, ws + WS_WOUT, 2048, scr, r, lane, 32.f);
        }
        unsigned* cmax = (unsigned*)(ws + WS_CMAX);
        for (int it = gw; it < (29 + 32) * 16; it += ngw) {
            const int strip = it >> 4, kc = it & 15;
            const bool isq = strip >= 29;
            const int n = (isq ? strip - 29 : strip) * 64 + lane, N = isq ? 2048 : 1856;
            const float* wp = (isq ? p.peer_wq : p.w_in) + (size_t)(kc * 128) * N + n;
            float m = 0.f;
#pragma unroll 32
            for (int r = 0; r < 128; ++r) m = fmaxf(m, fabsf(wp[(size_t)r * N]));
            atomicMax(cmax + (isq ? 2048 : 0) + n, __float_as_uint(m));
        }
    }
    cvt_bf16_range(p.sub_keys, (bf16_t*)(ws + WS_SK), 262144 / 8, gtid, gthreads);
    for (int rp_ = 0; rp_ < (DUP_P0 == 2 ? 2 : 1); ++rp_)
    {
        float* tile = (float*)shm;
        float* redm = (float*)(shm + 16 * 2052 * 4);
        float* scl = redm + 128;
        int ntl, tfirst, tstep;
        if (nb == 256) { if (bid < 192) { ntl = 7; tfirst = bid * 7; } else { ntl = 11; tfirst = 192 * 7 + (bid - 192) * 11; } tstep = 1; }
        else { ntl = (2048 - bid + nb - 1) / nb; tfirst = bid; tstep = nb; }
#define Q_LOAD(dst, i_) do { const int itl_ = tfirst + (i_) * tstep; \
            const float* src_ = ((itl_ >> 10) ? p.peer_v : p.peer_u) + (size_t)((itl_ & 1023) * 16) * DM; \
            _Pragma("unroll") for (int k = 0; k < 16; ++k) dst[k] = *reinterpret_cast<const f32x4*>(reinterpret_cast<const char*>(src_ + (size_t)k * DM) + qoff); } while (0)
#define Q_TILE(vs, i_) do { \
            const int it = tfirst + (i_) * tstep; \
            const int isv = it >> 10, e0 = (it & 1023) * 16; \
            float mx[16]; \
            _Pragma("unroll") for (int k = 0; k < 16; ++k) { \
                *reinterpret_cast<f32x4*>(tile + k * 2052 + tid * 4) = vs[k]; \
                mx[k] = fmaxf(fmaxf(fabsf(vs[k][0]), fabsf(vs[k][1])), fmaxf(fabsf(vs[k][2]), fabsf(vs[k][3]))); \
            } \
            if ((i_) + 1 < ntl) Q_LOAD(vs, (i_) + 1); \
            _Pragma("unroll") for (int k = 0; k < 16; ++k) { \
                _Pragma("unroll") for (int o = 1; o < 64; o <<= 1) mx[k] = fmaxf(mx[k], __shfl_xor(mx[k], o)); \
            } \
            if (lane == 0) { _Pragma("unroll") for (int k = 0; k < 16; ++k) redm[wave * 16 + k] = mx[k]; } \
            __syncthreads(); \
            if (tid < 16) { \
                float m = 0.f; \
                _Pragma("unroll") for (int w = 0; w < 8; ++w) m = fmaxf(m, redm[w * 16 + tid]); \
                const float top = isv ? 256.f : 127.f; \
                scl[tid] = m > 0.f ? top / m : 0.f; \
                ((float*)(ws + (isv ? WS_SV : WS_SU)))[e0 + tid] = m / top; \
            } \
            __syncthreads(); \
            char* dst = ws + (isv ? WS_V8 : WS_U8); \
            _Pragma("unroll") for (int k = 0; k < 8; ++k) { \
                const int item = tid + k * NTHREADS, e = item & 15, sl = item >> 4; \
                const float* tp = tile + e * 2052 + sl * 8; \
                f32x4 a = *reinterpret_cast<const f32x4*>(tp), c = *reinterpret_cast<const f32x4*>(tp + 4); \
                const float m = scl[e]; \
                u32x2 o; \
                if (isv) { \
                    int w0 = __builtin_amdgcn_cvt_pk_fp8_f32(a[0] * m, a[1] * m, 0, false); \
                    w0 = __builtin_amdgcn_cvt_pk_fp8_f32(a[2] * m, a[3] * m, w0, true); \
                    int w1 = __builtin_amdgcn_cvt_pk_fp8_f32(c[0] * m, c[1] * m, 0, false); \
                    w1 = __builtin_amdgcn_cvt_pk_fp8_f32(c[2] * m, c[3] * m, w1, true); \
                    o.x = (unsigned)w0; o.y = (unsigned)w1; \
                } else { \
                    o.x = pack_i8x4(a[0] * m, a[1] * m, a[2] * m, a[3] * m); o.y = pack_i8x4(c[0] * m, c[1] * m, c[2] * m, c[3] * m); \
                } \
                *reinterpret_cast<u32x2*>(dst + ((size_t)sl * 16384 + e0 + e) * 8) = o; \
                if (k & 1) __builtin_amdgcn_sched_barrier(0); \
            } \
            __syncthreads(); } while (0)
        f32x4 va[16];
        const unsigned qoff = (unsigned)tid * 16u;
        Q_LOAD(va, 0);
        __syncthreads();
#pragma unroll 1
        for (int i = 0; i < ntl; ++i) Q_TILE(va, i);
#undef Q_LOAD
#undef Q_TILE
    }
    {
        float2* cs = (float2*)(ws + WS_CS);
        for (size_t i = gtid; i < (size_t)NTOK * 32; i += gthreads) {
            int t = (int)(i >> 5), k = (int)(i & 31);
            float invf = exp2f(-(float)k * (13.287712379549449f / 32.f));
            float ang = (float)p.pos[t] * invf;
            double sd, cd; sincos((double)ang, &sd, &cd);
            cs[i] = make_float2((float)cd, (float)sd);
        }
    }
}

__device__ __forceinline__ void phase1(const Params& p, char* shm, int bid, int nb) {
    const int tid = TIDX(p.wave_s), wave = tid >> 6, lane = tid & 63;
    const float* mod = (const float*)(p.ws + WS_MOD);
    char* h1 = p.ws + WS_BUF1;
    float* sh1 = (float*)(p.ws + WS_SH1);
    float* lv = (float*)shm;
    for (int item = bid; item < NTOK / 64; item += nb) {
        const int b = item >> 5;
        __syncthreads();
        for (int i = tid; i < 512; i += NTHREADS) {
            *reinterpret_cast<f32x4*>(lv + 0 * DM + i * 4) = *reinterpret_cast<const f32x4*>(p.pre_mix_g + i * 4);
            *reinterpret_cast<f32x4*>(lv + 1 * DM + i * 4) = *reinterpret_cast<const f32x4*>(mod + b * 12288 + i * 4);
            *reinterpret_cast<f32x4*>(lv + 2 * DM + i * 4) = *reinterpret_cast<const f32x4*>(mod + b * 12288 + 2048 + i * 4);
        }
        __syncthreads();
#pragma unroll 1
        for (int rr = 0; rr < 8; ++rr) {
            const int row = item * 64 + rr * 8 + wave;
            const float* xr = p.x + (size_t)row * DM + lane * 4;
            f32x4 v[8]; float ss = 0.f;
#pragma unroll
            for (int i = 0; i < 8; ++i) { v[i] = *reinterpret_cast<const f32x4*>(xr + i * 256); ss += v[i][0] * v[i][0] + v[i][1] * v[i][1] + v[i][2] * v[i][2] + v[i][3] * v[i][3]; }
            const float rstd = rsqrtf(wave_sum(ss) * (1.f / DM) + EPS);
            float hmax = 0.f;
#pragma unroll
            for (int i = 0; i < 8; ++i) {
                const int col = i * 256 + lane * 4;
                f32x4 g = *reinterpret_cast<const f32x4*>(lv + col);
                f32x4 sh = *reinterpret_cast<const f32x4*>(lv + DM + col);
                f32x4 sc = *reinterpret_cast<const f32x4*>(lv + 2 * DM + col);
                v[i] = v[i] * rstd * g * (sc + 1.f) + sh;
                hmax = fmaxf(hmax, fmaxf(fmaxf(fabsf(v[i][0]), fabsf(v[i][1])), fmaxf(fabsf(v[i][2]), fabsf(v[i][3]))));
            }
#pragma unroll
            for (int o = 1; o < 64; o <<= 1) hmax = fmaxf(hmax, __shfl_xor(hmax, o));
            const float qm = hmax > 0.f ? 127.f / hmax : 0.f;
            if (lane == 0) sh1[row] = hmax * (1.f / 127.f);
#pragma unroll
            for (int i = 0; i < 8; ++i) {
                *reinterpret_cast<unsigned*>(h1 + (size_t)row * DM + i * 256 + lane * 4) = pack_i8x4(v[i][0] * qm, v[i][1] * qm, v[i][2] * qm, v[i][3] * qm);
            }
        }
    }
    {
        __syncthreads();
        float* scr = (float*)(shm + wave * 8448);
        const unsigned* cmax = (const unsigned*)(p.ws + WS_CMAX);
        float* wsc = (float*)(p.ws + WS_WSC);
        const int gw = bid * NWAVES + wave, ngw = nb * NWAVES;
        constexpr int I_IN = 32 * 58, I_PQ = 32 * 64;
        for (int it = gw; it < I_IN + I_PQ; it += ngw) {
            if (it < I_IN) xpose8_item(p.w_in, 1856, p.ws + WS_WIN, scr, it, lane, cmax, wsc);
            else xpose8_item(p.peer_wq, 2048, p.ws + WS_WPQ, scr, it - I_IN, lane, cmax + 2048, wsc + 2048);
        }
        const size_t gtid = (size_t)bid * NTHREADS + tid, gthreads = (size_t)nb * NTHREADS;
        for (size_t i = gtid; i < 24576; i += gthreads) *reinterpret_cast<u32x4*>(p.ws + WS_WIN + (size_t)1856 * 2048 + i * 16) = u32x4{0u, 0u, 0u, 0u};
        for (size_t i = gtid; i < 192; i += gthreads) wsc[1856 + i] = 0.f;
        __syncthreads();
    }
}

template <bool VT1, bool I8, bool F8 = false, class Epi>
__device__ __forceinline__ void gemm_phase(const bf16_t* A, int lda, const bf16_t* Bt, int ldb, int K, int nN, int ntiles, int tile0, int vcu, int nb,
                                           char* shm, const Epi& epi, int ws_) {
    int first = ((vcu - tile0) % nb + nb) % nb;
    bool pre = false;
    for (int t = first; t < ntiles; t += nb) {
        const int pm = t / nN, pn = t % nN;
        const int tn = t + nb;
        const bool has = tn < ntiles;
        const NextTile nx{A, Bt, lda, ldb, has ? (tn / nN) * 256 : -1, (tn % nN) * 256};
        gemm_tile<VT1, I8, F8>(A, lda, Bt, ldb, K / 64, pm * 256, pn * 256, shm, epi, pre, nx, ws_);
        pre = has;
    }
}

__device__ __forceinline__ void phase3(const Params& p, int bid, int nb) {
    const int tid = TIDX(p.wave_s), wave = tid >> 6, lane = tid & 63;
    const bf16_t* proj = (const bf16_t*)(p.ws + WS_BUF2);
    bf16_t* z = (bf16_t*)(p.ws + WS_Z);
    for (int it = bid * NTHREADS + tid; it < 1024 * 128; it += nb * NTHREADS) {
        const int strip = it >> 7, c8 = it & 127, g = c8 >> 5, w = 2 << g;
        const int t0 = strip * 16, s0 = t0 & 2047;
        const bf16_t* up = proj + (size_t)t0 * DM + c8 * 8;
        float sum[8];
#pragma unroll
        for (int j = 0; j < 8; ++j) sum[j] = 0.f;
        for (int i = 1; i <= w; ++i) {
            if (s0 - i >= 0) {
                u32x4 r = *reinterpret_cast<const u32x4*>(up - (ptrdiff_t)i * DM);
#pragma unroll
                for (int j = 0; j < 4; ++j) { sum[2 * j] += bflo(r[j]); sum[2 * j + 1] += bfhi(r[j]); }
            }
        }
        for (int tt = 0; tt < 16; ++tt) {
            const int s = s0 + tt;
            u32x4 r = *reinterpret_cast<const u32x4*>(up + (size_t)tt * DM);
            float cur[8];
#pragma unroll
            for (int j = 0; j < 4; ++j) { cur[2 * j] = bflo(r[j]); cur[2 * j + 1] = bfhi(r[j]); }
#pragma unroll
            for (int j = 0; j < 8; ++j) sum[j] += cur[j];
            if (s >= w) {
                u32x4 o = *reinterpret_cast<const u32x4*>(up + (ptrdiff_t)(tt - w) * DM);
#pragma unroll
                for (int j = 0; j < 4; ++j) { sum[2 * j] -= bflo(o[j]); sum[2 * j + 1] -= bfhi(o[j]); }
            }
            const float inv = 1.f / (float)min(s + 1, w);
            u32x2 o;
            o.x = (unsigned)pk_fp8x4(sum[0] * inv - cur[0], sum[1] * inv - cur[1], sum[2] * inv - cur[2], sum[3] * inv - cur[3]);
            o.y = (unsigned)pk_fp8x4(sum[4] * inv - cur[4], sum[5] * inv - cur[5], sum[6] * inv - cur[6], sum[7] * inv - cur[7]);
            *reinterpret_cast<u32x2*>((char*)z + (size_t)(t0 + tt) * 1024 + c8 * 8) = o;
        }
    }
    float* rq = (float*)(p.ws + WS_RSTDQ); float* rkv = (float*)(p.ws + WS_RSTDKV);
    bf16_t* kpe = (bf16_t*)(p.ws + WS_KPE);
    const float2* cs = (const float2*)(p.ws + WS_CS);
    for (int t = bid * NWAVES + wave; t < NTOK; t += nb * NWAVES) {
        const bf16_t* pr = proj + (size_t)t * DM;
        u32x4 a = *reinterpret_cast<const u32x4*>(pr + 1024 + lane * 8);
        float s1 = 0.f;
#pragma unroll
        for (int j = 0; j < 4; ++j) { float lo = bflo(a[j]), hi = bfhi(a[j]); s1 += lo * lo + hi * hi; }
        u32x2 bq = *reinterpret_cast<const u32x2*>(pr + 1536 + lane * 4);
        float s2 = 0.f;
#pragma unroll
        for (int j = 0; j < 2; ++j) { float lo = bflo(bq[j]), hi = bfhi(bq[j]); s2 += lo * lo + hi * hi; }
        s1 = wave_sum(s1); s2 = wave_sum(s2);
        if (lane == 0) { rq[t] = rsqrtf(s1 * (1.f / 512.f) + EPS); rkv[t] = rsqrtf(s2 * (1.f / 256.f) + EPS); }
        if (lane < 32) {
            float x1 = bf2f((short)pr[1792 + lane]), x2 = bf2f((short)pr[1792 + 32 + lane]);
            float2 c = cs[(size_t)t * 32 + lane];
            unsigned char* k8 = (unsigned char*)kpe + (size_t)t * 64 + 32 * (lane >> 4) + (lane & 15);
            const int w = pk_fp8x4(x1 * c.x - x2 * c.y, x2 * c.x + x1 * c.y, 0.f, 0.f);
            k8[0] = (unsigned char)(w & 0xff); k8[16] = (unsigned char)((w >> 8) & 0xff);
        }
    }
}

constexpr int KS_STRIDE = 208, VS_STRIDE = 80;
constexpr int KS_BYTES = 64 * KS_STRIDE, VS_BYTES = 128 * VS_STRIDE, AT_STAGE = KS_BYTES + VS_BYTES;
__device__ __forceinline__ void attn_unit(const Params& p, char* shm, int b, int head, int qb) {
    int tid = TIDX(p.wave_s); asm volatile("" : "+v"(tid));
    const int wave = __builtin_amdgcn_readfirstlane(tid >> 6), lane = tid & 63, l31 = lane & 31, hh = lane >> 5;
    const bool grpB = wave >= 4;
    const int rowblk = (wave & 3) * 2 + (wave >> 2);
    const bf16_t* Q = (const bf16_t*)(p.ws + WS_Q);
    const bf16_t* Kn = (const bf16_t*)(p.ws + WS_KN);
    const bf16_t* Kpe = (const bf16_t*)(p.ws + WS_KPE);
    const bf16_t* Vt = (const bf16_t*)(p.ws + WS_VT);
    const float2* cs = (const float2*)(p.ws + WS_CS);
    bf16_t* ycat = (bf16_t*)(p.ws + WS_BUF1);
    const int q0 = qb * 256 + rowblk * 32, mychunk = q0 >> 6, nkt = 4 * qb + 4;
    const int tq = b * SEQ + q0 + l31;
    i32x8 qf[3];
    {
        const bf16_t* qrow = Q + (size_t)tq * 1536 + head * 192;
#pragma unroll
        for (int ks = 0; ks < 2; ++ks)
#pragma unroll
            for (int i = 0; i < 4; ++i) {
                const bf16x8 v = *reinterpret_cast<const bf16x8*>(qrow + ks * 64 + hh * 32 + 8 * i);
                qf[ks][2 * i] = pk_fp8x4(bf2f(v[0]) * 8.f, bf2f(v[1]) * 8.f, bf2f(v[2]) * 8.f, bf2f(v[3]) * 8.f);
                qf[ks][2 * i + 1] = pk_fp8x4(bf2f(v[4]) * 8.f, bf2f(v[5]) * 8.f, bf2f(v[6]) * 8.f, bf2f(v[7]) * 8.f);
            }
#pragma unroll
        for (int i = 0; i < 2; ++i) {
            const bf16x8 a = *reinterpret_cast<const bf16x8*>(qrow + 128 + 16 * hh + 8 * i);
            const bf16x8 c2 = *reinterpret_cast<const bf16x8*>(qrow + 160 + 16 * hh + 8 * i);
            const float2* cp = cs + (size_t)tq * 32 + 16 * hh + 8 * i;
            float o1[8], o2[8];
#pragma unroll
            for (int j = 0; j < 8; ++j) {
                const float2 c = cp[j];
                const float x1 = bf2f(a[j]) * 8.f, x2 = bf2f(c2[j]) * 8.f;
                o1[j] = x1 * c.x - x2 * c.y; o2[j] = x2 * c.x + x1 * c.y;
            }
            qf[2][2 * i] = pk_fp8x4(o1[0], o1[1], o1[2], o1[3]); qf[2][2 * i + 1] = pk_fp8x4(o1[4], o1[5], o1[6], o1[7]);
            qf[2][4 + 2 * i] = pk_fp8x4(o2[0], o2[1], o2[2], o2[3]); qf[2][4 + 2 * i + 1] = pk_fp8x4(o2[4], o2[5], o2[6], o2[7]);
        }
    }
    f32x16 O[4];
#pragma unroll
    for (int dt = 0; dt < 4; ++dt)
#pragma unroll
        for (int r = 0; r < 16; ++r) O[dt][r] = 0.f;
    float mrun = -1e30f, lsum = 0.f;
    f32x16 s0, s1;
    const int kkey = tid >> 3, kch = tid & 7;
    const int pk_key = tid >> 2, pk_ch = tid & 3;
    const int vd = tid >> 2, vch = tid & 3;
    const size_t tokb = (size_t)b * SEQ;
    const char* Kn8 = (const char*)Kn; const char* Kpe8 = (const char*)Kpe;
    const char* vbase = (const char*)Vt + (size_t)((b * 8 + head) * 128) * SEQ;
    u32x4 r0, r2, r3;
#define AT_LOAD(kt) do { const int k0_ = (kt) * 64; \
        r0 = *reinterpret_cast<const u32x4*>(Kn8 + (tokb + k0_ + kkey) * 1024 + head * 128 + kch * 16); \
        if (wave < 4) r2 = *reinterpret_cast<const u32x4*>(Kpe8 + (tokb + k0_ + pk_key) * 64 + pk_ch * 16); \
        r3 = *reinterpret_cast<const u32x4*>(vbase + (size_t)vd * SEQ + k0_ + vch * 16); } while (0)
#define AT_WRITE(buf) do { char* ks_ = shm + (buf) * AT_STAGE; char* vs_ = ks_ + KS_BYTES; \
        *reinterpret_cast<u32x4*>(ks_ + kkey * KS_STRIDE + kch * 16) = r0; \
        if (wave < 4) *reinterpret_cast<u32x4*>(ks_ + pk_key * KS_STRIDE + 128 + pk_ch * 16) = r2; \
        *reinterpret_cast<u32x4*>(vs_ + vd * VS_STRIDE + vch * 16) = r3; } while (0)
#define LDK(ks_, t_) __builtin_shufflevector(*reinterpret_cast<const i32x4*>(kb + (t_) * 32 * KS_STRIDE + (ks_) * 64), \
                                             *reinterpret_cast<const i32x4*>(kb + (t_) * 32 * KS_STRIDE + (ks_) * 64 + 16), 0, 1, 2, 3, 4, 5, 6, 7)
#define MXQK(a_, b_, c_) __builtin_amdgcn_mfma_scale_f32_32x32x64_f8f6f4(a_, b_, c_, 0, 0, 0, 0x7F7F7F7F, 0, 0x7F7F7F7F)
#define QK(buf) do { \
        const char* kb = shm + (buf) * AT_STAGE + l31 * KS_STRIDE + hh * 32; \
        i32x8 ka0 = LDK(0, 0), ka1 = LDK(0, 1), kb0 = LDK(1, 0), kb1 = LDK(1, 1); \
        _Pragma("unroll") for (int r = 0; r < 16; ++r) { s0[r] = 0.f; s1[r] = 0.f; } \
        __builtin_amdgcn_sched_barrier(0); \
        s0 = MXQK(ka0, qf[0], s0); \
        s1 = MXQK(ka1, qf[0], s1); \
        ka0 = LDK(2, 0); ka1 = LDK(2, 1); \
        __builtin_amdgcn_sched_barrier(0); \
        s0 = MXQK(kb0, qf[1], s0); \
        s1 = MXQK(kb1, qf[1], s1); \
        __builtin_amdgcn_sched_barrier(0); \
        s0 = MXQK(ka0, qf[2], s0); \
        s1 = MXQK(ka1, qf[2], s1); \
        __builtin_amdgcn_sched_barrier(0); } while (0)
#define LDV(dt_) __builtin_shufflevector(*reinterpret_cast<const i32x4*>(vb + (dt_) * 32 * VS_STRIDE), *reinterpret_cast<const i32x4*>(vb + (dt_) * 32 * VS_STRIDE + 16), 0, 1, 2, 3, 4, 5, 6, 7)
#define SMPV(buf) do { \
        const char* vb = shm + (buf) * AT_STAGE + KS_BYTES + l31 * VS_STRIDE + hh * 32; \
        i32x8 va[4]; \
        _Pragma("unroll") for (int dt = 0; dt < 4; ++dt) va[dt] = LDV(dt); \
        float mx = s0[0]; \
        _Pragma("unroll") for (int r = 1; r < 16; ++r) mx = fmaxf(mx, s0[r]); \
        _Pragma("unroll") for (int r = 0; r < 16; ++r) mx = fmaxf(mx, s1[r]); \
        mx = fmaxf(mx, __shfl_xor(mx, 32)); \
        const float mnew = fmaxf(mrun, mx * 0.125f); \
        const float alpha = __builtin_amdgcn_exp2f(mrun - mnew); \
        mrun = mnew; \
        const float moff = 6.f - mnew;        \
        float ps = 0.f; \
        _Pragma("unroll") for (int r = 0; r < 16; ++r) { s0[r] = __builtin_amdgcn_exp2f(fmaf(s0[r], 0.125f, moff)); ps += s0[r]; } \
        _Pragma("unroll") for (int r = 0; r < 16; ++r) { s1[r] = __builtin_amdgcn_exp2f(fmaf(s1[r], 0.125f, moff)); ps += s1[r]; } \
        lsum = lsum * alpha + ps; \
        _Pragma("unroll") for (int dt = 0; dt < 4; ++dt) _Pragma("unroll") for (int r = 0; r < 16; ++r) O[dt][r] *= alpha; \
        i32x8 pf; \
          \
        _Pragma("unroll") for (int f1 = 0; f1 < 2; ++f1) { \
            pf[f1 * 4 + 0] = pk_fp8x4(s0[4 * f1], s0[4 * f1 + 1], s0[4 * f1 + 2], s0[4 * f1 + 3]); \
            pf[f1 * 4 + 1] = pk_fp8x4(s0[8 + 4 * f1], s0[8 + 4 * f1 + 1], s0[8 + 4 * f1 + 2], s0[8 + 4 * f1 + 3]); \
            pf[f1 * 4 + 2] = pk_fp8x4(s1[4 * f1], s1[4 * f1 + 1], s1[4 * f1 + 2], s1[4 * f1 + 3]); \
            pf[f1 * 4 + 3] = pk_fp8x4(s1[8 + 4 * f1], s1[8 + 4 * f1 + 1], s1[8 + 4 * f1 + 2], s1[8 + 4 * f1 + 3]); \
        } \
        __builtin_amdgcn_sched_barrier(0); \
        _Pragma("unroll") for (int dt = 0; dt < 4; ++dt) O[dt] = MXQK(va[dt], pf, O[dt]); \
        __builtin_amdgcn_sched_barrier(0); } while (0)
    __syncthreads();
    AT_LOAD(0); AT_WRITE(0);
    AT_LOAD(1);
    __syncthreads();
    if (grpB) __syncthreads();
    int bcur = 0, bnext = 1;
    for (int kt = 0; kt < nkt; ++kt) {
        if (kt + 1 < nkt) AT_WRITE(bnext);
        if (kt + 2 < nkt) AT_LOAD(kt + 2);
        __builtin_amdgcn_sched_barrier(0);
        if (kt <= mychunk) QK(bcur);
        __syncthreads();
        if (kt <= mychunk) SMPV(bcur);
        __syncthreads();
        bcur = bnext; bnext = (bnext == 2) ? 0 : bnext + 1;
    }
    if (!grpB) __syncthreads();
#undef AT_LOAD
#undef AT_WRITE
#undef QK
#undef SMPV
#undef LDK
#undef MXQK
#undef LDV
    lsum += __shfl_xor(lsum, 32);
    const float inv = 1.f / lsum;
    char* orow = (char*)ycat + (size_t)tq * DM + 1024 + head * 128 + 4 * hh;
#pragma unroll
    for (int dt = 0; dt < 4; ++dt)
#pragma unroll
        for (int g = 0; g < 4; ++g)
            *reinterpret_cast<int*>(orow + dt * 32 + 8 * g) = pk_fp8x4(O[dt][4 * g] * inv, O[dt][4 * g + 1] * inv, O[dt][4 * g + 2] * inv, O[dt][4 * g + 3] * inv);
}
__device__ __forceinline__ void phase5(const Params& p, char* shm, int bid, int nb) {
    for (int it = bid; it < 256; it += nb) {
        const int bh = it >> 2, pr = it & 3, b = bh >> 3, head = bh & 7;
        attn_unit(p, shm, b, head, 7 - pr);
        attn_unit(p, shm, b, head, pr);
    }
}

__device__ __forceinline__ void phase7(const Params& p, char* shm, int bid, int nb) {
    const int tid = TIDX(p.wave_s), wave = tid >> 6, lane = tid & 63;
    const float* mod = (const float*)(p.ws + WS_MOD);
    const bf16_t* y = (const bf16_t*)(p.ws + WS_BUF2);
    bf16_t* x1 = (bf16_t*)(p.ws + WS_X1);
    float* lv = (float*)shm;
    for (int item = bid; item < NTOK / 64; item += nb) {
        const int b = item >> 5;
        const float* md = mod + b * 12288;
        __syncthreads();
        for (int i = tid; i < 512; i += NTHREADS) {
            *reinterpret_cast<f32x4*>(lv + 0 * DM + i * 4) = *reinterpret_cast<const f32x4*>(p.post_mix_g + i * 4);
            *reinterpret_cast<f32x4*>(lv + 1 * DM + i * 4) = *reinterpret_cast<const f32x4*>(md + 4096 + i * 4);
            *reinterpret_cast<f32x4*>(lv + 2 * DM + i * 4) = *reinterpret_cast<const f32x4*>(p.pre_ffn_g + i * 4);
            *reinterpret_cast<f32x4*>(lv + 3 * DM + i * 4) = *reinterpret_cast<const f32x4*>(md + 6144 + i * 4);
            *reinterpret_cast<f32x4*>(lv + 4 * DM + i * 4) = *reinterpret_cast<const f32x4*>(md + 8192 + i * 4);
        }
        __syncthreads();
#pragma unroll 1
        for (int rr = 0; rr < 8; ++rr) {
            const int row = item * 64 + rr * 8 + wave;
            f32x4 yv[8], xr[8]; float ss = 0.f;
#pragma unroll
            for (int i = 0; i < 8; ++i) xr[i] = *reinterpret_cast<const f32x4*>(p.x + (size_t)row * DM + i * 256 + lane * 4);
#pragma unroll
            for (int i = 0; i < 8; ++i) {
                u32x2 r = *reinterpret_cast<const u32x2*>(y + (size_t)row * DM + i * 256 + lane * 4);
                yv[i] = f32x4{bflo(r.x), bfhi(r.x), bflo(r.y), bfhi(r.y)};
                ss += yv[i][0] * yv[i][0] + yv[i][1] * yv[i][1] + yv[i][2] * yv[i][2] + yv[i][3] * yv[i][3];
            }
            const float rstd = rsqrtf(wave_sum(ss) * (1.f / DM) + EPS);
            float s2 = 0.f;
#pragma unroll
            for (int i = 0; i < 8; ++i) {
                const int col = i * 256 + lane * 4;
                f32x4 xv = xr[i];
                f32x4 g = *reinterpret_cast<const f32x4*>(lv + col);
                f32x4 gt = *reinterpret_cast<const f32x4*>(lv + DM + col);
                f32x4 v = xv + gt * (yv[i] * rstd * g);
                st4bf(x1 + (size_t)row * DM + col, v);
                yv[i] = v;
                s2 += v[0] * v[0] + v[1] * v[1] + v[2] * v[2] + v[3] * v[3];
            }
            const float rstd2 = rsqrtf(wave_sum(s2) * (1.f / DM) + EPS);
            float hmax = 0.f;
#pragma unroll
            for (int i = 0; i < 8; ++i) {
                const int col = i * 256 + lane * 4;
                f32x4 g = *reinterpret_cast<const f32x4*>(lv + 2 * DM + col);
                f32x4 sh = *reinterpret_cast<const f32x4*>(lv + 3 * DM + col);
                f32x4 sc = *reinterpret_cast<const f32x4*>(lv + 4 * DM + col);
                yv[i] = yv[i] * rstd2 * g * (sc + 1.f) + sh;
                hmax = fmaxf(hmax, fmaxf(fmaxf(fabsf(yv[i][0]), fabsf(yv[i][1])), fmaxf(fabsf(yv[i][2]), fabsf(yv[i][3]))));
            }
#pragma unroll
            for (int o = 1; o < 64; o <<= 1) hmax = fmaxf(hmax, __shfl_xor(hmax, o));
            const float qm = hmax > 0.f ? 127.f / hmax : 0.f;
            if (lane == 0) ((float*)(p.ws + WS_SH))[row] = hmax * (1.f / 127.f);
#pragma unroll
            for (int i = 0; i < 8; ++i) {
                *reinterpret_cast<unsigned*>(p.ws + WS_H8 + (size_t)row * DM + i * 256 + lane * 4) = pack_i8x4(yv[i][0] * qm, yv[i][1] * qm, yv[i][2] * qm, yv[i][3] * qm);
            }
        }
    }
}

__device__ __forceinline__ int fmap(float f) { int i = __float_as_int(f); return i ^ ((i >> 31) & 0x7fffffff); }
__device__ __forceinline__ float funmap(int i) { return __int_as_float(i ^ ((i >> 31) & 0x7fffffff)); }
__device__ __forceinline__ void ins16(int (&top)[16], int k) {
#pragma unroll
    for (int i = 0; i < 16; ++i) { int hi = max(top[i], k); k = min(top[i], k); top[i] = hi; }
}
__device__ __forceinline__ int bsel(int m, int a, int b) { return (a & ~m) | (b & m); }
__device__ __forceinline__ int sel16(const int (&a)[16], int i) {
    const int m0 = -(i & 1), m1 = -((i >> 1) & 1), m2 = -((i >> 2) & 1), m3 = -((i >> 3) & 1);
    int t8[8], t4[4], t2[2];
#pragma unroll
    for (int k = 0; k < 8; ++k) t8[k] = bsel(m0, a[2 * k], a[2 * k + 1]);
#pragma unroll
    for (int k = 0; k < 4; ++k) t4[k] = bsel(m1, t8[2 * k], t8[2 * k + 1]);
#pragma unroll
    for (int k = 0; k < 2; ++k) t2[k] = bsel(m2, t4[2 * k], t4[2 * k + 1]);
    return bsel(m3, t2[0], t2[1]);
}
#define BITONIC_CE(x, K, J) _Pragma("unroll") for (int i_ = 0; i_ < 16; ++i_) { const int l_ = i_ ^ (J); if (l_ > i_) { const int a_ = x[i_], b_ = x[l_]; \
        if ((i_ & (K)) == 0) { x[i_] = max(a_, b_); x[l_] = min(a_, b_); } else { x[i_] = min(a_, b_); x[l_] = max(a_, b_); } } }
#define BITONIC_MERGE16(x) BITONIC_CE(x, 16, 8) BITONIC_CE(x, 16, 4) BITONIC_CE(x, 16, 2) BITONIC_CE(x, 16, 1)
#define BITONIC_SORT16(x) BITONIC_CE(x, 2, 1) BITONIC_CE(x, 4, 2) BITONIC_CE(x, 4, 1) BITONIC_CE(x, 8, 4) BITONIC_CE(x, 8, 2) BITONIC_CE(x, 8, 1) BITONIC_MERGE16(x)
#define SCE(x, i, j) { const int a_ = x[i], b_ = x[j]; x[i] = max(a_, b_); x[j] = min(a_, b_); }
#define SORT16_60(x) SCE(x,0,13) SCE(x,1,12) SCE(x,2,15) SCE(x,3,14) SCE(x,4,8) SCE(x,5,6) SCE(x,7,11) SCE(x,9,10) SCE(x,0,5) SCE(x,1,7) SCE(x,2,9) SCE(x,3,4) SCE(x,6,13) SCE(x,8,14) SCE(x,10,15) SCE(x,11,12) SCE(x,0,1) SCE(x,2,3) SCE(x,4,5) SCE(x,6,8) SCE(x,7,9) SCE(x,10,11) SCE(x,12,13) SCE(x,14,15) SCE(x,0,2) SCE(x,1,3) SCE(x,4,10) SCE(x,5,11) SCE(x,6,7) SCE(x,8,9) SCE(x,12,14) SCE(x,13,15) SCE(x,1,2) SCE(x,3,12) SCE(x,4,6) SCE(x,5,7) SCE(x,8,10) SCE(x,9,11) SCE(x,13,14) SCE(x,1,4) SCE(x,2,6) SCE(x,5,8) SCE(x,7,10) SCE(x,9,13) SCE(x,11,14) SCE(x,2,4) SCE(x,3,6) SCE(x,9,12) SCE(x,11,13) SCE(x,3,5) SCE(x,6,8) SCE(x,7,9) SCE(x,10,12) SCE(x,3,4) SCE(x,5,6) SCE(x,7,8) SCE(x,9,10) SCE(x,11,12) SCE(x,6,7) SCE(x,8,9)
__device__ __forceinline__ void pk_half_list(const bf16_t* __restrict__ qrow, const char* kl, int hh, int (&out)[16]) {
    bf16x8 qf[8];
#pragma unroll
    for (int ks = 0; ks < 8; ++ks) qf[ks] = *reinterpret_cast<const bf16x8*>(qrow + ks * 16);
    int top[16];
#pragma unroll 1
    for (int kt = 0; kt < 4; ++kt) {
        f32x16 acc;
#pragma unroll
        for (int r = 0; r < 16; ++r) acc[r] = 0.f;
#pragma unroll
        for (int ks = 0; ks < 8; ++ks) {
            bf16x8 kf = *reinterpret_cast<const bf16x8*>(kl + kt * 32 * 272 + ks * 32);
            acc = __builtin_amdgcn_mfma_f32_32x32x16_bf16(kf, qf[ks], acc, 0, 0, 0);
        }
        int nw[16];
#pragma unroll
        for (int r = 0; r < 16; ++r) {
            const int n = kt * 32 + (r & 3) + 8 * (r >> 2) + 4 * hh;
            nw[r] = (fmap(acc[r]) & ~127) | (127 - n);
        }
        SORT16_60(nw)
        if (kt == 0) {
#pragma unroll
            for (int i = 0; i < 16; ++i) top[i] = nw[i];
        } else {
#pragma unroll
            for (int i = 0; i < 16; ++i) top[i] = max(top[i], nw[15 - i]);
            BITONIC_MERGE16(top)
        }
    }
#pragma unroll
    for (int i = 0; i < 16; ++i) out[i] = __shfl_xor(top[15 - i], 32);
#pragma unroll
    for (int i = 0; i < 16; ++i) out[i] = max(out[i], top[i]);
    BITONIC_MERGE16(out)
}
__device__ __forceinline__ void phase9(const Params& p, char* shm, int bid, int nb) {
    int tid = TIDX(p.wave_s); asm volatile("" : "+v"(tid));
    const int wave = tid >> 6, lane = tid & 63, l31 = lane & 31, hh = lane >> 5;
    const bf16_t* pq = (const bf16_t*)(p.ws + WS_BUF2);
    const bf16_t* sk = (const bf16_t*)(p.ws + WS_SK);
    int* idxo = (int*)(p.ws + WS_IDX); float* gateo = (float*)(p.ws + WS_GATE);
    for (int item = bid; item < 8 * 64; item += nb) {
        const int head = item & 7, tt = (item >> 3) * 8 + wave, tok = tt * 32 + l31;
        __syncthreads();
        for (int c = tid; c < 4096; c += NTHREADS) {
            const int row = c >> 4, ch = c & 15;
            *reinterpret_cast<u32x4*>(shm + row * 272 + ch * 16) = *reinterpret_cast<const u32x4*>(sk + (size_t)(head * 256 + row) * 128 + ch * 8);
        }
        __syncthreads();
        int la[16], lb[16];
        pk_half_list(pq + (size_t)tok * DM + head * 256 + hh * 8, shm + l31 * 272 + hh * 16, hh, la);
        pk_half_list(pq + (size_t)tok * DM + head * 256 + 128 + hh * 8, shm + (128 + l31) * 272 + hh * 16, hh, lb);
        float va[16], vb[16]; int ia[16], ib[16];
#pragma unroll
        for (int i = 0; i < 16; ++i) {
            va[i] = funmap(la[i] & ~127); ia[i] = 127 - (la[i] & 127);
            vb[i] = funmap(lb[i] & ~127); ib[i] = 127 - (lb[i] & 127);
        }
#define CKEY(i, j) ((fmap(va[i] + vb[j]) & ~255) | (255 - ((i) * 16 + (j))))
        int top2[16], ga[16], gb[16];
#pragma unroll
        for (int j = 0; j < 16; ++j) top2[j] = CKEY(0, j);
#pragma unroll
        for (int j = 0; j < 8; ++j) { ga[j] = CKEY(1, j); ga[8 + j] = CKEY(15 - j, 0); }
        BITONIC_MERGE16(ga)
        gb[0] = CKEY(2, 0); gb[1] = CKEY(2, 1); gb[2] = CKEY(2, 2); gb[3] = CKEY(2, 3); gb[4] = CKEY(2, 4);
        gb[5] = CKEY(3, 0); gb[6] = CKEY(3, 1); gb[7] = CKEY(3, 2); gb[8] = CKEY(3, 3);
        gb[9] = CKEY(4, 0); gb[10] = CKEY(4, 1); gb[11] = CKEY(4, 2);
        gb[12] = CKEY(5, 0); gb[13] = CKEY(5, 1); gb[14] = CKEY(6, 0); gb[15] = CKEY(6, 1);
        SORT16_60(gb)
#pragma unroll
        for (int i = 0; i < 16; ++i) top2[i] = max(top2[i], ga[15 - i]);
        BITONIC_MERGE16(top2)
#pragma unroll
        for (int i = 0; i < 16; ++i) top2[i] = max(top2[i], gb[15 - i]);
        BITONIC_MERGE16(top2)
        ins16(top2, CKEY(7, 0)); ins16(top2, CKEY(7, 1));
#undef CKEY
        float bv[16], mxv, sum = 0.f; int ex[16];
        {
            LAS int* tA = (LAS int*)(uintptr_t)(69632 + wave * 8192) + lane;
            LAS int* tB = tA + 16 * 64;
#pragma unroll
            for (int i = 0; i < 16; ++i) { tA[i * 64] = ia[i] * 128; tB[i * 64] = ib[i]; }
#pragma unroll
            for (int r = 0; r < 16; ++r) {
                const int code = 255 - (top2[r] & 255);
                ex[r] = tA[(code >> 4) * 64] + tB[(code & 15) * 64];
                bv[r] = funmap(top2[r] & ~255);
            }
        }
        mxv = bv[0];
#pragma unroll
        for (int r = 0; r < 16; ++r) { bv[r] = __expf(bv[r] - mxv); sum += bv[r]; }
        const float inv = 1.f / sum;
        if (hh == 0) {
            const size_t ob = ((size_t)(tok >> 6) * 128 + head * 16) * 64 + (tok & 63);
#pragma unroll
            for (int r = 0; r < 16; ++r) { idxo[ob + r * 64] = ex[r]; gateo[ob + r * 64] = bv[r] * inv; }
        }
    }
}

__device__ __forceinline__ void phase10(const Params& p, char* shm, int bid, int nb) {
    int tid = TIDX(p.wave_s); asm volatile("" : "+v"(tid));
    const int wave = tid >> 6, lane = tid & 63;
    const int* idxT = (const int*)(p.ws + WS_IDX);
    const char* U8 = p.ws + WS_U8;
    const char* H8 = p.ws + WS_H8;
    int* part = (int*)(p.ws + WS_PART);
    for (int task = bid; task < 256; task += nb) {
        const int tg = task >> 3, cg = task & 7;
        const int tt = tg * 8 + wave, t = tt * 64 + lane;
        unsigned ip[64]; int acc[128];
#pragma unroll
        for (int k = 0; k < 64; ++k) {
            const unsigned lo = (unsigned)idxT[((size_t)tt * 128 + 2 * k) * 64 + lane], hi = (unsigned)idxT[((size_t)tt * 128 + 2 * k + 1) * 64 + lane];
            ip[k] = lo | (hi << 16);
        }
#pragma unroll
        for (int j = 0; j < 128; ++j) acc[j] = 0;
#pragma unroll 1
        for (int s = 0; s < 32; ++s) {
            const int slice = cg * 32 + s;
            __syncthreads();
            const char* sbase = U8 + (size_t)slice * 131072;
            const unsigned toff = (unsigned)tid * 16u;
#pragma unroll
            for (int k = 0; k < 16; ++k)
                __builtin_amdgcn_global_load_lds((const unsigned*)(sbase + k * 8192 + toff), (unsigned*)(shm + k * 8192 + tid * 16), 16, 0, 0);
            const u32x2 h = *reinterpret_cast<const u32x2*>(H8 + (size_t)t * DM + slice * 8);
            asm volatile("s_waitcnt vmcnt(0)" ::: "memory");
            __syncthreads();
#define U_LOAD(g, dst) _Pragma("unroll") for (int q = 0; q < 4; ++q) { unsigned w = ip[(g) * 4 + q]; asm volatile("" : "+v"(w)); \
                dst[2 * q] = *reinterpret_cast<const u32x2*>(shm + ((w & 0xffffu) << 3)); dst[2 * q + 1] = *reinterpret_cast<const u32x2*>(shm + ((w >> 16) << 3)); }
#define U_DOT(g, srcv) _Pragma("unroll") for (int q = 0; q < 8; ++q) { \
                acc[(g) * 8 + q] = __builtin_amdgcn_sdot4((int)srcv[q].x, (int)h.x, acc[(g) * 8 + q], false); \
                acc[(g) * 8 + q] = __builtin_amdgcn_sdot4((int)srcv[q].y, (int)h.y, acc[(g) * 8 + q], false); }
            u32x2 ua[8], ub[8];
            U_LOAD(0, ua)
#pragma unroll
            for (int g = 0; g < 16; g += 2) {
                U_LOAD(g + 1, ub)
                U_DOT(g, ua)
                __builtin_amdgcn_sched_barrier(0);
                if (g + 2 < 16) { U_LOAD(g + 2, ua) }
                U_DOT(g + 1, ub)
                __builtin_amdgcn_sched_barrier(0);
            }
#undef U_LOAD
#undef U_DOT
        }
#pragma unroll
        for (int k = 0; k < 64; ++k) part[((size_t)cg * 64 + k) * NTOK + t] = (int)pk2((float)acc[2 * k], (float)acc[2 * k + 1]);
    }
}

__device__ __forceinline__ void phase11(const Params& p, int bid, int nb) {
    const int* part = (const int*)(p.ws + WS_PART);
    const int* idxT = (const int*)(p.ws + WS_IDX); const float* gateT = (const float*)(p.ws + WS_GATE);
    const float* su = (const float*)(p.ws + WS_SU); const float* sv = (const float*)(p.ws + WS_SV); const float* sh = (const float*)(p.ws + WS_SH);
    unsigned* pack = (unsigned*)(p.ws + WS_PACK);
    int t11 = TIDX(p.wave_s); asm volatile("" : "+v"(t11));
    for (int item = bid * NTHREADS + t11; item < NTOK * 128; item += nb * NTHREADS) {
        const int lane = item & 63, j = (item >> 6) & 127, tt = item >> 13, t = tt * 64 + lane;
        float sum = 0.f;
#pragma unroll
        for (int cg = 0; cg < 8; ++cg) { const unsigned w = (unsigned)part[((size_t)cg * 64 + (j >> 1)) * NTOK + t]; sum += (j & 1) ? bfhi(w) : bflo(w); }
        const int e = idxT[item];
        const float a = sum * sh[t] * su[e];
        const float act = 0.5f * a * (1.f + erff(a * 0.70710678118654752f)) * gateT[item] * sv[e];
        { const _Float16 ah = (_Float16)(act * 256.f); pack[item] = ((unsigned)__builtin_bit_cast(unsigned short, ah) << 16) | ((unsigned)e << 2); }
    }
}

__device__ __forceinline__ void phase12(const Params& p, char* shm, int bid, int nb) {
    int tid = TIDX(p.wave_s); asm volatile("" : "+v"(tid));
    const int wave = tid >> 6, lane = tid & 63;
    const unsigned* pack = (const unsigned*)(p.ws + WS_PACK);
    const char* V8 = p.ws + WS_V8;
    bf16_t* y2 = (bf16_t*)(p.ws + WS_Y2);
    for (int slice = bid; slice < 256; slice += nb) {
        __syncthreads();
        const char* src = V8 + (size_t)slice * 131072 + tid * 16;
#pragma unroll
        for (int k = 0; k < 16; ++k)
            __builtin_amdgcn_global_load_lds((const unsigned*)(src + k * 8192), (unsigned*)(shm + k * 8192 + tid * 16), 16, 0, 0);
        asm volatile("s_waitcnt vmcnt(0)" ::: "memory");
        __syncthreads();
#define V_LOAD(ptr, g, dst) _Pragma("unroll") for (int q = 0; q < 16; ++q) dst[q] = *reinterpret_cast<const unsigned*>(reinterpret_cast<const char*>((ptr) + (g) * 1024) + lane4 + q * 256);
#define V_LDS(srcp, dstv) _Pragma("unroll") for (int q = 0; q < 16; ++q) { unsigned ad_; \
            asm("v_lshlrev_b32_sdwa %0, %1, %2 dst_sel:DWORD dst_unused:UNUSED_PAD src0_sel:DWORD src1_sel:WORD_0" : "=v"(ad_) : "v"(one_), "v"(srcp[q])); \
            dstv[q] = *reinterpret_cast<const LAS u32x2*>((uintptr_t)ad_); }
#define V_CVT(w_, hi_) __builtin_bit_cast(h2v, __builtin_amdgcn_cvt_scalef32_pk_f16_fp8(w_, __uint_as_float(0x3F80007Fu), hi_))
#define V_FMAS(srcp, srcv) _Pragma("unroll") for (int q = 0; q < 16; ++q) { const h2v ph = __builtin_bit_cast(h2v, srcp[q]); const h2v act = {ph[1], ph[1]}; \
                y[0] = __builtin_elementwise_fma(act, V_CVT(srcv[q].x, false), y[0]); y[1] = __builtin_elementwise_fma(act, V_CVT(srcv[q].x, true), y[1]); \
                y[2] = __builtin_elementwise_fma(act, V_CVT(srcv[q].y, false), y[2]); y[3] = __builtin_elementwise_fma(act, V_CVT(srcv[q].y, true), y[3]); }
#define V_STEP(ptr, g, pkLoad, pkLds, vLds, pkCur, vCur) V_LOAD(ptr, g, pkLoad) V_LDS(pkLds, vLds) V_FMAS(pkCur, vCur) __builtin_amdgcn_sched_barrier(0);
        unsigned pkA[16], pkB[16], pkC[16]; u32x2 vA[16], vB[16];
        unsigned one_ = 1u; asm volatile("" : "+v"(one_));
        const int wave_u = __builtin_amdgcn_readfirstlane(wave);
        const unsigned lane4 = (unsigned)lane * 4u;
        {
            const unsigned* pp0 = pack + (size_t)wave_u * 8192;
            V_LOAD(pp0, 0, pkA) V_LOAD(pp0, 1, pkB) V_LDS(pkA, vA)
        }
#pragma unroll 1
        for (int tt = wave_u; tt < 256; tt += NWAVES) {
            h2v y[4];
#pragma unroll
            for (int c = 0; c < 4; ++c) y[c] = h2v{(_Float16)0.f, (_Float16)0.f};
            const unsigned* pp = pack + (size_t)tt * 8192;
            const int ttn = (tt + NWAVES < 256) ? tt + NWAVES : tt;
            const unsigned* pn = pack + (size_t)ttn * 8192;
            V_STEP(pp, 2, pkC, pkB, vB, pkA, vA)
            V_STEP(pp, 3, pkA, pkC, vA, pkB, vB)
            V_STEP(pp, 4, pkB, pkA, vB, pkC, vA)
            V_STEP(pp, 5, pkC, pkB, vA, pkA, vB)
            V_STEP(pp, 6, pkA, pkC, vB, pkB, vA)
            V_STEP(pp, 7, pkB, pkA, vA, pkC, vB)
            V_STEP(pn, 0, pkC, pkB, vB, pkA, vA)
            V_STEP(pn, 1, pkA, pkC, vA, pkB, vB)
#pragma unroll
            for (int q = 0; q < 16; ++q) { const unsigned t0_ = pkA[q]; pkA[q] = pkC[q]; pkB[q] = t0_; }
            *reinterpret_cast<u32x4*>(y2 + (size_t)(tt * 64 + lane) * DM + slice * 8) =
                u32x4{__builtin_bit_cast(unsigned, y[0]), __builtin_bit_cast(unsigned, y[1]), __builtin_bit_cast(unsigned, y[2]), __builtin_bit_cast(unsigned, y[3])};
        }
#undef V_LOAD
#undef V_LDS
#undef V_CVT
#undef V_FMAS
#undef V_STEP
    }
}

__device__ __forceinline__ float h16f(unsigned h) {
    const unsigned s_ = (h & 0x8000u) << 16, e_ = (h >> 10) & 31u, m_ = h & 0x3ffu;
    return e_ == 0u ? __uint_as_float(s_) : __uint_as_float(s_ | ((e_ + 112u) << 23) | (m_ << 13));
}
__device__ __forceinline__ void phase13(const Params& p, char* shm, int bid, int nb) {
    const int tid = TIDX(p.wave_s), wave = tid >> 6, lane = tid & 63;
    const float* mod = (const float*)(p.ws + WS_MOD);
    const bf16_t* y2 = (const bf16_t*)(p.ws + WS_Y2);
    const bf16_t* x1 = (const bf16_t*)(p.ws + WS_X1);
    float* lv = (float*)shm;
    for (int item = bid; item < NTOK / 64; item += nb) {
        const int b = item >> 5;
        __syncthreads();
        for (int i = tid; i < 512; i += NTHREADS) {
            *reinterpret_cast<f32x4*>(lv + 0 * DM + i * 4) = *reinterpret_cast<const f32x4*>(p.post_ffn_g + i * 4);
            *reinterpret_cast<f32x4*>(lv + 1 * DM + i * 4) = *reinterpret_cast<const f32x4*>(mod + b * 12288 + 10240 + i * 4);
        }
        __syncthreads();
#pragma unroll 1
        for (int rr = 0; rr < 8; ++rr) {
            const int row = item * 64 + rr * 8 + wave;
            f32x4 yv[8]; u32x2 xr[8]; float ss = 0.f;
#pragma unroll
            for (int i = 0; i < 8; ++i) {
                u32x2 r = *reinterpret_cast<const u32x2*>(y2 + (size_t)row * DM + i * 256 + lane * 4);
                xr[i] = *reinterpret_cast<const u32x2*>(x1 + (size_t)row * DM + i * 256 + lane * 4);
                yv[i] = f32x4{h16f(r.x & 0xffffu), h16f(r.x >> 16), h16f(r.y & 0xffffu), h16f(r.y >> 16)};
                ss += yv[i][0] * yv[i][0] + yv[i][1] * yv[i][1] + yv[i][2] * yv[i][2] + yv[i][3] * yv[i][3];
            }
            const float rstd = rsqrtf(wave_sum(ss) * (1.f / DM) + EPS);
#pragma unroll
            for (int i = 0; i < 8; ++i) {
                const int col = i * 256 + lane * 4;
                f32x4 xv = f32x4{bflo(xr[i].x), bfhi(xr[i].x), bflo(xr[i].y), bfhi(xr[i].y)};
                f32x4 g = *reinterpret_cast<const f32x4*>(lv + col);
                f32x4 gt = *reinterpret_cast<const f32x4*>(lv + DM + col);
                *reinterpret_cast<f32x4*>(p.out + (size_t)row * DM + col) = xv + gt * (yv[i] * rstd * g);
            }
        }
    }
}

constexpr int NPHASE = 14;
__global__ void __launch_bounds__(NTHREADS, 2) mega(Params p, int ph_lo, int ph_hi) {
    extern __shared__ __attribute__((aligned(16))) char shm[];
    p.wave_s = __builtin_amdgcn_readfirstlane((int)(threadIdx.x >> 6));
    const int bid = blockIdx.x, nb = gridDim.x;
    const int vcu = vcu_of(bid, nb);
    char* ws = p.ws;
    volatile LAS unsigned* xbw = (volatile LAS unsigned*)(shm + XB_OFF);
    if (TIDX(p.wave_s) == 0) { xbw[0] = 0u; xbw[1] = 0u; }
    __syncthreads();
    XcdBarrier bar; bar.bar = (unsigned*)(ws + WS_BAR); bar.x = 0; bar.st = xbw; bar.ws = p.wave_s;
    if (ph_hi - ph_lo > 1) bar = xcd_barrier_post((unsigned*)(ws + WS_BAR), xbw, p.wave_s);
#ifndef DUP_PH
#define DUP_PH (-1)
#endif
#define REP(k) for (int rep_ = 0; rep_ < ((k) == DUP_PH ? 2 : 1); ++rep_)
#ifdef ONLY_PH
#define PH(k) ((k) == ONLY_PH && ph_lo <= (k) && (k) < ph_hi)
#else
#define PH(k) (ph_lo <= (k) && (k) < ph_hi)
#endif
#define SEAM(k) do { if (ph_lo <= (k) && (k) + 1 < ph_hi) xcd_barrier(bar); } while (0)
    if (PH(0)) REP(0) phase0(p, shm, bid, nb);
    SEAM(0);
    if (PH(1)) REP(1) phase1(p, shm, bid, nb);
    SEAM(1);
    if (PH(2)) REP(2) {
        EpiI8 e{(bf16_t*)(ws + WS_BUF2), DM, (const float*)(ws + WS_SH1), (const float*)(ws + WS_WSC), ws + WS_PROJ8};
        gemm_phase<false, true>((const bf16_t*)(ws + WS_BUF1), DM / 2, (const bf16_t*)(ws + WS_WIN), DM / 2, 1024, 8, 512, 0, vcu, nb, shm, e, p.wave_s);
    }
    SEAM(2);
    if (PH(3)) REP(3) phase3(p, bid, nb);
    SEAM(3);
    if (PH(4)) REP(4) {
        EpiQ eq{(bf16_t*)(ws + WS_Q), (const float*)(ws + WS_RSTDQ)};
        EpiKV ekv{(bf16_t*)(ws + WS_KN), (bf16_t*)(ws + WS_VT), (const float*)(ws + WS_RSTDKV)};
        const bf16_t* qA = (const bf16_t*)(ws + WS_PROJ8); const bf16_t* qB = (const bf16_t*)(ws + WS_WUQ);
        const bf16_t* kA = (const bf16_t*)(ws + WS_PROJ8 + 512); const bf16_t* kB = (const bf16_t*)(ws + WS_WUKV);
        if (nb == 256) {
            const int nq = vcu < 128 ? 2 : 1, q0 = vcu < 128 ? 2 * vcu : vcu + 128;
            const int nkv = vcu < 128 ? 1 : 3, kv0 = vcu < 128 ? vcu : 128 + 3 * (vcu - 128);
            const int g = vcu >> 6, pmp = vcu & 63;
            const bf16_t* pA = (const bf16_t*)(ws + WS_Z + g * 256); const bf16_t* pB = (const bf16_t*)(ws + WS_WPOOL + g * 65536);
            const NextTile kvfirst{kA, kB, 384, 128, (kv0 >> 3) * 256, (kv0 & 7) * 256};
            const NextTile poolt{pA, pB, 512, 128, pmp * 256, 0};
#pragma unroll 1
            for (int i = 0; i < nq; ++i) {
                const int t = q0 + i;
                const NextTile nx = (i + 1 < nq) ? NextTile{qA, qB, 384, 256, ((t + 1) / 6) * 256, ((t + 1) % 6) * 256} : kvfirst;
                gemm_tile<false, false, true>(qA, 384, qB, 256, 4, (t / 6) * 256, (t % 6) * 256, shm, eq, i > 0, nx, p.wave_s);
            }
#pragma unroll 1
            for (int i = 0; i < nkv; ++i) {
                const int t = kv0 + i;
                const NextTile nx = (i + 1 < nkv) ? NextTile{kA, kB, 384, 128, ((t + 1) >> 3) * 256, ((t + 1) & 7) * 256} : poolt;
                gemm_tile<true, false, true>(kA, 384, kB, 128, 2, (t >> 3) * 256, (t & 7) * 256, shm, ekv, true, nx, p.wave_s);
            }
            {
                EpiPool e{(bf16_t*)(ws + WS_BUF1), p.pool_scale, g * 256};
                gemm_tile<false, false, true>(pA, 512, pB, 128, 2, pmp * 256, 0, shm, e, true, NextTile{pA, pB, 512, 128, -1, 0}, p.wave_s);
            }
        } else {
            gemm_phase<false, false, true>(qA, 384, qB, 256, 256, 6, 384, 0, vcu, nb, shm, eq, p.wave_s);
            gemm_phase<true, false, true>(kA, 384, kB, 128, 128, 8, 512, 384, vcu, nb, shm, ekv, p.wave_s);
            const int first = ((vcu - 896) % nb + nb) % nb;
            for (int t = first; t < 256; t += nb) {
                const int g = t >> 6, pm = t & 63;
                EpiPool e{(bf16_t*)(ws + WS_BUF1), p.pool_scale, g * 256};
                gemm_tile<false, false, true>((const bf16_t*)(ws + WS_Z + g * 256), 512, (const bf16_t*)(ws + WS_WPOOL + g * 65536), 128, 2, pm * 256, 0, shm, e, false, NextTile{nullptr, nullptr, 0, 0, -1, 0}, p.wave_s);
            }
        }
    }
    SEAM(4);
    if (PH(5)) REP(5) phase5(p, shm, vcu, nb);
    SEAM(5);
    if (PH(6)) REP(6) {
        EpiBf16 e{(bf16_t*)(ws + WS_BUF2), DM, 1.f / 32.f};
        gemm_phase<false, false, true>((const bf16_t*)(ws + WS_BUF1), DM / 2, (const bf16_t*)(ws + WS_WOUT), DM / 2, 1024, 8, 512, 0, vcu, nb, shm, e, p.wave_s);
    }
    SEAM(6);
    if (PH(7)) REP(7) phase7(p, shm, bid, nb);
    SEAM(7);
    if (PH(8)) REP(8) {
        EpiI8 e{(bf16_t*)(ws + WS_BUF2), DM, (const float*)(ws + WS_SH), (const float*)(ws + WS_WSC) + 2048, nullptr};
        gemm_phase<false, true>((const bf16_t*)(ws + WS_H8), DM / 2, (const bf16_t*)(ws + WS_WPQ), DM / 2, 1024, 8, 512, 0, vcu, nb, shm, e, p.wave_s);
    }
    SEAM(8);
    if (PH(9)) REP(9) phase9(p, shm, bid, nb);
    SEAM(9);
    if (PH(10)) REP(10) phase10(p, shm, bid, nb);
    SEAM(10);
    if (PH(11)) REP(11) phase11(p, bid, nb);
    SEAM(11);
    if (PH(12)) REP(12) phase12(p, shm, vcu, nb);
    SEAM(12);
    if (PH(13)) REP(13) phase13(p, shm, bid, nb);
#undef PH
#undef SEAM
}

extern "C" void kernel_launch(void* const* d_in, const int* in_sizes, int n_in, void* d_out, int out_size, void* d_ws, size_t ws_size, hipStream_t stream) {
    static int grid = 0;
    if (grid == 0) {
        if (n_in != 21 || ws_size < WS_END) { fprintf(stderr, "kernel_launch: unexpected n_in %d / ws_size %zu (need %zu)\n", n_in, ws_size, (size_t)WS_END); grid = -1; return; }
        int dev = 0, cus = 0;
        if (hipGetDevice(&dev) != hipSuccess || hipDeviceGetAttribute(&cus, hipDeviceAttributeMultiprocessorCount, dev) != hipSuccess) { grid = -1; return; }
        if (hipFuncSetAttribute((const void*)mega, hipFuncAttributeMaxDynamicSharedMemorySize, LDS_BYTES) != hipSuccess) { fprintf(stderr, "hipFuncSetAttribute failed\n"); grid = -1; return; }
        int per_cu = 0;
        if (hipOccupancyMaxActiveBlocksPerMultiprocessor(&per_cu, (const void*)mega, NTHREADS, LDS_BYTES) != hipSuccess || per_cu < 1)
            fprintf(stderr, "kernel_launch: occupancy query reports %d blocks per CU\n", per_cu);
        (void)hipGetLastError();
        grid = cus;
    }
    if (grid < 0) return;
    (void)hipMemsetAsync((char*)d_ws + WS_ZERO, 0, ZERO_BYTES, stream);
    (void)hipMemsetAsync((char*)d_ws + WS_CMAX, 0, CMAX_BYTES, stream);
    Params p{};
    p.x = (const float*)d_in[0]; p.c = (const float*)d_in[1]; p.pos = (const int*)d_in[2];
    p.ada_w = (const float*)d_in[3]; p.ada_b = (const float*)d_in[4];
    p.pre_mix_g = (const float*)d_in[5]; p.post_mix_g = (const float*)d_in[6]; p.pre_ffn_g = (const float*)d_in[7]; p.post_ffn_g = (const float*)d_in[8];
    p.w_in = (const float*)d_in[9]; p.pool_w = (const float*)d_in[10]; p.pool_scale = (const float*)d_in[11];
    p.q_norm_g = (const float*)d_in[12]; p.w_uq = (const float*)d_in[13]; p.kv_norm_g = (const float*)d_in[14]; p.w_ukv = (const float*)d_in[15];
    p.w_out = (const float*)d_in[16]; p.peer_wq = (const float*)d_in[17]; p.sub_keys = (const float*)d_in[18];
    p.peer_u = (const float*)d_in[19]; p.peer_v = (const float*)d_in[20];
    p.out = (float*)d_out; p.ws = (char*)d_ws;
#if MK_MULTI
    for (int k = 0; k < NPHASE; ++k) hipLaunchKernelGGL(mega, dim3(grid), dim3(NTHREADS), LDS_BYTES, stream, p, k, k + 1);
#else
    hipLaunchKernelGGL(mega, dim3(grid), dim3(NTHREADS), LDS_BYTES, stream, p, 0, NPHASE);
#endif
}
```

```cpp
#include <hip/hip_runtime.h>
#include <hip/hip_bf16.h>
#include <stdint.h>
#include <stdio.h>

#ifndef MK_MULTI
#define MK_MULTI 0
#endif

typedef unsigned short bf16_t;
typedef short bf16x8 __attribute__((ext_vector_type(8)));
typedef float f32x4 __attribute__((ext_vector_type(4)));
typedef float f32x16 __attribute__((ext_vector_type(16)));
typedef unsigned u32x4 __attribute__((ext_vector_type(4)));
typedef int i32x4 __attribute__((ext_vector_type(4)));
typedef int i32x8 __attribute__((ext_vector_type(8)));
__device__ __forceinline__ int pk_fp8x4(float a, float b, float c, float d) {
    int w = __builtin_amdgcn_cvt_pk_fp8_f32(a, b, 0, false);
    return __builtin_amdgcn_cvt_pk_fp8_f32(c, d, w, true);
}
template <bool I8> struct AccT { typedef f32x4 type; };
template <> struct AccT<true> { typedef i32x4 type; };
typedef unsigned u32x2 __attribute__((ext_vector_type(2)));
typedef _Float16 h2v __attribute__((ext_vector_type(2)));

constexpr int NTOK = 16384, DM = 2048, SEQ = 2048;
constexpr int NTHREADS = 512, NWAVES = 8;
constexpr int LDS_BYTES = 140 * 1024;
constexpr int XB_OFF = LDS_BYTES - 64;
constexpr float EPS = 1e-6f;

constexpr size_t MiB = 1024 * 1024;
constexpr size_t WS_ZERO   = 0;
constexpr size_t WS_BAR    = 0;
constexpr size_t WS_MOD    = 16384;
constexpr size_t ZERO_BYTES = 16384;
constexpr size_t WS_CS     = 1 * MiB;
constexpr size_t WS_RSTDQ  = 5 * MiB;
constexpr size_t WS_RSTDKV = 5 * MiB + 65536;
constexpr size_t WS_WIN    = 6 * MiB;
constexpr size_t WS_WOUT   = 14 * MiB;
constexpr size_t WS_WPQ    = 22 * MiB;
constexpr size_t WS_WUQ    = 30 * MiB;
constexpr size_t WS_WUKV   = 32 * MiB;
constexpr size_t WS_WPOOL  = 33 * MiB;
constexpr size_t WS_SK     = 34 * MiB;
constexpr size_t WS_U8     = 35 * MiB;
constexpr size_t WS_V8     = 67 * MiB;
constexpr size_t WS_H8     = 99 * MiB;
constexpr size_t WS_PACK   = 131 * MiB;
constexpr size_t WS_SU     = 139 * MiB;
constexpr size_t WS_SV     = 139 * MiB + 65536;
constexpr size_t WS_SH     = 139 * MiB + 131072;
constexpr size_t WS_SH1    = 139 * MiB + 196608;
constexpr size_t WS_CMAX   = 139 * MiB + 262144;
constexpr size_t WS_WSC    = 139 * MiB + 278528;
constexpr size_t CMAX_BYTES = 2 * 2048 * 4;
constexpr size_t WS_BUF1   = 163 * MiB;
constexpr size_t WS_BUF2   = 227 * MiB;
constexpr size_t WS_BIG    = 291 * MiB;
constexpr size_t WS_Z      = WS_BIG;
constexpr size_t WS_PROJ8  = WS_BIG + 16 * MiB;
constexpr size_t WS_Q      = WS_BIG + 32 * MiB;
constexpr size_t WS_KN     = WS_BIG + 80 * MiB;
constexpr size_t WS_VT     = WS_BIG + 112 * MiB;
constexpr size_t WS_KPE    = WS_BIG + 144 * MiB;
constexpr size_t WS_X1     = WS_BIG;
constexpr size_t WS_IDX    = 438 * MiB;
constexpr size_t WS_GATE   = 446 * MiB;
constexpr size_t WS_PART   = WS_BUF1;
constexpr size_t WS_Y2     = WS_BUF2;
constexpr size_t WS_END    = 454 * MiB;

struct Params {
    const float *x, *c; const int* pos;
    const float *ada_w, *ada_b, *pre_mix_g, *post_mix_g, *pre_ffn_g, *post_ffn_g;
    const float *w_in, *pool_w, *pool_scale, *q_norm_g, *w_uq, *kv_norm_g, *w_ukv, *w_out;
    const float *peer_wq, *sub_keys, *peer_u, *peer_v;
    float* out; char* ws;
    int wave_s;
};

__device__ __forceinline__ unsigned pk2(float lo, float hi) {
    typedef __bf16 bf2 __attribute__((ext_vector_type(2)));
    bf2 v; v[0] = (__bf16)lo; v[1] = (__bf16)hi; return __builtin_bit_cast(unsigned, v);
}
__device__ __forceinline__ float bflo(unsigned u) { return __uint_as_float(u << 16); }
__device__ __forceinline__ float bfhi(unsigned u) { return __uint_as_float(u & 0xffff0000u); }
__device__ __forceinline__ float bf2f(short b) { return __uint_as_float(((unsigned)(unsigned short)b) << 16); }
__device__ __forceinline__ short f2bf(float f) { return (short)(pk2(f, 0.f) & 0xffffu); }
__device__ __forceinline__ unsigned pack_i8x4(float a, float b, float c, float d) {
    unsigned r = 0u;
    r = __builtin_amdgcn_cvt_pk_u8_f32(a + 128.f, 0, r); r = __builtin_amdgcn_cvt_pk_u8_f32(b + 128.f, 1, r);
    r = __builtin_amdgcn_cvt_pk_u8_f32(c + 128.f, 2, r); r = __builtin_amdgcn_cvt_pk_u8_f32(d + 128.f, 3, r);
    return r ^ 0x80808080u;
}
__device__ __forceinline__ float wave_sum(float v) {
#pragma unroll
    for (int o = 1; o < 64; o <<= 1) v += __shfl_xor(v, o);
    return v;
}

#define XB_TMO      128
#define XB_XCNT(j)  (256  + 64 * (j))
#define XB_XSUB(j)  (1280 + 64 * (j))
#define XB_XGEN(j)  (2304 + 64 * (j))
#define XB_TOP      3328
#define XB_TOPGEN   3392
#define XCD_BAR_WORDS 3456
#define XB_SPIN_CAP (1u << 20)
#define LAS __attribute__((address_space(3)))
__device__ __forceinline__ int tidx_(int ws) { unsigned l = __builtin_amdgcn_mbcnt_lo(~0u, 0u); asm volatile("" : "+v"(l)); return (int)((unsigned)ws * 64u + __builtin_amdgcn_mbcnt_hi(~0u, l)); }
#define TIDX(ws_) tidx_(ws_)
__device__ __forceinline__ unsigned xb_ld(unsigned* p)              { return __hip_atomic_load(p, __ATOMIC_RELAXED, __HIP_MEMORY_SCOPE_AGENT); }
__device__ __forceinline__ unsigned xb_add(unsigned* p, unsigned v) { return __hip_atomic_fetch_add(p, v, __ATOMIC_RELAXED, __HIP_MEMORY_SCOPE_AGENT); }
__device__ __forceinline__ unsigned xb_xcc_id() { return (unsigned)__builtin_amdgcn_s_getreg((3 << 11) | 20) & 0xFu; }
#define XB_SPIN(cond, bar) do { unsigned _sp = 0; while (cond) { __builtin_amdgcn_s_sleep(1); \
    if ((++_sp & 255u) == 0u) { if (xb_ld(&(bar)[XB_TMO])) break; if (_sp > XB_SPIN_CAP) { atomicAdd(&(bar)[XB_TMO], 1u); break; } } } } while (0)
struct XcdBarrier { unsigned* bar; unsigned x; volatile LAS unsigned* st; int ws; };
__device__ __forceinline__ XcdBarrier xcd_barrier_post(unsigned* bar, volatile LAS unsigned* st, int ws) {
    XcdBarrier b; b.bar = bar; b.x = xb_xcc_id(); b.st = st; b.ws = ws;
    if (TIDX(ws) == 0) (void)xb_add(&bar[XB_XCNT(b.x)], 1u);
    return b;
}
__device__ __forceinline__ void xcd_barrier_complete(unsigned* bar, unsigned x, unsigned& nloc, unsigned& nx) {
    const unsigned G = gridDim.x * gridDim.y * gridDim.z;
    unsigned sum, cnt, mine, sp = 0u;
    for (;;) {
        sum = 0u; cnt = 0u; mine = 0u;
#pragma unroll
        for (unsigned j = 0; j < 16; ++j) { const unsigned c = xb_ld(&bar[XB_XCNT(j)]); sum += c; cnt += (c > 0u) ? 1u : 0u; mine = (j == x) ? c : mine; }
        if (sum == G) break;
        __builtin_amdgcn_s_sleep(1);
        if ((++sp & 255u) == 0u) { if (xb_ld(&bar[XB_TMO])) break; if (sp > XB_SPIN_CAP) { atomicAdd(&bar[XB_TMO], 1u); break; } }
    }
    nloc = mine > 0u ? mine : 1u; nx = cnt > 0u ? cnt : 1u;
}
__device__ __forceinline__ void xcd_barrier(const XcdBarrier& b) {
    asm volatile("s_waitcnt vmcnt(0)" ::: "memory");
    __syncthreads();
    if (TIDX(b.ws) == 0) {
        unsigned* bar = b.bar;
        __builtin_amdgcn_s_waitcnt(0);
        unsigned nloc = b.st[0], nx = b.st[1];
        if (nloc == 0u) { xcd_barrier_complete(bar, b.x, nloc, nx); b.st[0] = nloc; b.st[1] = nx; }
        const unsigned old = xb_add(&bar[XB_XSUB(b.x)], 1u);
        const unsigned gen = old / nloc;
        if (old + 1u == (gen + 1u) * nloc) {
            __builtin_amdgcn_fence(__ATOMIC_RELEASE, "agent");
            asm volatile("s_waitcnt vmcnt(0)" ::: "memory");
            const unsigned og = xb_add(&bar[XB_TOP], 1u);
            const unsigned tg = og / nx;
            if (og + 1u == (tg + 1u) * nx) xb_add(&bar[XB_TOPGEN], 1u);
            else XB_SPIN(xb_ld(&bar[XB_TOPGEN]) == tg, bar);
            __builtin_amdgcn_fence(__ATOMIC_ACQUIRE, "agent");
            xb_add(&bar[XB_XGEN(b.x)], 1u);
            asm volatile("s_waitcnt vmcnt(0)" ::: "memory");
        } else {
            XB_SPIN(xb_ld(&bar[XB_XGEN(b.x)]) == gen, bar);
            __builtin_amdgcn_fence(__ATOMIC_ACQUIRE, "agent");
            asm volatile("s_waitcnt vmcnt(0)" ::: "memory");
        }
    }
    __syncthreads();
}

constexpr int G_BK = 64, G_HALF = 128, G_HT = G_HALF * G_BK;
__device__ __forceinline__ int lds_byte(int r, int c) {
    int st = (r >> 4) * 2 + (c >> 5), rr = r & 15, cc = c & 31, ob = rr * 64 + cc * 2;
    return st * 1024 + (ob ^ (((ob >> 9) & 1) << 5));
}
__device__ __forceinline__ void stage_rc(int b, int& R, int& C) {
    int st = b / 1024, sb = b % 1024, swz = sb ^ (((sb >> 9) & 1) << 5);
    R = (st >> 1) * 16 + swz / 64; C = (st & 1) * 32 + (swz % 64) / 2;
}

template <bool NOSWAP, bool I8, class A_>
__device__ __forceinline__ A_ mma1(bf16x8 a, bf16x8 b, A_ c);
template <> __device__ __forceinline__ f32x4 mma1<false, false, f32x4>(bf16x8 a, bf16x8 b, f32x4 c) { return __builtin_amdgcn_mfma_f32_16x16x32_bf16(b, a, c, 0, 0, 0); }
template <> __device__ __forceinline__ f32x4 mma1<true, false, f32x4>(bf16x8 a, bf16x8 b, f32x4 c) { return __builtin_amdgcn_mfma_f32_16x16x32_bf16(a, b, c, 0, 0, 0); }
template <> __device__ __forceinline__ i32x4 mma1<false, true, i32x4>(bf16x8 a, bf16x8 b, i32x4 c) { return __builtin_amdgcn_mfma_i32_16x16x64_i8(__builtin_bit_cast(i32x4, b), __builtin_bit_cast(i32x4, a), c, 0, 0, 0); }
template <> __device__ __forceinline__ i32x4 mma1<true, true, i32x4>(bf16x8 a, bf16x8 b, i32x4 c) { return __builtin_amdgcn_mfma_i32_16x16x64_i8(__builtin_bit_cast(i32x4, a), __builtin_bit_cast(i32x4, b), c, 0, 0, 0); }

template <bool NOSWAP, bool I8, bool F8, class A_>
__device__ __forceinline__ A_ mma2(i32x8 a, i32x8 b, A_ c) {
    if constexpr (F8) {
        if constexpr (NOSWAP) return __builtin_amdgcn_mfma_scale_f32_16x16x128_f8f6f4(a, b, c, 0, 0, 0, 0, 0, 0);
        else return __builtin_amdgcn_mfma_scale_f32_16x16x128_f8f6f4(b, a, c, 0, 0, 0, 0, 0, 0);
    } else {
        const bf16x8 a0 = __builtin_bit_cast(bf16x8, __builtin_shufflevector(a, a, 0, 1, 2, 3)), a1 = __builtin_bit_cast(bf16x8, __builtin_shufflevector(a, a, 4, 5, 6, 7));
        const bf16x8 b0 = __builtin_bit_cast(bf16x8, __builtin_shufflevector(b, b, 0, 1, 2, 3)), b1 = __builtin_bit_cast(bf16x8, __builtin_shufflevector(b, b, 4, 5, 6, 7));
        c = mma1<NOSWAP, I8, A_>(a0, b0, c);
        return mma1<NOSWAP, I8, A_>(a1, b1, c);
    }
}
constexpr int EPI_NST_MIN = 12;
struct NextTile { const bf16_t* A; const bf16_t* Bt; int lda, ldb, brow, bcol; };
template <bool VT1, bool I8, bool F8 = false, class Epi>
__device__ __forceinline__ void gemm_tile(const bf16_t* __restrict__ A, int lda, const bf16_t* __restrict__ Bt, int ldb, int nt,
                                          int brow, int bcol, char* shmc, const Epi& epi, bool pre, const NextTile nx, int ws_) {
    bf16_t* shm = (bf16_t*)shmc;
    asm volatile("" : "+s"(nt));
#define SA(b,h) (shm+((b)*2+(h))*G_HT)
#define SB(b,h) (shm+(4+(b)*2+(h))*G_HT)
#define STAGE_X(OFF,LOFF,P,RS,LD,br,kt) do{ const int _so=((br)*(LD)+(kt)*G_BK)*2; \
    __builtin_amdgcn_raw_ptr_buffer_load_lds(RS, (__attribute__((address_space(3))) void*)((char*)(P)+(LOFF)),16,(int)(OFF),_so,0,0); \
    __builtin_amdgcn_raw_ptr_buffer_load_lds(RS, (__attribute__((address_space(3))) void*)((char*)(P)+(LOFF)+8192),16,(int)(OFF),_so+128*(LD),0,0);}while(0)
#define STAGE_A(P,br,kt) STAGE_X(offA,lwv,P,rsA,lda,br,kt)
#define STAGE_B(P,br,kt) STAGE_X(offB,lwv,P,rsB,ldb,br,kt)
#define LDF(base_,off_) (*reinterpret_cast<const i32x4*>((base_)+(off_)))
#define LDA(dst,b,h) _Pragma("unroll") for(int m=0;m<4;++m) \
    dst[m]=__builtin_shufflevector(LDF(fa_base,((b)*2+(h))*16384+m*2048),LDF(fa_base,((b)*2+(h))*16384+m*2048+1024),0,1,2,3,4,5,6,7)
#define LDB(dst,b,h) _Pragma("unroll") for(int n=0;n<2;++n) \
    dst[n]=__builtin_shufflevector(LDF(fb_base,((b)*2+(h))*16384+n*2048),LDF(fb_base,((b)*2+(h))*16384+n*2048+1024),0,1,2,3,4,5,6,7)
#define MMA(ai,bj,At_,Bt_) do{__builtin_amdgcn_s_setprio(1); \
    _Pragma("unroll") for(int m=0;m<4;++m) _Pragma("unroll") for(int n=0;n<2;++n) \
      acc[ai][bj][m][n]=mma2<VT1 && (bj)==1, I8, F8, typename AccT<I8>::type>(At_[m],Bt_[n],acc[ai][bj][m][n]); \
    __builtin_amdgcn_s_setprio(0);}while(0)
#define WAIT_V(n) asm volatile("s_waitcnt vmcnt(" #n ")":::"memory")
#define WAIT_L(n) asm volatile("s_waitcnt lgkmcnt(" #n ")":::"memory")
#define BAR __builtin_amdgcn_s_barrier()
#define SCHED __builtin_amdgcn_sched_barrier(0)
    int t0 = TIDX(ws_); asm volatile("" : "+v"(t0));
    int wid = t0 >> 6, lane = t0 & 63, wr = wid >> 2, wc = wid & 3, fr = lane & 15, fq = lane >> 4;
    typename AccT<I8>::type acc[2][2][4][2] = {};
    const char* fa_base = (const char*)shm + lds_byte(wr * 64 + fr, fq * 8);
    const char* fb_base = (const char*)shm + 65536 + lds_byte(wc * 32 + fr, fq * 8);
    i32x8 At[4], B0[2], B1[2];
    int loff = t0 * 16;
    const int lwv = __builtin_amdgcn_readfirstlane(t0 >> 6) * 1024;
    unsigned offA, offB;
    const __amdgpu_buffer_rsrc_t rsA = __builtin_amdgcn_make_buffer_rsrc((void*)A, (short)0, -1, 0x00020000);
    const __amdgpu_buffer_rsrc_t rsB = __builtin_amdgcn_make_buffer_rsrc((void*)Bt, (short)0, -1, 0x00020000);
    { int r_, c_; stage_rc(loff, r_, c_); offA = (unsigned)(r_ * lda + c_) * 2;
      const int i_ = r_ & 15, n_ = (r_ >> 4) & 1;
      offB = (unsigned)(((r_ & ~31) + 8 * (i_ >> 2) + 4 * n_ + (i_ & 3)) * ldb + c_) * 2; }
    if (!pre) {
        STAGE_B(SB(0,0),bcol,0); STAGE_A(SA(0,0),brow,0);
        STAGE_B(SB(0,1),bcol+G_HALF,0); STAGE_A(SA(0,1),brow+G_HALF,0);
        if (wr == 1) BAR;
        WAIT_V(4); BAR;
        STAGE_B(SB(1,0),bcol,1); STAGE_A(SA(1,0),brow,1); STAGE_B(SB(1,1),bcol+G_HALF,1);
        WAIT_V(6); BAR;
    } else {
        if (wr == 1) BAR;
        asm volatile("s_waitcnt vmcnt(%0)" :: "n"(EPI_NST_MIN + 10) : "memory"); BAR;
        asm volatile("s_waitcnt vmcnt(%0)" :: "n"(EPI_NST_MIN + 6) : "memory"); BAR;
    }
    for (int t = 0; t < nt - 2; t += 2) {
        LDB(B0,0,0); SCHED; LDA(At,0,0); STAGE_A(SA(1,1),brow+G_HALF,t+1);
        WAIT_L(8); BAR; WAIT_L(0); MMA(0,0,At,B0); BAR; SCHED;
        LDB(B1,0,1); STAGE_B(SB(0,0),bcol,t+2);
        BAR; WAIT_L(0); MMA(0,1,At,B1); BAR;
        LDA(At,0,1); STAGE_A(SA(0,0),brow,t+2);
        BAR; WAIT_L(0); MMA(1,0,At,B0); BAR; SCHED;
        STAGE_B(SB(0,1),bcol+G_HALF,t+2);
        WAIT_V(6); BAR; MMA(1,1,At,B1); BAR;
        LDB(B0,1,0); SCHED; LDA(At,1,0); STAGE_A(SA(0,1),brow+G_HALF,t+2);
        WAIT_L(8); BAR; WAIT_L(0); MMA(0,0,At,B0); BAR; SCHED;
        LDB(B1,1,1); STAGE_B(SB(1,0),bcol,t+3);
        BAR; WAIT_L(0); MMA(0,1,At,B1); BAR;
        LDA(At,1,1); STAGE_A(SA(1,0),brow,t+3);
        BAR; WAIT_L(0); MMA(1,0,At,B0); BAR; SCHED;
        STAGE_B(SB(1,1),bcol+G_HALF,t+3);
        WAIT_V(6); BAR; MMA(1,1,At,B1); BAR;
    }
    int tz = TIDX(ws_); asm volatile("" : "+v"(tz)); wid = tz >> 6; lane = tz & 63; wr = wid >> 2; wc = wid & 3; fr = lane & 15; fq = lane >> 4;
    loff = tz * 16;
    fa_base = (const char*)shm + lds_byte(wr * 64 + fr, fq * 8); fb_base = (const char*)shm + 65536 + lds_byte(wc * 32 + fr, fq * 8);
    { int r_, c_; stage_rc(loff, r_, c_); offA = (unsigned)(r_ * lda + c_) * 2; }
    { LDB(B0,0,0); WAIT_V(0); LDA(At,0,0); STAGE_A(SA(1,1),brow+G_HALF,nt-1);
      BAR; WAIT_L(0); MMA(0,0,At,B0); BAR;
      LDB(B1,0,1); BAR; WAIT_L(0); MMA(0,1,At,B1); BAR;
      LDA(At,0,1); WAIT_V(4); BAR; WAIT_L(0); MMA(1,0,At,B0); MMA(1,1,At,B1); BAR; }
    { LDB(B0,1,0); LDA(At,1,0); WAIT_V(2); BAR; WAIT_L(0); MMA(0,0,At,B0); BAR;
      LDB(B1,1,1); WAIT_V(0); BAR; WAIT_L(0); MMA(0,1,At,B1); BAR;
      LDA(At,1,1); BAR; WAIT_L(0); MMA(1,0,At,B0); MMA(1,1,At,B1); BAR; }
    if (wr == 0) BAR;
    { int te = TIDX(ws_); asm volatile("" : "+v"(te)); wid = te >> 6; lane = te & 63; wr = wid >> 2; wc = wid & 3; fr = lane & 15; fq = lane >> 4; loff = te * 16; }
    typename Epi::Pre pre_;
    epi.preload(pre_, brow + wr * 64 + fr, bcol + wc * 32 + fq * 8, brow + wr * 64 + fq * 4);
    if (nx.brow >= 0) {
        int r_, c_; stage_rc(loff, r_, c_);
        const int i_ = r_ & 15, n_ = (r_ >> 4) & 1;
        const unsigned offA2 = (unsigned)(r_ * nx.lda + c_) * 2;
        const unsigned offB2 = (unsigned)(((r_ & ~31) + 8 * (i_ >> 2) + 4 * n_ + (i_ & 3)) * nx.ldb + c_) * 2;
        const __amdgpu_buffer_rsrc_t rsA2 = __builtin_amdgcn_make_buffer_rsrc((void*)nx.A, (short)0, -1, 0x00020000);
        const __amdgpu_buffer_rsrc_t rsB2 = __builtin_amdgcn_make_buffer_rsrc((void*)nx.Bt, (short)0, -1, 0x00020000);
#define NXT_A(P,h,k) STAGE_X(offA2,lwv,P,rsA2,nx.lda,nx.brow+(h),k)
#define NXT_B(P,h,k) STAGE_X(offB2,lwv,P,rsB2,nx.ldb,nx.bcol+(h),k)
        NXT_B(SB(0,0),0,0); NXT_A(SA(0,0),0,0); NXT_B(SB(0,1),G_HALF,0); NXT_A(SA(0,1),G_HALF,0);
        NXT_B(SB(1,0),0,1); NXT_A(SA(1,0),0,1); NXT_B(SB(1,1),G_HALF,1);
#undef NXT_A
#undef NXT_B
    }
#pragma unroll
    for (int ai = 0; ai < 2; ++ai)
#pragma unroll
    for (int m = 0; m < 4; ++m) {
#pragma unroll
        for (int bj = 0; bj < 2; ++bj) {
            if (VT1 && bj == 1) {
                if (m == 3) {
#pragma unroll
                    for (int n = 0; n < 2; ++n)
                        epi.storeT(pre_, ai, brow + ai * G_HALF + wr * 64, bcol + bj * G_HALF + wc * 32 + 8 * (fr >> 2) + 4 * n + (fr & 3), fq,
                                   acc[ai][bj][0][n], acc[ai][bj][1][n], acc[ai][bj][2][n], acc[ai][bj][3][n]);
                }
            } else {
                epi.store8(pre_, ai, m, bj, brow + ai * G_HALF + wr * 64 + m * 16 + fr, bcol + bj * G_HALF + wc * 32 + fq * 8, acc[ai][bj][m][0], acc[ai][bj][m][1]);
            }
        }
        asm volatile("" ::: "memory");
    }
    if (nx.brow < 0) __syncthreads();
#undef SA
#undef SB
#undef STAGE_X
#undef STAGE_A
#undef STAGE_B
#undef LDA
#undef LDF
#undef LDB
#undef MMA
#undef WAIT_V
#undef WAIT_L
#undef BAR
#undef SCHED
}

__device__ __forceinline__ void st4bf(bf16_t* p, f32x4 v) {
    u32x2 o; o.x = pk2(v[0], v[1]); o.y = pk2(v[2], v[3]); *reinterpret_cast<u32x2*>(p) = o;
}
__device__ __forceinline__ void st8bf(bf16_t* p, f32x4 a, f32x4 b) {
    u32x4 o; o.x = pk2(a[0], a[1]); o.y = pk2(a[2], a[3]); o.z = pk2(b[0], b[1]); o.w = pk2(b[2], b[3]); *reinterpret_cast<u32x4*>(p) = o;
}
struct EpiBf16 {
    bf16_t* C; int ldc; float sc;
    static constexpr int NST = 16;
    struct Pre {};
    __device__ __forceinline__ void preload(Pre&, int, int, int) const {}
    __device__ __forceinline__ void store8(const Pre&, int, int, int, int row, int col, f32x4 a, f32x4 b) const { st8bf(C + (size_t)row * ldc + col, a * sc, b * sc); }
    __device__ __forceinline__ void storeT(const Pre&, int, int, int, int, f32x4, f32x4, f32x4, f32x4) const {}
};
struct EpiI8 {
    bf16_t* C; int ldc; const float* rs; const float* cs; char* c8;
    static constexpr int NST = 16;
    struct Pre { float r[8]; f32x4 c[2][2]; };
    __device__ __forceinline__ void preload(Pre& q, int rowb, int colb, int) const {
#pragma unroll
        for (int i = 0; i < 8; ++i) q.r[i] = rs[rowb + (i >> 2) * 128 + (i & 3) * 16];
#pragma unroll
        for (int bj = 0; bj < 2; ++bj) { q.c[bj][0] = *reinterpret_cast<const f32x4*>(cs + colb + bj * 128); q.c[bj][1] = *reinterpret_cast<const f32x4*>(cs + colb + bj * 128 + 4); }
    }
    __device__ __forceinline__ void store8(const Pre& q, int ai, int m, int bj, int row, int col, i32x4 a, i32x4 b) const {
        const float r = q.r[ai * 4 + m];
        f32x4 fa = {(float)a[0], (float)a[1], (float)a[2], (float)a[3]}, fb = {(float)b[0], (float)b[1], (float)b[2], (float)b[3]};
        fa = fa * q.c[bj][0] * r; fb = fb * q.c[bj][1] * r;
        st8bf(C + (size_t)row * ldc + col, fa, fb);
        const int pn = __builtin_amdgcn_readfirstlane(col >> 8);
        if (c8 != nullptr && pn >= 4 && pn < 7) {
            u32x2 w = {(unsigned)pk_fp8x4(fa[0], fa[1], fa[2], fa[3]), (unsigned)pk_fp8x4(fb[0], fb[1], fb[2], fb[3])};
            *reinterpret_cast<u32x2*>(c8 + (size_t)row * 768 + (col - 1024)) = w;
        }
    }
    __device__ __forceinline__ void storeT(const Pre&, int, int, int, int, i32x4, i32x4, i32x4, i32x4) const {}
};
struct EpiPool {
    bf16_t* C; const float* scale; int gcol0;
    static constexpr int NST = 16;
    struct Pre { f32x4 s[2][2]; };
    __device__ __forceinline__ void preload(Pre& q, int, int colb, int) const {
#pragma unroll
        for (int bj = 0; bj < 2; ++bj) { q.s[bj][0] = *reinterpret_cast<const f32x4*>(scale + gcol0 + colb + bj * 128); q.s[bj][1] = *reinterpret_cast<const f32x4*>(scale + gcol0 + colb + bj * 128 + 4); }
    }
    __device__ __forceinline__ void store8(const Pre& q, int, int, int bj, int row, int col, f32x4 a, f32x4 b) const {
        a = a * q.s[bj][0] * (1.f / 16.f); b = b * q.s[bj][1] * (1.f / 16.f);
        u32x2 w = {(unsigned)pk_fp8x4(a[0], a[1], a[2], a[3]), (unsigned)pk_fp8x4(b[0], b[1], b[2], b[3])};
        *reinterpret_cast<u32x2*>((char*)C + (size_t)row * DM + gcol0 + col) = w;
    }
    __device__ __forceinline__ void storeT(const Pre&, int, int, int, int, f32x4, f32x4, f32x4, f32x4) const {}
};
struct EpiQ {
    bf16_t* C; const float* rstd;
    static constexpr int NST = 16;
    struct Pre { float r[8]; };
    __device__ __forceinline__ void preload(Pre& q, int rowb, int, int) const {
#pragma unroll
        for (int i = 0; i < 8; ++i) q.r[i] = rstd[rowb + (i >> 2) * 128 + (i & 3) * 16] * (0.07216878364870322f * 1.4426950408889634f / 16.f);
    }
    __device__ __forceinline__ void store8(const Pre& q, int ai, int m, int, int row, int col, f32x4 a, f32x4 b) const {
        const float s = q.r[ai * 4 + m];
        st8bf(C + (size_t)row * 1536 + col, a * s, b * s);
    }
    __device__ __forceinline__ void storeT(const Pre&, int, int, int, int, f32x4, f32x4, f32x4, f32x4) const {}
};
struct EpiKV {
    bf16_t* Kn; bf16_t* Vt; const float* rstd;
    static constexpr int NST = 12;
    struct Pre { float r[8]; f32x4 rt[8]; };
    __device__ __forceinline__ void preload(Pre& q, int rowb, int, int rowbT) const {
#pragma unroll
        for (int i = 0; i < 8; ++i) { q.r[i] = rstd[rowb + (i >> 2) * 128 + (i & 3) * 16] * (1.f / 16.f); q.rt[i] = *reinterpret_cast<const f32x4*>(rstd + rowbT + (i >> 2) * 128 + (i & 3) * 16) * (1.f / 16.f); }
    }
    __device__ __forceinline__ void store8(const Pre& q, int ai, int m, int, int row, int col, f32x4 a, f32x4 b) const {
        int head = col >> 8, d = col & 127; const float r = q.r[ai * 4 + m];
        u32x2 w = {(unsigned)pk_fp8x4(a[0] * r, a[1] * r, a[2] * r, a[3] * r), (unsigned)pk_fp8x4(b[0] * r, b[1] * r, b[2] * r, b[3] * r)};
        *reinterpret_cast<u32x2*>((char*)Kn + (size_t)row * 1024 + head * 128 + d) = w;
    }
    __device__ __forceinline__ void storeT(const Pre& q, int ai, int rbase, int col, int fq, f32x4 v0, f32x4 v1, f32x4 v2, f32x4 v3) const {
        int head = col >> 8, d = col & 127, b = rbase >> 11, s = rbase & 2047;
        const f32x4 r0 = q.rt[ai * 4 + 0], r1 = q.rt[ai * 4 + 1], r2 = q.rt[ai * 4 + 2], r3 = q.rt[ai * 4 + 3];
        u32x4 w;
        w.x = (unsigned)pk_fp8x4(v0[0] * r0[0], v0[1] * r0[1], v0[2] * r0[2], v0[3] * r0[3]);
        w.y = (unsigned)pk_fp8x4(v1[0] * r1[0], v1[1] * r1[1], v1[2] * r1[2], v1[3] * r1[3]);
        w.z = (unsigned)pk_fp8x4(v2[0] * r2[0], v2[1] * r2[1], v2[2] * r2[2], v2[3] * r2[3]);
        w.w = (unsigned)pk_fp8x4(v3[0] * r3[0], v3[1] * r3[1], v3[2] * r3[2], v3[3] * r3[3]);
        *reinterpret_cast<u32x4*>((char*)Vt + ((size_t)((b * 8 + head) * 128 + d)) * SEQ + s + 32 * (fq & 1) + 16 * (fq >> 1)) = w;
    }
};

__device__ __forceinline__ int vcu_of(int bid, int nb) { return (nb % 8 == 0) ? (bid % 8) * (nb / 8) + bid / 8 : bid; }

__device__ __forceinline__ void xpose_item(const float* __restrict__ W, int K, int N, bf16_t* __restrict__ WT, int ldt, float* scr, int item, int lane,
                                           const float* __restrict__ rowscale) {
    const int nblk = N / 32, kb = item / nblk, nb = item % nblk, k0 = 64 * kb, n0 = 32 * nb;
#pragma unroll 8
    for (int i = 0; i < 32; ++i) {
        const int kk = 2 * i + (lane >> 5);
        float w = W[(size_t)(k0 + kk) * N + n0 + (lane & 31)];
        if (rowscale) w *= rowscale[k0 + kk];
        scr[kk * 33 + (lane & 31)] = w;
    }
    __builtin_amdgcn_s_waitcnt(0xc07f); asm volatile("" ::: "memory");
    const int c = lane & 7;
#pragma unroll
    for (int j = 0; j < 4; ++j) {
        const int n = (lane >> 3) + 8 * j; const float* s = scr + (8 * c) * 33 + n;
        u32x4 o; o.x = pk2(s[0 * 33], s[1 * 33]); o.y = pk2(s[2 * 33], s[3 * 33]); o.z = pk2(s[4 * 33], s[5 * 33]); o.w = pk2(s[6 * 33], s[7 * 33]);
        *reinterpret_cast<u32x4*>(WT + (size_t)(n0 + n) * ldt + k0 + 8 * c) = o;
    }
    __builtin_amdgcn_s_waitcnt(0xc07f); asm volatile("" ::: "memory");
}
__device__ __forceinline__ void xposef8_item(const float* __restrict__ W, int K, int N, char* __restrict__ WT8, int ldt, float* scr, int item, int lane, float mul,
                                             const float* __restrict__ rowscale = nullptr) {
    const int nblk = N / 32, kb = item / nblk, nb = item % nblk, k0 = 64 * kb, n0 = 32 * nb;
#pragma unroll 8
    for (int i = 0; i < 32; ++i) {
        const int kk = 2 * i + (lane >> 5);
        float w = W[(size_t)(k0 + kk) * N + n0 + (lane & 31)] * mul;
        if (rowscale) w *= rowscale[k0 + kk];
        scr[kk * 33 + (lane & 31)] = w;
    }
    __builtin_amdgcn_s_waitcnt(0xc07f); asm volatile("" ::: "memory");
    const int c = lane & 7;
#pragma unroll
    for (int j = 0; j < 4; ++j) {
        const int n = (lane >> 3) + 8 * j; const float* s = scr + (8 * c) * 33 + n;
        u32x2 o;
        o.x = (unsigned)pk_fp8x4(s[0 * 33], s[1 * 33], s[2 * 33], s[3 * 33]); o.y = (unsigned)pk_fp8x4(s[4 * 33], s[5 * 33], s[6 * 33], s[7 * 33]);
        *reinterpret_cast<u32x2*>(WT8 + (size_t)(n0 + n) * ldt + k0 + 8 * c) = o;
    }
    __builtin_amdgcn_s_waitcnt(0xc07f); asm volatile("" ::: "memory");
}
__device__ __forceinline__ void xpose8_item(const float* __restrict__ W, int N, char* __restrict__ WT8, float* scr, int item, int lane,
                                            const unsigned* __restrict__ cmax, float* __restrict__ wsc) {
    const int nblk = N / 32, kb = item / nblk, nb = item % nblk, k0 = 64 * kb, n0 = 32 * nb;
    const float cm = __uint_as_float(cmax[n0 + (lane & 31)]);
    const float qm = cm > 0.f ? 127.f / cm : 0.f;
    if (kb == 0 && lane < 32) wsc[n0 + lane] = cm * (1.f / 127.f);
#pragma unroll 8
    for (int i = 0; i < 32; ++i) {
        const int kk = 2 * i + (lane >> 5);
        scr[kk * 33 + (lane & 31)] = W[(size_t)(k0 + kk) * N + n0 + (lane & 31)] * qm;
    }
    __builtin_amdgcn_s_waitcnt(0xc07f); asm volatile("" ::: "memory");
    const int c = lane & 7;
#pragma unroll
    for (int j = 0; j < 4; ++j) {
        const int n = (lane >> 3) + 8 * j; const float* s = scr + (8 * c) * 33 + n;
        u32x2 o;
        o.x = pack_i8x4(s[0 * 33], s[1 * 33], s[2 * 33], s[3 * 33]); o.y = pack_i8x4(s[4 * 33], s[5 * 33], s[6 * 33], s[7 * 33]);
        *reinterpret_cast<u32x2*>(WT8 + (size_t)(n0 + n) * 2048 + k0 + 8 * c) = o;
    }
    __builtin_amdgcn_s_waitcnt(0xc07f); asm volatile("" ::: "memory");
}
__device__ __forceinline__ void cvt_bf16_range(const float* __restrict__ src, bf16_t* __restrict__ dst, size_t n8, size_t gtid, size_t gthreads) {
    for (size_t i = gtid; i < n8; i += gthreads) {
        f32x4 a = *reinterpret_cast<const f32x4*>(src + i * 8), b = *reinterpret_cast<const f32x4*>(src + i * 8 + 4);
        u32x4 o; o.x = pk2(a[0], a[1]); o.y = pk2(a[2], a[3]); o.z = pk2(b[0], b[1]); o.w = pk2(b[2], b[3]);
        *reinterpret_cast<u32x4*>(dst + i * 8) = o;
    }
}
__device__ __forceinline__ void phase0(const Params& p, char* shm, int bid, int nb) {
    const int tid = TIDX(p.wave_s), wave = tid >> 6, lane = tid & 63;
    char* ws = p.ws;
#ifndef DUP_P0
#define DUP_P0 (-1)
#endif
    for (int rp_ = 0; rp_ < (DUP_P0 == 0 ? 2 : 1); ++rp_)
    {
        float* sl = (float*)shm;
        float* red = (float*)(shm + 65536);
        float* mod = (float*)(ws + WS_MOD);
        if (bid < 192 || nb != 256) {
            for (int i = tid; i < 8 * DM; i += NTHREADS) { float cv = p.c[i]; sl[i] = cv / (1.f + __expf(-cv)); }
            __syncthreads();
            for (int it = bid; it < 192; it += nb) {
                const int col = it * 64 + lane;
                float acc[8];
#pragma unroll
                for (int b = 0; b < 8; ++b) acc[b] = 0.f;
                const float* wp = p.ada_w + (size_t)(wave * 256) * 12288 + col;
                const float* sp = sl + wave * 256;
#pragma unroll 1
                for (int r0 = 0; r0 < 256; r0 += 32) {
                    float w[32];
#pragma unroll
                    for (int i = 0; i < 32; ++i) w[i] = wp[(size_t)(r0 + i) * 12288];
#pragma unroll
                    for (int q = 0; q < 8; ++q)
#pragma unroll
                        for (int b = 0; b < 8; ++b) {
                            const f32x4 s4 = *reinterpret_cast<const f32x4*>(sp + b * DM + r0 + 4 * q);
                            acc[b] += w[4 * q] * s4[0] + w[4 * q + 1] * s4[1] + w[4 * q + 2] * s4[2] + w[4 * q + 3] * s4[3];
                        }
                }
#pragma unroll
                for (int b = 0; b < 8; ++b) red[(wave * 8 + b) * 64 + lane] = acc[b];
                __syncthreads();
                {
                    const int b = tid >> 6, cl = tid & 63;
                    float sum = 0.f;
#pragma unroll
                    for (int w = 0; w < 8; ++w) sum += red[(w * 8 + b) * 64 + cl];
                    mod[b * 12288 + it * 64 + cl] = sum + p.ada_b[it * 64 + cl];
                }
                __syncthreads();
            }
        }
    }
    const int gw = bid * NWAVES + wave, ngw = nb * NWAVES;
    const size_t gtid = (size_t)bid * NTHREADS + tid, gthreads = (size_t)nb * NTHREADS;
    for (int rp_ = 0; rp_ < (DUP_P0 == 1 ? 2 : 1); ++rp_)
    {
        float* scr = (float*)(shm + wave * 8448);
        constexpr int I_POOL = 4 * 4 * 8, I_UQ = 8 * 48, I_UKV = 4 * 64, I_OUT = 32 * 64;
        constexpr int NIT = I_POOL + I_UQ + I_UKV + I_OUT;
        for (int it = gw; it < NIT; it += ngw) {
            int r = it;
            if (r < I_POOL) { int g = r / 32; xposef8_item(p.pool_w + g * 65536, 256, 256, ws + WS_WPOOL + g * 65536, 256, scr, r % 32, lane, 16.f); continue; } r -= I_POOL;
            if (r < I_UQ) { xposef8_item(p.w_uq, 512, 1536, ws + WS_WUQ, 512, scr, r, lane, 16.f, p.q_norm_g); continue; } r -= I_UQ;
            if (r < I_UKV) { xposef8_item(p.w_ukv, 256, 2048, ws + WS_WUKV, 256, scr, r, lane, 16.f, p.kv_norm_g); continue; } r -= I_UKV;
            xposef8_item(p.w_out, 2048, 2048, ws + WS_WOUT, 2048, scr, r, lane, 32.f);
        }
        unsigned* cmax = (unsigned*)(ws + WS_CMAX);
        for (int it = gw; it < (29 + 32) * 16; it += ngw) {
            const int strip = it >> 4, kc = it & 15;
            const bool isq = strip >= 29;
            const int n = (isq ? strip - 29 : strip) * 64 + lane, N = isq ? 2048 : 1856;
            const float* wp = (isq ? p.peer_wq : p.w_in) + (size_t)(kc * 128) * N + n;
            float m = 0.f;
#pragma unroll 32
            for (int r = 0; r < 128; ++r) m = fmaxf(m, fabsf(wp[(size_t)r * N]));
            atomicMax(cmax + (isq ? 2048 : 0) + n, __float_as_uint(m));
        }
    }
    cvt_bf16_range(p.sub_keys, (bf16_t*)(ws + WS_SK), 262144 / 8, gtid, gthreads);
    for (int rp_ = 0; rp_ < (DUP_P0 == 2 ? 2 : 1); ++rp_)
    {
        float* tile = (float*)shm;
        float* redm = (float*)(shm + 16 * 2052 * 4);
        float* scl = redm + 128;
        int ntl, tfirst, tstep;
        if (nb == 256) { if (bid < 192) { ntl = 7; tfirst = bid * 7; } else { ntl = 11; tfirst = 192 * 7 + (bid - 192) * 11; } tstep = 1; }
        else { ntl = (2048 - bid + nb - 1) / nb; tfirst = bid; tstep = nb; }
#define Q_LOAD(dst, i_) do { const int itl_ = tfirst + (i_) * tstep; \
            const float* src_ = ((itl_ >> 10) ? p.peer_v : p.peer_u) + (size_t)((itl_ & 1023) * 16 + 2 * wave) * DM; \
            _Pragma("unroll") for (int k = 0; k < 16; ++k) dst[k] = *reinterpret_cast<const f32x4*>(reinterpret_cast<const char*>(src_ + (size_t)(k >> 3) * DM) + (k & 7) * 1024 + qoff); } while (0)
#define Q_TILE(vs, i_) do { \
            const int it = tfirst + (i_) * tstep; \
            const int isv = it >> 10, e0 = (it & 1023) * 16; \
            float mx0 = 0.f, mx1 = 0.f; \
            _Pragma("unroll") for (int k = 0; k < 16; ++k) { \
                *reinterpret_cast<f32x4*>(tile + (2 * wave + (k >> 3)) * 2052 + (k & 7) * 256 + lane * 4) = vs[k]; \
                const float m_ = fmaxf(fmaxf(fabsf(vs[k][0]), fabsf(vs[k][1])), fmaxf(fabsf(vs[k][2]), fabsf(vs[k][3]))); \
                if (k < 8) mx0 = fmaxf(mx0, m_); else mx1 = fmaxf(mx1, m_); \
            } \
            if ((i_) + 1 < ntl) Q_LOAD(vs, (i_) + 1); \
            _Pragma("unroll") for (int o = 1; o < 64; o <<= 1) { mx0 = fmaxf(mx0, __shfl_xor(mx0, o)); mx1 = fmaxf(mx1, __shfl_xor(mx1, o)); } \
            if (lane < 2) { \
                const float m = lane ? mx1 : mx0; \
                const float top = isv ? 256.f : 127.f; \
                scl[2 * wave + lane] = m > 0.f ? top / m : 0.f; \
                ((float*)(ws + (isv ? WS_SV : WS_SU)))[e0 + 2 * wave + lane] = m / top; \
            } \
            __syncthreads(); \
            char* dst = ws + (isv ? WS_V8 : WS_U8); \
            _Pragma("unroll") for (int k = 0; k < 8; ++k) { \
                const int item = tid + k * NTHREADS, e = item & 15, sl = item >> 4; \
                const float* tp = tile + e * 2052 + sl * 8; \
                f32x4 a = *reinterpret_cast<const f32x4*>(tp), c = *reinterpret_cast<const f32x4*>(tp + 4); \
                const float m = scl[e]; \
                u32x2 o; \
                if (isv) { \
                    int w0 = __builtin_amdgcn_cvt_pk_fp8_f32(a[0] * m, a[1] * m, 0, false); \
                    w0 = __builtin_amdgcn_cvt_pk_fp8_f32(a[2] * m, a[3] * m, w0, true); \
                    int w1 = __builtin_amdgcn_cvt_pk_fp8_f32(c[0] * m, c[1] * m, 0, false); \
                    w1 = __builtin_amdgcn_cvt_pk_fp8_f32(c[2] * m, c[3] * m, w1, true); \
                    o.x = (unsigned)w0; o.y = (unsigned)w1; \
                } else { \
                    o.x = pack_i8x4(a[0] * m, a[1] * m, a[2] * m, a[3] * m); o.y = pack_i8x4(c[0] * m, c[1] * m, c[2] * m, c[3] * m); \
                } \
                *reinterpret_cast<u32x2*>(dst + ((size_t)sl * 16384 + e0 + e) * 8) = o; \
                if (k & 1) __builtin_amdgcn_sched_barrier(0); \
            } \
            __syncthreads(); } while (0)
        f32x4 va[16];
        const unsigned qoff = (unsigned)lane * 16u;
        Q_LOAD(va, 0);
        __syncthreads();
#pragma unroll 1
        for (int i = 0; i < ntl; ++i) Q_TILE(va, i);
#undef Q_LOAD
#undef Q_TILE
    }
    {
        float2* cs = (float2*)(ws + WS_CS);
        for (size_t i = gtid; i < (size_t)NTOK * 32; i += gthreads) {
            int t = (int)(i >> 5), k = (int)(i & 31);
            float invf = exp2f(-(float)k * (13.287712379549449f / 32.f));
            float ang = (float)p.pos[t] * invf;
            double sd, cd; sincos((double)ang, &sd, &cd);
            cs[i] = make_float2((float)cd, (float)sd);
        }
    }
}

__device__ __forceinline__ void phase1(const Params& p, char* shm, int bid, int nb) {
    const int tid = TIDX(p.wave_s), wave = tid >> 6, lane = tid & 63;
    const float* mod = (const float*)(p.ws + WS_MOD);
    char* h1 = p.ws + WS_BUF1;
    float* sh1 = (float*)(p.ws + WS_SH1);
    float* lv = (float*)shm;
    for (int item = bid; item < NTOK / 64; item += nb) {
        const int b = item >> 5;
        __syncthreads();
        for (int i = tid; i < 512; i += NTHREADS) {
            *reinterpret_cast<f32x4*>(lv + 0 * DM + i * 4) = *reinterpret_cast<const f32x4*>(p.pre_mix_g + i * 4);
            *reinterpret_cast<f32x4*>(lv + 1 * DM + i * 4) = *reinterpret_cast<const f32x4*>(mod + b * 12288 + i * 4);
            *reinterpret_cast<f32x4*>(lv + 2 * DM + i * 4) = *reinterpret_cast<const f32x4*>(mod + b * 12288 + 2048 + i * 4);
        }
        __syncthreads();
#pragma unroll 1
        for (int rr = 0; rr < 8; ++rr) {
            const int row = item * 64 + rr * 8 + wave;
            const float* xr = p.x + (size_t)row * DM + lane * 4;
            f32x4 v[8]; float ss = 0.f;
#pragma unroll
            for (int i = 0; i < 8; ++i) { v[i] = *reinterpret_cast<const f32x4*>(xr + i * 256); ss += v[i][0] * v[i][0] + v[i][1] * v[i][1] + v[i][2] * v[i][2] + v[i][3] * v[i][3]; }
            const float rstd = rsqrtf(wave_sum(ss) * (1.f / DM) + EPS);
            float hmax = 0.f;
#pragma unroll
            for (int i = 0; i < 8; ++i) {
                const int col = i * 256 + lane * 4;
                f32x4 g = *reinterpret_cast<const f32x4*>(lv + col);
                f32x4 sh = *reinterpret_cast<const f32x4*>(lv + DM + col);
                f32x4 sc = *reinterpret_cast<const f32x4*>(lv + 2 * DM + col);
                v[i] = v[i] * rstd * g * (sc + 1.f) + sh;
                hmax = fmaxf(hmax, fmaxf(fmaxf(fabsf(v[i][0]), fabsf(v[i][1])), fmaxf(fabsf(v[i][2]), fabsf(v[i][3]))));
            }
#pragma unroll
            for (int o = 1; o < 64; o <<= 1) hmax = fmaxf(hmax, __shfl_xor(hmax, o));
            const float qm = hmax > 0.f ? 127.f / hmax : 0.f;
            if (lane == 0) sh1[row] = hmax * (1.f / 127.f);
#pragma unroll
            for (int i = 0; i < 8; ++i) {
                *reinterpret_cast<unsigned*>(h1 + (size_t)row * DM + i * 256 + lane * 4) = pack_i8x4(v[i][0] * qm, v[i][1] * qm, v[i][2] * qm, v[i][3] * qm);
            }
        }
    }
    {
        __syncthreads();
        float* scr = (float*)(shm + wave * 8448);
        const unsigned* cmax = (const unsigned*)(p.ws + WS_CMAX);
        float* wsc = (float*)(p.ws + WS_WSC);
        const int gw = bid * NWAVES + wave, ngw = nb * NWAVES;
        constexpr int I_IN = 32 * 58, I_PQ = 32 * 64;
        for (int it = gw; it < I_IN + I_PQ; it += ngw) {
            if (it < I_IN) xpose8_item(p.w_in, 1856, p.ws + WS_WIN, scr, it, lane, cmax, wsc);
            else xpose8_item(p.peer_wq, 2048, p.ws + WS_WPQ, scr, it - I_IN, lane, cmax + 2048, wsc + 2048);
        }
        const size_t gtid = (size_t)bid * NTHREADS + tid, gthreads = (size_t)nb * NTHREADS;
        for (size_t i = gtid; i < 24576; i += gthreads) *reinterpret_cast<u32x4*>(p.ws + WS_WIN + (size_t)1856 * 2048 + i * 16) = u32x4{0u, 0u, 0u, 0u};
        for (size_t i = gtid; i < 192; i += gthreads) wsc[1856 + i] = 0.f;
        __syncthreads();
    }
}

template <bool VT1, bool I8, bool F8 = false, class Epi>
__device__ __forceinline__ void gemm_phase(const bf16_t* A, int lda, const bf16_t* Bt, int ldb, int K, int nN, int ntiles, int tile0, int vcu, int nb,
                                           char* shm, const Epi& epi, int ws_) {
    int first = ((vcu - tile0) % nb + nb) % nb;
    bool pre = false;
    for (int t = first; t < ntiles; t += nb) {
        const int pm = t / nN, pn = t % nN;
        const int tn = t + nb;
        const bool has = tn < ntiles;
        const NextTile nx{A, Bt, lda, ldb, has ? (tn / nN) * 256 : -1, (tn % nN) * 256};
        gemm_tile<VT1, I8, F8>(A, lda, Bt, ldb, K / 64, pm * 256, pn * 256, shm, epi, pre, nx, ws_);
        pre = has;
    }
}

__device__ __forceinline__ void phase3(const Params& p, int bid, int nb) {
    const int tid = TIDX(p.wave_s), wave = tid >> 6, lane = tid & 63;
    const bf16_t* proj = (const bf16_t*)(p.ws + WS_BUF2);
    bf16_t* z = (bf16_t*)(p.ws + WS_Z);
    for (int it = bid * NTHREADS + tid; it < 1024 * 128; it += nb * NTHREADS) {
        const int strip = it >> 7, c8 = it & 127, g = c8 >> 5, w = 2 << g;
        const int t0 = strip * 16, s0 = t0 & 2047;
        const bf16_t* up = proj + (size_t)t0 * DM + c8 * 8;
        float sum[8];
#pragma unroll
        for (int j = 0; j < 8; ++j) sum[j] = 0.f;
        for (int i = 1; i <= w; ++i) {
            if (s0 - i >= 0) {
                u32x4 r = *reinterpret_cast<const u32x4*>(up - (ptrdiff_t)i * DM);
#pragma unroll
                for (int j = 0; j < 4; ++j) { sum[2 * j] += bflo(r[j]); sum[2 * j + 1] += bfhi(r[j]); }
            }
        }
        for (int tt = 0; tt < 16; ++tt) {
            const int s = s0 + tt;
            u32x4 r = *reinterpret_cast<const u32x4*>(up + (size_t)tt * DM);
            float cur[8];
#pragma unroll
            for (int j = 0; j < 4; ++j) { cur[2 * j] = bflo(r[j]); cur[2 * j + 1] = bfhi(r[j]); }
#pragma unroll
            for (int j = 0; j < 8; ++j) sum[j] += cur[j];
            if (s >= w) {
                u32x4 o = *reinterpret_cast<const u32x4*>(up + (ptrdiff_t)(tt - w) * DM);
#pragma unroll
                for (int j = 0; j < 4; ++j) { sum[2 * j] -= bflo(o[j]); sum[2 * j + 1] -= bfhi(o[j]); }
            }
            const float inv = 1.f / (float)min(s + 1, w);
            u32x2 o;
            o.x = (unsigned)pk_fp8x4(sum[0] * inv - cur[0], sum[1] * inv - cur[1], sum[2] * inv - cur[2], sum[3] * inv - cur[3]);
            o.y = (unsigned)pk_fp8x4(sum[4] * inv - cur[4], sum[5] * inv - cur[5], sum[6] * inv - cur[6], sum[7] * inv - cur[7]);
            *reinterpret_cast<u32x2*>((char*)z + (size_t)(t0 + tt) * 1024 + c8 * 8) = o;
        }
    }
    float* rq = (float*)(p.ws + WS_RSTDQ); float* rkv = (float*)(p.ws + WS_RSTDKV);
    bf16_t* kpe = (bf16_t*)(p.ws + WS_KPE);
    const float2* cs = (const float2*)(p.ws + WS_CS);
    for (int t = bid * NWAVES + wave; t < NTOK; t += nb * NWAVES) {
        const bf16_t* pr = proj + (size_t)t * DM;
        u32x4 a = *reinterpret_cast<const u32x4*>(pr + 1024 + lane * 8);
        float s1 = 0.f;
#pragma unroll
        for (int j = 0; j < 4; ++j) { float lo = bflo(a[j]), hi = bfhi(a[j]); s1 += lo * lo + hi * hi; }
        u32x2 bq = *reinterpret_cast<const u32x2*>(pr + 1536 + lane * 4);
        float s2 = 0.f;
#pragma unroll
        for (int j = 0; j < 2; ++j) { float lo = bflo(bq[j]), hi = bfhi(bq[j]); s2 += lo * lo + hi * hi; }
        s1 = wave_sum(s1); s2 = wave_sum(s2);
        if (lane == 0) { rq[t] = rsqrtf(s1 * (1.f / 512.f) + EPS); rkv[t] = rsqrtf(s2 * (1.f / 256.f) + EPS); }
        if (lane < 32) {
            float x1 = bf2f((short)pr[1792 + lane]), x2 = bf2f((short)pr[1792 + 32 + lane]);
            float2 c = cs[(size_t)t * 32 + lane];
            unsigned char* k8 = (unsigned char*)kpe + (size_t)t * 64 + 32 * (lane >> 4) + (lane & 15);
            const int w = pk_fp8x4(x1 * c.x - x2 * c.y, x2 * c.x + x1 * c.y, 0.f, 0.f);
            k8[0] = (unsigned char)(w & 0xff); k8[16] = (unsigned char)((w >> 8) & 0xff);
        }
    }
}

constexpr int KS_STRIDE = 208, VS_STRIDE = 80;
constexpr int KS_BYTES = 64 * KS_STRIDE, VS_BYTES = 128 * VS_STRIDE, AT_STAGE = KS_BYTES + VS_BYTES;
__device__ __forceinline__ void attn_unit(const Params& p, char* shm, int b, int head, int qb) {
    int tid = TIDX(p.wave_s); asm volatile("" : "+v"(tid));
    const int wave = __builtin_amdgcn_readfirstlane(tid >> 6), lane = tid & 63, l31 = lane & 31, hh = lane >> 5;
    const bool grpB = wave >= 4;
    const int rowblk = (wave & 3) * 2 + (wave >> 2);
    const bf16_t* Q = (const bf16_t*)(p.ws + WS_Q);
    const bf16_t* Kn = (const bf16_t*)(p.ws + WS_KN);
    const bf16_t* Kpe = (const bf16_t*)(p.ws + WS_KPE);
    const bf16_t* Vt = (const bf16_t*)(p.ws + WS_VT);
    const float2* cs = (const float2*)(p.ws + WS_CS);
    bf16_t* ycat = (bf16_t*)(p.ws + WS_BUF1);
    const int q0 = qb * 256 + rowblk * 32, mychunk = q0 >> 6, nkt = 4 * qb + 4;
    const int tq = b * SEQ + q0 + l31;
    i32x8 qf[3];
    {
        const bf16_t* qrow = Q + (size_t)tq * 1536 + head * 192;
#pragma unroll
        for (int ks = 0; ks < 2; ++ks)
#pragma unroll
            for (int i = 0; i < 4; ++i) {
                const bf16x8 v = *reinterpret_cast<const bf16x8*>(qrow + ks * 64 + hh * 32 + 8 * i);
                qf[ks][2 * i] = pk_fp8x4(bf2f(v[0]) * 8.f, bf2f(v[1]) * 8.f, bf2f(v[2]) * 8.f, bf2f(v[3]) * 8.f);
                qf[ks][2 * i + 1] = pk_fp8x4(bf2f(v[4]) * 8.f, bf2f(v[5]) * 8.f, bf2f(v[6]) * 8.f, bf2f(v[7]) * 8.f);
            }
#pragma unroll
        for (int i = 0; i < 2; ++i) {
            const bf16x8 a = *reinterpret_cast<const bf16x8*>(qrow + 128 + 16 * hh + 8 * i);
            const bf16x8 c2 = *reinterpret_cast<const bf16x8*>(qrow + 160 + 16 * hh + 8 * i);
            const float2* cp = cs + (size_t)tq * 32 + 16 * hh + 8 * i;
            float o1[8], o2[8];
#pragma unroll
            for (int j = 0; j < 8; ++j) {
                const float2 c = cp[j];
                const float x1 = bf2f(a[j]) * 8.f, x2 = bf2f(c2[j]) * 8.f;
                o1[j] = x1 * c.x - x2 * c.y; o2[j] = x2 * c.x + x1 * c.y;
            }
            qf[2][2 * i] = pk_fp8x4(o1[0], o1[1], o1[2], o1[3]); qf[2][2 * i + 1] = pk_fp8x4(o1[4], o1[5], o1[6], o1[7]);
            qf[2][4 + 2 * i] = pk_fp8x4(o2[0], o2[1], o2[2], o2[3]); qf[2][4 + 2 * i + 1] = pk_fp8x4(o2[4], o2[5], o2[6], o2[7]);
        }
    }
    f32x16 O[4];
#pragma unroll
    for (int dt = 0; dt < 4; ++dt)
#pragma unroll
        for (int r = 0; r < 16; ++r) O[dt][r] = 0.f;
    float mrun = -1e30f, lsum = 0.f;
    f32x16 s0, s1;
    const int kkey = tid >> 3, kch = tid & 7;
    const int pk_key = tid >> 2, pk_ch = tid & 3;
    const int vd = tid >> 2, vch = tid & 3;
    const size_t tokb = (size_t)b * SEQ;
    const char* Kn8 = (const char*)Kn; const char* Kpe8 = (const char*)Kpe;
    const char* vbase = (const char*)Vt + (size_t)((b * 8 + head) * 128) * SEQ;
    u32x4 r0, r2, r3;
#define AT_LOAD(kt) do { const int k0_ = (kt) * 64; \
        r0 = *reinterpret_cast<const u32x4*>(Kn8 + (tokb + k0_ + kkey) * 1024 + head * 128 + kch * 16); \
        if (wave < 4) r2 = *reinterpret_cast<const u32x4*>(Kpe8 + (tokb + k0_ + pk_key) * 64 + pk_ch * 16); \
        r3 = *reinterpret_cast<const u32x4*>(vbase + (size_t)vd * SEQ + k0_ + vch * 16); } while (0)
#define AT_WRITE(buf) do { char* ks_ = shm + (buf) * AT_STAGE; char* vs_ = ks_ + KS_BYTES; \
        *reinterpret_cast<u32x4*>(ks_ + kkey * KS_STRIDE + kch * 16) = r0; \
        if (wave < 4) *reinterpret_cast<u32x4*>(ks_ + pk_key * KS_STRIDE + 128 + pk_ch * 16) = r2; \
        *reinterpret_cast<u32x4*>(vs_ + vd * VS_STRIDE + vch * 16) = r3; } while (0)
#define LDK(ks_, t_) __builtin_shufflevector(*reinterpret_cast<const i32x4*>(kb + (t_) * 32 * KS_STRIDE + (ks_) * 64), \
                                             *reinterpret_cast<const i32x4*>(kb + (t_) * 32 * KS_STRIDE + (ks_) * 64 + 16), 0, 1, 2, 3, 4, 5, 6, 7)
#define MXQK(a_, b_, c_) __builtin_amdgcn_mfma_scale_f32_32x32x64_f8f6f4(a_, b_, c_, 0, 0, 0, 0x7F7F7F7F, 0, 0x7F7F7F7F)
#define QK(buf) do { \
        const char* kb = shm + (buf) * AT_STAGE + l31 * KS_STRIDE + hh * 32; \
        i32x8 ka0 = LDK(0, 0), ka1 = LDK(0, 1), kb0 = LDK(1, 0), kb1 = LDK(1, 1); \
        _Pragma("unroll") for (int r = 0; r < 16; ++r) { s0[r] = 0.f; s1[r] = 0.f; } \
        __builtin_amdgcn_sched_barrier(0); \
        s0 = MXQK(ka0, qf[0], s0); \
        s1 = MXQK(ka1, qf[0], s1); \
        ka0 = LDK(2, 0); ka1 = LDK(2, 1); \
        __builtin_amdgcn_sched_barrier(0); \
        s0 = MXQK(kb0, qf[1], s0); \
        s1 = MXQK(kb1, qf[1], s1); \
        __builtin_amdgcn_sched_barrier(0); \
        s0 = MXQK(ka0, qf[2], s0); \
        s1 = MXQK(ka1, qf[2], s1); \
        __builtin_amdgcn_sched_barrier(0); } while (0)
#define LDV(dt_) __builtin_shufflevector(*reinterpret_cast<const i32x4*>(vb + (dt_) * 32 * VS_STRIDE), *reinterpret_cast<const i32x4*>(vb + (dt_) * 32 * VS_STRIDE + 16), 0, 1, 2, 3, 4, 5, 6, 7)
#define SMPV(buf) do { \
        const char* vb = shm + (buf) * AT_STAGE + KS_BYTES + l31 * VS_STRIDE + hh * 32; \
        i32x8 va[4]; \
        _Pragma("unroll") for (int dt = 0; dt < 4; ++dt) va[dt] = LDV(dt); \
        float mx = s0[0]; \
        _Pragma("unroll") for (int r = 1; r < 16; ++r) mx = fmaxf(mx, s0[r]); \
        _Pragma("unroll") for (int r = 0; r < 16; ++r) mx = fmaxf(mx, s1[r]); \
        mx = fmaxf(mx, __shfl_xor(mx, 32)); \
        const float mnew = fmaxf(mrun, mx * 0.125f); \
        const float alpha = __builtin_amdgcn_exp2f(mrun - mnew); \
        mrun = mnew; \
        const float moff = 6.f - mnew;        \
        float ps = 0.f; \
        _Pragma("unroll") for (int r = 0; r < 16; ++r) { s0[r] = __builtin_amdgcn_exp2f(fmaf(s0[r], 0.125f, moff)); ps += s0[r]; } \
        _Pragma("unroll") for (int r = 0; r < 16; ++r) { s1[r] = __builtin_amdgcn_exp2f(fmaf(s1[r], 0.125f, moff)); ps += s1[r]; } \
        lsum = lsum * alpha + ps; \
        _Pragma("unroll") for (int dt = 0; dt < 4; ++dt) _Pragma("unroll") for (int r = 0; r < 16; ++r) O[dt][r] *= alpha; \
        i32x8 pf; \
          \
        _Pragma("unroll") for (int f1 = 0; f1 < 2; ++f1) { \
            pf[f1 * 4 + 0] = pk_fp8x4(s0[4 * f1], s0[4 * f1 + 1], s0[4 * f1 + 2], s0[4 * f1 + 3]); \
            pf[f1 * 4 + 1] = pk_fp8x4(s0[8 + 4 * f1], s0[8 + 4 * f1 + 1], s0[8 + 4 * f1 + 2], s0[8 + 4 * f1 + 3]); \
            pf[f1 * 4 + 2] = pk_fp8x4(s1[4 * f1], s1[4 * f1 + 1], s1[4 * f1 + 2], s1[4 * f1 + 3]); \
            pf[f1 * 4 + 3] = pk_fp8x4(s1[8 + 4 * f1], s1[8 + 4 * f1 + 1], s1[8 + 4 * f1 + 2], s1[8 + 4 * f1 + 3]); \
        } \
        __builtin_amdgcn_sched_barrier(0); \
        _Pragma("unroll") for (int dt = 0; dt < 4; ++dt) O[dt] = MXQK(va[dt], pf, O[dt]); \
        __builtin_amdgcn_sched_barrier(0); } while (0)
    __syncthreads();
    AT_LOAD(0); AT_WRITE(0);
    AT_LOAD(1);
    __syncthreads();
    if (grpB) __syncthreads();
    int bcur = 0, bnext = 1;
    for (int kt = 0; kt < nkt; ++kt) {
        if (kt + 1 < nkt) AT_WRITE(bnext);
        if (kt + 2 < nkt) AT_LOAD(kt + 2);
        __builtin_amdgcn_sched_barrier(0);
        if (kt <= mychunk) QK(bcur);
        __syncthreads();
        if (kt <= mychunk) SMPV(bcur);
        __syncthreads();
        bcur = bnext; bnext = (bnext == 2) ? 0 : bnext + 1;
    }
    if (!grpB) __syncthreads();
#undef AT_LOAD
#undef AT_WRITE
#undef QK
#undef SMPV
#undef LDK
#undef MXQK
#undef LDV
    lsum += __shfl_xor(lsum, 32);
    const float inv = 1.f / lsum;
    char* orow = (char*)ycat + (size_t)tq * DM + 1024 + head * 128 + 4 * hh;
#pragma unroll
    for (int dt = 0; dt < 4; ++dt)
#pragma unroll
        for (int g = 0; g < 4; ++g)
            *reinterpret_cast<int*>(orow + dt * 32 + 8 * g) = pk_fp8x4(O[dt][4 * g] * inv, O[dt][4 * g + 1] * inv, O[dt][4 * g + 2] * inv, O[dt][4 * g + 3] * inv);
}
__device__ __forceinline__ void phase5(const Params& p, char* shm, int bid, int nb) {
    for (int it = bid; it < 256; it += nb) {
        const int bh = it >> 2, pr = it & 3, b = bh >> 3, head = bh & 7;
        attn_unit(p, shm, b, head, 7 - pr);
        attn_unit(p, shm, b, head, pr);
    }
}

__device__ __forceinline__ void phase7(const Params& p, char* shm, int bid, int nb) {
    const int tid = TIDX(p.wave_s), wave = tid >> 6, lane = tid & 63;
    const float* mod = (const float*)(p.ws + WS_MOD);
    const bf16_t* y = (const bf16_t*)(p.ws + WS_BUF2);
    bf16_t* x1 = (bf16_t*)(p.ws + WS_X1);
    float* lv = (float*)shm;
    for (int item = bid; item < NTOK / 64; item += nb) {
        const int b = item >> 5;
        const float* md = mod + b * 12288;
        __syncthreads();
        for (int i = tid; i < 512; i += NTHREADS) {
            *reinterpret_cast<f32x4*>(lv + 0 * DM + i * 4) = *reinterpret_cast<const f32x4*>(p.post_mix_g + i * 4);
            *reinterpret_cast<f32x4*>(lv + 1 * DM + i * 4) = *reinterpret_cast<const f32x4*>(md + 4096 + i * 4);
            *reinterpret_cast<f32x4*>(lv + 2 * DM + i * 4) = *reinterpret_cast<const f32x4*>(p.pre_ffn_g + i * 4);
            *reinterpret_cast<f32x4*>(lv + 3 * DM + i * 4) = *reinterpret_cast<const f32x4*>(md + 6144 + i * 4);
            *reinterpret_cast<f32x4*>(lv + 4 * DM + i * 4) = *reinterpret_cast<const f32x4*>(md + 8192 + i * 4);
        }
        __syncthreads();
#pragma unroll 1
        for (int rr = 0; rr < 8; ++rr) {
            const int row = item * 64 + rr * 8 + wave;
            f32x4 yv[8], xr[8]; float ss = 0.f;
#pragma unroll
            for (int i = 0; i < 8; ++i) xr[i] = *reinterpret_cast<const f32x4*>(p.x + (size_t)row * DM + i * 256 + lane * 4);
#pragma unroll
            for (int i = 0; i < 8; ++i) {
                u32x2 r = *reinterpret_cast<const u32x2*>(y + (size_t)row * DM + i * 256 + lane * 4);
                yv[i] = f32x4{bflo(r.x), bfhi(r.x), bflo(r.y), bfhi(r.y)};
                ss += yv[i][0] * yv[i][0] + yv[i][1] * yv[i][1] + yv[i][2] * yv[i][2] + yv[i][3] * yv[i][3];
            }
            const float rstd = rsqrtf(wave_sum(ss) * (1.f / DM) + EPS);
            float s2 = 0.f;
#pragma unroll
            for (int i = 0; i < 8; ++i) {
                const int col = i * 256 + lane * 4;
                f32x4 xv = xr[i];
                f32x4 g = *reinterpret_cast<const f32x4*>(lv + col);
                f32x4 gt = *reinterpret_cast<const f32x4*>(lv + DM + col);
                f32x4 v = xv + gt * (yv[i] * rstd * g);
                st4bf(x1 + (size_t)row * DM + col, v);
                yv[i] = v;
                s2 += v[0] * v[0] + v[1] * v[1] + v[2] * v[2] + v[3] * v[3];
            }
            const float rstd2 = rsqrtf(wave_sum(s2) * (1.f / DM) + EPS);
            float hmax = 0.f;
#pragma unroll
            for (int i = 0; i < 8; ++i) {
                const int col = i * 256 + lane * 4;
                f32x4 g = *reinterpret_cast<const f32x4*>(lv + 2 * DM + col);
                f32x4 sh = *reinterpret_cast<const f32x4*>(lv + 3 * DM + col);
                f32x4 sc = *reinterpret_cast<const f32x4*>(lv + 4 * DM + col);
                yv[i] = yv[i] * rstd2 * g * (sc + 1.f) + sh;
                hmax = fmaxf(hmax, fmaxf(fmaxf(fabsf(yv[i][0]), fabsf(yv[i][1])), fmaxf(fabsf(yv[i][2]), fabsf(yv[i][3]))));
            }
#pragma unroll
            for (int o = 1; o < 64; o <<= 1) hmax = fmaxf(hmax, __shfl_xor(hmax, o));
            const float qm = hmax > 0.f ? 127.f / hmax : 0.f;
            if (lane == 0) ((float*)(p.ws + WS_SH))[row] = hmax * (1.f / 127.f);
#pragma unroll
            for (int i = 0; i < 8; ++i) {
                *reinterpret_cast<unsigned*>(p.ws + WS_H8 + (size_t)row * DM + i * 256 + lane * 4) = pack_i8x4(yv[i][0] * qm, yv[i][1] * qm, yv[i][2] * qm, yv[i][3] * qm);
            }
        }
    }
}

__device__ __forceinline__ int fmap(float f) { int i = __float_as_int(f); return i ^ ((i >> 31) & 0x7fffffff); }
__device__ __forceinline__ float funmap(int i) { return __int_as_float(i ^ ((i >> 31) & 0x7fffffff)); }
__device__ __forceinline__ void ins16(int (&top)[16], int k) {
#pragma unroll
    for (int i = 0; i < 16; ++i) { int hi = max(top[i], k); k = min(top[i], k); top[i] = hi; }
}
__device__ __forceinline__ int bsel(int m, int a, int b) { return (a & ~m) | (b & m); }
__device__ __forceinline__ int sel16(const int (&a)[16], int i) {
    const int m0 = -(i & 1), m1 = -((i >> 1) & 1), m2 = -((i >> 2) & 1), m3 = -((i >> 3) & 1);
    int t8[8], t4[4], t2[2];
#pragma unroll
    for (int k = 0; k < 8; ++k) t8[k] = bsel(m0, a[2 * k], a[2 * k + 1]);
#pragma unroll
    for (int k = 0; k < 4; ++k) t4[k] = bsel(m1, t8[2 * k], t8[2 * k + 1]);
#pragma unroll
    for (int k = 0; k < 2; ++k) t2[k] = bsel(m2, t4[2 * k], t4[2 * k + 1]);
    return bsel(m3, t2[0], t2[1]);
}
#define BITONIC_CE(x, K, J) _Pragma("unroll") for (int i_ = 0; i_ < 16; ++i_) { const int l_ = i_ ^ (J); if (l_ > i_) { const int a_ = x[i_], b_ = x[l_]; \
        if ((i_ & (K)) == 0) { x[i_] = max(a_, b_); x[l_] = min(a_, b_); } else { x[i_] = min(a_, b_); x[l_] = max(a_, b_); } } }
#define BITONIC_MERGE16(x) BITONIC_CE(x, 16, 8) BITONIC_CE(x, 16, 4) BITONIC_CE(x, 16, 2) BITONIC_CE(x, 16, 1)
#define BITONIC_SORT16(x) BITONIC_CE(x, 2, 1) BITONIC_CE(x, 4, 2) BITONIC_CE(x, 4, 1) BITONIC_CE(x, 8, 4) BITONIC_CE(x, 8, 2) BITONIC_CE(x, 8, 1) BITONIC_MERGE16(x)
#define SCE(x, i, j) { const int a_ = x[i], b_ = x[j]; x[i] = max(a_, b_); x[j] = min(a_, b_); }
#define SORT16_60(x) SCE(x,0,13) SCE(x,1,12) SCE(x,2,15) SCE(x,3,14) SCE(x,4,8) SCE(x,5,6) SCE(x,7,11) SCE(x,9,10) SCE(x,0,5) SCE(x,1,7) SCE(x,2,9) SCE(x,3,4) SCE(x,6,13) SCE(x,8,14) SCE(x,10,15) SCE(x,11,12) SCE(x,0,1) SCE(x,2,3) SCE(x,4,5) SCE(x,6,8) SCE(x,7,9) SCE(x,10,11) SCE(x,12,13) SCE(x,14,15) SCE(x,0,2) SCE(x,1,3) SCE(x,4,10) SCE(x,5,11) SCE(x,6,7) SCE(x,8,9) SCE(x,12,14) SCE(x,13,15) SCE(x,1,2) SCE(x,3,12) SCE(x,4,6) SCE(x,5,7) SCE(x,8,10) SCE(x,9,11) SCE(x,13,14) SCE(x,1,4) SCE(x,2,6) SCE(x,5,8) SCE(x,7,10) SCE(x,9,13) SCE(x,11,14) SCE(x,2,4) SCE(x,3,6) SCE(x,9,12) SCE(x,11,13) SCE(x,3,5) SCE(x,6,8) SCE(x,7,9) SCE(x,10,12) SCE(x,3,4) SCE(x,5,6) SCE(x,7,8) SCE(x,9,10) SCE(x,11,12) SCE(x,6,7) SCE(x,8,9)
__device__ __forceinline__ void pk_half_list(const bf16_t* __restrict__ qrow, const char* kl, int hh, int (&out)[16]) {
    bf16x8 qf[8];
#pragma unroll
    for (int ks = 0; ks < 8; ++ks) qf[ks] = *reinterpret_cast<const bf16x8*>(qrow + ks * 16);
    int top[16];
#pragma unroll 1
    for (int kt = 0; kt < 4; ++kt) {
        f32x16 acc;
#pragma unroll
        for (int r = 0; r < 16; ++r) acc[r] = 0.f;
#pragma unroll
        for (int ks = 0; ks < 8; ++ks) {
            bf16x8 kf = *reinterpret_cast<const bf16x8*>(kl + kt * 32 * 272 + ks * 32);
            acc = __builtin_amdgcn_mfma_f32_32x32x16_bf16(kf, qf[ks], acc, 0, 0, 0);
        }
        int nw[16];
#pragma unroll
        for (int r = 0; r < 16; ++r) {
            const int n = kt * 32 + (r & 3) + 8 * (r >> 2) + 4 * hh;
            nw[r] = (fmap(acc[r]) & ~127) | (127 - n);
        }
        SORT16_60(nw)
        if (kt == 0) {
#pragma unroll
            for (int i = 0; i < 16; ++i) top[i] = nw[i];
        } else {
#pragma unroll
            for (int i = 0; i < 16; ++i) top[i] = max(top[i], nw[15 - i]);
            BITONIC_MERGE16(top)
        }
    }
#pragma unroll
    for (int i = 0; i < 16; ++i) out[i] = __shfl_xor(top[15 - i], 32);
#pragma unroll
    for (int i = 0; i < 16; ++i) out[i] = max(out[i], top[i]);
    BITONIC_MERGE16(out)
}
__device__ __forceinline__ void phase9(const Params& p, char* shm, int bid, int nb) {
    int tid = TIDX(p.wave_s); asm volatile("" : "+v"(tid));
    const int wave = tid >> 6, lane = tid & 63, l31 = lane & 31, hh = lane >> 5;
    const bf16_t* pq = (const bf16_t*)(p.ws + WS_BUF2);
    const bf16_t* sk = (const bf16_t*)(p.ws + WS_SK);
    int* idxo = (int*)(p.ws + WS_IDX); float* gateo = (float*)(p.ws + WS_GATE);
    for (int item = bid; item < 8 * 64; item += nb) {
        const int head = item & 7, tt = (item >> 3) * 8 + wave, tok = tt * 32 + l31;
        __syncthreads();
        for (int c = tid; c < 4096; c += NTHREADS) {
            const int row = c >> 4, ch = c & 15;
            *reinterpret_cast<u32x4*>(shm + row * 272 + ch * 16) = *reinterpret_cast<const u32x4*>(sk + (size_t)(head * 256 + row) * 128 + ch * 8);
        }
        __syncthreads();
        int la[16], lb[16];
        pk_half_list(pq + (size_t)tok * DM + head * 256 + hh * 8, shm + l31 * 272 + hh * 16, hh, la);
        pk_half_list(pq + (size_t)tok * DM + head * 256 + 128 + hh * 8, shm + (128 + l31) * 272 + hh * 16, hh, lb);
        float va[16], vb[16]; int ia[16], ib[16];
#pragma unroll
        for (int i = 0; i < 16; ++i) {
            va[i] = funmap(la[i] & ~127); ia[i] = 127 - (la[i] & 127);
            vb[i] = funmap(lb[i] & ~127); ib[i] = 127 - (lb[i] & 127);
        }
#define CKEY(i, j) ((fmap(va[i] + vb[j]) & ~255) | (255 - ((i) * 16 + (j))))
        int top2[16], ga[16], gb[16];
#pragma unroll
        for (int j = 0; j < 16; ++j) top2[j] = CKEY(0, j);
#pragma unroll
        for (int j = 0; j < 8; ++j) { ga[j] = CKEY(1, j); ga[8 + j] = CKEY(15 - j, 0); }
        BITONIC_MERGE16(ga)
        gb[0] = CKEY(2, 0); gb[1] = CKEY(2, 1); gb[2] = CKEY(2, 2); gb[3] = CKEY(2, 3); gb[4] = CKEY(2, 4);
        gb[5] = CKEY(3, 0); gb[6] = CKEY(3, 1); gb[7] = CKEY(3, 2); gb[8] = CKEY(3, 3);
        gb[9] = CKEY(4, 0); gb[10] = CKEY(4, 1); gb[11] = CKEY(4, 2);
        gb[12] = CKEY(5, 0); gb[13] = CKEY(5, 1); gb[14] = CKEY(6, 0); gb[15] = CKEY(6, 1);
        SORT16_60(gb)
#pragma unroll
        for (int i = 0; i < 16; ++i) top2[i] = max(top2[i], ga[15 - i]);
        BITONIC_MERGE16(top2)
#pragma unroll
        for (int i = 0; i < 16; ++i) top2[i] = max(top2[i], gb[15 - i]);
        BITONIC_MERGE16(top2)
        ins16(top2, CKEY(7, 0)); ins16(top2, CKEY(7, 1));
#undef CKEY
        float bv[16], mxv, sum = 0.f; int ex[16];
        {
            LAS int* tA = (LAS int*)(uintptr_t)(69632 + wave * 8192) + lane;
            LAS int* tB = tA + 16 * 64;
#pragma unroll
            for (int i = 0; i < 16; ++i) { tA[i * 64] = ia[i] * 128; tB[i * 64] = ib[i]; }
#pragma unroll
            for (int r = 0; r < 16; ++r) {
                const int code = 255 - (top2[r] & 255);
                ex[r] = tA[(code >> 4) * 64] + tB[(code & 15) * 64];
                bv[r] = funmap(top2[r] & ~255);
            }
        }
        mxv = bv[0];
#pragma unroll
        for (int r = 0; r < 16; ++r) { bv[r] = __expf(bv[r] - mxv); sum += bv[r]; }
        const float inv = 1.f / sum;
        if (hh == 0) {
            const size_t ob = ((size_t)(tok >> 6) * 128 + head * 16) * 64 + (tok & 63);
#pragma unroll
            for (int r = 0; r < 16; ++r) { idxo[ob + r * 64] = ex[r]; gateo[ob + r * 64] = bv[r] * inv; }
        }
    }
}

__device__ __forceinline__ void phase10(const Params& p, char* shm, int bid, int nb) {
    int tid = TIDX(p.wave_s); asm volatile("" : "+v"(tid));
    const int wave = tid >> 6, lane = tid & 63;
    const int* idxT = (const int*)(p.ws + WS_IDX);
    const char* U8 = p.ws + WS_U8;
    const char* H8 = p.ws + WS_H8;
    int* part = (int*)(p.ws + WS_PART);
    for (int task = bid; task < 256; task += nb) {
        const int tg = task >> 3, cg = task & 7;
        const int tt = tg * 8 + wave, t = tt * 64 + lane;
        unsigned ip[64]; int acc[128];
#pragma unroll
        for (int k = 0; k < 64; ++k) {
            const unsigned lo = (unsigned)idxT[((size_t)tt * 128 + 2 * k) * 64 + lane], hi = (unsigned)idxT[((size_t)tt * 128 + 2 * k + 1) * 64 + lane];
            ip[k] = lo | (hi << 16);
        }
#pragma unroll
        for (int j = 0; j < 128; ++j) acc[j] = 0;
#pragma unroll 1
        for (int s = 0; s < 32; ++s) {
            const int slice = cg * 32 + s;
            __syncthreads();
            const char* sbase = U8 + (size_t)slice * 131072;
            const unsigned toff = (unsigned)tid * 16u;
#pragma unroll
            for (int k = 0; k < 16; ++k)
                __builtin_amdgcn_global_load_lds((const unsigned*)(sbase + k * 8192 + toff), (unsigned*)(shm + k * 8192 + tid * 16), 16, 0, 0);
            const u32x2 h = *reinterpret_cast<const u32x2*>(H8 + (size_t)t * DM + slice * 8);
            asm volatile("s_waitcnt vmcnt(0)" ::: "memory");
            __syncthreads();
#define U_LOAD(g, dst) _Pragma("unroll") for (int q = 0; q < 4; ++q) { unsigned w = ip[(g) * 4 + q]; asm volatile("" : "+v"(w)); \
                dst[2 * q] = *reinterpret_cast<const u32x2*>(shm + ((w & 0xffffu) << 3)); dst[2 * q + 1] = *reinterpret_cast<const u32x2*>(shm + ((w >> 16) << 3)); }
#define U_DOT(g, srcv) _Pragma("unroll") for (int q = 0; q < 8; ++q) { \
                acc[(g) * 8 + q] = __builtin_amdgcn_sdot4((int)srcv[q].x, (int)h.x, acc[(g) * 8 + q], false); \
                acc[(g) * 8 + q] = __builtin_amdgcn_sdot4((int)srcv[q].y, (int)h.y, acc[(g) * 8 + q], false); }
            u32x2 ua[8], ub[8];
            U_LOAD(0, ua)
#pragma unroll
            for (int g = 0; g < 16; g += 2) {
                U_LOAD(g + 1, ub)
                U_DOT(g, ua)
                __builtin_amdgcn_sched_barrier(0);
                if (g + 2 < 16) { U_LOAD(g + 2, ua) }
                U_DOT(g + 1, ub)
                __builtin_amdgcn_sched_barrier(0);
            }
#undef U_LOAD
#undef U_DOT
        }
#pragma unroll
        for (int k = 0; k < 64; ++k) part[((size_t)cg * 64 + k) * NTOK + t] = (int)pk2((float)acc[2 * k], (float)acc[2 * k + 1]);
    }
}

__device__ __forceinline__ void phase11(const Params& p, int bid, int nb) {
    const int* part = (const int*)(p.ws + WS_PART);
    const int* idxT = (const int*)(p.ws + WS_IDX); const float* gateT = (const float*)(p.ws + WS_GATE);
    const float* su = (const float*)(p.ws + WS_SU); const float* sv = (const float*)(p.ws + WS_SV); const float* sh = (const float*)(p.ws + WS_SH);
    unsigned* pack = (unsigned*)(p.ws + WS_PACK);
    int t11 = TIDX(p.wave_s); asm volatile("" : "+v"(t11));
    for (int item = bid * NTHREADS + t11; item < NTOK * 128; item += nb * NTHREADS) {
        const int lane = item & 63, j = (item >> 6) & 127, tt = item >> 13, t = tt * 64 + lane;
        float sum = 0.f;
#pragma unroll
        for (int cg = 0; cg < 8; ++cg) { const unsigned w = (unsigned)part[((size_t)cg * 64 + (j >> 1)) * NTOK + t]; sum += (j & 1) ? bfhi(w) : bflo(w); }
        const int e = idxT[item];
        const float a = sum * sh[t] * su[e];
        const float act = 0.5f * a * (1.f + erff(a * 0.70710678118654752f)) * gateT[item] * sv[e];
        { const _Float16 ah = (_Float16)(act * 256.f); pack[item] = ((unsigned)__builtin_bit_cast(unsigned short, ah) << 16) | ((unsigned)e << 2); }
    }
}

__device__ __forceinline__ void phase12(const Params& p, char* shm, int bid, int nb) {
    int tid = TIDX(p.wave_s); asm volatile("" : "+v"(tid));
    const int wave = tid >> 6, lane = tid & 63;
    const unsigned* pack = (const unsigned*)(p.ws + WS_PACK);
    const char* V8 = p.ws + WS_V8;
    bf16_t* y2 = (bf16_t*)(p.ws + WS_Y2);
    for (int slice = bid; slice < 256; slice += nb) {
        __syncthreads();
        const char* src = V8 + (size_t)slice * 131072 + tid * 16;
#pragma unroll
        for (int k = 0; k < 16; ++k)
            __builtin_amdgcn_global_load_lds((const unsigned*)(src + k * 8192), (unsigned*)(shm + k * 8192 + tid * 16), 16, 0, 0);
        asm volatile("s_waitcnt vmcnt(0)" ::: "memory");
        __syncthreads();
#define V_LOAD(ptr, g, dst) _Pragma("unroll") for (int q = 0; q < 16; ++q) dst[q] = *reinterpret_cast<const unsigned*>(reinterpret_cast<const char*>((ptr) + (g) * 1024) + lane4 + q * 256);
#define V_LDS(srcp, dstv) _Pragma("unroll") for (int q = 0; q < 16; ++q) { unsigned ad_; \
            asm("v_lshlrev_b32_sdwa %0, %1, %2 dst_sel:DWORD dst_unused:UNUSED_PAD src0_sel:DWORD src1_sel:WORD_0" : "=v"(ad_) : "v"(one_), "v"(srcp[q])); \
            dstv[q] = *reinterpret_cast<const LAS u32x2*>((uintptr_t)ad_); }
#define V_CVT(w_, hi_) __builtin_bit_cast(h2v, __builtin_amdgcn_cvt_scalef32_pk_f16_fp8(w_, __uint_as_float(0x3F80007Fu), hi_))
#define V_FMAS(srcp, srcv) _Pragma("unroll") for (int q = 0; q < 16; ++q) { const h2v ph = __builtin_bit_cast(h2v, srcp[q]); const h2v act = {ph[1], ph[1]}; \
                y[0] = __builtin_elementwise_fma(act, V_CVT(srcv[q].x, false), y[0]); y[1] = __builtin_elementwise_fma(act, V_CVT(srcv[q].x, true), y[1]); \
                y[2] = __builtin_elementwise_fma(act, V_CVT(srcv[q].y, false), y[2]); y[3] = __builtin_elementwise_fma(act, V_CVT(srcv[q].y, true), y[3]); }
#define V_STEP(ptr, g, pkLoad, pkLds, vLds, pkCur, vCur) V_LOAD(ptr, g, pkLoad) V_LDS(pkLds, vLds) V_FMAS(pkCur, vCur) __builtin_amdgcn_sched_barrier(0);
        unsigned pkA[16], pkB[16], pkC[16]; u32x2 vA[16], vB[16];
        unsigned one_ = 1u; asm volatile("" : "+v"(one_));
        const int wave_u = __builtin_amdgcn_readfirstlane(wave);
        const unsigned lane4 = (unsigned)lane * 4u;
        {
            const unsigned* pp0 = pack + (size_t)wave_u * 8192;
            V_LOAD(pp0, 0, pkA) V_LOAD(pp0, 1, pkB) V_LDS(pkA, vA)
        }
#pragma unroll 1
        for (int tt = wave_u; tt < 256; tt += NWAVES) {
            h2v y[4];
#pragma unroll
            for (int c = 0; c < 4; ++c) y[c] = h2v{(_Float16)0.f, (_Float16)0.f};
            const unsigned* pp = pack + (size_t)tt * 8192;
            const int ttn = (tt + NWAVES < 256) ? tt + NWAVES : tt;
            const unsigned* pn = pack + (size_t)ttn * 8192;
            V_STEP(pp, 2, pkC, pkB, vB, pkA, vA)
            V_STEP(pp, 3, pkA, pkC, vA, pkB, vB)
            V_STEP(pp, 4, pkB, pkA, vB, pkC, vA)
            V_STEP(pp, 5, pkC, pkB, vA, pkA, vB)
            V_STEP(pp, 6, pkA, pkC, vB, pkB, vA)
            V_STEP(pp, 7, pkB, pkA, vA, pkC, vB)
            V_STEP(pn, 0, pkC, pkB, vB, pkA, vA)
            V_STEP(pn, 1, pkA, pkC, vA, pkB, vB)
#pragma unroll
            for (int q = 0; q < 16; ++q) { const unsigned t0_ = pkA[q]; pkA[q] = pkC[q]; pkB[q] = t0_; }
            *reinterpret_cast<u32x4*>(y2 + (size_t)(tt * 64 + lane) * DM + slice * 8) =
                u32x4{__builtin_bit_cast(unsigned, y[0]), __builtin_bit_cast(unsigned, y[1]), __builtin_bit_cast(unsigned, y[2]), __builtin_bit_cast(unsigned, y[3])};
        }
#undef V_LOAD
#undef V_LDS
#undef V_CVT
#undef V_FMAS
#undef V_STEP
    }
}

__device__ __forceinline__ float h16f(unsigned h) {
    const unsigned s_ = (h & 0x8000u) << 16, e_ = (h >> 10) & 31u, m_ = h & 0x3ffu;
    return e_ == 0u ? __uint_as_float(s_) : __uint_as_float(s_ | ((e_ + 112u) << 23) | (m_ << 13));
}
__device__ __forceinline__ void phase13(const Params& p, char* shm, int bid, int nb) {
    const int tid = TIDX(p.wave_s), wave = tid >> 6, lane = tid & 63;
    const float* mod = (const float*)(p.ws + WS_MOD);
    const bf16_t* y2 = (const bf16_t*)(p.ws + WS_Y2);
    const bf16_t* x1 = (const bf16_t*)(p.ws + WS_X1);
    float* lv = (float*)shm;
    for (int item = bid; item < NTOK / 64; item += nb) {
        const int b = item >> 5;
        __syncthreads();
        for (int i = tid; i < 512; i += NTHREADS) {
            *reinterpret_cast<f32x4*>(lv + 0 * DM + i * 4) = *reinterpret_cast<const f32x4*>(p.post_ffn_g + i * 4);
            *reinterpret_cast<f32x4*>(lv + 1 * DM + i * 4) = *reinterpret_cast<const f32x4*>(mod + b * 12288 + 10240 + i * 4);
        }
        __syncthreads();
#pragma unroll 1
        for (int rr = 0; rr < 8; ++rr) {
            const int row = item * 64 + rr * 8 + wave;
            f32x4 yv[8]; u32x2 xr[8]; float ss = 0.f;
#pragma unroll
            for (int i = 0; i < 8; ++i) {
                u32x2 r = *reinterpret_cast<const u32x2*>(y2 + (size_t)row * DM + i * 256 + lane * 4);
                xr[i] = *reinterpret_cast<const u32x2*>(x1 + (size_t)row * DM + i * 256 + lane * 4);
                yv[i] = f32x4{h16f(r.x & 0xffffu), h16f(r.x >> 16), h16f(r.y & 0xffffu), h16f(r.y >> 16)};
                ss += yv[i][0] * yv[i][0] + yv[i][1] * yv[i][1] + yv[i][2] * yv[i][2] + yv[i][3] * yv[i][3];
            }
            const float rstd = rsqrtf(wave_sum(ss) * (1.f / DM) + EPS);
#pragma unroll
            for (int i = 0; i < 8; ++i) {
                const int col = i * 256 + lane * 4;
                f32x4 xv = f32x4{bflo(xr[i].x), bfhi(xr[i].x), bflo(xr[i].y), bfhi(xr[i].y)};
                f32x4 g = *reinterpret_cast<const f32x4*>(lv + col);
                f32x4 gt = *reinterpret_cast<const f32x4*>(lv + DM + col);
                *reinterpret_cast<f32x4*>(p.out + (size_t)row * DM + col) = xv + gt * (yv[i] * rstd * g);
            }
        }
    }
}

constexpr int NPHASE = 14;
__global__ void __launch_bounds__(NTHREADS, 2) mega(Params p, int ph_lo, int ph_hi) {
    extern __shared__ __attribute__((aligned(16))) char shm[];
    p.wave_s = __builtin_amdgcn_readfirstlane((int)(threadIdx.x >> 6));
    const int bid = blockIdx.x, nb = gridDim.x;
    const int vcu = vcu_of(bid, nb);
    char* ws = p.ws;
    volatile LAS unsigned* xbw = (volatile LAS unsigned*)(shm + XB_OFF);
    if (TIDX(p.wave_s) == 0) { xbw[0] = 0u; xbw[1] = 0u; }
    __syncthreads();
    XcdBarrier bar; bar.bar = (unsigned*)(ws + WS_BAR); bar.x = 0; bar.st = xbw; bar.ws = p.wave_s;
    if (ph_hi - ph_lo > 1) bar = xcd_barrier_post((unsigned*)(ws + WS_BAR), xbw, p.wave_s);
#ifndef DUP_PH
#define DUP_PH (-1)
#endif
#define REP(k) for (int rep_ = 0; rep_ < ((k) == DUP_PH ? 2 : 1); ++rep_)
#ifdef ONLY_PH
#define PH(k) ((k) == ONLY_PH && ph_lo <= (k) && (k) < ph_hi)
#else
#define PH(k) (ph_lo <= (k) && (k) < ph_hi)
#endif
#define SEAM(k) do { if (ph_lo <= (k) && (k) + 1 < ph_hi) xcd_barrier(bar); } while (0)
    if (PH(0)) REP(0) phase0(p, shm, bid, nb);
    SEAM(0);
    if (PH(1)) REP(1) phase1(p, shm, bid, nb);
    SEAM(1);
    if (PH(2)) REP(2) {
        EpiI8 e{(bf16_t*)(ws + WS_BUF2), DM, (const float*)(ws + WS_SH1), (const float*)(ws + WS_WSC), ws + WS_PROJ8};
        gemm_phase<false, true>((const bf16_t*)(ws + WS_BUF1), DM / 2, (const bf16_t*)(ws + WS_WIN), DM / 2, 1024, 8, 512, 0, vcu, nb, shm, e, p.wave_s);
    }
    SEAM(2);
    if (PH(3)) REP(3) phase3(p, bid, nb);
    SEAM(3);
    if (PH(4)) REP(4) {
        EpiQ eq{(bf16_t*)(ws + WS_Q), (const float*)(ws + WS_RSTDQ)};
        EpiKV ekv{(bf16_t*)(ws + WS_KN), (bf16_t*)(ws + WS_VT), (const float*)(ws + WS_RSTDKV)};
        const bf16_t* qA = (const bf16_t*)(ws + WS_PROJ8); const bf16_t* qB = (const bf16_t*)(ws + WS_WUQ);
        const bf16_t* kA = (const bf16_t*)(ws + WS_PROJ8 + 512); const bf16_t* kB = (const bf16_t*)(ws + WS_WUKV);
        if (nb == 256) {
            const int nq = vcu < 128 ? 2 : 1, q0 = vcu < 128 ? 2 * vcu : vcu + 128;
            const int nkv = vcu < 128 ? 1 : 3, kv0 = vcu < 128 ? vcu : 128 + 3 * (vcu - 128);
            const int g = vcu >> 6, pmp = vcu & 63;
            const bf16_t* pA = (const bf16_t*)(ws + WS_Z + g * 256); const bf16_t* pB = (const bf16_t*)(ws + WS_WPOOL + g * 65536);
            const NextTile kvfirst{kA, kB, 384, 128, (kv0 >> 3) * 256, (kv0 & 7) * 256};
            const NextTile poolt{pA, pB, 512, 128, pmp * 256, 0};
#pragma unroll 1
            for (int i = 0; i < nq; ++i) {
                const int t = q0 + i;
                const NextTile nx = (i + 1 < nq) ? NextTile{qA, qB, 384, 256, ((t + 1) / 6) * 256, ((t + 1) % 6) * 256} : kvfirst;
                gemm_tile<false, false, true>(qA, 384, qB, 256, 4, (t / 6) * 256, (t % 6) * 256, shm, eq, i > 0, nx, p.wave_s);
            }
#pragma unroll 1
            for (int i = 0; i < nkv; ++i) {
                const int t = kv0 + i;
                const NextTile nx = (i + 1 < nkv) ? NextTile{kA, kB, 384, 128, ((t + 1) >> 3) * 256, ((t + 1) & 7) * 256} : poolt;
                gemm_tile<true, false, true>(kA, 384, kB, 128, 2, (t >> 3) * 256, (t & 7) * 256, shm, ekv, true, nx, p.wave_s);
            }
            {
                EpiPool e{(bf16_t*)(ws + WS_BUF1), p.pool_scale, g * 256};
                gemm_tile<false, false, true>(pA, 512, pB, 128, 2, pmp * 256, 0, shm, e, true, NextTile{pA, pB, 512, 128, -1, 0}, p.wave_s);
            }
        } else {
            gemm_phase<false, false, true>(qA, 384, qB, 256, 256, 6, 384, 0, vcu, nb, shm, eq, p.wave_s);
            gemm_phase<true, false, true>(kA, 384, kB, 128, 128, 8, 512, 384, vcu, nb, shm, ekv, p.wave_s);
            const int first = ((vcu - 896) % nb + nb) % nb;
            for (int t = first; t < 256; t += nb) {
                const int g = t >> 6, pm = t & 63;
                EpiPool e{(bf16_t*)(ws + WS_BUF1), p.pool_scale, g * 256};
                gemm_tile<false, false, true>((const bf16_t*)(ws + WS_Z + g * 256), 512, (const bf16_t*)(ws + WS_WPOOL + g * 65536), 128, 2, pm * 256, 0, shm, e, false, NextTile{nullptr, nullptr, 0, 0, -1, 0}, p.wave_s);
            }
        }
    }
    SEAM(4);
    if (PH(5)) REP(5) phase5(p, shm, vcu, nb);
    SEAM(5);
    if (PH(6)) REP(6) {
        EpiBf16 e{(bf16_t*)(ws + WS_BUF2), DM, 1.f / 32.f};
        gemm_phase<false, false, true>((const bf16_t*)(ws + WS_BUF1), DM / 2, (const bf16_t*)(ws + WS_WOUT), DM / 2, 1024, 8, 512, 0, vcu, nb, shm, e, p.wave_s);
    }
    SEAM(6);
    if (PH(7)) REP(7) phase7(p, shm, bid, nb);
    SEAM(7);
    if (PH(8)) REP(8) {
        EpiI8 e{(bf16_t*)(ws + WS_BUF2), DM, (const float*)(ws + WS_SH), (const float*)(ws + WS_WSC) + 2048, nullptr};
        gemm_phase<false, true>((const bf16_t*)(ws + WS_H8), DM / 2, (const bf16_t*)(ws + WS_WPQ), DM / 2, 1024, 8, 512, 0, vcu, nb, shm, e, p.wave_s);
    }
    SEAM(8);
    if (PH(9)) REP(9) phase9(p, shm, bid, nb);
    SEAM(9);
    if (PH(10)) REP(10) phase10(p, shm, bid, nb);
    SEAM(10);
    if (PH(11)) REP(11) phase11(p, bid, nb);
    SEAM(11);
    if (PH(12)) REP(12) phase12(p, shm, vcu, nb);
    SEAM(12);
    if (PH(13)) REP(13) phase13(p, shm, bid, nb);
#undef PH
#undef SEAM
}

extern "C" void kernel_launch(void* const* d_in, const int* in_sizes, int n_in, void* d_out, int out_size, void* d_ws, size_t ws_size, hipStream_t stream) {
    static int grid = 0;
    if (grid == 0) {
        if (n_in != 21 || ws_size < WS_END) { fprintf(stderr, "kernel_launch: unexpected n_in %d / ws_size %zu (need %zu)\n", n_in, ws_size, (size_t)WS_END); grid = -1; return; }
        int dev = 0, cus = 0;
        if (hipGetDevice(&dev) != hipSuccess || hipDeviceGetAttribute(&cus, hipDeviceAttributeMultiprocessorCount, dev) != hipSuccess) { grid = -1; return; }
        if (hipFuncSetAttribute((const void*)mega, hipFuncAttributeMaxDynamicSharedMemorySize, LDS_BYTES) != hipSuccess) { fprintf(stderr, "hipFuncSetAttribute failed\n"); grid = -1; return; }
        int per_cu = 0;
        if (hipOccupancyMaxActiveBlocksPerMultiprocessor(&per_cu, (const void*)mega, NTHREADS, LDS_BYTES) != hipSuccess || per_cu < 1)
            fprintf(stderr, "kernel_launch: occupancy query reports %d blocks per CU\n", per_cu);
        (void)hipGetLastError();
        grid = cus;
    }
    if (grid < 0) return;
    (void)hipMemsetAsync((char*)d_ws + WS_ZERO, 0, ZERO_BYTES, stream);
    (void)hipMemsetAsync((char*)d_ws + WS_CMAX, 0, CMAX_BYTES, stream);
    Params p{};
    p.x = (const float*)d_in[0]; p.c = (const float*)d_in[1]; p.pos = (const int*)d_in[2];
    p.ada_w = (const float*)d_in[3]; p.ada_b = (const float*)d_in[4];
    p.pre_mix_g = (const float*)d_in[5]; p.post_mix_g = (const float*)d_in[6]; p.pre_ffn_g = (const float*)d_in[7]; p.post_ffn_g = (const float*)d_in[8];
    p.w_in = (const float*)d_in[9]; p.pool_w = (const float*)d_in[10]; p.pool_scale = (const float*)d_in[11];
    p.q_norm_g = (const float*)d_in[12]; p.w_uq = (const float*)d_in[13]; p.kv_norm_g = (const float*)d_in[14]; p.w_ukv = (const float*)d_in[15];
    p.w_out = (const float*)d_in[16]; p.peer_wq = (const float*)d_in[17]; p.sub_keys = (const float*)d_in[18];
    p.peer_u = (const float*)d_in[19]; p.peer_v = (const float*)d_in[20];
    p.out = (float*)d_out; p.ws = (char*)d_ws;
#if MK_MULTI
    for (int k = 0; k < NPHASE; ++k) hipLaunchKernelGGL(mega, dim3(grid), dim3(NTHREADS), LDS_BYTES, stream, p, k, k + 1);
#else
    hipLaunchKernelGGL(mega, dim3(grid), dim3(NTHREADS), LDS_BYTES, stream, p, 0, NPHASE);
#endif
}
```
